# Optimizing an MI355X kernel written in HIP

```python
import jax, jax.numpy as jnp
from jax import lax
import numpy as np

D_MODEL = 1024
BATCH = 16
SEQ = 4096
DEPTH = 4

MLA_HEADS = 8
QK_NOPE_DIM = 64
QK_ROPE_DIM = 32
V_HEAD_DIM = 64
Q_LORA_RANK = 256
KV_LORA_RANK = 128
ROPE_THETA = 10000.0
Q_BLOCK = 128

MLSTM_HEADS = 4
MLSTM_QK_DIM = 64
MLSTM_V_DIM = 128
CONV_K = 4
CHUNK = 64

D_FF = 2816
EPS = 1e-6

MLA_WIDTH = MLA_HEADS * V_HEAD_DIM
MLSTM_WIDTH = MLSTM_HEADS * MLSTM_V_DIM
MIX_WIDTH = MLA_WIDTH + MLSTM_WIDTH
MLSTM_QK_WIDTH = MLSTM_HEADS * MLSTM_QK_DIM
Q_UP_WIDTH = MLA_HEADS * (QK_NOPE_DIM + QK_ROPE_DIM)
KV_UP_WIDTH = MLA_HEADS * (QK_NOPE_DIM + V_HEAD_DIM)
IN_SPLITS = (Q_LORA_RANK, KV_LORA_RANK, QK_ROPE_DIM,
             MLSTM_QK_WIDTH, MLSTM_QK_WIDTH, MLSTM_WIDTH, MLSTM_WIDTH,
             MLSTM_HEADS, MLSTM_HEADS)
D_IN = sum(IN_SPLITS)

kernel_name = "hymba_mla_mlstm_macaron"


def rmsnorm(x, g):
    xf = x.astype(jnp.float32)
    y = xf * lax.rsqrt(jnp.mean(xf * xf, axis=-1, keepdims=True) + EPS)
    return (y * g.astype(jnp.float32)).astype(x.dtype)


def head_rmsnorm(x, g):
    B, S, H, d = x.shape
    xf = x.astype(jnp.float32)
    y = xf * lax.rsqrt(jnp.mean(xf * xf, axis=-1, keepdims=True) + EPS)
    return (y.reshape(B, S, H * d) * g.astype(jnp.float32)).astype(x.dtype)


def half_swiglu(x, g, w_gate, w_up, w_down):
    h = rmsnorm(x, g)
    return x + 0.5 * ((jax.nn.silu(h @ w_gate) * (h @ w_up)) @ w_down)


def rope_tables(positions):
    inv = ROPE_THETA ** (-jnp.arange(0, QK_ROPE_DIM, 2, dtype=jnp.float32) / QK_ROPE_DIM)
    ang = positions.astype(jnp.float32)[..., None] * inv
    cos, sin = jnp.cos(ang), jnp.sin(ang)
    return jnp.concatenate([cos, cos], -1), jnp.concatenate([sin, sin], -1)


def apply_rope(x, cos, sin):
    xf = x.astype(jnp.float32)
    x1, x2 = jnp.split(xf, 2, axis=-1)
    rot = jnp.concatenate([-x2, x1], axis=-1)
    return (xf * cos + rot * sin).astype(x.dtype)


def mla_attention(c_q, c_kv, k_rope_raw, cos, sin, q_norm_g, w_uq, kv_norm_g, w_ukv):
    B, S = c_q.shape[:2]
    q = (rmsnorm(c_q, q_norm_g) @ w_uq).reshape(B, S, MLA_HEADS, QK_NOPE_DIM + QK_ROPE_DIM)
    q_nope, q_rope = q[..., :QK_NOPE_DIM], q[..., QK_NOPE_DIM:]
    q_rope = apply_rope(q_rope, cos[:, :, None, :], sin[:, :, None, :])
    kv = (rmsnorm(c_kv, kv_norm_g) @ w_ukv).reshape(B, S, MLA_HEADS, QK_NOPE_DIM + V_HEAD_DIM)
    k_nope, v = kv[..., :QK_NOPE_DIM], kv[..., QK_NOPE_DIM:]
    k_rope = apply_rope(k_rope_raw, cos, sin)
    nb = S // Q_BLOCK
    qn_b = q_nope.reshape(B, nb, Q_BLOCK, MLA_HEADS, QK_NOPE_DIM).swapaxes(0, 1)
    qr_b = q_rope.reshape(B, nb, Q_BLOCK, MLA_HEADS, QK_ROPE_DIM).swapaxes(0, 1)
    key_pos = jnp.arange(S)
    scale = (QK_NOPE_DIM + QK_ROPE_DIM) ** -0.5

    def one_block(args):
        qn, qr, blk = args
        s = (jnp.einsum('bqhd,bkhd->bhqk', qn, k_nope)
             + jnp.einsum('bqhr,bkr->bhqk', qr, k_rope))
        s = s.astype(jnp.float32) * scale
        q_pos = blk * Q_BLOCK + jnp.arange(Q_BLOCK)
        s = jnp.where(key_pos[None, :] <= q_pos[:, None], s, -jnp.inf)
        p = jax.nn.softmax(s, axis=-1).astype(v.dtype)
        return jnp.einsum('bhqk,bkhd->bqhd', p, v)

    o = lax.map(one_block, (qn_b, qr_b, jnp.arange(nb)))
    return o.swapaxes(0, 1).reshape(B, S, MLA_HEADS, V_HEAD_DIM)


def causal_depthwise_conv(u, w, b):
    C = u.shape[-1]
    y = lax.conv_general_dilated(u, w[:, None, :].astype(u.dtype), window_strides=(1,),
                                 padding=[(CONV_K - 1, 0)],
                                 dimension_numbers=('NWC', 'WIO', 'NWC'),
                                 feature_group_count=C)
    return y + b


def mlstm_chunkwise(q, k, v, i_pre, log_f):
    B, S, H, dk = q.shape
    dv = v.shape[-1]
    nc, L = S // CHUNK, CHUNK
    f32 = jnp.float32

    def chunks(t):
        return t.astype(f32).reshape(B, nc, L, H, -1).transpose(0, 3, 1, 2, 4)

    qc = chunks(q) * (dk ** -0.5)
    kc, vc = chunks(k), chunks(v)
    ig = i_pre.astype(f32).reshape(B, nc, L, H).transpose(0, 3, 1, 2)
    lf = log_f.astype(f32).reshape(B, nc, L, H).transpose(0, 3, 1, 2)
    b = jnp.cumsum(lf, axis=-1)
    b_end = b[..., -1]

    w_end = b_end[..., None] - b + ig
    g = jnp.max(w_end, axis=-1)
    e_end = jnp.exp(w_end - g[..., None])
    kv_chunk = jnp.einsum('bhcl,bhcld,bhcle->bhcde', e_end, kc, vc)
    n_chunk = jnp.einsum('bhcl,bhcld->bhcd', e_end, kc)

    def step(carry, xs):
        C, n, m = carry
        a, gc, kvc, nck = xs
        m_new = jnp.maximum(a + m, gc)
        d_old = jnp.exp(a + m - m_new)
        d_new = jnp.exp(gc - m_new)
        C_new = d_old[..., None, None] * C + d_new[..., None, None] * kvc
        n_new = d_old[..., None] * n + d_new[..., None] * nck
        return (C_new, n_new, m_new), (C, n, m)

    init = (jnp.zeros((B, H, dk, dv), f32), jnp.zeros((B, H, dk), f32), jnp.zeros((B, H), f32))
    xs = (jnp.moveaxis(b_end, 2, 0), jnp.moveaxis(g, 2, 0),
          jnp.moveaxis(kv_chunk, 2, 0), jnp.moveaxis(n_chunk, 2, 0))
    _, (C_prev, n_prev, m_prev) = lax.scan(step, init, xs)
    C_prev = jnp.moveaxis(C_prev, 0, 2)
    n_prev = jnp.moveaxis(n_prev, 0, 2)
    m_prev = jnp.moveaxis(m_prev, 0, 2)

    causal = jnp.tril(jnp.ones((L, L), dtype=bool))
    log_d = jnp.where(causal, b[..., :, None] - b[..., None, :] + ig[..., None, :], -jnp.inf)
    inter = b + m_prev[..., None]
    m_t = jnp.maximum(inter, jnp.max(log_d, axis=-1))
    p = jnp.exp(log_d - m_t[..., None]) * jnp.einsum('bhcld,bhcsd->bhcls', qc, kc)
    e_inter = jnp.exp(inter - m_t)
    num = (e_inter[..., None] * jnp.einsum('bhcld,bhcde->bhcle', qc, C_prev)
           + jnp.einsum('bhcls,bhcse->bhcle', p, vc))
    den = e_inter * jnp.einsum('bhcld,bhcd->bhcl', qc, n_prev) + jnp.sum(p, axis=-1)
    h = num / jnp.maximum(jnp.abs(den), jnp.exp(-m_t))[..., None]
    return h.transpose(0, 2, 3, 1, 4).reshape(B, S, H, dv).astype(v.dtype)


def setup_inputs(seed: int = 0) -> dict:
    key = jax.random.key(seed)
    ks = jax.random.split(key, 32)
    f32 = jnp.float32

    def w(k, shape, fan_in):
        return jax.random.normal(k, shape, f32) * (fan_in ** -0.5)

    def gain(k, shape):
        return 1.0 + 0.02 * jax.random.normal(k, shape, f32)

    x = jax.random.normal(ks[0], (BATCH, SEQ, D_MODEL), f32)
    offsets = jax.random.randint(ks[1], (BATCH, 1), 0, 4096, dtype=jnp.int32)
    positions = (offsets + jnp.arange(SEQ, dtype=jnp.int32)[None, :]).astype(jnp.int32)
    return {
        "x": x,
        "positions": positions,
        "ffn1_norm": gain(ks[2], (DEPTH, D_MODEL)),
        "ffn1_w_gate": w(ks[3], (DEPTH, D_MODEL, D_FF), D_MODEL),
        "ffn1_w_up": w(ks[4], (DEPTH, D_MODEL, D_FF), D_MODEL),
        "ffn1_w_down": w(ks[5], (DEPTH, D_FF, D_MODEL), D_FF),
        "mix_norm": gain(ks[6], (DEPTH, D_MODEL)),
        "w_in": w(ks[7], (DEPTH, D_MODEL, D_IN), D_MODEL),
        "q_latent_norm": gain(ks[8], (DEPTH, Q_LORA_RANK)),
        "w_uq": w(ks[9], (DEPTH, Q_LORA_RANK, Q_UP_WIDTH), Q_LORA_RANK),
        "kv_latent_norm": gain(ks[10], (DEPTH, KV_LORA_RANK)),
        "w_ukv": w(ks[11], (DEPTH, KV_LORA_RANK, KV_UP_WIDTH), KV_LORA_RANK),
        "conv_w": w(ks[12], (DEPTH, CONV_K, 2 * MLSTM_QK_WIDTH), CONV_K),
        "conv_b": 0.01 * jax.random.normal(ks[13], (DEPTH, 2 * MLSTM_QK_WIDTH), f32),
        "b_igate": 0.1 * jax.random.normal(ks[14], (DEPTH, MLSTM_HEADS), f32),
        "b_fgate": (jnp.linspace(3.0, 6.0, MLSTM_HEADS, dtype=f32)[None, :]
                    + 0.1 * jax.random.normal(ks[15], (DEPTH, MLSTM_HEADS), f32)),
        "attn_head_norm": gain(ks[16], (DEPTH, MLA_WIDTH)),
        "mlstm_head_norm": gain(ks[17], (DEPTH, MLSTM_WIDTH)),
        "w_out": w(ks[18], (DEPTH, MIX_WIDTH, D_MODEL), MIX_WIDTH),
        "ffn2_norm": gain(ks[19], (DEPTH, D_MODEL)),
        "ffn2_w_gate": w(ks[20], (DEPTH, D_MODEL, D_FF), D_MODEL),
        "ffn2_w_up": w(ks[21], (DEPTH, D_MODEL, D_FF), D_MODEL),
        "ffn2_w_down": w(ks[22], (DEPTH, D_FF, D_MODEL), D_FF),
        "final_norm": gain(ks[23], (D_MODEL,)),
    }


def reference(x, positions, ffn1_norm, ffn1_w_gate, ffn1_w_up, ffn1_w_down,
              mix_norm, w_in, q_latent_norm, w_uq, kv_latent_norm, w_ukv,
              conv_w, conv_b, b_igate, b_fgate, attn_head_norm, mlstm_head_norm,
              w_out, ffn2_norm, ffn2_w_gate, ffn2_w_up, ffn2_w_down, final_norm):
    B, S, _ = x.shape
    cos, sin = rope_tables(positions)
    split_idx = [int(v) for v in np.cumsum(IN_SPLITS)[:-1]]

    for l in range(DEPTH):
        x = half_swiglu(x, ffn1_norm[l], ffn1_w_gate[l], ffn1_w_up[l], ffn1_w_down[l])

        h = rmsnorm(x, mix_norm[l])
        z = h @ w_in[l]
        c_q, c_kv, k_r, q_m, k_m, v_m, o_m, i_m, f_m = jnp.split(z, split_idx, axis=-1)

        y_att = mla_attention(c_q, c_kv, k_r, cos, sin, q_latent_norm[l], w_uq[l],
                              kv_latent_norm[l], w_ukv[l])
        y_att = head_rmsnorm(y_att, attn_head_norm[l])

        qk = jax.nn.silu(causal_depthwise_conv(jnp.concatenate([q_m, k_m], axis=-1),
                                               conv_w[l], conv_b[l]))
        q_c, k_c = jnp.split(qk, 2, axis=-1)
        i_pre = (i_m + b_igate[l]).astype(jnp.float32)
        log_f = jax.nn.log_sigmoid((f_m + b_fgate[l]).astype(jnp.float32))
        y_mem = mlstm_chunkwise(q_c.reshape(B, S, MLSTM_HEADS, MLSTM_QK_DIM),
                                k_c.reshape(B, S, MLSTM_HEADS, MLSTM_QK_DIM),
                                v_m.reshape(B, S, MLSTM_HEADS, MLSTM_V_DIM),
                                i_pre, log_f)
        y_mem = jax.nn.sigmoid(o_m) * head_rmsnorm(y_mem, mlstm_head_norm[l])

        x = x + jnp.concatenate([y_att, y_mem], axis=-1) @ w_out[l]

        x = half_swiglu(x, ffn2_norm[l], ffn2_w_gate[l], ffn2_w_up[l], ffn2_w_down[l])

    return rmsnorm(x, final_norm)
```

```cpp
#include <hip/hip_runtime.h>
#include <cstdio>
#include <cstdint>

#define LAS __attribute__((address_space(3)))
#define GAS __attribute__((address_space(1)))
typedef unsigned short bf16_t;
typedef short bf16x8 __attribute__((ext_vector_type(8)));
typedef short s16x4 __attribute__((ext_vector_type(4)));
typedef float f32x2 __attribute__((ext_vector_type(2)));
typedef float f32x4 __attribute__((ext_vector_type(4)));
typedef float f32x16 __attribute__((ext_vector_type(16)));
typedef unsigned u32x2 __attribute__((ext_vector_type(2)));
typedef unsigned u32x4 __attribute__((ext_vector_type(4)));
typedef GAS unsigned gu32;

namespace cfg {
constexpr int NB = 16, S = 4096, M = NB * S, D = 1024, DEPTH = 4, FF = 2816;
constexpr int NH = 8, DQK = 96, DNOPE = 64, DROPE = 32, DVH = 64, QLR = 256, KVLR = 128;
constexpr int MH = 4, MDK = 64, MDV = 128, CHUNK = 64, NCHUNK = S / CHUNK;
constexpr int DIN = 1960, DINP = 2048;
constexpr float EPS = 1e-6f;
constexpr float LOG2E = 1.4426950408889634f;
constexpr float QSCALE = 0.10206207261596575f * LOG2E;
}
namespace ws {
constexpr size_t MiB = 1u << 20;
constexpr size_t CTL = 0, ZERO_BYTES = 1 * MiB;
constexpr size_t SSQKV = 1 * MiB, SSQQ = 2 * MiB;
constexpr size_t SMALLP = 3 * MiB;
constexpr size_t SSQX = 24 * MiB;
constexpr size_t ROPE = 8 * MiB, IFG = 16 * MiB;
constexpr size_t WBASE = 32 * MiB, WLAYER = 40 * MiB;
constexpr size_t W_GU1 = 0, W_D1 = 11 * MiB, W_GU2 = 11 * MiB + 5632 * 1024, W_D2 = 27 * MiB + 512 * 1024, W_IN = 33 * MiB, W_UQ = 37 * MiB, W_KV = 37 * MiB + 512 * 1024, W_O = 38 * MiB;
constexpr size_t XB = 192 * MiB;
constexpr size_t H = 320 * MiB;
constexpr size_t CQ = 320 * MiB, CKV = 352 * MiB, QM = 368 * MiB, KM = 400 * MiB, VM = 432 * MiB, OG = 496 * MiB, Q = 560 * MiB, KF = 656 * MiB, VT = 752 * MiB, Y = 816 * MiB, END = 944 * MiB;
static_assert(W_D1 + 1024 * 2816 * 2 <= W_GU2 && W_GU2 + 5632 * 1024 * 2 <= W_D2 && W_D2 + 1024 * 2816 * 2 <= W_IN && W_IN + 2048 * 1024 * 2 <= W_UQ && W_UQ + 768 * 256 * 2 <= W_KV && W_KV + 1024 * 128 * 2 <= W_O && W_O + 1024 * 1024 * 2 <= WLAYER, "weight map");
static_assert(H + (size_t)cfg::M * cfg::FF * 2 <= Y + (size_t)cfg::M * 1024 * 2 && Y + (size_t)cfg::M * 1024 * 2 == END, "activation map");
constexpr int CW_QUEUE = 1024, CW_BAR = 4096;
}
namespace pg8 {
#define PG8_LAS __attribute__((address_space(3)))
typedef unsigned short bf16_t;
typedef short bf16x8 __attribute__((ext_vector_type(8)));
typedef float f32x4 __attribute__((ext_vector_type(4)));
typedef unsigned u32x4 __attribute__((ext_vector_type(4)));
constexpr int BM = 256, BK = 64, HALF = 128, HTB = HALF * BK * 2  , STAGE_BYTES = 8 * HTB, NXCD = 8, WGM = 8;

__host__ __device__ __forceinline__ int lds_byte(int r, int c) { const int st = (r >> 4) * 2 + (c >> 5), rr = r & 15, cc = c & 31, ob = rr * 64 + cc * 2; return st * 1024 + (ob ^ (((ob >> 9) & 1) << 5)); }
__host__ __device__ __forceinline__ void stage_rc(int b, int& R, int& C) { const int st = b / 1024, sb = b % 1024, swz = sb ^ (((sb >> 9) & 1) << 5); R = (st >> 1) * 16 + swz / 64; C = (st & 1) * 32 + (swz % 64) / 2; }
__host__ __device__ __forceinline__ int perm32(int rho) { const int n = rho >> 4, i = rho & 15; return 8 * (i >> 2) + 4 * n + (i & 3); }

struct Unit { int pm, pn; };
struct Gemm { const bf16_t* A; const bf16_t* Bt; int M, N, K; };

template <bool COLS> struct PanelOrderT {
    int n, c;
    __host__ __device__ void init(int M, int N, int, int c_) { c = c_; n = COLS ? (M / BM) : (N / BM); }
    __host__ __device__ bool next(int i, Unit& u) const { if (i >= n) return false; if (COLS) { u.pm = i; u.pn = c; } else { u.pm = c; u.pn = i; } return true; }
    __device__ __forceinline__ void a_ready(const Unit&) const {}
    __device__ __forceinline__ void done(const Unit&) const {}
};
typedef PanelOrderT<false> PanelOrder;
typedef PanelOrderT<true> PanelOrderC;
struct LatinOrder {
    int x, j, k, r_lo, r_hi;
    __host__ __device__ void init(int bx, int lo, int hi) { x = bx & 7; const int w = bx >> 3; j = w & 7; k = w >> 3; r_lo = lo; r_hi = hi; }
    __host__ __device__ int own_round() const { return (8 - 2 * k) & 7; }
    __host__ __device__ int own_panel() const { return 32 * x + 8 * (own_round() >> 1) + j; }
    __host__ __device__ bool next(int i, Unit& u) const { const int r = r_lo + i; if (r >= r_hi) return false; u.pm = 32 * x + 8 * (r >> 1) + j; u.pn = (2 * k + r) & 7; return true; }
    __device__ __forceinline__ void a_ready(const Unit&) const {}
    __device__ __forceinline__ void done(const Unit&) const {}
};

struct StaticOrder {
    int nM, nN, nwg, G, c;
    __host__ __device__ void init(int M, int N, int G_, int c_) { nM = M / BM; nN = N / BM; nwg = nM * nN; G = G_; c = c_; }
    __host__ __device__ bool next(int i, Unit& u) const {
        const long L = (long)i * G + c; if (L >= nwg) return false;
        int wgid = (int)L; { const int q = nwg / NXCD, r = nwg % NXCD, xcd = wgid % NXCD, off = wgid / NXCD; wgid = (xcd < r ? xcd * (q + 1) : r * (q + 1) + (xcd - r) * q) + off; }
        const int nig = WGM * nN, gid = wgid / nig, fm = gid * WGM, gsz = (nM - fm) < WGM ? (nM - fm) : WGM;
        u.pm = fm + ((wgid % nig) % gsz); u.pn = (wgid % nig) / gsz; return true;
    }
    __device__ __forceinline__ void a_ready(const Unit&) const {}
    __device__ __forceinline__ void done(const Unit&) const {}
};

typedef __bf16 bf16x2v_t __attribute__((ext_vector_type(2)));
__device__ __forceinline__ unsigned cvt_pk_bf16(float lo, float hi) { typedef float f32x2v_t __attribute__((ext_vector_type(2))); const f32x2v_t v = {lo, hi}; const bf16x2v_t b = __builtin_convertvector(v, bf16x2v_t); return __builtin_bit_cast(unsigned, b); }
__device__ __forceinline__ float silu_f(float x) { return x * __builtin_amdgcn_rcpf(1.f + __builtin_amdgcn_exp2f(-cfg::LOG2E * x)); }
__device__ __forceinline__ float sigmoid_f(float x) { return __builtin_amdgcn_rcpf(1.f + __builtin_amdgcn_exp2f(-cfg::LOG2E * x)); }
__device__ __forceinline__ u32x4 pack8(const f32x4 a, const f32x4 b) { u32x4 w; w.x = cvt_pk_bf16(a[0], a[1]); w.y = cvt_pk_bf16(a[2], a[3]); w.z = cvt_pk_bf16(b[0], b[1]); w.w = cvt_pk_bf16(b[2], b[3]); return w; }
__device__ __forceinline__ float sumsq8(const f32x4 a, const f32x4 b) { return (a[0] * a[0] + a[1] * a[1]) + (a[2] * a[2] + a[3] * a[3]) + (b[0] * b[0] + b[1] * b[1]) + (b[2] * b[2] + b[3] * b[3]); }
__device__ __forceinline__ float row_ssq16(const float* buf, int row, int fq);
__device__ __forceinline__ float quad_sum(float v) {
    { const auto r = __builtin_amdgcn_permlane16_swap(__float_as_uint(v), __float_as_uint(v), false, false); v = __uint_as_float(r[0]) + __uint_as_float(r[1]); }
    { const auto r = __builtin_amdgcn_permlane32_swap(__float_as_uint(v), __float_as_uint(v), false, false); v = __uint_as_float(r[0]) + __uint_as_float(r[1]); }
    return v; }

__device__ __forceinline__ float row_ssq16(const float* buf, int row, int fq) { const f32x4 v = *(const f32x4*)(buf + (size_t)row * 16 + 4 * fq); return quad_sum((v[0] + v[1]) + (v[2] + v[3])); }
__device__ __forceinline__ float row_ssq4(const float* buf, int row) { const f32x4 v = *(const f32x4*)(buf + (size_t)row * 4); return (v[0] + v[1]) + (v[2] + v[3]); }
__device__ __forceinline__ const float* ssqx_buf(unsigned char* W, int si) { return (const float*)(W + ws::SSQX) + (size_t)(si & 1) * cfg::M * 16; }

template <class Sched> __device__ __forceinline__ int rstd_table(PG8_LAS float* tab, const Sched& S, const float* ssq, int tid) {
    Unit u; int gid0 = 0, last = -1; asm volatile("" : "+v"(tid));
    for (int i = 0; S.next(i, u); ++i) {
        if (i == 0) gid0 = u.pm >> 3;
        if (u.pm != last) { last = u.pm;
            if (tid < 256) { const f32x4* p = (const f32x4*)(ssq + (size_t)(u.pm * BM + tid) * 16); const f32x4 a = p[0], b = p[1], c = p[2], d = p[3];
                const float t = ((a[0] + a[1]) + (a[2] + a[3])) + ((b[0] + b[1]) + (b[2] + b[3])) + ((c[0] + c[1]) + (c[2] + c[3])) + ((d[0] + d[1]) + (d[2] + d[3]));
                tab[((u.pm >> 3) - gid0) * 256 + tid] = __builtin_amdgcn_rsqf(t * (1.f / cfg::D) + cfg::EPS); } } }
    __syncthreads();
    return gid0;
}

struct EpiSwiGLU {
    static constexpr bool PERM = true, AFTER_DRAIN = false;
    unsigned char* W; int si;
    const PG8_LAS float* rstab; int gid0;
    static constexpr int ND = 2;
    struct Def { u32x4 a[4], b[4]; };
    static __device__ __forceinline__ f32x2 swi2(const f32x2 g, const f32x2 u) {
        const f32x2 t = g * (f32x2){-cfg::LOG2E, -cfg::LOG2E};
        f32x2 s; s[0] = __builtin_amdgcn_exp2f(fminf(t[0], 60.f)); s[1] = __builtin_amdgcn_exp2f(fminf(t[1], 60.f));
        s = s + (f32x2){1.f, 1.f};
        const float r = __builtin_amdgcn_rcpf(s[0] * s[1]);
        const f32x2 sig = (f32x2){s[1], s[0]} * (f32x2){r, r};
        return (g * sig) * u;
    }
    template <bool DEFER_HALF> __device__ __forceinline__ void run(const f32x4 (&acc)[2][2][4][2], const Unit& u_, int wr, int wc, int fr, int fq, Def& D) const {
        Unit u = u_; asm volatile("" : "+s"(u.pm), "+s"(u.pn), "+v"(fr), "+v"(fq));
        bf16_t* const H = (bf16_t*)(W + ws::H);
        const int row0 = u.pm * BM + wr * 64 + fr, hcol = u.pn * 128 + wc * 32 + 8 * fq;
        float rsv[2][4];
        { const PG8_LAS float* tp = rstab + ((u.pm >> 3) - gid0) * 256 + wr * 64 + fr;
#pragma unroll
          for (int ai = 0; ai < 2; ++ai)
#pragma unroll
              for (int m = 0; m < 4; ++m) rsv[ai][m] = tp[ai * HALF + m * 16]; }
#pragma unroll
        for (int ai = 1; ai >= 0; --ai)
#pragma unroll
            for (int m = 3; m >= 0; --m) {
                const int row = row0 + ai * HALF + m * 16;
                const float rs = rsv[ai][m];
                const f32x2 rs2 = {rs, rs};
                if (DEFER_HALF && ai == 1 && m >= 4 - ND) {
                    f32x4 g0, g1, u0, u1;
#pragma unroll
                    for (int e = 0; e < 4; ++e) { g0[e] = acc[1][0][m][0][e] * rs; g1[e] = acc[1][0][m][1][e] * rs; u0[e] = acc[1][1][m][0][e] * rs; u1[e] = acc[1][1][m][1][e] * rs; }
                    D.a[m] = pack8(g0, g1); D.b[m] = pack8(u0, u1);
                } else {
                    f32x4 h0, h1;
#pragma unroll
                    for (int n = 0; n < 2; ++n)
#pragma unroll
                        for (int e = 0; e < 4; e += 2) {
                            const f32x2 ga = {acc[ai][0][m][n][e], acc[ai][0][m][n][e + 1]}, ua = {acc[ai][1][m][n][e], acc[ai][1][m][n][e + 1]};
                            const f32x2 hh = swi2(ga * rs2, ua * rs2);
                            if (n == 0) { h0[e] = hh[0]; h0[e + 1] = hh[1]; } else { h1[e] = hh[0]; h1[e + 1] = hh[1]; }
                        }
                    *(u32x4*)(H + (size_t)row * cfg::FF + hcol) = pack8(h0, h1);
                }
            }
    }
    __device__ __forceinline__ void operator()(const f32x4 (&acc)[2][2][4][2], const Unit& u_, int wr, int wc, int fr, int fq) const { Def D; run<false>(acc, u_, wr, wc, fr, fq, D); }
    __device__ __forceinline__ void later(Def& D, const int q) const {
#pragma unroll
        for (int d = 2 * q; d < 2 * q + 2; ++d) {
            const int m = 4 - ND + (d >> 2), j = d & 3;
            const u32x4 ga = D.a[m], ua = D.b[m];
            const unsigned gw = (j == 0) ? ga.x : (j == 1) ? ga.y : (j == 2) ? ga.z : ga.w, uw = (j == 0) ? ua.x : (j == 1) ? ua.y : (j == 2) ? ua.z : ua.w;
            const f32x2 g = {__uint_as_float(gw << 16), __uint_as_float(gw & 0xffff0000u)}, uu = {__uint_as_float(uw << 16), __uint_as_float(uw & 0xffff0000u)};
            const f32x2 hh = swi2(g, uu);
            const unsigned ow = cvt_pk_bf16(hh[0], hh[1]);
            if (j == 0) D.a[m].x = ow; else if (j == 1) D.a[m].y = ow; else if (j == 2) D.a[m].z = ow; else D.a[m].w = ow;
        }
    }
    __device__ __forceinline__ void pin(Def& D, const int q) const {
#pragma unroll
        for (int d = 2 * q; d < 2 * q + 2; ++d) { const int m = 4 - ND + (d >> 2), j = d & 3;
            if (j == 0) asm volatile("" : "+v"(D.a[m].x)); else if (j == 1) asm volatile("" : "+v"(D.a[m].y)); else if (j == 2) asm volatile("" : "+v"(D.a[m].z)); else asm volatile("" : "+v"(D.a[m].w)); }
    }
    __device__ __forceinline__ void flush(const Def& D, const Unit& u_, int wr, int wc, int fr, int fq) const {
        Unit u = u_; asm volatile("" : "+s"(u.pm), "+s"(u.pn), "+v"(fr), "+v"(fq));
        bf16_t* const H = (bf16_t*)(W + ws::H);
        const int row0 = u.pm * BM + wr * 64 + fr + HALF, hcol = u.pn * 128 + wc * 32 + 8 * fq;
#pragma unroll
        for (int m = 4 - ND; m < 4; ++m) *(u32x4*)(H + (size_t)(row0 + m * 16) * cfg::FF + hcol) = D.a[m];
    }
};

struct EpiResid {
    static constexpr bool PERM = true, AFTER_DRAIN = false;
    unsigned char* W; int si; float alpha;
    __device__ __forceinline__ void prefetch_unused(const Unit& u_, PG8_LAS unsigned char* junk, int tid) const {
        Unit u = u_; asm volatile("" : "+s"(u.pm), "+s"(u.pn), "+v"(tid));
        const unsigned char* base = W + ws::XB + ((size_t)u.pm * BM * cfg::D + (size_t)u.pn * BM) * 2;
#pragma unroll
        for (int i = 0; i < 2; ++i) { const int ln = tid + 512 * i;
            __builtin_amdgcn_global_load_lds((const unsigned*)(base + (size_t)(ln >> 2) * (cfg::D * 2) + (ln & 3) * 128), (PG8_LAS unsigned*)junk, 4, 0, 0); }
    }
    __device__ __forceinline__ void operator()(const f32x4 (&acc)[2][2][4][2], const Unit& u_, int wr, int wc, int fr, int fq) const {
        Unit u = u_; asm volatile("" : "+s"(u.pm), "+s"(u.pn), "+v"(fr), "+v"(fq));
        bf16_t* const xb = (bf16_t*)(W + ws::XB); float* const ssq_out = (float*)ssqx_buf(W, si);
        const int row0 = u.pm * BM + wr * 64 + fr, col0 = u.pn * BM + wc * 32 + 8 * fq;
        u32x4 xin[2][4][2];
#pragma unroll
        for (int ai = 0; ai < 2; ++ai)
#pragma unroll
            for (int m = 0; m < 4; ++m)
#pragma unroll
                for (int bj = 0; bj < 2; ++bj) xin[ai][m][bj] = *(const u32x4*)(xb + (size_t)(row0 + ai * HALF + m * 16) * cfg::D + col0 + bj * HALF);
#pragma unroll
        for (int ai = 0; ai < 2; ++ai)
#pragma unroll
            for (int m = 0; m < 4; ++m) {
                const int row = row0 + ai * HALF + m * 16; const size_t off = (size_t)row * cfg::D + col0; float part = 0.f;
#pragma unroll
                for (int bj = 0; bj < 2; ++bj) {
                    const u32x4 b = xin[ai][m][bj];
                    f32x4 x0, x1;
                    x0[0] = __uint_as_float(b.x << 16); x0[1] = __uint_as_float(b.x & 0xffff0000u); x0[2] = __uint_as_float(b.y << 16); x0[3] = __uint_as_float(b.y & 0xffff0000u);
                    x1[0] = __uint_as_float(b.z << 16); x1[1] = __uint_as_float(b.z & 0xffff0000u); x1[2] = __uint_as_float(b.w << 16); x1[3] = __uint_as_float(b.w & 0xffff0000u);
                    x0 = x0 + acc[ai][bj][m][0] * alpha; x1 = x1 + acc[ai][bj][m][1] * alpha;
                    *(u32x4*)(xb + off + bj * HALF) = pack8(x0, x1);
                    part += sumsq8(x0, x1);
                }
                part = quad_sum(part);
                if (fq == 0) ssq_out[(size_t)row * 16 + u.pn * 4 + wc] = part;
            }
    }
};

struct EpiWin {
    static constexpr bool PERM = true, AFTER_DRAIN = false;
    unsigned char* W; int l;
    __device__ __forceinline__ void operator()(const f32x4 (&acc)[2][2][4][2], const Unit& u_, int wr, int wc, int fr, int fq) const {
        Unit u = u_; asm volatile("" : "+s"(u.pm), "+s"(u.pn), "+v"(fr), "+v"(fq));
        const float* const ssq = ssqx_buf(W, 3 * l + 1);
        bf16_t* const CQ = (bf16_t*)(W + ws::CQ); bf16_t* const CKV = (bf16_t*)(W + ws::CKV); bf16_t* const KF = (bf16_t*)(W + ws::KF); bf16_t* const QM = (bf16_t*)(W + ws::QM);
        bf16_t* const KM = (bf16_t*)(W + ws::KM); bf16_t* const VM = (bf16_t*)(W + ws::VM); bf16_t* const OG = (bf16_t*)(W + ws::OG); float* const IF = (float*)(W + ws::IFG);
        float* const ssq_q = (float*)(W + ws::SSQQ); float* const ssq_kv = (float*)(W + ws::SSQKV);
        const f32x2* const rope = (const f32x2*)(W + ws::ROPE);
        const float* const b_i = (const float*)(W + ws::SMALLP) + l * 4096 + 2560; const float* const b_f = b_i + 4;
        const int row0 = u.pm * BM + wr * 64 + fr, pn = u.pn, cw = wc * 32 + 8 * fq;
        f32x4 pq[2][4]; float rsv[2][4];
#pragma unroll
        for (int ai = 0; ai < 2; ++ai)
#pragma unroll
            for (int m = 0; m < 4; ++m) pq[ai][m] = *(const f32x4*)(ssq + (size_t)(row0 + ai * HALF + m * 16) * 16 + 4 * fq);
#pragma unroll
        for (int ai = 0; ai < 2; ++ai)
#pragma unroll
            for (int m = 0; m < 4; ++m) rsv[ai][m] = __builtin_amdgcn_rsqf(quad_sum((pq[ai][m][0] + pq[ai][m][1]) + (pq[ai][m][2] + pq[ai][m][3])) * (1.f / cfg::D) + cfg::EPS);
#pragma unroll
        for (int ai = 0; ai < 2; ++ai)
#pragma unroll
            for (int m = 0; m < 4; ++m) {
                const int row = row0 + ai * HALF + m * 16;
                const float rs = rsv[ai][m];
                f32x4 v[2][2];
#pragma unroll
                for (int bj = 0; bj < 2; ++bj) { v[bj][0] = acc[ai][bj][m][0] * rs; v[bj][1] = acc[ai][bj][m][1] * rs; }
                if (pn == 0) {
                    float part = 0.f;
#pragma unroll
                    for (int bj = 0; bj < 2; ++bj) { *(u32x4*)(CQ + (size_t)row * cfg::QLR + bj * HALF + cw) = pack8(v[bj][0], v[bj][1]); part += sumsq8(v[bj][0], v[bj][1]); }
                    part = quad_sum(part); if (fq == 0) ssq_q[(size_t)row * 4 + wc] = part;
                } else if (pn == 1) {
                    *(u32x4*)(CKV + (size_t)row * cfg::KVLR + cw) = pack8(v[0][0], v[0][1]);
                    float part = quad_sum(sumsq8(v[0][0], v[0][1])); if (fq == 0) ssq_kv[(size_t)row * 4 + wc] = part;
                    if (wc == 0) {
                        const f32x4 cs0 = *(const f32x4*)(rope + (size_t)row * 16 + 4 * fq), cs1 = *(const f32x4*)(rope + (size_t)row * 16 + 4 * fq + 2);
                        f32x4 r0, r1;
                        r0[0] = v[1][0][0] * cs0[0] - v[1][0][1] * cs0[1]; r0[1] = v[1][0][1] * cs0[0] + v[1][0][0] * cs0[1];
                        r0[2] = v[1][0][2] * cs0[2] - v[1][0][3] * cs0[3]; r0[3] = v[1][0][3] * cs0[2] + v[1][0][2] * cs0[3];
                        r1[0] = v[1][1][0] * cs1[0] - v[1][1][1] * cs1[1]; r1[1] = v[1][1][1] * cs1[0] + v[1][1][0] * cs1[1];
                        r1[2] = v[1][1][2] * cs1[2] - v[1][1][3] * cs1[3]; r1[3] = v[1][1][3] * cs1[2] + v[1][1][2] * cs1[3];
                        const u32x4 w = pack8(r0, r1);
                        const int b = row >> 12, s = row & 4095;
#pragma unroll
                        for (int h = 0; h < cfg::NH; ++h) *(u32x4*)(KF + ((size_t)(b * cfg::NH + h) * cfg::S + s) * cfg::DQK + cfg::DNOPE + 8 * fq) = w;
                    } else if (wc == 1 && fq == 0) {
                        f32x4 ig, lf;
#pragma unroll
                        for (int e = 0; e < 4; ++e) { ig[e] = v[1][0][e] + b_i[e]; const float z = v[1][1][e] + b_f[e]; lf[e] = fminf(z, 0.f) - log1pf(__expf(-fabsf(z))); }
                        *(f32x4*)(IF + (size_t)row * 8) = ig; *(f32x4*)(IF + (size_t)row * 8 + 4) = lf;
                    }
                } else if (pn < 4) {
                    bf16_t* dst = (pn == 2) ? QM : KM;
#pragma unroll
                    for (int bj = 0; bj < 2; ++bj) *(u32x4*)(dst + (size_t)row * 256 + bj * HALF + cw) = pack8(v[bj][0], v[bj][1]);
                } else if (pn < 6) {
#pragma unroll
                    for (int bj = 0; bj < 2; ++bj) *(u32x4*)(VM + (size_t)row * 512 + (pn - 4) * 256 + bj * HALF + cw) = pack8(v[bj][0], v[bj][1]);
                } else {
#pragma unroll
                    for (int bj = 0; bj < 2; ++bj) { f32x4 a, b;
#pragma unroll
                        for (int e = 0; e < 4; ++e) { a[e] = sigmoid_f(v[bj][0][e]); b[e] = sigmoid_f(v[bj][1][e]); }
                        *(u32x4*)(OG + (size_t)row * 512 + (pn - 6) * 256 + bj * HALF + cw) = pack8(a, b); }
                }
            }
    }
};

struct EpiQ {
    static constexpr bool PERM = true, AFTER_DRAIN = false;
    unsigned char* W; int l;
    __device__ __forceinline__ void operator()(const f32x4 (&acc)[2][2][4][2], const Unit& u_, int wr, int wc, int fr, int fq) const {
        Unit u = u_; asm volatile("" : "+s"(u.pm), "+s"(u.pn), "+v"(fr), "+v"(fq));
        const float* const ssq_q = (const float*)(W + ws::SSQQ); const f32x2* const rope = (const f32x2*)(W + ws::ROPE); bf16_t* const Q = (bf16_t*)(W + ws::Q);
        const int row0 = u.pm * BM + wr * 64 + fr;
        f32x4 pq[2][4];
#pragma unroll
        for (int ai = 0; ai < 2; ++ai)
#pragma unroll
            for (int m = 0; m < 4; ++m) pq[ai][m] = *(const f32x4*)(ssq_q + (size_t)(row0 + ai * HALF + m * 16) * 4);
#pragma unroll
        for (int ai = 0; ai < 2; ++ai)
#pragma unroll
            for (int m = 0; m < 4; ++m) {
                const int row = row0 + ai * HALF + m * 16; const int b = row >> 12, s = row & 4095;
                const float rs = __builtin_amdgcn_rsqf(((pq[ai][m][0] + pq[ai][m][1]) + (pq[ai][m][2] + pq[ai][m][3])) * (1.f / cfg::QLR) + cfg::EPS) * cfg::QSCALE;
#pragma unroll
                for (int bj = 0; bj < 2; ++bj) {
                    const int col = u.pn * BM + bj * HALF + wc * 32 + 8 * fq, h = col / cfg::DQK, d = col - h * cfg::DQK;
                    f32x4 v0 = acc[ai][bj][m][0] * rs, v1 = acc[ai][bj][m][1] * rs;
                    if (d >= cfg::DNOPE) {
                        const int i0 = (d - cfg::DNOPE) >> 1;
                        const f32x4 cs0 = *(const f32x4*)(rope + (size_t)row * 16 + i0), cs1 = *(const f32x4*)(rope + (size_t)row * 16 + i0 + 2);
                        f32x4 r0, r1;
                        r0[0] = v0[0] * cs0[0] - v0[1] * cs0[1]; r0[1] = v0[1] * cs0[0] + v0[0] * cs0[1];
                        r0[2] = v0[2] * cs0[2] - v0[3] * cs0[3]; r0[3] = v0[3] * cs0[2] + v0[2] * cs0[3];
                        r1[0] = v1[0] * cs1[0] - v1[1] * cs1[1]; r1[1] = v1[1] * cs1[0] + v1[0] * cs1[1];
                        r1[2] = v1[2] * cs1[2] - v1[3] * cs1[3]; r1[3] = v1[3] * cs1[2] + v1[2] * cs1[3];
                        v0 = r0; v1 = r1;
                    }
                    *(u32x4*)(Q + ((size_t)(b * cfg::NH + h) * cfg::S + s) * cfg::DQK + d) = pack8(v0, v1);
                }
            }
    }
};

struct EpiKN {
    static constexpr bool PERM = true, AFTER_DRAIN = false;
    unsigned char* W; int l;
    __device__ __forceinline__ void operator()(const f32x4 (&acc)[2][2][4][2], const Unit& u_, int wr, int wc, int fr, int fq) const {
        Unit u = u_; asm volatile("" : "+s"(u.pm), "+s"(u.pn), "+v"(fr), "+v"(fq));
        const float* const ssq_kv = (const float*)(W + ws::SSQKV); bf16_t* const KF = (bf16_t*)(W + ws::KF);
        const int row0 = u.pm * BM + wr * 64 + fr;
        f32x4 pq[2][4];
#pragma unroll
        for (int ai = 0; ai < 2; ++ai)
#pragma unroll
            for (int m = 0; m < 4; ++m) pq[ai][m] = *(const f32x4*)(ssq_kv + (size_t)(row0 + ai * HALF + m * 16) * 4);
#pragma unroll
        for (int ai = 0; ai < 2; ++ai)
#pragma unroll
            for (int m = 0; m < 4; ++m) {
                const int row = row0 + ai * HALF + m * 16; const int b = row >> 12, s = row & 4095;
                const float rs = __builtin_amdgcn_rsqf(((pq[ai][m][0] + pq[ai][m][1]) + (pq[ai][m][2] + pq[ai][m][3])) * (1.f / cfg::KVLR) + cfg::EPS);
#pragma unroll
                for (int bj = 0; bj < 2; ++bj) {
                    const int col = u.pn * BM + bj * HALF + wc * 32 + 8 * fq, h = col >> 6, d = col & 63;
                    *(u32x4*)(KF + ((size_t)(b * cfg::NH + h) * cfg::S + s) * cfg::DQK + d) = pack8(acc[ai][bj][m][0] * rs, acc[ai][bj][m][1] * rs);
                }
            }
    }
};

struct EpiVT {
    static constexpr bool PERM = true, AFTER_DRAIN = false;
    unsigned char* W; int l;
    __device__ __forceinline__ void operator()(const f32x4 (&acc)[2][2][4][2], const Unit& u_, int wr, int wc, int fr, int fq) const {
        Unit u = u_; asm volatile("" : "+s"(u.pm), "+s"(u.pn), "+v"(fr), "+v"(fq));
        const float* const ssq_kv = (const float*)(W + ws::SSQKV); bf16_t* const VT = (bf16_t*)(W + ws::VT);
        const int row0 = u.pm * BM + wr * 64 + fr;
#pragma unroll
        for (int bj = 0; bj < 2; ++bj) {
            const int tok = u.pn * BM + bj * HALF + wc * 32 + 8 * fq; const int b = tok >> 12, s = tok & 4095;
            f32x4 rs0, rs1;
#pragma unroll
            for (int e = 0; e < 4; ++e) { rs0[e] = __builtin_amdgcn_rsqf(row_ssq4(ssq_kv, tok + e) * (1.f / cfg::KVLR) + cfg::EPS); rs1[e] = __builtin_amdgcn_rsqf(row_ssq4(ssq_kv, tok + 4 + e) * (1.f / cfg::KVLR) + cfg::EPS); }
#pragma unroll
            for (int ai = 0; ai < 2; ++ai)
#pragma unroll
                for (int m = 0; m < 4; ++m) {
                    const int r = row0 + ai * HALF + m * 16;
                    *(u32x4*)(VT + ((size_t)(b * 512 + r)) * cfg::S + s) = pack8(acc[ai][bj][m][0] * rs0, acc[ai][bj][m][1] * rs1);
                }
        }
    }
};

struct EpiNull {
    static constexpr bool PERM = true, AFTER_DRAIN = false;
    float* dummy;
    __device__ __forceinline__ void operator()(const f32x4 (&acc)[2][2][4][2], const Unit& u, int wr, int wc, int fr, int fq) const {
        f32x4 t = acc[0][0][0][0];
#pragma unroll
        for (int ai = 0; ai < 2; ++ai)
#pragma unroll
            for (int bj = 0; bj < 2; ++bj)
#pragma unroll
                for (int m = 0; m < 4; ++m) { t = t + acc[ai][bj][m][0]; t = t + acc[ai][bj][m][1]; }
        dummy[(size_t)(u.pm * 4 + (u.pn & 3)) * 512 + (wr * 4 + wc) * 64 + fr + 16 * fq] = (t[0] + t[1]) + (t[2] + t[3]);
    }
};
__device__ __forceinline__ void glds16_saddr(const void* sbase, unsigned voff, unsigned lds_dst) {
    asm volatile("s_mov_b32 m0, %2\n\ts_nop 0\n\tglobal_load_lds_dwordx4 %0, %1" : : "v"(voff), "s"(sbase), "s"(lds_dst) : "memory", "m0"); }
constexpr int PF_JUNK_OFF = 131072 + 8192, PF_DIST = 8;
template <class E, class = void> struct HasPrefetch { static constexpr bool v = false; };
template <class E> struct HasPrefetch<E, decltype((void)&E::prefetch)> { static constexpr bool v = true; };
template <class E, class = void> struct HasDefer { static constexpr bool v = false; struct Def {}; };
template <class E> struct HasDefer<E, decltype((void)sizeof(typename E::Def))> { static constexpr bool v = true; typedef typename E::Def Def; };
template <class Epi, class Sched, bool ALIGN_EPI = false, bool SP2 = false>
__device__ __forceinline__ void gemm_phase(PG8_LAS unsigned char* lds, const Gemm g, const Sched& S, const Epi& E) {
    int tid_ = threadIdx.x; asm volatile("" : "+v"(tid_));
    const int tid = tid_, wid = __builtin_amdgcn_readfirstlane(tid >> 6), lane = tid & 63, wr = wid >> 2, wc = wid & 3, fr = lane & 15, fq = lane >> 4;
    int K_ = g.K; asm volatile("" : "+s"(K_));
    const int K = K_, nt = K / BK; const int tpf = (nt > PF_DIST) ? ((nt - PF_DIST) & ~1) : 0; (void)tpf;
    unsigned voffA[2], voffB[2];
#pragma unroll
    for (int i = 0; i < 2; ++i) { int R, C; stage_rc(tid * 16 + i * 8192, R, C); const int Rb = Epi::PERM ? ((R & ~31) + perm32(R & 31)) : R;
        voffA[i] = (unsigned)(R * K + C) * 2u; voffB[i] = (unsigned)(Rb * K + C) * 2u; }
    const size_t kstep = (size_t)(BK * 2);
    const size_t hstep = (size_t)HALF * K * 2;
    const size_t tstep = 2 * hstep;
    const unsigned lds0_ = (unsigned)(uintptr_t)lds;
    const unsigned ldsw = (unsigned)wid * 1024u;
    const int aoff = lds_byte(wr * 64 + fr, fq * 8), boff = lds_byte(wc * 32 + fr, fq * 8);
#define PG8_SA(b, h) (((b) * 2 + (h)) * HTB)
#define PG8_SB(b, h) ((4 + (b) * 2 + (h)) * HTB)
#define PG8_STAGE(bufoff, gbase, voff) do { _Pragma("unroll") for (int _i = 0; _i < 2; ++_i) \
        glds16_saddr((const void*)(gbase), (voff)[_i], lds0_ + (unsigned)((bufoff) + _i * 8192) + ldsw); } while (0)
#define PG8_LDA(dst, b, h) do { _Pragma("unroll") for (int m = 0; m < 4; ++m) _Pragma("unroll") for (int k = 0; k < 2; ++k) dst[m][k] = *(const PG8_LAS bf16x8*)(lds + PG8_SA(b, h) + aoff + m * 2048 + k * 1024); } while (0)
#define PG8_LDB(dst, b, h) do { _Pragma("unroll") for (int n = 0; n < 2; ++n) _Pragma("unroll") for (int k = 0; k < 2; ++k) dst[n][k] = *(const PG8_LAS bf16x8*)(lds + PG8_SB(b, h) + boff + n * 2048 + k * 1024); } while (0)
#define PG8_MMA(ai, bj, At, Bt) do { if (PG8_PRIO) __builtin_amdgcn_s_setprio(1); _Pragma("unroll") for (int m = 0; m < 4; ++m) _Pragma("unroll") for (int n = 0; n < 2; ++n) _Pragma("unroll") for (int k = 0; k < 2; ++k) \
        acc[ai][bj][m][n] = __builtin_amdgcn_mfma_f32_16x16x32_bf16(Bt[n][k], At[m][k], acc[ai][bj][m][n], 0, 0, 0); if (PG8_PRIO) __builtin_amdgcn_s_setprio(0); } while (0)
#define PG8_PIN(q) do { _Pragma("unroll") for (int _q = 0; _q < 32; ++_q) { __builtin_amdgcn_sched_group_barrier(0x008, 1, 0); __builtin_amdgcn_sched_group_barrier(0x002, 1, 0); if ((_q & 3) == 0) __builtin_amdgcn_sched_group_barrier(0x400, 1, 0); } E.pin(DF, q); } while (0)
#define PG8_WAIT_V(n) asm volatile("s_waitcnt vmcnt(" #n ")" ::: "memory")
#define PG8_WAIT_L(n) asm volatile("s_waitcnt lgkmcnt(" #n ")" ::: "memory")
#define PG8_BAR __builtin_amdgcn_s_barrier()
#define PG8_SCHED __builtin_amdgcn_sched_barrier(0)
#define PG8_ITER(F0, F1, F2, F3, G0, G1, G2, G3) \
            if constexpr (HasPrefetch<Epi>::v) { if (t == tpf) E.prefetch(cur, lds + PF_JUNK_OFF + wid * 256, tid); } \
            const bool last = (t == nt - 2); \
            const char* a1 = cA + (size_t)(t + 1) * kstep; \
            const char* a2 = last ? nA : cA + (size_t)(t + 2) * kstep; const char* b2 = last ? nB : cB + (size_t)(t + 2) * kstep; \
            const char* a3 = a2 + kstep; const char* b3 = b2 + kstep; \
            if (last && has_next) S.a_ready(nxt); \
            PG8_LDB(B0, 0, 0); PG8_LDB(B1, 0, 1); PG8_SCHED; PG8_LDA(At, 0, 0); PG8_STAGE(PG8_SA(1, 1), a1 + hstep, voffA); \
            PG8_WAIT_V(8); PG8_WAIT_L(0); PG8_BAR; F0; PG8_MMA(0, 0, At, B0); PG8_MMA(0, 1, At, B1); G0; PG8_BAR; PG8_SCHED; \
            PG8_LDA(At, 0, 1); PG8_STAGE(PG8_SB(0, 0), b2, voffB); PG8_STAGE(PG8_SB(0, 1), b2 + hstep, voffB); PG8_STAGE(PG8_SA(0, 0), a2, voffA); \
            PG8_WAIT_V(8); PG8_WAIT_L(0); PG8_BAR; F1; PG8_MMA(1, 0, At, B0); PG8_MMA(1, 1, At, B1); G1; PG8_BAR; PG8_SCHED; \
            PG8_LDB(B0, 1, 0); PG8_LDB(B1, 1, 1); PG8_SCHED; PG8_LDA(At, 1, 0); PG8_STAGE(PG8_SA(0, 1), a2 + hstep, voffA); \
            PG8_WAIT_V(8); PG8_WAIT_L(0); PG8_BAR; F2; PG8_MMA(0, 0, At, B0); PG8_MMA(0, 1, At, B1); G2; PG8_BAR; PG8_SCHED; \
            PG8_LDA(At, 1, 1); PG8_STAGE(PG8_SB(1, 0), b3, voffB); PG8_STAGE(PG8_SB(1, 1), b3 + hstep, voffB); PG8_STAGE(PG8_SA(1, 0), a3, voffA); \
            PG8_WAIT_V(8); PG8_WAIT_L(0); PG8_BAR; F3; PG8_MMA(1, 0, At, B0); PG8_MMA(1, 1, At, B1); G3; PG8_BAR; PG8_SCHED;
    Unit cur, nxt; int ui = 0;
    if (!S.next(0, cur)) return;
    f32x4 acc[2][2][4][2];
#pragma unroll
    for (int a = 0; a < 2; ++a)
#pragma unroll
        for (int b = 0; b < 2; ++b)
#pragma unroll
            for (int m = 0; m < 4; ++m)
#pragma unroll
                for (int n = 0; n < 2; ++n) acc[a][b][m][n] = (f32x4){0.f, 0.f, 0.f, 0.f};
    bf16x8 At[4][2], B0[2][2], B1[2][2];
    typename HasDefer<Epi>::Def DF; Unit prv = cur; (void)prv;
    if constexpr (HasDefer<Epi>::v) {
#pragma unroll
        for (int m = 0; m < 4; ++m) { DF.a[m] = (u32x4){0u, 0u, 0u, 0u}; DF.b[m] = (u32x4){0u, 0u, 0u, 0u}; } }
    const char* cA = (const char*)g.A + (size_t)cur.pm * tstep; const char* cB = (const char*)g.Bt + (size_t)cur.pn * tstep;
    S.a_ready(cur);
    if constexpr (SP2) {
        PG8_STAGE(PG8_SB(0, 0), cB, voffB); PG8_STAGE(PG8_SB(0, 1), cB + hstep, voffB); PG8_STAGE(PG8_SA(0, 0), cA, voffA); PG8_STAGE(PG8_SA(0, 1), cA + hstep, voffA);
        if (wr == 1) PG8_BAR;
        PG8_WAIT_V(2); PG8_BAR;
        PG8_STAGE(PG8_SB(1, 0), cB + kstep, voffB); PG8_STAGE(PG8_SA(1, 0), cA + kstep, voffA); PG8_STAGE(PG8_SB(1, 1), cB + hstep + kstep, voffB);
        PG8_WAIT_V(6); PG8_BAR;
    } else {
        PG8_STAGE(PG8_SB(0, 0), cB, voffB); PG8_STAGE(PG8_SA(0, 0), cA, voffA); PG8_STAGE(PG8_SB(0, 1), cB + hstep, voffB); PG8_STAGE(PG8_SA(0, 1), cA + hstep, voffA);
        if (wr == 1) PG8_BAR;
        PG8_WAIT_V(4); PG8_BAR;
        PG8_STAGE(PG8_SB(1, 0), cB + kstep, voffB); PG8_STAGE(PG8_SA(1, 0), cA + kstep, voffA); PG8_STAGE(PG8_SB(1, 1), cB + hstep + kstep, voffB);
        PG8_WAIT_V(6); PG8_BAR;
    }
    for (;;) {
        const bool has_next = S.next(ui + 1, nxt);
        const char* nA = has_next ? (const char*)g.A + (size_t)nxt.pm * tstep : cA; const char* nB = has_next ? (const char*)g.Bt + (size_t)nxt.pn * tstep : cB;
        if constexpr (SP2) {
            if constexpr (HasDefer<Epi>::v) {
                { const int t = 0; constexpr bool PG8_PRIO = false; PG8_ITER(PG8_SCHED; E.later(DF, 0), PG8_SCHED; E.later(DF, 1), PG8_SCHED; E.later(DF, 2), PG8_SCHED; E.later(DF, 3), PG8_PIN(0), PG8_PIN(1), PG8_PIN(2), PG8_PIN(3)) }
                if constexpr (Epi::ND == 4) { const int t = 2; constexpr bool PG8_PRIO = false; PG8_ITER(PG8_SCHED; E.later(DF, 4), PG8_SCHED; E.later(DF, 5), PG8_SCHED; E.later(DF, 6), PG8_SCHED; E.later(DF, 7), PG8_PIN(4), PG8_PIN(5), PG8_PIN(6), PG8_PIN(7)) }
                for (int t = Epi::ND; t < nt; t += 2) { constexpr bool PG8_PRIO = true; PG8_ITER((void)0, (void)0, (void)0, (void)0, (void)0, (void)0, (void)0, (void)0) }
            } else {
                for (int t = 0; t < nt; t += 2) { constexpr bool PG8_PRIO = true; PG8_ITER((void)0, (void)0, (void)0, (void)0, (void)0, (void)0, (void)0, (void)0) }
            }
        } else {
        for (int t = 0; t < nt; t += 2) { constexpr bool PG8_PRIO = true;
            if constexpr (HasPrefetch<Epi>::v) { if (t == tpf) E.prefetch(cur, lds + PF_JUNK_OFF + wid * 256, tid); }
            const bool last = (t == nt - 2);
            const char* a1 = cA + (size_t)(t + 1) * kstep;
            const char* a2 = last ? nA : cA + (size_t)(t + 2) * kstep; const char* b2 = last ? nB : cB + (size_t)(t + 2) * kstep;
            const char* a3 = a2 + kstep; const char* b3 = b2 + kstep;
            if (last && has_next) S.a_ready(nxt);
            PG8_LDB(B0, 0, 0); PG8_SCHED; PG8_LDA(At, 0, 0); PG8_STAGE(PG8_SA(1, 1), a1 + hstep, voffA);
            PG8_WAIT_L(8); PG8_BAR; PG8_WAIT_L(0); PG8_MMA(0, 0, At, B0); PG8_BAR; PG8_SCHED;
            PG8_LDB(B1, 0, 1); PG8_STAGE(PG8_SB(0, 0), b2, voffB);
            PG8_BAR; PG8_WAIT_L(0); PG8_MMA(0, 1, At, B1); PG8_BAR;
            PG8_LDA(At, 0, 1); PG8_STAGE(PG8_SA(0, 0), a2, voffA);
            PG8_BAR; PG8_WAIT_L(0); PG8_MMA(1, 0, At, B0); PG8_BAR; PG8_SCHED;
            PG8_STAGE(PG8_SB(0, 1), b2 + hstep, voffB);
            PG8_WAIT_V(6); PG8_BAR; PG8_MMA(1, 1, At, B1); PG8_BAR;
            PG8_LDB(B0, 1, 0); PG8_SCHED; PG8_LDA(At, 1, 0); PG8_STAGE(PG8_SA(0, 1), a2 + hstep, voffA);
            PG8_WAIT_L(8); PG8_BAR; PG8_WAIT_L(0); PG8_MMA(0, 0, At, B0); PG8_BAR; PG8_SCHED;
            PG8_LDB(B1, 1, 1); PG8_STAGE(PG8_SB(1, 0), b3, voffB);
            PG8_BAR; PG8_WAIT_L(0); PG8_MMA(0, 1, At, B1); PG8_BAR;
            PG8_LDA(At, 1, 1); PG8_STAGE(PG8_SA(1, 0), a3, voffA);
            PG8_BAR; PG8_WAIT_L(0); PG8_MMA(1, 0, At, B0); PG8_BAR; PG8_SCHED;
            PG8_STAGE(PG8_SB(1, 1), b3 + hstep, voffB);
            PG8_WAIT_V(6); PG8_BAR; PG8_MMA(1, 1, At, B1); PG8_BAR;
        }
        }
        if constexpr (ALIGN_EPI) { if (wr == 0) PG8_BAR; }
        if constexpr (HasDefer<Epi>::v) {
            if (ui > 0) E.flush(DF, prv, wr, wc, fr, fq);
            if (has_next) { E.template run<true>(acc, cur, wr, wc, fr, fq, DF); prv = cur; } else E.template run<false>(acc, cur, wr, wc, fr, fq, DF);
            S.done(cur);
        } else
        if constexpr (!Epi::AFTER_DRAIN) { E(acc, cur, wr, wc, fr, fq); S.done(cur); }
        if (!has_next) break;
#pragma unroll
        for (int a = 0; a < 2; ++a)
#pragma unroll
            for (int b = 0; b < 2; ++b)
#pragma unroll
                for (int m = 0; m < 4; ++m)
#pragma unroll
                    for (int n = 0; n < 2; ++n) acc[a][b][m][n] = (f32x4){0.f, 0.f, 0.f, 0.f};
        cur = nxt; cA = nA; cB = nB; ++ui;
        if constexpr (ALIGN_EPI) { if (wr == 1) PG8_BAR; }
    }
    PG8_WAIT_V(0);
    if constexpr (!ALIGN_EPI) { if (wr == 0) PG8_BAR; }
    PG8_BAR;
    if constexpr (Epi::AFTER_DRAIN) { E.fused(acc, cur, wr, wc, fr, fq, lds, wid, lane); S.done(cur); }
#undef PG8_SA
#undef PG8_SB
#undef PG8_STAGE
#undef PG8_LDA
#undef PG8_LDB
#undef PG8_MMA
#undef PG8_WAIT_V
#undef PG8_ITER
#undef PG8_PIN
#undef PG8_WAIT_L
#undef PG8_BAR
#undef PG8_SCHED
}
}
#define XB_TMO      128
#define XB_XCNT(j)  (256  + 64 * (j))
#define XB_XSUB(j)  (1280 + 64 * (j))
#define XB_XGEN(j)  (2304 + 64 * (j))
#define XB_TOP      3328
#define XB_TOPGEN   3392
#define XCD_BAR_WORDS 3456
#define XB_SPIN_CAP (1u << 18)

__device__ __forceinline__ unsigned xb_ld(unsigned* p)              { return __hip_atomic_load(p, __ATOMIC_RELAXED, __HIP_MEMORY_SCOPE_AGENT); }
__device__ __forceinline__ unsigned xb_add(unsigned* p, unsigned v) { return __hip_atomic_fetch_add(p, v, __ATOMIC_RELAXED, __HIP_MEMORY_SCOPE_AGENT); }
__device__ __forceinline__ unsigned xb_xcc_id() { return (unsigned)__builtin_amdgcn_s_getreg((3 << 11) | 20) & 0xFu; }
#define XB_SPIN(cond, bar) do { unsigned _sp = 0; while (cond) { __builtin_amdgcn_s_sleep(1); \
    if ((++_sp & 255u) == 0u) { if (xb_ld(&(bar)[XB_TMO])) break; if (_sp > XB_SPIN_CAP) { atomicAdd(&(bar)[XB_TMO], 1u); break; } } } } while (0)

struct XcdBarrier {
    unsigned* bar; unsigned x;
    volatile LAS unsigned* st;
};

__device__ __forceinline__ XcdBarrier xcd_barrier_post(unsigned* bar, volatile LAS unsigned* st) {
    XcdBarrier b; b.bar = bar; b.x = xb_xcc_id(); b.st = st;
    if (threadIdx.x == 0) (void)xb_add(&bar[XB_XCNT(b.x)], 1u);
    return b;
}
__device__ __forceinline__ void xcd_barrier_complete(unsigned* bar, unsigned x, unsigned& nloc, unsigned& nx) {
    const unsigned G = gridDim.x * gridDim.y * gridDim.z;
    unsigned sum, cnt, mine, sp = 0u;
    for (;;) {
        sum = 0u; cnt = 0u; mine = 0u;
#pragma unroll
        for (unsigned j = 0; j < 16; ++j) { const unsigned c = xb_ld(&bar[XB_XCNT(j)]); sum += c; cnt += (c > 0u) ? 1u : 0u; mine = (j == x) ? c : mine; }
        if (sum == G) break;
        __builtin_amdgcn_s_sleep(1);
        if ((++sp & 255u) == 0u) { if (xb_ld(&bar[XB_TMO])) break; if (sp > XB_SPIN_CAP) { atomicAdd(&bar[XB_TMO], 1u); break; } }
    }
    nloc = mine > 0u ? mine : 1u; nx = cnt > 0u ? cnt : 1u;
}

__device__ __forceinline__ void xcd_barrier(const XcdBarrier& b) {
    asm volatile("s_waitcnt vmcnt(0)" ::: "memory");
    __syncthreads();
    if (threadIdx.x == 0) {
        unsigned* bar = b.bar;
        __builtin_amdgcn_s_waitcnt(0);
        unsigned nloc = b.st[0], nx = b.st[1];
        if (nloc == 0u) { xcd_barrier_complete(bar, b.x, nloc, nx); b.st[0] = nloc; b.st[1] = nx; }
        const unsigned old = xb_add(&bar[XB_XSUB(b.x)], 1u);
        const unsigned gen = old / nloc;
        if (old + 1u == (gen + 1u) * nloc) {
            __builtin_amdgcn_fence(__ATOMIC_RELEASE, "agent");
            asm volatile("s_waitcnt vmcnt(0)" ::: "memory");
            const unsigned og = xb_add(&bar[XB_TOP], 1u);
            const unsigned tg = og / nx;
            if (og + 1u == (tg + 1u) * nx) xb_add(&bar[XB_TOPGEN], 1u);
            else XB_SPIN(xb_ld(&bar[XB_TOPGEN]) == tg, bar);
            __builtin_amdgcn_fence(__ATOMIC_ACQUIRE, "agent");
            xb_add(&bar[XB_XGEN(b.x)], 1u);
            asm volatile("s_waitcnt vmcnt(0)" ::: "memory");
        } else {
            XB_SPIN(xb_ld(&bar[XB_XGEN(b.x)]) == gen, bar);
            __builtin_amdgcn_fence(__ATOMIC_ACQUIRE, "agent");
            asm volatile("s_waitcnt vmcnt(0)" ::: "memory");
        }
    }
    __syncthreads();
}
typedef __bf16 bf16x2_t __attribute__((ext_vector_type(2)));
__device__ __forceinline__ unsigned cvtpk(float lo, float hi) { const f32x2 v = {lo, hi}; const bf16x2_t b = __builtin_convertvector(v, bf16x2_t); return __builtin_bit_cast(unsigned, b); }
__device__ __forceinline__ float bf2f(unsigned short b) { return __uint_as_float((unsigned)b << 16); }
__device__ __forceinline__ float bflo(unsigned w) { return __uint_as_float(w << 16); }
__device__ __forceinline__ float bfhi(unsigned w) { return __uint_as_float(w & 0xffff0000u); }
__device__ __forceinline__ void glds16(const void* gsrc, unsigned lds_dst) { unsigned keep;
    asm volatile("s_mov_b32 %0, m0\n\ts_mov_b32 m0, %2\n\ts_nop 0\n\tglobal_load_lds_dwordx4 %1, off\n\ts_mov_b32 m0, %0" : "=&s"(keep) : "v"(gsrc), "s"(lds_dst) : "memory"); }
__device__ __forceinline__ float half_swap_max(float m) { auto rr = __builtin_amdgcn_permlane32_swap(__float_as_uint(m), __float_as_uint(m), false, false); return fmaxf(__uint_as_float(rr[0]), __uint_as_float(rr[1])); }
__device__ __forceinline__ float half_swap_sum(float m) { auto rr = __builtin_amdgcn_permlane32_swap(__float_as_uint(m), __float_as_uint(m), false, false); return __uint_as_float(rr[0]) + __uint_as_float(rr[1]); }

namespace att {
constexpr int KTB = 64 * 192, VTB = 64 * 128, NSTG = 6;
constexpr int L_K = 0, L_V = NSTG * KTB, L_END = L_V + NSTG * VTB;
constexpr float THR = 8.f;
#define ATT_WAITBAR(N) asm volatile("s_waitcnt vmcnt(" #N ") lgkmcnt(0)\n\ts_barrier" ::: "memory")
__device__ __forceinline__ int slot_of(int t) { return t % NSTG; }
__device__ __forceinline__ float max3(float a, float b, float c) { return fmaxf(fmaxf(a, b), c); }

__device__ __forceinline__ void qk_tile(f32x16& p0, f32x16& p1, const LAS unsigned char* kb, const bf16x8 (&qf)[6], const f32x16& negm, int hi, int kc) {
    int g0 = hi + kc; if (g0 >= 12) g0 -= 12;
    bf16x8 ka[2][2];
#pragma unroll
    for (int d = 0; d < 2; ++d) { int g = g0 + 2 * d; if (g >= 12) g -= 12; ka[d][0] = *(const LAS bf16x8*)(kb + g * 16); ka[d][1] = *(const LAS bf16x8*)(kb + 32 * 192 + g * 16); }
#pragma unroll
    for (int d = 0; d < 6; ++d) {
        if (d == 0) { p0 = __builtin_amdgcn_mfma_f32_32x32x16_bf16(ka[0][0], qf[0], negm, 0, 0, 0); p1 = __builtin_amdgcn_mfma_f32_32x32x16_bf16(ka[0][1], qf[0], negm, 0, 0, 0); }
        else { p0 = __builtin_amdgcn_mfma_f32_32x32x16_bf16(ka[d & 1][0], qf[d], p0, 0, 0, 0); p1 = __builtin_amdgcn_mfma_f32_32x32x16_bf16(ka[d & 1][1], qf[d], p1, 0, 0, 0); }
        if (d + 2 < 6) { int g = g0 + 2 * (d + 2); if (g >= 12) g -= 12; if (g >= 12) g -= 12; ka[d & 1][0] = *(const LAS bf16x8*)(kb + g * 16); ka[d & 1][1] = *(const LAS bf16x8*)(kb + 32 * 192 + g * 16); }
    }
}
__device__ __forceinline__ void mask_tile(f32x16& p0, f32x16& p1, int kb0, int qrel) {
#pragma unroll
    for (int r = 0; r < 16; ++r) { const int kv = kb0 + 16 * (r >> 3) + (r & 7); if (kv > qrel) p0[r] = -INFINITY; if (kv + 32 > qrel) p1[r] = -INFINITY; }
}

__device__ __forceinline__ void attn_unit(LAS unsigned char* lds, int bh, int qbA, int qbB, const bf16_t* __restrict__ Q, const bf16_t* __restrict__ KF, const bf16_t* __restrict__ VT, bf16_t* __restrict__ Y, gu32* qhead, unsigned& knext) {
    int tid_ = threadIdx.x; asm volatile("" : "+v"(tid_));
    const int tid = tid_, lane = tid & 63, r32 = lane & 31, hi = lane >> 5;
    const int wid = __builtin_amdgcn_readfirstlane(tid >> 6);
    const unsigned lds0 = (unsigned)(uintptr_t)lds;
    const char* Kg = (const char*)(KF + (size_t)bh * cfg::S * cfg::DQK);
    const char* Vg = (const char*)(VT + (size_t)bh * cfg::DVH * cfg::S);
    const char *s0, *s1, *s2; unsigned d0, d1, d2; int str1, lst1;
    { const int p = wid * 64 + lane, row = p / 12, gq = p - row * 12; int g = gq - ((row >> 2) & 3); if (g < 0) g += 12; s0 = Kg + row * 192 + g * 16; d0 = lds0 + L_K + wid * 1024; }
    if (wid < 4) { const int p = (wid + 8) * 64 + lane, row = p / 12, gq = p - row * 12; int g = gq - ((row >> 2) & 3); if (g < 0) g += 12; s1 = Kg + row * 192 + g * 16; d1 = lds0 + L_K + (wid + 8) * 1024; str1 = KTB; lst1 = KTB; }
    else { const int p = (wid - 4) * 64 + lane, row = p >> 3, gq = p & 7, g = gq ^ ((row >> 1) & 7); s1 = Vg + (size_t)row * (cfg::S * 2) + g * 16; d1 = lds0 + L_V + (wid - 4) * 1024; str1 = 128; lst1 = VTB; }
    { const int p = ((wid & 3) + 4) * 64 + lane, row = p >> 3, gq = p & 7, g = gq ^ ((row >> 1) & 7); s2 = Vg + (size_t)row * (cfg::S * 2) + g * 16; d2 = lds0 + L_V + ((wid & 3) + 4) * 1024; }
#define ATT_ISSUE(t, stg) do { glds16(s0 + (size_t)(t) * KTB, (unsigned)__builtin_amdgcn_readfirstlane(d0 + (stg) * KTB)); \
        glds16(s1 + (size_t)(t) * str1, (unsigned)__builtin_amdgcn_readfirstlane(d1 + (stg) * lst1)); \
        if (wid < 4) glds16(s2 + (size_t)(t) * 128, (unsigned)__builtin_amdgcn_readfirstlane(d2 + (stg) * VTB)); } while (0)
    const int NTA = 4 * (qbA + 1), NTT = NTA + ((qbB >= 0) ? 4 * (qbB + 1) : 0);
#define ATT_ISSUE_T(T) do { const int T_ = (T); ATT_ISSUE((T_ < NTA) ? T_ : T_ - NTA, slot_of(T_)); } while (0)
    ATT_ISSUE_T(0); ATT_ISSUE_T(1); ATT_ISSUE_T(2); ATT_ISSUE_T(3);
    const int krow = (r32 & 0x13) | ((r32 & 4) << 1) | ((r32 & 8) >> 1);
    const int kc = (krow >> 2) & 3;
    const LAS unsigned char* kbase = lds + L_K + krow * 192;
    const LAS unsigned char* vbase = lds + L_V + r32 * 128;
    const int vx = (r32 >> 1) & 7;
    const int qrel = wid * 32 + r32;
  for (int half = 0; half < ((qbB >= 0) ? 2 : 1); ++half) {
    const int qb = half ? qbB : qbA, TO = half ? NTA : 0;
    const int NT = 4 * (qb + 1);
    const bf16_t* Qw = Q + ((size_t)bh * cfg::S + qb * 256 + wid * 32 + r32) * cfg::DQK + hi * 8;
    bf16x8 qf[6];
#pragma unroll
    for (int d = 0; d < 6; ++d) qf[d] = *(const bf16x8*)(Qw + d * 16);
    f32x16 o0, o1, negm;
#pragma unroll
    for (int r = 0; r < 16; ++r) { o0[r] = 0.f; o1[r] = 0.f; negm[r] = 0.f; }
    float mref = 0.f, l_run = 0.f;
    const int qminw = qb * 256 + wid * 32;
    const int tlast = (qminw + 31) >> 6;
    f32x16 pa0, pa1, pb0, pb1;
    if (wid < 4) ATT_WAITBAR(9); else ATT_WAITBAR(6);
    qk_tile(pa0, pa1, kbase + slot_of(TO) * KTB, qf, negm, hi, kc);
    if (63 > qminw) mask_tile(pa0, pa1, -qb * 256 + 8 * hi, qrel);
#define ATT_ROWMAX(c0, c1, rm) float rm; { float ma = max3(c0[0], c0[1], c1[0]), mb = max3(c0[2], c0[3], c1[1]); ma = max3(ma, c1[2], c1[3]); \
        _Pragma("unroll") for (int r = 4; r < 16; r += 4) { ma = max3(ma, c0[r], c0[r + 1]); mb = max3(mb, c0[r + 2], c0[r + 3]); ma = max3(ma, c1[r], c1[r + 1]); mb = max3(mb, c1[r + 2], c1[r + 3]); } \
        rm = half_swap_max(fmaxf(ma, mb)); }
    { ATT_ROWMAX(pa0, pa1, rm0); mref = rm0;
#pragma unroll
      for (int r = 0; r < 16; ++r) { pa0[r] -= rm0; pa1[r] -= rm0; negm[r] = -rm0; } }
#define ATT_RESCALE(c0, c1, rm) if (__builtin_expect(__any(rm > THR), 0)) { const float dl = fmaxf(rm, 0.f); mref += dl; \
        _Pragma("unroll") for (int r = 0; r < 16; ++r) { c0[r] -= dl; c1[r] -= dl; negm[r] = -mref; } \
        const float f = __builtin_amdgcn_exp2f(-dl); l_run *= f; \
        _Pragma("unroll") for (int r = 0; r < 16; ++r) { o0[r] *= f; o1[r] *= f; } }
    u32x4 pw0, pw1, pw2, pw3;
#define ATT_EXPPACK(c0, c1) do { \
        _Pragma("unroll") for (int r = 0; r < 16; ++r) { c0[r] = __builtin_amdgcn_exp2f(c0[r]); c1[r] = __builtin_amdgcn_exp2f(c1[r]); } \
        f32x2 sacc = {0.f, 0.f}; \
        _Pragma("unroll") for (int r = 0; r < 16; r += 2) { sacc += (f32x2){c0[r], c0[r + 1]}; sacc += (f32x2){c1[r], c1[r + 1]}; } \
        l_run += sacc[0] + sacc[1]; \
        pw0 = (u32x4){cvtpk(c0[0], c0[1]), cvtpk(c0[2], c0[3]), cvtpk(c0[4], c0[5]), cvtpk(c0[6], c0[7])}; \
        pw1 = (u32x4){cvtpk(c0[8], c0[9]), cvtpk(c0[10], c0[11]), cvtpk(c0[12], c0[13]), cvtpk(c0[14], c0[15])}; \
        pw2 = (u32x4){cvtpk(c1[0], c1[1]), cvtpk(c1[2], c1[3]), cvtpk(c1[4], c1[5]), cvtpk(c1[6], c1[7])}; \
        pw3 = (u32x4){cvtpk(c1[8], c1[9]), cvtpk(c1[10], c1[11]), cvtpk(c1[12], c1[13]), cvtpk(c1[14], c1[15])}; } while (0)
#define ATT_PV(slot) do { const LAS unsigned char* vb = vbase + (slot) * VTB; \
        _Pragma("unroll") for (int ks = 0; ks < 4; ++ks) { const int g = (2 * ks + hi) ^ vx; \
            const bf16x8 v0 = *(const LAS bf16x8*)(vb + g * 16), v1 = *(const LAS bf16x8*)(vb + 32 * 128 + g * 16); \
            const bf16x8 pf = __builtin_bit_cast(bf16x8, (ks == 0) ? pw0 : (ks == 1) ? pw1 : (ks == 2) ? pw2 : pw3); \
            o0 = __builtin_amdgcn_mfma_f32_32x32x16_bf16(v0, pf, o0, 0, 0, 0); o1 = __builtin_amdgcn_mfma_f32_32x32x16_bf16(v1, pf, o1, 0, 0, 0); } } while (0)
#define ATT_STEADY(cur0, cur1, nxt0, nxt1, t) do { const int t_ = (t); \
        if (wid < 4) ATT_WAITBAR(6); else ATT_WAITBAR(4);            \
        ATT_ISSUE_T(TO + t_ + 4); \
        ATT_ROWMAX(cur0, cur1, rm_); ATT_RESCALE(cur0, cur1, rm_); \
        bf16x8 vf_[2][2];                                              \
        { const LAS unsigned char* vb_ = vbase + slot_of(TO + t_) * VTB; \
          _Pragma("unroll") for (int ks = 0; ks < 2; ++ks) { const int g = (2 * ks + hi) ^ vx; vf_[ks][0] = *(const LAS bf16x8*)(vb_ + g * 16); vf_[ks][1] = *(const LAS bf16x8*)(vb_ + 32 * 128 + g * 16); } } \
        __builtin_amdgcn_sched_barrier(0); \
        qk_tile(nxt0, nxt1, kbase + slot_of(TO + t_ + 1) * KTB, qf, negm, hi, kc); ATT_EXPPACK(cur0, cur1); \
        { const LAS unsigned char* vb_ = vbase + slot_of(TO + t_) * VTB; \
          _Pragma("unroll") for (int ks = 0; ks < 4; ++ks) { const bf16x8 pf = __builtin_bit_cast(bf16x8, (ks == 0) ? pw0 : (ks == 1) ? pw1 : (ks == 2) ? pw2 : pw3); \
            o0 = __builtin_amdgcn_mfma_f32_32x32x16_bf16(vf_[ks & 1][0], pf, o0, 0, 0, 0); o1 = __builtin_amdgcn_mfma_f32_32x32x16_bf16(vf_[ks & 1][1], pf, o1, 0, 0, 0); \
            if (ks < 2) { const int g = (2 * (ks + 2) + hi) ^ vx; vf_[ks][0] = *(const LAS bf16x8*)(vb_ + g * 16); vf_[ks][1] = *(const LAS bf16x8*)(vb_ + 32 * 128 + g * 16); } } } } while (0)
#define ATT_GENERAL(cur0, cur1, nxt0, nxt1, t) do { const int t_ = (t); \
        if (t_ + 1 < NT) { const int left = NTT - (TO + t_) - 2, nfly = (left < 2) ? left : 2;        \
            if (nfly == 2) { if (wid < 4) ATT_WAITBAR(6); else ATT_WAITBAR(4); } else if (nfly == 1) { if (wid < 4) ATT_WAITBAR(3); else ATT_WAITBAR(2); } else ATT_WAITBAR(0); } \
        if (TO + t_ + 4 < NTT) ATT_ISSUE_T(TO + t_ + 4);        \
        const bool do_cur = (t_ <= tlast), do_next = (t_ + 1 < NT) && (t_ + 1 <= tlast); \
        if (do_cur) { ATT_ROWMAX(cur0, cur1, rm_); ATT_RESCALE(cur0, cur1, rm_); } \
        if (do_next) { qk_tile(nxt0, nxt1, kbase + slot_of(TO + t_ + 1) * KTB, qf, negm, hi, kc); \
            if (64 * (t_ + 1) + 63 > qminw) mask_tile(nxt0, nxt1, 64 * (t_ + 1) - qb * 256 + 8 * hi, qrel); } \
        if (do_cur) { ATT_EXPPACK(cur0, cur1); ATT_PV(slot_of(TO + t_)); } } while (0)
    int t = 0;
    for (; t + 3 <= 4 * qb; t += 2) {
        ATT_STEADY(pa0, pa1, pb0, pb1, t);
        ATT_STEADY(pb0, pb1, pa0, pa1, t + 1);
    }
    if (half == ((qbB >= 0) ? 1 : 0) && tid == 0) knext = __hip_atomic_fetch_add(qhead, 1u, __ATOMIC_RELAXED, __HIP_MEMORY_SCOPE_AGENT);
    for (; t < NT; t += 2) {
        ATT_GENERAL(pa0, pa1, pb0, pb1, t);
        ATT_GENERAL(pb0, pb1, pa0, pa1, t + 1);
    }
#undef ATT_STEADY
#undef ATT_GENERAL
#undef ATT_PV
#undef ATT_EXPPACK
#undef ATT_RESCALE
#undef ATT_ROWMAX
    const float l_tot = half_swap_sum(l_run), inv = 1.f / l_tot;
    float ss = 0.f;
#pragma unroll
    for (int r = 0; r < 16; ++r) { o0[r] *= inv; o1[r] *= inv; ss += o0[r] * o0[r] + o1[r] * o1[r]; }
    ss = half_swap_sum(ss);
    const float rs = __builtin_amdgcn_rsqf(ss * (1.f / cfg::DVH) + cfg::EPS);
    bf16_t* yp = Y + ((size_t)(bh >> 3) * cfg::S + qb * 256 + qrel) * cfg::D + (bh & 7) * cfg::DVH + 8 * hi;
#pragma unroll
    for (int k = 0; k < 2; ++k) {
#pragma unroll
        for (int hf = 0; hf < 2; ++hf) {
            const f32x16& o = hf ? o1 : o0;
            const int ra = 8 * k, rb = 8 * k + 4;
            const unsigned ax = cvtpk(o[ra] * rs, o[ra + 1] * rs), ay = cvtpk(o[ra + 2] * rs, o[ra + 3] * rs);
            const unsigned bx = cvtpk(o[rb] * rs, o[rb + 1] * rs), by = cvtpk(o[rb + 2] * rs, o[rb + 3] * rs);
            const auto sx = __builtin_amdgcn_permlane32_swap(ax, bx, false, false), sy = __builtin_amdgcn_permlane32_swap(ay, by, false, false);
            *(u32x4*)(yp + 32 * hf + 16 * k) = (u32x4){sx[0], sy[0], sx[1], sy[1]};
        }
    }
  }
    ATT_WAITBAR(0);
#undef ATT_ISSUE_T
#undef ATT_ISSUE
}
}
namespace mls {
constexpr int PITCH = 144, VPITCH = 304;
constexpr int O_QN = 0, O_KN = 64 * PITCH, O_VN = 2 * 64 * PITCH, O_G = O_VN + 64 * VPITCH, STAGE = O_G + 1024;
constexpr int O_HS = 2 * STAGE, O_CW = O_HS + 2 * 8 * 64 * 4, L_END = O_CW + (5 * 128) * 4;
static_assert(STAGE % 16 == 0 && O_G % 16 == 0 && O_VN % 16 == 0, "mls LDS map");
typedef short v4i16_t __attribute__((ext_vector_type(4)));
__device__ __forceinline__ s16x4 trrd(const LAS unsigned char* p) { return __builtin_bit_cast(s16x4, __builtin_amdgcn_ds_read_tr16_b64_v4i16((LAS v4i16_t*)p)); }
__device__ __forceinline__ bf16x8 cat8(const s16x4 a, const s16x4 b) { return (bf16x8){a[0], a[1], a[2], a[3], b[0], b[1], b[2], b[3]}; }

struct StageRegs { bf16x8 rq[4], rk[4], rv[2]; float ig, lf; u32x2 og[4]; };

__device__ __forceinline__ void load_stage(StageRegs& R, int b, int h, int c, const bf16_t* __restrict__ QM, const bf16_t* __restrict__ KM, const bf16_t* __restrict__ VM, const bf16_t* __restrict__ OG,
                                           const float* __restrict__ IF, int tid) {
    const int r = tid >> 3, c8 = tid & 7, lane = tid & 63, wid = tid >> 6;
    const int tok = b * cfg::S + c * 64 + r;
#pragma unroll
    for (int j = 0; j < 4; ++j) {
        const bool ok = (c > 0) || (r - 3 + j >= 0);
        const size_t off = (size_t)(tok - 3 + j) * 256 + h * 64 + c8 * 8;
        R.rq[j] = ok ? *(const bf16x8*)(QM + off) : (bf16x8){0, 0, 0, 0, 0, 0, 0, 0};
        R.rk[j] = ok ? *(const bf16x8*)(KM + off) : (bf16x8){0, 0, 0, 0, 0, 0, 0, 0};
    }
    R.rv[0] = *(const bf16x8*)(VM + (size_t)tok * 512 + h * 128 + c8 * 8);
    R.rv[1] = *(const bf16x8*)(VM + (size_t)tok * 512 + h * 128 + 64 + c8 * 8);
    { const size_t tg = (size_t)b * cfg::S + c * 64 + lane; R.ig = IF[tg * 8 + h]; R.lf = IF[tg * 8 + 4 + h]; }
#pragma unroll
    for (int lb = 0; lb < 4; ++lb) R.og[lb] = *(const u32x2*)(OG + ((size_t)b * cfg::S + c * 64 + 16 * lb + (lane & 15)) * 512 + h * 128 + 16 * wid + 4 * ((lane >> 4) & 3));
}
__device__ __forceinline__ void write_stage(const StageRegs& R, LAS unsigned char* st, const LAS float* cw, int tid) {
    const int r = tid >> 3, c8 = tid & 7, lane = tid & 63, wid = tid >> 6;
    float q[8], k[8];
#pragma unroll
    for (int e = 0; e < 8; ++e) { q[e] = cw[512 + 8 * c8 + e]; k[e] = cw[512 + 64 + 8 * c8 + e]; }
#pragma unroll
    for (int j = 0; j < 4; ++j)
#pragma unroll
        for (int e = 0; e < 8; ++e) { q[e] += cw[j * 128 + 8 * c8 + e] * bf2f((unsigned short)R.rq[j][e]); k[e] += cw[j * 128 + 64 + 8 * c8 + e] * bf2f((unsigned short)R.rk[j][e]); }
#pragma unroll
    for (int e = 0; e < 8; ++e) { q[e] = pg8::silu_f(q[e]) * 0.125f; k[e] = pg8::silu_f(k[e]); }
    u32x4 qw, kw; qw.x = cvtpk(q[0], q[1]); qw.y = cvtpk(q[2], q[3]); qw.z = cvtpk(q[4], q[5]); qw.w = cvtpk(q[6], q[7]);
    kw.x = cvtpk(k[0], k[1]); kw.y = cvtpk(k[2], k[3]); kw.z = cvtpk(k[4], k[5]); kw.w = cvtpk(k[6], k[7]);
    *(LAS u32x4*)(st + O_QN + r * PITCH + c8 * 16) = qw;
    *(LAS u32x4*)(st + O_KN + r * PITCH + c8 * 16) = kw;
    *(LAS bf16x8*)(st + O_VN + r * VPITCH + c8 * 16) = R.rv[0];
    *(LAS bf16x8*)(st + O_VN + r * VPITCH + 128 + c8 * 16) = R.rv[1];
    if (wid == 0) {
        float bsum = R.lf;
#pragma unroll
        for (int o = 1; o < 64; o <<= 1) { const float t = __uint_as_float((unsigned)__builtin_amdgcn_ds_bpermute((lane - o) << 2, (int)__float_as_uint(bsum))); if (lane >= o) bsum += t; }
        const float u = R.ig - bsum; float cm = u;
#pragma unroll
        for (int o = 1; o < 64; o <<= 1) { const float t = __uint_as_float((unsigned)__builtin_amdgcn_ds_bpermute((lane - o) << 2, (int)__float_as_uint(cm))); if (lane >= o) cm = fmaxf(cm, t); }
        LAS float* G = (LAS float*)(st + O_G);
        G[lane] = bsum; G[64 + lane] = u; G[128 + lane] = cm;
        if (lane == 63) { G[192] = bsum; G[193] = cm; }
    }
}

__device__ __forceinline__ void mlstm_unit(LAS unsigned char* lds, int b, int h, const bf16_t* __restrict__ QM, const bf16_t* __restrict__ KM, const bf16_t* __restrict__ VM, const bf16_t* __restrict__ OG,
                                           const float* __restrict__ IF, const float* __restrict__ convw, const float* __restrict__ convb, bf16_t* __restrict__ Y) {
    int tid_ = threadIdx.x; asm volatile("" : "+v"(tid_));
    const int tid = tid_, lane = tid & 63, fr = lane & 15, g = lane >> 4;
    const int wid = __builtin_amdgcn_readfirstlane(tid >> 6);
    LAS float* cw = (LAS float*)(lds + O_CW);
    for (int i = tid; i < 640; i += 512) { const int j = i >> 7, ch = i & 127; const int gch = (ch < 64) ? (h * 64 + ch) : (256 + h * 64 + ch - 64);
        cw[i] = (j < 4) ? convw[j * 512 + gch] : convb[gch]; }
    __syncthreads();
    StageRegs R;
    load_stage(R, b, h, 0, QM, KM, VM, OG, IF, tid);
    write_stage(R, lds, cw, tid);
    __syncthreads();
    f32x4 C[4][2];
#pragma unroll
    for (int kb = 0; kb < 4; ++kb) { C[kb][0] = (f32x4){0.f, 0.f, 0.f, 0.f}; C[kb][1] = (f32x4){0.f, 0.f, 0.f, 0.f}; }
    float m_prev = 0.f;
    const bf16x8 ones = {0x3F80, 0x3F80, 0x3F80, 0x3F80, 0x3F80, 0x3F80, 0x3F80, 0x3F80};
    const int trV = (fr >> 2) * VPITCH + (16 * wid + 4 * (fr & 3)) * 2;
    const int trK = (fr >> 2) * PITCH + (4 * (fr & 3)) * 2;
    for (int c = 0; c < cfg::NCHUNK; ++c) {
        const LAS unsigned char* st = lds + (c & 1) * STAGE;
        LAS unsigned char* stn = lds + ((c + 1) & 1) * STAGE;
        const u32x2 og0 = R.og[0], og1 = R.og[1], og2 = R.og[2], og3 = R.og[3];
        if (c + 1 < cfg::NCHUNK) load_stage(R, b, h, c + 1, QM, KM, VM, OG, IF, tid);
        const LAS float* G = (const LAS float*)(st + O_G);
        const float b_end = G[192], umax = G[193];
        bf16x8 Cf[2][2];
#pragma unroll
        for (int c2 = 0; c2 < 2; ++c2)
#pragma unroll
            for (int p2 = 0; p2 < 2; ++p2) { u32x4 w; w.x = cvtpk(C[2 * p2][c2][0], C[2 * p2][c2][1]); w.y = cvtpk(C[2 * p2][c2][2], C[2 * p2][c2][3]);
                w.z = cvtpk(C[2 * p2 + 1][c2][0], C[2 * p2 + 1][c2][1]); w.w = cvtpk(C[2 * p2 + 1][c2][2], C[2 * p2 + 1][c2][3]); Cf[c2][p2] = __builtin_bit_cast(bf16x8, w); }
        f32x4 hv[4]; float hsq[4];
#pragma unroll
        for (int lb = 0; lb < 4; ++lb) {
            const int l = 16 * lb + fr;
            const float wl = fmaxf(m_prev, G[128 + l]), bl = G[l];
            const LAS unsigned char* qrow = st + O_QN + l * PITCH;
            const bf16x8 qa0 = *(const LAS bf16x8*)(qrow + g * 16), qa1 = *(const LAS bf16x8*)(qrow + 64 + g * 16);
            u32x4 Pw[2] = {(u32x4){0u, 0u, 0u, 0u}, (u32x4){0u, 0u, 0u, 0u}};
#pragma unroll
            for (int sb = 0; sb <= lb; ++sb) {
                const LAS unsigned char* krow = st + O_KN + (16 * sb + fr) * PITCH;
                const bf16x8 ka0 = *(const LAS bf16x8*)(krow + g * 16), ka1 = *(const LAS bf16x8*)(krow + 64 + g * 16);
                f32x4 s4 = (f32x4){0.f, 0.f, 0.f, 0.f};
                s4 = __builtin_amdgcn_mfma_f32_16x16x32_bf16(ka0, qa0, s4, 0, 0, 0); s4 = __builtin_amdgcn_mfma_f32_16x16x32_bf16(ka1, qa1, s4, 0, 0, 0);
                const f32x4 u4 = *(const LAS f32x4*)(st + O_G + (64 + 16 * sb + 4 * g) * 4);
                float pv[4];
#pragma unroll
                for (int r = 0; r < 4; ++r) { float e = __builtin_amdgcn_exp2f((u4[r] - wl) * cfg::LOG2E) * s4[r]; if (sb == lb && 4 * g + r > fr) e = 0.f; pv[r] = e; }
                if (sb & 1) { Pw[sb >> 1].z = cvtpk(pv[0], pv[1]); Pw[sb >> 1].w = cvtpk(pv[2], pv[3]); } else { Pw[sb >> 1].x = cvtpk(pv[0], pv[1]); Pw[sb >> 1].y = cvtpk(pv[2], pv[3]); }
            }
            f32x4 H0 = (f32x4){0.f, 0.f, 0.f, 0.f}, H1 = H0, I0 = H0, I1 = H0;
#pragma unroll
            for (int p = 0; p <= (lb >> 1); ++p) {
                const LAS unsigned char* vblk = st + O_VN + (32 * p + 4 * g) * VPITCH + trV;
                const bf16x8 vf = cat8(trrd(vblk), trrd(vblk + 16 * VPITCH));
                const bf16x8 pf = __builtin_bit_cast(bf16x8, Pw[p]);
                H0 = __builtin_amdgcn_mfma_f32_16x16x32_bf16(vf, pf, H0, 0, 0, 0); H1 = __builtin_amdgcn_mfma_f32_16x16x32_bf16(ones, pf, H1, 0, 0, 0);
            }
#pragma unroll
            for (int p2 = 0; p2 < 2; ++p2) {
                const u32x2 qa = *(const LAS u32x2*)(qrow + (32 * p2 + 4 * g) * 2), qb2 = *(const LAS u32x2*)(qrow + (32 * p2 + 16 + 4 * g) * 2);
                const bf16x8 qp = __builtin_bit_cast(bf16x8, (u32x4){qa.x, qa.y, qb2.x, qb2.y});
                I0 = __builtin_amdgcn_mfma_f32_16x16x32_bf16(Cf[0][p2], qp, I0, 0, 0, 0); I1 = __builtin_amdgcn_mfma_f32_16x16x32_bf16(Cf[1][p2], qp, I1, 0, 0, 0);
            }
            const float ei = __builtin_amdgcn_exp2f((m_prev - wl) * cfg::LOG2E);
            const float den = ei * I1[0] + H1[0];
            const float bound = __builtin_amdgcn_exp2f(-(bl + wl) * cfg::LOG2E);
            const float rden = 1.f / fmaxf(fabsf(den), bound);
            float sq = 0.f;
#pragma unroll
            for (int r = 0; r < 4; ++r) { hv[lb][r] = (ei * I0[r] + H0[r]) * rden; sq += hv[lb][r] * hv[lb][r]; }
            hsq[lb] = pg8::quad_sum(sq);
        }
        { LAS float* hs = (LAS float*)(lds + O_HS) + (c & 1) * 512 + wid * 64;
          if (g == 0) {
#pragma unroll
              for (int lb = 0; lb < 4; ++lb) hs[16 * lb + fr] = hsq[lb]; } }
        { const float mx = fmaxf(m_prev, umax);
          const float d_old = __builtin_amdgcn_exp2f((m_prev - mx) * cfg::LOG2E), d_new = __builtin_amdgcn_exp2f((umax - mx) * cfg::LOG2E);
          m_prev = b_end + mx;
#pragma unroll
          for (int kb = 0; kb < 4; ++kb) { C[kb][0] = C[kb][0] * d_old; C[kb][1] = C[kb][1] * d_old; }
#pragma unroll
          for (int ks = 0; ks < 2; ++ks) {
              const f32x4 ua = *(const LAS f32x4*)(st + O_G + (64 + 32 * ks + 8 * g) * 4), ub = *(const LAS f32x4*)(st + O_G + (64 + 32 * ks + 8 * g + 4) * 4);
              float ee[8];
#pragma unroll
              for (int j = 0; j < 4; ++j) { ee[j] = __builtin_amdgcn_exp2f((ua[j] - umax) * cfg::LOG2E) * d_new; ee[4 + j] = __builtin_amdgcn_exp2f((ub[j] - umax) * cfg::LOG2E) * d_new; }
              const LAS unsigned char* vblk = st + O_VN + (32 * ks + 8 * g) * VPITCH + trV;
              const s16x4 va = trrd(vblk), vb4 = trrd(vblk + 4 * VPITCH);
              u32x4 ve, eo;
              ve.x = cvtpk(bf2f((unsigned short)va[0]) * ee[0], bf2f((unsigned short)va[1]) * ee[1]); ve.y = cvtpk(bf2f((unsigned short)va[2]) * ee[2], bf2f((unsigned short)va[3]) * ee[3]);
              ve.z = cvtpk(bf2f((unsigned short)vb4[0]) * ee[4], bf2f((unsigned short)vb4[1]) * ee[5]); ve.w = cvtpk(bf2f((unsigned short)vb4[2]) * ee[6], bf2f((unsigned short)vb4[3]) * ee[7]);
              eo.x = cvtpk(ee[0], ee[1]); eo.y = cvtpk(ee[2], ee[3]); eo.z = cvtpk(ee[4], ee[5]); eo.w = cvtpk(ee[6], ee[7]);
              const bf16x8 vef = __builtin_bit_cast(bf16x8, ve), eof = __builtin_bit_cast(bf16x8, eo);
#pragma unroll
              for (int kb = 0; kb < 4; ++kb) {
                  const LAS unsigned char* kblk = st + O_KN + (32 * ks + 8 * g) * PITCH + 32 * kb + trK;
                  const bf16x8 kt = cat8(trrd(kblk), trrd(kblk + 4 * PITCH));
                  C[kb][0] = __builtin_amdgcn_mfma_f32_16x16x32_bf16(kt, vef, C[kb][0], 0, 0, 0); C[kb][1] = __builtin_amdgcn_mfma_f32_16x16x32_bf16(kt, eof, C[kb][1], 0, 0, 0);
              }
          } }
        if (c + 1 < cfg::NCHUNK) write_stage(R, stn, cw, tid);
        asm volatile("s_waitcnt lgkmcnt(0)\n\ts_barrier" ::: "memory");
        { const LAS float* hsr = (const LAS float*)(lds + O_HS) + (c & 1) * 512;
          const size_t tok0 = (size_t)b * cfg::S + c * 64;
#pragma unroll
          for (int lb = 0; lb < 4; ++lb) { const int l = 16 * lb + fr; float tot = 0.f;
#pragma unroll
              for (int w = 0; w < 8; ++w) tot += hsr[w * 64 + l];
              const float rs = __builtin_amdgcn_rsqf(tot * (1.f / cfg::MDV) + cfg::EPS);
              const u32x2 og = (lb == 0) ? og0 : (lb == 1) ? og1 : (lb == 2) ? og2 : og3;
              u32x2 o; o.x = cvtpk(hv[lb][0] * rs * bflo(og.x), hv[lb][1] * rs * bfhi(og.x)); o.y = cvtpk(hv[lb][2] * rs * bflo(og.y), hv[lb][3] * rs * bfhi(og.y));
              *(u32x2*)(Y + (tok0 + l) * cfg::D + 512 + h * 128 + 16 * wid + 4 * g) = o; } }
    }
    __syncthreads();
}
}
#ifndef MK_PER_PHASE
#define MK_PER_PHASE 0
#endif
constexpr int LDS_BYTES = 147456, MISC_OFF = 131072 + 320, RSTAB_OFF = 131072 + 1024;
constexpr int NPHASE = 34;

struct Params { const float* in[24]; float* out; unsigned char* ws; int ph_lo, ph_hi, li, pad; };

struct MapId { __device__ __forceinline__ int operator()(int n) const { return n; } };
struct MapGate { int up; __device__ __forceinline__ int operator()(int n) const { return ((n >> 7) << 8) + up * 128 + (n & 127); } };
struct MapWin { __device__ __forceinline__ int operator()(int n) const {
    if (n < 384) return n;
    if (n < 416) { const int i = n - 384; return 384 + ((i < 16) ? 2 * i : 2 * (i - 16) + 1); }
    if (n < 1952) return n + 96;
    return n - 1952 + 416; } };
struct MapUq { __device__ __forceinline__ int operator()(int n) const { const int h = n / 96, d = n - h * 96; if (d < 64) return n; const int i = d - 64; return h * 96 + 64 + ((i < 16) ? 2 * i : 2 * (i - 16) + 1); } };
struct MapKv { __device__ __forceinline__ int operator()(int n) const { const int h = n >> 7, j = n & 127; return (j < 64) ? (h * 64 + j) : (512 + h * 64 + j - 64); } };
template <class Map> __device__ __forceinline__ void conv_item(const float* __restrict__ W, int K, int N, bf16_t* WT, const float* gA, const float* gB, int gsplit, const Map dst, LAS float* scr, int item, int lane) {
    const int nblk = (N + 31) >> 5, kb = item / nblk, nb = item - kb * nblk, k0 = 64 * kb, n0 = 32 * nb, n = n0 + 4 * (lane & 7);
#pragma unroll
    for (int i = 0; i < 8; ++i) { const int kk = 8 * i + (lane >> 3), k = k0 + kk; float gv = 1.f; if (gA) gv = (k < gsplit) ? gA[k] : gB[k - gsplit];
        f32x4 v = (f32x4){0.f, 0.f, 0.f, 0.f}; if (n < N) v = *(const f32x4*)(W + (size_t)k * N + n);
        LAS float* d = scr + kk * 33 + 4 * (lane & 7); d[0] = v[0] * gv; d[1] = v[1] * gv; d[2] = v[2] * gv; d[3] = v[3] * gv; }
    asm volatile("s_waitcnt lgkmcnt(0)" ::: "memory");
    const int c = lane & 7;
#pragma unroll
    for (int j = 0; j < 4; ++j) { const int nn = (lane >> 3) + 8 * j, nd = n0 + nn; const LAS float* s = scr + (8 * c) * 33 + nn;
        if (nd < N) { u32x4 o; o.x = cvtpk(s[0 * 33], s[1 * 33]); o.y = cvtpk(s[2 * 33], s[3 * 33]); o.z = cvtpk(s[4 * 33], s[5 * 33]); o.w = cvtpk(s[6 * 33], s[7 * 33]);
            *(u32x4*)(WT + (size_t)dst(nd) * K + k0 + 8 * c) = o; } }
    asm volatile("s_waitcnt lgkmcnt(0)" ::: "memory");
}
__device__ __forceinline__ float wave_sum(float v, int lane) {
#pragma unroll
    for (int o = 1; o < 64; o <<= 1) v += __uint_as_float((unsigned)__builtin_amdgcn_ds_bpermute((lane ^ o) << 2, (int)__float_as_uint(v)));
    return v;
}

__global__ void __launch_bounds__(512, 2) hymba_fwd(Params P) {
    extern __shared__ __attribute__((aligned(16))) unsigned char lds_raw[];
    LAS unsigned char* lds = (LAS unsigned char*)lds_raw;
    volatile LAS unsigned* MISC = (volatile LAS unsigned*)(lds + MISC_OFF);
    const int G = gridDim.x, bx = blockIdx.x;
#define LOCAL_TID() int tid = threadIdx.x; asm volatile("" : "+v"(tid)); const int lane = tid & 63, wave = __builtin_amdgcn_readfirstlane(tid >> 6), gw = bx * 8 + wave, NGW = G * 8; (void)lane; (void)gw; (void)NGW
    gu32* ctl = (gu32*)(P.ws + ws::CTL);
    { LOCAL_TID(); for (int u = tid; u < 32; u += 512) MISC[u] = 0u; }
    __syncthreads();
#if MK_PER_PHASE
    const int lo = P.ph_lo;
#else
    (void)xcd_barrier_post((unsigned*)ctl + ws::CW_BAR, MISC + 8);
#endif
#ifndef ATT_PROBE_VAR
#define ATT_PROBE_VAR 0
#endif
#ifndef PROBE_DOUBLE
#define PROBE_DOUBLE 0
#endif
#ifndef PH_MASK
#define PH_MASK 0xffff
#endif
#if MK_PER_PHASE
#define IN(k) (lo == (k))
#define SEAM(k) do { } while (0)
#else
#define IN(k) true
#define SEAM(k) do { XcdBarrier b_; unsigned* bp_ = (unsigned*)(P.ws + ws::CTL) + ws::CW_BAR; asm volatile("" : "+s"(bp_)); b_.bar = bp_; b_.x = (unsigned)__builtin_amdgcn_readfirstlane((int)xb_xcc_id()); b_.st = MISC + 8; xcd_barrier(b_); } while (0)
#endif
#define LAUNDER_W() GAS unsigned char* Wg_ = (GAS unsigned char*)P.ws; asm volatile("" : "+s"(Wg_)); unsigned char* W = (unsigned char*)Wg_

    if ((PH_MASK & 1) && IN(0)) {
        LOCAL_TID(); LAUNDER_W(); float* const ssqx = (float*)(W + ws::SSQX); bf16_t* const XBp = (bf16_t*)(W + ws::XB);
        LAS float* scr = (LAS float*)(lds + wave * 16384);
        constexpr int I_FF = 16 * 88, I_DN = 44 * 32, I_IN = 16 * 62, I_UQ = 4 * 24, I_KV = 2 * 32, I_O = 16 * 32;
        constexpr int I_LAYER = 4 * I_FF + 2 * I_DN + I_IN + I_UQ + I_KV + I_O;
        for (int it = gw; it < cfg::DEPTH * I_LAYER; it += NGW) {
            const int l = it / I_LAYER; int r = it - l * I_LAYER;
            unsigned char* wl = W + ws::WBASE + (size_t)l * ws::WLAYER;
            const size_t oFF = (size_t)l * cfg::D * cfg::FF;
            if (r < I_FF) { conv_item(P.in[3] + oFF, 1024, 2816, (bf16_t*)(wl + ws::W_GU1), P.in[2] + l * 1024, nullptr, 1024, MapGate{0}, scr, r, lane); continue; } r -= I_FF;
            if (r < I_FF) { conv_item(P.in[4] + oFF, 1024, 2816, (bf16_t*)(wl + ws::W_GU1), P.in[2] + l * 1024, nullptr, 1024, MapGate{1}, scr, r, lane); continue; } r -= I_FF;
            if (r < I_DN) { conv_item(P.in[5] + oFF, 2816, 1024, (bf16_t*)(wl + ws::W_D1), nullptr, nullptr, 0, MapId{}, scr, r, lane); continue; } r -= I_DN;
            if (r < I_FF) { conv_item(P.in[20] + oFF, 1024, 2816, (bf16_t*)(wl + ws::W_GU2), P.in[19] + l * 1024, nullptr, 1024, MapGate{0}, scr, r, lane); continue; } r -= I_FF;
            if (r < I_FF) { conv_item(P.in[21] + oFF, 1024, 2816, (bf16_t*)(wl + ws::W_GU2), P.in[19] + l * 1024, nullptr, 1024, MapGate{1}, scr, r, lane); continue; } r -= I_FF;
            if (r < I_DN) { conv_item(P.in[22] + oFF, 2816, 1024, (bf16_t*)(wl + ws::W_D2), nullptr, nullptr, 0, MapId{}, scr, r, lane); continue; } r -= I_DN;
            if (r < I_IN) { conv_item(P.in[7] + (size_t)l * 1024 * cfg::DIN, 1024, cfg::DIN, (bf16_t*)(wl + ws::W_IN), P.in[6] + l * 1024, nullptr, 1024, MapWin{}, scr, r, lane); continue; } r -= I_IN;
            if (r < I_UQ) { conv_item(P.in[9] + (size_t)l * 256 * 768, 256, 768, (bf16_t*)(wl + ws::W_UQ), P.in[8] + l * 256, nullptr, 256, MapUq{}, scr, r, lane); continue; } r -= I_UQ;
            if (r < I_KV) { conv_item(P.in[11] + (size_t)l * 128 * 1024, 128, 1024, (bf16_t*)(wl + ws::W_KV), P.in[10] + l * 128, nullptr, 128, MapKv{}, scr, r, lane); continue; } r -= I_KV;
            conv_item(P.in[18] + (size_t)l * 1024 * 1024, 1024, 1024, (bf16_t*)(wl + ws::W_O), P.in[16] + l * 512, P.in[17] + l * 512, 512, MapId{}, scr, r, lane);
        }
        for (int i = bx * 512 + tid; i < cfg::DEPTH * 88 * 128; i += G * 512) { const int l = i / (88 * 128), r = i - l * (88 * 128);
            *(u32x4*)(W + ws::WBASE + (size_t)l * ws::WLAYER + ws::W_IN + (size_t)424 * 2048 + (size_t)r * 16) = (u32x4){0u, 0u, 0u, 0u}; }
#ifdef NANFILL
        for (size_t i = (size_t)bx * 512 + tid; i < (NANFILL_BYTES >> 4); i += (size_t)G * 512) *(u32x4*)(W + NANFILL_OFF + i * 16) = (u32x4){0xffffffffu, 0xffffffffu, 0xffffffffu, 0xffffffffu};
#endif
        for (int i = bx * 512 + tid; i < cfg::DEPTH * 2568; i += G * 512) { const int l = i / 2568, r = i - l * 2568;
            const float v = (r < 2048) ? P.in[12][l * 2048 + r] : (r < 2560) ? P.in[13][l * 512 + r - 2048] : (r < 2564) ? P.in[14][l * 4 + r - 2560] : P.in[15][l * 4 + r - 2564];
            ((float*)(W + ws::SMALLP))[l * 4096 + r] = v; }
        for (int i = bx * 512 + tid; i < cfg::M * 16; i += G * 512) { const int tok = i >> 4, k = i & 15;
            const float inv = exp2f(-(float)k * (13.287712379549449f / 16.f)); const float ang = (float)((const int*)P.in[1])[tok] * inv;
            float sn, cs; sincosf(ang, &sn, &cs); ((f32x2*)(W + ws::ROPE))[i] = (f32x2){cs, sn}; }
        for (int m = gw; m < cfg::M; m += NGW) {
            const f32x4* xr = (const f32x4*)(P.in[0] + (size_t)m * cfg::D) + 4 * lane; f32x4 v[4]; float s = 0.f;
#pragma unroll
            for (int j = 0; j < 4; ++j) { v[j] = xr[j]; s += (v[j][0] * v[j][0] + v[j][1] * v[j][1]) + (v[j][2] * v[j][2] + v[j][3] * v[j][3]); }
            s = wave_sum(s, lane);
            u32x4* o16 = (u32x4*)(XBp + (size_t)m * cfg::D) + 2 * lane;
            o16[0] = (u32x4){cvtpk(v[0][0], v[0][1]), cvtpk(v[0][2], v[0][3]), cvtpk(v[1][0], v[1][1]), cvtpk(v[1][2], v[1][3])};
            o16[1] = (u32x4){cvtpk(v[2][0], v[2][1]), cvtpk(v[2][2], v[2][3]), cvtpk(v[3][0], v[3][1]), cvtpk(v[3][2], v[3][3])};
            if (lane < 16) ssqx[(size_t)m * 16 + lane] = (lane == 0) ? s : 0.f;
        }
        __syncthreads();
    }
    SEAM(0);
#if PROBE_DOUBLE == 9
    if ((PH_MASK & 1) && IN(0)) {
        LOCAL_TID(); LAUNDER_W(); float* const ssqx = (float*)(W + ws::SSQX); bf16_t* const XBp = (bf16_t*)(W + ws::XB);
        LAS float* scr = (LAS float*)(lds + wave * 16384);
        constexpr int I_FF = 16 * 88, I_DN = 44 * 32, I_IN = 16 * 62, I_UQ = 4 * 24, I_KV = 2 * 32, I_O = 16 * 32;
        constexpr int I_LAYER = 4 * I_FF + 2 * I_DN + I_IN + I_UQ + I_KV + I_O;
        for (int it = gw; it < cfg::DEPTH * I_LAYER; it += NGW) {
            const int l = it / I_LAYER; int r = it - l * I_LAYER;
            unsigned char* wl = W + ws::WBASE + (size_t)l * ws::WLAYER;
            const size_t oFF = (size_t)l * cfg::D * cfg::FF;
            if (r < I_FF) { conv_item(P.in[3] + oFF, 1024, 2816, (bf16_t*)(wl + ws::W_GU1), P.in[2] + l * 1024, nullptr, 1024, MapGate{0}, scr, r, lane); continue; } r -= I_FF;
            if (r < I_FF) { conv_item(P.in[4] + oFF, 1024, 2816, (bf16_t*)(wl + ws::W_GU1), P.in[2] + l * 1024, nullptr, 1024, MapGate{1}, scr, r, lane); continue; } r -= I_FF;
            if (r < I_DN) { conv_item(P.in[5] + oFF, 2816, 1024, (bf16_t*)(wl + ws::W_D1), nullptr, nullptr, 0, MapId{}, scr, r, lane); continue; } r -= I_DN;
            if (r < I_FF) { conv_item(P.in[20] + oFF, 1024, 2816, (bf16_t*)(wl + ws::W_GU2), P.in[19] + l * 1024, nullptr, 1024, MapGate{0}, scr, r, lane); continue; } r -= I_FF;
            if (r < I_FF) { conv_item(P.in[21] + oFF, 1024, 2816, (bf16_t*)(wl + ws::W_GU2), P.in[19] + l * 1024, nullptr, 1024, MapGate{1}, scr, r, lane); continue; } r -= I_FF;
            if (r < I_DN) { conv_item(P.in[22] + oFF, 2816, 1024, (bf16_t*)(wl + ws::W_D2), nullptr, nullptr, 0, MapId{}, scr, r, lane); continue; } r -= I_DN;
            if (r < I_IN) { conv_item(P.in[7] + (size_t)l * 1024 * cfg::DIN, 1024, cfg::DIN, (bf16_t*)(wl + ws::W_IN), P.in[6] + l * 1024, nullptr, 1024, MapWin{}, scr, r, lane); continue; } r -= I_IN;
            if (r < I_UQ) { conv_item(P.in[9] + (size_t)l * 256 * 768, 256, 768, (bf16_t*)(wl + ws::W_UQ), P.in[8] + l * 256, nullptr, 256, MapUq{}, scr, r, lane); continue; } r -= I_UQ;
            if (r < I_KV) { conv_item(P.in[11] + (size_t)l * 128 * 1024, 128, 1024, (bf16_t*)(wl + ws::W_KV), P.in[10] + l * 128, nullptr, 128, MapKv{}, scr, r, lane); continue; } r -= I_KV;
            conv_item(P.in[18] + (size_t)l * 1024 * 1024, 1024, 1024, (bf16_t*)(wl + ws::W_O), P.in[16] + l * 512, P.in[17] + l * 512, 512, MapId{}, scr, r, lane);
        }
        for (int i = bx * 512 + tid; i < cfg::DEPTH * 88 * 128; i += G * 512) { const int l = i / (88 * 128), r = i - l * (88 * 128);
            *(u32x4*)(W + ws::WBASE + (size_t)l * ws::WLAYER + ws::W_IN + (size_t)424 * 2048 + (size_t)r * 16) = (u32x4){0u, 0u, 0u, 0u}; }
#ifdef NANFILL
        for (size_t i = (size_t)bx * 512 + tid; i < (NANFILL_BYTES >> 4); i += (size_t)G * 512) *(u32x4*)(W + NANFILL_OFF + i * 16) = (u32x4){0xffffffffu, 0xffffffffu, 0xffffffffu, 0xffffffffu};
#endif
        for (int i = bx * 512 + tid; i < cfg::DEPTH * 2568; i += G * 512) { const int l = i / 2568, r = i - l * 2568;
            const float v = (r < 2048) ? P.in[12][l * 2048 + r] : (r < 2560) ? P.in[13][l * 512 + r - 2048] : (r < 2564) ? P.in[14][l * 4 + r - 2560] : P.in[15][l * 4 + r - 2564];
            ((float*)(W + ws::SMALLP))[l * 4096 + r] = v; }
        for (int i = bx * 512 + tid; i < cfg::M * 16; i += G * 512) { const int tok = i >> 4, k = i & 15;
            const float inv = exp2f(-(float)k * (13.287712379549449f / 16.f)); const float ang = (float)((const int*)P.in[1])[tok] * inv;
            float sn, cs; sincosf(ang, &sn, &cs); ((f32x2*)(W + ws::ROPE))[i] = (f32x2){cs, sn}; }
        for (int m = gw; m < cfg::M; m += NGW) {
            const f32x4* xr = (const f32x4*)(P.in[0] + (size_t)m * cfg::D) + lane; f32x4 v[4]; float s = 0.f;
#pragma unroll
            for (int j = 0; j < 4; ++j) { v[j] = xr[64 * j]; s += (v[j][0] * v[j][0] + v[j][1] * v[j][1]) + (v[j][2] * v[j][2] + v[j][3] * v[j][3]); }
            s = wave_sum(s, lane);
            u32x2* o8 = (u32x2*)(XBp + (size_t)m * cfg::D) + lane;
#pragma unroll
            for (int j = 0; j < 4; ++j) { u32x2 w; w.x = cvtpk(v[j][0], v[j][1]); w.y = cvtpk(v[j][2], v[j][3]); o8[64 * j] = w; }
            if (lane < 16) ssqx[(size_t)m * 16 + lane] = (lane == 0) ? s : 0.f;
        }
        __syncthreads();
    }
    SEAM(0);
#endif

    { constexpr int l = 0;
        const int pb = 1 + 8 * l;
        if ((PH_MASK & 2) && IN(pb + 0)) {
            LAUNDER_W(); unsigned char* wl = W + ws::WBASE + (size_t)l * ws::WLAYER;
            pg8::Gemm g{(const bf16_t*)(W + ws::XB), (const bf16_t*)(wl + ws::W_GU1), cfg::M, 2 * cfg::FF, cfg::D}; pg8::StaticOrder S; S.init(cfg::M, 2 * cfg::FF, G, bx);
            const int gid0_ = pg8::rstd_table((LAS float*)(lds + RSTAB_OFF), S, pg8::ssqx_buf(W, 3 * l), (int)threadIdx.x);
            pg8::EpiSwiGLU E{W, 3 * l, (const LAS float*)(lds + RSTAB_OFF), gid0_};
            pg8::gemm_phase<pg8::EpiSwiGLU, pg8::StaticOrder, true, true>(lds, g, S, E);
        }
        SEAM(pb + 0);
#if PROBE_DOUBLE == 1
        if ((PH_MASK & 2) && IN(pb + 0)) {
            LAUNDER_W(); unsigned char* wl = W + ws::WBASE + (size_t)l * ws::WLAYER;
            pg8::Gemm g{(const bf16_t*)(W + ws::XB), (const bf16_t*)(wl + ws::W_GU1), cfg::M, 2 * cfg::FF, cfg::D}; pg8::StaticOrder S; S.init(cfg::M, 2 * cfg::FF, G, bx);
            const int gid0_ = pg8::rstd_table((LAS float*)(lds + RSTAB_OFF), S, pg8::ssqx_buf(W, 3 * l), (int)threadIdx.x);
            pg8::EpiSwiGLU E{W, 3 * l, (const LAS float*)(lds + RSTAB_OFF), gid0_};
            pg8::gemm_phase<pg8::EpiSwiGLU, pg8::StaticOrder, true, true>(lds, g, S, E);
        }
        SEAM(pb + 0);
#endif
#if PROBE_DOUBLE == 11
        if ((PH_MASK & 2) && IN(pb + 0)) {
            LAUNDER_W(); unsigned char* wl = W + ws::WBASE + (size_t)l * ws::WLAYER;
            pg8::Gemm g{(const bf16_t*)(W + ws::XB), (const bf16_t*)(wl + ws::W_GU1), cfg::M, 2 * cfg::FF, cfg::D}; pg8::StaticOrder S; S.init(cfg::M, 2 * cfg::FF, G, bx);
            pg8::EpiNull E{P.out};
            pg8::gemm_phase<pg8::EpiNull, pg8::StaticOrder, true, true>(lds, g, S, E);
        }
        SEAM(pb + 0);
#endif
        if ((PH_MASK & 4) && IN(pb + 1)) {
            LAUNDER_W(); unsigned char* wl = W + ws::WBASE + (size_t)l * ws::WLAYER;
            pg8::Gemm g{(const bf16_t*)(W + ws::H), (const bf16_t*)(wl + ws::W_D1), cfg::M, cfg::D, cfg::FF}; pg8::StaticOrder S; S.init(cfg::M, cfg::D, G, bx);
            pg8::EpiResid E{W, 3 * l + 1, 0.5f};
            pg8::gemm_phase<pg8::EpiResid, pg8::StaticOrder, true, true>(lds, g, S, E);
        }
        SEAM(pb + 1);
#if PROBE_DOUBLE == 2
        if ((PH_MASK & 4) && IN(pb + 1)) {
            LAUNDER_W(); unsigned char* wl = W + ws::WBASE + (size_t)l * ws::WLAYER;
            pg8::Gemm g{(const bf16_t*)(W + ws::H), (const bf16_t*)(wl + ws::W_D1), cfg::M, cfg::D, cfg::FF}; pg8::StaticOrder S; S.init(cfg::M, cfg::D, G, bx);
            pg8::EpiResid E{W, 3 * l + 1, 0.0f};
            pg8::gemm_phase<pg8::EpiResid, pg8::StaticOrder, true, true>(lds, g, S, E);
        }
        SEAM(pb + 1);
#endif
        if ((PH_MASK & 8) && IN(pb + 2)) {
            LAUNDER_W(); unsigned char* wl = W + ws::WBASE + (size_t)l * ws::WLAYER;
            pg8::Gemm g{(const bf16_t*)(W + ws::XB), (const bf16_t*)(wl + ws::W_IN), cfg::M, cfg::DINP, cfg::D}; pg8::StaticOrder S; S.init(cfg::M, cfg::DINP, G, bx);
            pg8::EpiWin E{W, l};
            pg8::gemm_phase<pg8::EpiWin, pg8::StaticOrder, true, true>(lds, g, S, E);
        }
        SEAM(pb + 2);
#if PROBE_DOUBLE == 3
        if ((PH_MASK & 8) && IN(pb + 2)) {
            LAUNDER_W(); unsigned char* wl = W + ws::WBASE + (size_t)l * ws::WLAYER;
            pg8::Gemm g{(const bf16_t*)(W + ws::XB), (const bf16_t*)(wl + ws::W_IN), cfg::M, cfg::DINP, cfg::D}; pg8::StaticOrder S; S.init(cfg::M, cfg::DINP, G, bx);
            pg8::EpiWin E{W, l};
            pg8::gemm_phase<pg8::EpiWin, pg8::StaticOrder, true, true>(lds, g, S, E);
        }
        SEAM(pb + 2);
#endif
        if ((PH_MASK & (16 | 512 | 1024)) && IN(pb + 3)) {
            if (PH_MASK & 16) { LAUNDER_W(); unsigned char* wl = W + ws::WBASE + (size_t)l * ws::WLAYER;
              pg8::Gemm g{(const bf16_t*)(W + ws::CQ), (const bf16_t*)(wl + ws::W_UQ), cfg::M, 768, 256}; pg8::StaticOrder S; S.init(cfg::M, 768, G, bx);
              pg8::EpiQ E{W, l};
              pg8::gemm_phase<pg8::EpiQ, pg8::StaticOrder, true, true>(lds, g, S, E); }
            if (PH_MASK & 512) { LAUNDER_W(); unsigned char* wl = W + ws::WBASE + (size_t)l * ws::WLAYER;
              pg8::Gemm g{(const bf16_t*)(W + ws::CKV), (const bf16_t*)(wl + ws::W_KV), cfg::M, 512, 128}; pg8::StaticOrder S; S.init(cfg::M, 512, G, bx);
              pg8::EpiKN E{W, l};
              pg8::gemm_phase<pg8::EpiKN, pg8::StaticOrder, true, true>(lds, g, S, E); }
            if (PH_MASK & 1024) { LAUNDER_W(); unsigned char* wl = W + ws::WBASE + (size_t)l * ws::WLAYER;
              pg8::Gemm g{(const bf16_t*)(wl + ws::W_KV) + 512 * 128, (const bf16_t*)(W + ws::CKV), 512, cfg::M, 128}; pg8::StaticOrder S; S.init(512, cfg::M, G, bx);
              pg8::EpiVT E{W, l};
              pg8::gemm_phase<pg8::EpiVT, pg8::StaticOrder, true, true>(lds, g, S, E); }
        }
        SEAM(pb + 3);
#if PROBE_DOUBLE == 4
        if ((PH_MASK & (16 | 512 | 1024)) && IN(pb + 3)) {
            if (PH_MASK & 16) { LAUNDER_W(); unsigned char* wl = W + ws::WBASE + (size_t)l * ws::WLAYER;
              pg8::Gemm g{(const bf16_t*)(W + ws::CQ), (const bf16_t*)(wl + ws::W_UQ), cfg::M, 768, 256}; pg8::StaticOrder S; S.init(cfg::M, 768, G, bx);
              pg8::EpiQ E{W, l};
              pg8::gemm_phase<pg8::EpiQ, pg8::StaticOrder, true, true>(lds, g, S, E); }
            if (PH_MASK & 512) { LAUNDER_W(); unsigned char* wl = W + ws::WBASE + (size_t)l * ws::WLAYER;
              pg8::Gemm g{(const bf16_t*)(W + ws::CKV), (const bf16_t*)(wl + ws::W_KV), cfg::M, 512, 128}; pg8::StaticOrder S; S.init(cfg::M, 512, G, bx);
              pg8::EpiKN E{W, l};
              pg8::gemm_phase<pg8::EpiKN, pg8::StaticOrder, true, true>(lds, g, S, E); }
            if (PH_MASK & 1024) { LAUNDER_W(); unsigned char* wl = W + ws::WBASE + (size_t)l * ws::WLAYER;
              pg8::Gemm g{(const bf16_t*)(wl + ws::W_KV) + 512 * 128, (const bf16_t*)(W + ws::CKV), 512, cfg::M, 128}; pg8::StaticOrder S; S.init(512, cfg::M, G, bx);
              pg8::EpiVT E{W, l};
              pg8::gemm_phase<pg8::EpiVT, pg8::StaticOrder, true, true>(lds, g, S, E); }
        }
        SEAM(pb + 3);
#endif
        if ((PH_MASK & 96) && IN(pb + 4)) {
            LOCAL_TID(); LAUNDER_W(); const float* sp = (const float*)(W + ws::SMALLP) + l * 4096;
            const int x0 = (int)__builtin_amdgcn_readfirstlane((int)(xb_xcc_id() & 7u));
            for (int xs = 0; xs < 8; ++xs) {
                const int x = (x0 + xs) & 7;
                gu32* head = (gu32*)(W + ws::CTL) + ws::CW_QUEUE + (l * 8 + x) * 64 + 0 * 32;
                bool have = false; unsigned kp = 0u;
                for (;;) {
                    if (tid == 0) MISC[0] = have ? kp : __hip_atomic_fetch_add(head, 1u, __ATOMIC_RELAXED, __HIP_MEMORY_SCOPE_AGENT);
                    __syncthreads();
                    const int k = (int)MISC[0] + 0;
                    __syncthreads();
                    have = false;
                    if (k >= 200) break;
                    if (k < 8) { if (PH_MASK & 64) { const int u = x * 8 + k; mls::mlstm_unit(lds, u >> 2, u & 3, (const bf16_t*)(W + ws::QM), (const bf16_t*)(W + ws::KM), (const bf16_t*)(W + ws::VM), (const bf16_t*)(W + ws::OG),
                                                  (const float*)(W + ws::IFG), sp, sp + 2048, (bf16_t*)(W + ws::Y)); } }
                    else if (PH_MASK & 32) { const int a = k - 8; const int bhq = x * 16 + ((a < 64) ? (a & 15) : ((a - 64) & 15)); const int qa = (a < 64) ? (a >> 4) : 11 - ((a - 64) >> 4), qb2 = (a < 64) ? 15 - (a >> 4) : -1; att::attn_unit(lds, bhq, qa, qb2, (const bf16_t*)(W + ws::Q), (const bf16_t*)(W + ws::KF), (const bf16_t*)(W + ws::VT), (bf16_t*)(W + ws::Y), head, kp); have = true; }
                }
            }
        }
        SEAM(pb + 4);
#if PROBE_DOUBLE == 5
        if ((PH_MASK & 96) && IN(pb + 4)) {
            LOCAL_TID(); LAUNDER_W(); const float* sp = (const float*)(W + ws::SMALLP) + l * 4096;
            const int x0 = (int)__builtin_amdgcn_readfirstlane((int)(xb_xcc_id() & 7u));
            for (int xs = 0; xs < 8; ++xs) {
                const int x = (x0 + xs) & 7;
                gu32* head = (gu32*)(W + ws::CTL) + ws::CW_QUEUE + (l * 8 + x) * 64 + 1 * 32;
                for (;;) {
                    if (tid == 0) MISC[0] = __hip_atomic_fetch_add(head, 1u, __ATOMIC_RELAXED, __HIP_MEMORY_SCOPE_AGENT);
                    __syncthreads();
                    const int k = (int)MISC[0] + 0;
                    __syncthreads();
                    if (k >= 200) break;
                    if (k < 8) { if (PH_MASK & 64) { const int u = x * 8 + k; mls::mlstm_unit(lds, u >> 2, u & 3, (const bf16_t*)(W + ws::QM), (const bf16_t*)(W + ws::KM), (const bf16_t*)(W + ws::VM), (const bf16_t*)(W + ws::OG),
                                                  (const float*)(W + ws::IFG), sp, sp + 2048, (bf16_t*)(W + ws::Y)); } }
                    else if (PH_MASK & 32) { const int a = k - 8; const int bhq = x * 16 + ((a < 64) ? (a & 15) : ((a - 64) & 15)); const int qa = (a < 64) ? (a >> 4) : 11 - ((a - 64) >> 4), qb2 = (a < 64) ? 15 - (a >> 4) : -1; { unsigned kd_ = 0u; att::attn_unit(lds, bhq, qa, qb2, (const bf16_t*)(W + ws::Q), (const bf16_t*)(W + ws::KF), (const bf16_t*)(W + ws::VT), (bf16_t*)(W + ws::Y), head, kd_); } }
                }
            }
        }
        SEAM(pb + 4);
#endif
#if PROBE_DOUBLE == 7
        if ((PH_MASK & 96) && IN(pb + 4)) {
            LOCAL_TID(); LAUNDER_W(); const float* sp = (const float*)(W + ws::SMALLP) + l * 4096;
            const int x0 = (int)__builtin_amdgcn_readfirstlane((int)(xb_xcc_id() & 7u));
            for (int xs = 0; xs < 8; ++xs) {
                const int x = (x0 + xs) & 7;
                gu32* head = (gu32*)(W + ws::CTL) + ws::CW_QUEUE + (l * 8 + x) * 64 + 1 * 32;
                for (;;) {
                    if (tid == 0) MISC[0] = __hip_atomic_fetch_add(head, 1u, __ATOMIC_RELAXED, __HIP_MEMORY_SCOPE_AGENT);
                    __syncthreads();
                    const int k = (int)MISC[0] + 0;
                    __syncthreads();
                    if (k >= 8) break;
                    if (k < 8) { if (PH_MASK & 64) { const int u = x * 8 + k; mls::mlstm_unit(lds, u >> 2, u & 3, (const bf16_t*)(W + ws::QM), (const bf16_t*)(W + ws::KM), (const bf16_t*)(W + ws::VM), (const bf16_t*)(W + ws::OG),
                                                  (const float*)(W + ws::IFG), sp, sp + 2048, (bf16_t*)(W + ws::Y)); } }
                    else if (PH_MASK & 32) { const int a = k - 8; const int bhq = x * 16 + ((a < 64) ? (a & 15) : ((a - 64) & 15)); const int qa = (a < 64) ? (a >> 4) : 11 - ((a - 64) >> 4), qb2 = (a < 64) ? 15 - (a >> 4) : -1; { unsigned kd_ = 0u; att::attn_unit(lds, bhq, qa, qb2, (const bf16_t*)(W + ws::Q), (const bf16_t*)(W + ws::KF), (const bf16_t*)(W + ws::VT), (bf16_t*)(W + ws::Y), head, kd_); } }
                }
            }
        }
        SEAM(pb + 4);
#endif
#if PROBE_DOUBLE == 8
        if ((PH_MASK & 96) && IN(pb + 4)) {
            LOCAL_TID(); LAUNDER_W(); const float* sp = (const float*)(W + ws::SMALLP) + l * 4096;
            const int x0 = (int)__builtin_amdgcn_readfirstlane((int)(xb_xcc_id() & 7u));
            for (int xs = 0; xs < 8; ++xs) {
                const int x = (x0 + xs) & 7;
                gu32* head = (gu32*)(W + ws::CTL) + ws::CW_QUEUE + (l * 8 + x) * 64 + 1 * 32;
                for (;;) {
                    if (tid == 0) MISC[0] = __hip_atomic_fetch_add(head, 1u, __ATOMIC_RELAXED, __HIP_MEMORY_SCOPE_AGENT);
                    __syncthreads();
                    const int k = (int)MISC[0] + 8;
                    __syncthreads();
                    if (k >= 200) break;
                    if (k < 8) { if (PH_MASK & 64) { const int u = x * 8 + k; mls::mlstm_unit(lds, u >> 2, u & 3, (const bf16_t*)(W + ws::QM), (const bf16_t*)(W + ws::KM), (const bf16_t*)(W + ws::VM), (const bf16_t*)(W + ws::OG),
                                                  (const float*)(W + ws::IFG), sp, sp + 2048, (bf16_t*)(W + ws::Y)); } }
                    else if (PH_MASK & 32) { const int a = k - 8; const int bhq = x * 16 + ((a < 64) ? (a & 15) : ((a - 64) & 15)); const int qa = (a < 64) ? (a >> 4) : 11 - ((a - 64) >> 4), qb2 = (a < 64) ? 15 - (a >> 4) : -1; { unsigned kd_ = 0u; att::attn_unit(lds, bhq, qa, qb2, (const bf16_t*)(W + ws::Q), (const bf16_t*)(W + ws::KF), (const bf16_t*)(W + ws::VT), (bf16_t*)(W + ws::Y), head, kd_); } }
                }
            }
        }
        SEAM(pb + 4);
#endif
        if ((PH_MASK & 128) && IN(pb + 5)) {
            LAUNDER_W(); unsigned char* wl = W + ws::WBASE + (size_t)l * ws::WLAYER;
            pg8::Gemm g{(const bf16_t*)(W + ws::Y), (const bf16_t*)(wl + ws::W_O), cfg::M, cfg::D, cfg::D}; pg8::StaticOrder S; S.init(cfg::M, cfg::D, G, bx);
            pg8::EpiResid E{W, 3 * l + 2, 1.0f};
            pg8::gemm_phase<pg8::EpiResid, pg8::StaticOrder, true, true>(lds, g, S, E);
        }
        SEAM(pb + 5);
#if PROBE_DOUBLE == 6
        if ((PH_MASK & 128) && IN(pb + 5)) {
            LAUNDER_W(); unsigned char* wl = W + ws::WBASE + (size_t)l * ws::WLAYER;
            pg8::Gemm g{(const bf16_t*)(W + ws::Y), (const bf16_t*)(wl + ws::W_O), cfg::M, cfg::D, cfg::D}; pg8::StaticOrder S; S.init(cfg::M, cfg::D, G, bx);
            pg8::EpiResid E{W, 3 * l + 2, 0.0f};
            pg8::gemm_phase<pg8::EpiResid, pg8::StaticOrder, true, true>(lds, g, S, E);
        }
        SEAM(pb + 5);
#endif
        if ((PH_MASK & 2) && IN(pb + 6)) {
            LAUNDER_W(); unsigned char* wl = W + ws::WBASE + (size_t)l * ws::WLAYER;
            pg8::Gemm g{(const bf16_t*)(W + ws::XB), (const bf16_t*)(wl + ws::W_GU2), cfg::M, 2 * cfg::FF, cfg::D}; pg8::StaticOrder S; S.init(cfg::M, 2 * cfg::FF, G, bx);
            const int gid0_ = pg8::rstd_table((LAS float*)(lds + RSTAB_OFF), S, pg8::ssqx_buf(W, 3 * l + 2), (int)threadIdx.x);
            pg8::EpiSwiGLU E{W, 3 * l + 2, (const LAS float*)(lds + RSTAB_OFF), gid0_};
            pg8::gemm_phase<pg8::EpiSwiGLU, pg8::StaticOrder, true, true>(lds, g, S, E);
        }
        SEAM(pb + 6);
        if ((PH_MASK & 4) && IN(pb + 7)) {
            LAUNDER_W(); unsigned char* wl = W + ws::WBASE + (size_t)l * ws::WLAYER;
            pg8::Gemm g{(const bf16_t*)(W + ws::H), (const bf16_t*)(wl + ws::W_D2), cfg::M, cfg::D, cfg::FF}; pg8::StaticOrder S; S.init(cfg::M, cfg::D, G, bx);
            pg8::EpiResid E{W, 3 * l + 3, 0.5f};
            pg8::gemm_phase<pg8::EpiResid, pg8::StaticOrder, true, true>(lds, g, S, E);
        }
        SEAM(pb + 7);
        }
    { constexpr int l = 1;
        const int pb = 1 + 8 * l;
        if ((PH_MASK & 2) && IN(pb + 0)) {
            LAUNDER_W(); unsigned char* wl = W + ws::WBASE + (size_t)l * ws::WLAYER;
            pg8::Gemm g{(const bf16_t*)(W + ws::XB), (const bf16_t*)(wl + ws::W_GU1), cfg::M, 2 * cfg::FF, cfg::D}; pg8::StaticOrder S; S.init(cfg::M, 2 * cfg::FF, G, bx);
            const int gid0_ = pg8::rstd_table((LAS float*)(lds + RSTAB_OFF), S, pg8::ssqx_buf(W, 3 * l), (int)threadIdx.x);
            pg8::EpiSwiGLU E{W, 3 * l, (const LAS float*)(lds + RSTAB_OFF), gid0_};
            pg8::gemm_phase<pg8::EpiSwiGLU, pg8::StaticOrder, true, true>(lds, g, S, E);
        }
        SEAM(pb + 0);
#if PROBE_DOUBLE == 1
        if ((PH_MASK & 2) && IN(pb + 0)) {
            LAUNDER_W(); unsigned char* wl = W + ws::WBASE + (size_t)l * ws::WLAYER;
            pg8::Gemm g{(const bf16_t*)(W + ws::XB), (const bf16_t*)(wl + ws::W_GU1), cfg::M, 2 * cfg::FF, cfg::D}; pg8::StaticOrder S; S.init(cfg::M, 2 * cfg::FF, G, bx);
            const int gid0_ = pg8::rstd_table((LAS float*)(lds + RSTAB_OFF), S, pg8::ssqx_buf(W, 3 * l), (int)threadIdx.x);
            pg8::EpiSwiGLU E{W, 3 * l, (const LAS float*)(lds + RSTAB_OFF), gid0_};
            pg8::gemm_phase<pg8::EpiSwiGLU, pg8::StaticOrder, true, true>(lds, g, S, E);
        }
        SEAM(pb + 0);
#endif
#if PROBE_DOUBLE == 11
        if ((PH_MASK & 2) && IN(pb + 0)) {
            LAUNDER_W(); unsigned char* wl = W + ws::WBASE + (size_t)l * ws::WLAYER;
            pg8::Gemm g{(const bf16_t*)(W + ws::XB), (const bf16_t*)(wl + ws::W_GU1), cfg::M, 2 * cfg::FF, cfg::D}; pg8::StaticOrder S; S.init(cfg::M, 2 * cfg::FF, G, bx);
            pg8::EpiNull E{P.out};
            pg8::gemm_phase<pg8::EpiNull, pg8::StaticOrder, true, true>(lds, g, S, E);
        }
        SEAM(pb + 0);
#endif
        if ((PH_MASK & 4) && IN(pb + 1)) {
            LAUNDER_W(); unsigned char* wl = W + ws::WBASE + (size_t)l * ws::WLAYER;
            pg8::Gemm g{(const bf16_t*)(W + ws::H), (const bf16_t*)(wl + ws::W_D1), cfg::M, cfg::D, cfg::FF}; pg8::StaticOrder S; S.init(cfg::M, cfg::D, G, bx);
            pg8::EpiResid E{W, 3 * l + 1, 0.5f};
            pg8::gemm_phase<pg8::EpiResid, pg8::StaticOrder, true, true>(lds, g, S, E);
        }
        SEAM(pb + 1);
#if PROBE_DOUBLE == 2
        if ((PH_MASK & 4) && IN(pb + 1)) {
            LAUNDER_W(); unsigned char* wl = W + ws::WBASE + (size_t)l * ws::WLAYER;
            pg8::Gemm g{(const bf16_t*)(W + ws::H), (const bf16_t*)(wl + ws::W_D1), cfg::M, cfg::D, cfg::FF}; pg8::StaticOrder S; S.init(cfg::M, cfg::D, G, bx);
            pg8::EpiResid E{W, 3 * l + 1, 0.0f};
            pg8::gemm_phase<pg8::EpiResid, pg8::StaticOrder, true, true>(lds, g, S, E);
        }
        SEAM(pb + 1);
#endif
        if ((PH_MASK & 8) && IN(pb + 2)) {
            LAUNDER_W(); unsigned char* wl = W + ws::WBASE + (size_t)l * ws::WLAYER;
            pg8::Gemm g{(const bf16_t*)(W + ws::XB), (const bf16_t*)(wl + ws::W_IN), cfg::M, cfg::DINP, cfg::D}; pg8::StaticOrder S; S.init(cfg::M, cfg::DINP, G, bx);
            pg8::EpiWin E{W, l};
            pg8::gemm_phase<pg8::EpiWin, pg8::StaticOrder, true, true>(lds, g, S, E);
        }
        SEAM(pb + 2);
#if PROBE_DOUBLE == 3
        if ((PH_MASK & 8) && IN(pb + 2)) {
            LAUNDER_W(); unsigned char* wl = W + ws::WBASE + (size_t)l * ws::WLAYER;
            pg8::Gemm g{(const bf16_t*)(W + ws::XB), (const bf16_t*)(wl + ws::W_IN), cfg::M, cfg::DINP, cfg::D}; pg8::StaticOrder S; S.init(cfg::M, cfg::DINP, G, bx);
            pg8::EpiWin E{W, l};
            pg8::gemm_phase<pg8::EpiWin, pg8::StaticOrder, true, true>(lds, g, S, E);
        }
        SEAM(pb + 2);
#endif
        if ((PH_MASK & (16 | 512 | 1024)) && IN(pb + 3)) {
            if (PH_MASK & 16) { LAUNDER_W(); unsigned char* wl = W + ws::WBASE + (size_t)l * ws::WLAYER;
              pg8::Gemm g{(const bf16_t*)(W + ws::CQ), (const bf16_t*)(wl + ws::W_UQ), cfg::M, 768, 256}; pg8::StaticOrder S; S.init(cfg::M, 768, G, bx);
              pg8::EpiQ E{W, l};
              pg8::gemm_phase<pg8::EpiQ, pg8::StaticOrder, true, true>(lds, g, S, E); }
            if (PH_MASK & 512) { LAUNDER_W(); unsigned char* wl = W + ws::WBASE + (size_t)l * ws::WLAYER;
              pg8::Gemm g{(const bf16_t*)(W + ws::CKV), (const bf16_t*)(wl + ws::W_KV), cfg::M, 512, 128}; pg8::StaticOrder S; S.init(cfg::M, 512, G, bx);
              pg8::EpiKN E{W, l};
              pg8::gemm_phase<pg8::EpiKN, pg8::StaticOrder, true, true>(lds, g, S, E); }
            if (PH_MASK & 1024) { LAUNDER_W(); unsigned char* wl = W + ws::WBASE + (size_t)l * ws::WLAYER;
              pg8::Gemm g{(const bf16_t*)(wl + ws::W_KV) + 512 * 128, (const bf16_t*)(W + ws::CKV), 512, cfg::M, 128}; pg8::StaticOrder S; S.init(512, cfg::M, G, bx);
              pg8::EpiVT E{W, l};
              pg8::gemm_phase<pg8::EpiVT, pg8::StaticOrder, true, true>(lds, g, S, E); }
        }
        SEAM(pb + 3);
#if PROBE_DOUBLE == 4
        if ((PH_MASK & (16 | 512 | 1024)) && IN(pb + 3)) {
            if (PH_MASK & 16) { LAUNDER_W(); unsigned char* wl = W + ws::WBASE + (size_t)l * ws::WLAYER;
              pg8::Gemm g{(const bf16_t*)(W + ws::CQ), (const bf16_t*)(wl + ws::W_UQ), cfg::M, 768, 256}; pg8::StaticOrder S; S.init(cfg::M, 768, G, bx);
              pg8::EpiQ E{W, l};
              pg8::gemm_phase<pg8::EpiQ, pg8::StaticOrder, true, true>(lds, g, S, E); }
            if (PH_MASK & 512) { LAUNDER_W(); unsigned char* wl = W + ws::WBASE + (size_t)l * ws::WLAYER;
              pg8::Gemm g{(const bf16_t*)(W + ws::CKV), (const bf16_t*)(wl + ws::W_KV), cfg::M, 512, 128}; pg8::StaticOrder S; S.init(cfg::M, 512, G, bx);
              pg8::EpiKN E{W, l};
              pg8::gemm_phase<pg8::EpiKN, pg8::StaticOrder, true, true>(lds, g, S, E); }
            if (PH_MASK & 1024) { LAUNDER_W(); unsigned char* wl = W + ws::WBASE + (size_t)l * ws::WLAYER;
              pg8::Gemm g{(const bf16_t*)(wl + ws::W_KV) + 512 * 128, (const bf16_t*)(W + ws::CKV), 512, cfg::M, 128}; pg8::StaticOrder S; S.init(512, cfg::M, G, bx);
              pg8::EpiVT E{W, l};
              pg8::gemm_phase<pg8::EpiVT, pg8::StaticOrder, true, true>(lds, g, S, E); }
        }
        SEAM(pb + 3);
#endif
        if ((PH_MASK & 96) && IN(pb + 4)) {
            LOCAL_TID(); LAUNDER_W(); const float* sp = (const float*)(W + ws::SMALLP) + l * 4096;
            const int x0 = (int)__builtin_amdgcn_readfirstlane((int)(xb_xcc_id() & 7u));
            for (int xs = 0; xs < 8; ++xs) {
                const int x = (x0 + xs) & 7;
                gu32* head = (gu32*)(W + ws::CTL) + ws::CW_QUEUE + (l * 8 + x) * 64 + 0 * 32;
                bool have = false; unsigned kp = 0u;
                for (;;) {
                    if (tid == 0) MISC[0] = have ? kp : __hip_atomic_fetch_add(head, 1u, __ATOMIC_RELAXED, __HIP_MEMORY_SCOPE_AGENT);
                    __syncthreads();
                    const int k = (int)MISC[0] + 0;
                    __syncthreads();
                    have = false;
                    if (k >= 200) break;
                    if (k < 8) { if (PH_MASK & 64) { const int u = x * 8 + k; mls::mlstm_unit(lds, u >> 2, u & 3, (const bf16_t*)(W + ws::QM), (const bf16_t*)(W + ws::KM), (const bf16_t*)(W + ws::VM), (const bf16_t*)(W + ws::OG),
                                                  (const float*)(W + ws::IFG), sp, sp + 2048, (bf16_t*)(W + ws::Y)); } }
                    else if (PH_MASK & 32) { const int a = k - 8; const int bhq = x * 16 + ((a < 64) ? (a & 15) : ((a - 64) & 15)); const int qa = (a < 64) ? (a >> 4) : 11 - ((a - 64) >> 4), qb2 = (a < 64) ? 15 - (a >> 4) : -1; att::attn_unit(lds, bhq, qa, qb2, (const bf16_t*)(W + ws::Q), (const bf16_t*)(W + ws::KF), (const bf16_t*)(W + ws::VT), (bf16_t*)(W + ws::Y), head, kp); have = true; }
                }
            }
        }
        SEAM(pb + 4);
#if PROBE_DOUBLE == 5
        if ((PH_MASK & 96) && IN(pb + 4)) {
            LOCAL_TID(); LAUNDER_W(); const float* sp = (const float*)(W + ws::SMALLP) + l * 4096;
            const int x0 = (int)__builtin_amdgcn_readfirstlane((int)(xb_xcc_id() & 7u));
            for (int xs = 0; xs < 8; ++xs) {
                const int x = (x0 + xs) & 7;
                gu32* head = (gu32*)(W + ws::CTL) + ws::CW_QUEUE + (l * 8 + x) * 64 + 1 * 32;
                for (;;) {
                    if (tid == 0) MISC[0] = __hip_atomic_fetch_add(head, 1u, __ATOMIC_RELAXED, __HIP_MEMORY_SCOPE_AGENT);
                    __syncthreads();
                    const int k = (int)MISC[0] + 0;
                    __syncthreads();
                    if (k >= 200) break;
                    if (k < 8) { if (PH_MASK & 64) { const int u = x * 8 + k; mls::mlstm_unit(lds, u >> 2, u & 3, (const bf16_t*)(W + ws::QM), (const bf16_t*)(W + ws::KM), (const bf16_t*)(W + ws::VM), (const bf16_t*)(W + ws::OG),
                                                  (const float*)(W + ws::IFG), sp, sp + 2048, (bf16_t*)(W + ws::Y)); } }
                    else if (PH_MASK & 32) { const int a = k - 8; const int bhq = x * 16 + ((a < 64) ? (a & 15) : ((a - 64) & 15)); const int qa = (a < 64) ? (a >> 4) : 11 - ((a - 64) >> 4), qb2 = (a < 64) ? 15 - (a >> 4) : -1; { unsigned kd_ = 0u; att::attn_unit(lds, bhq, qa, qb2, (const bf16_t*)(W + ws::Q), (const bf16_t*)(W + ws::KF), (const bf16_t*)(W + ws::VT), (bf16_t*)(W + ws::Y), head, kd_); } }
                }
            }
        }
        SEAM(pb + 4);
#endif
#if PROBE_DOUBLE == 7
        if ((PH_MASK & 96) && IN(pb + 4)) {
            LOCAL_TID(); LAUNDER_W(); const float* sp = (const float*)(W + ws::SMALLP) + l * 4096;
            const int x0 = (int)__builtin_amdgcn_readfirstlane((int)(xb_xcc_id() & 7u));
            for (int xs = 0; xs < 8; ++xs) {
                const int x = (x0 + xs) & 7;
                gu32* head = (gu32*)(W + ws::CTL) + ws::CW_QUEUE + (l * 8 + x) * 64 + 1 * 32;
                for (;;) {
                    if (tid == 0) MISC[0] = __hip_atomic_fetch_add(head, 1u, __ATOMIC_RELAXED, __HIP_MEMORY_SCOPE_AGENT);
                    __syncthreads();
                    const int k = (int)MISC[0] + 0;
                    __syncthreads();
                    if (k >= 8) break;
                    if (k < 8) { if (PH_MASK & 64) { const int u = x * 8 + k; mls::mlstm_unit(lds, u >> 2, u & 3, (const bf16_t*)(W + ws::QM), (const bf16_t*)(W + ws::KM), (const bf16_t*)(W + ws::VM), (const bf16_t*)(W + ws::OG),
                                                  (const float*)(W + ws::IFG), sp, sp + 2048, (bf16_t*)(W + ws::Y)); } }
                    else if (PH_MASK & 32) { const int a = k - 8; const int bhq = x * 16 + ((a < 64) ? (a & 15) : ((a - 64) & 15)); const int qa = (a < 64) ? (a >> 4) : 11 - ((a - 64) >> 4), qb2 = (a < 64) ? 15 - (a >> 4) : -1; { unsigned kd_ = 0u; att::attn_unit(lds, bhq, qa, qb2, (const bf16_t*)(W + ws::Q), (const bf16_t*)(W + ws::KF), (const bf16_t*)(W + ws::VT), (bf16_t*)(W + ws::Y), head, kd_); } }
                }
            }
        }
        SEAM(pb + 4);
#endif
#if PROBE_DOUBLE == 8
        if ((PH_MASK & 96) && IN(pb + 4)) {
            LOCAL_TID(); LAUNDER_W(); const float* sp = (const float*)(W + ws::SMALLP) + l * 4096;
            const int x0 = (int)__builtin_amdgcn_readfirstlane((int)(xb_xcc_id() & 7u));
            for (int xs = 0; xs < 8; ++xs) {
                const int x = (x0 + xs) & 7;
                gu32* head = (gu32*)(W + ws::CTL) + ws::CW_QUEUE + (l * 8 + x) * 64 + 1 * 32;
                for (;;) {
                    if (tid == 0) MISC[0] = __hip_atomic_fetch_add(head, 1u, __ATOMIC_RELAXED, __HIP_MEMORY_SCOPE_AGENT);
                    __syncthreads();
                    const int k = (int)MISC[0] + 8;
                    __syncthreads();
                    if (k >= 200) break;
                    if (k < 8) { if (PH_MASK & 64) { const int u = x * 8 + k; mls::mlstm_unit(lds, u >> 2, u & 3, (const bf16_t*)(W + ws::QM), (const bf16_t*)(W + ws::KM), (const bf16_t*)(W + ws::VM), (const bf16_t*)(W + ws::OG),
                                                  (const float*)(W + ws::IFG), sp, sp + 2048, (bf16_t*)(W + ws::Y)); } }
                    else if (PH_MASK & 32) { const int a = k - 8; const int bhq = x * 16 + ((a < 64) ? (a & 15) : ((a - 64) & 15)); const int qa = (a < 64) ? (a >> 4) : 11 - ((a - 64) >> 4), qb2 = (a < 64) ? 15 - (a >> 4) : -1; { unsigned kd_ = 0u; att::attn_unit(lds, bhq, qa, qb2, (const bf16_t*)(W + ws::Q), (const bf16_t*)(W + ws::KF), (const bf16_t*)(W + ws::VT), (bf16_t*)(W + ws::Y), head, kd_); } }
                }
            }
        }
        SEAM(pb + 4);
#endif
        if ((PH_MASK & 128) && IN(pb + 5)) {
            LAUNDER_W(); unsigned char* wl = W + ws::WBASE + (size_t)l * ws::WLAYER;
            pg8::Gemm g{(const bf16_t*)(W + ws::Y), (const bf16_t*)(wl + ws::W_O), cfg::M, cfg::D, cfg::D}; pg8::StaticOrder S; S.init(cfg::M, cfg::D, G, bx);
            pg8::EpiResid E{W, 3 * l + 2, 1.0f};
            pg8::gemm_phase<pg8::EpiResid, pg8::StaticOrder, true, true>(lds, g, S, E);
        }
        SEAM(pb + 5);
#if PROBE_DOUBLE == 6
        if ((PH_MASK & 128) && IN(pb + 5)) {
            LAUNDER_W(); unsigned char* wl = W + ws::WBASE + (size_t)l * ws::WLAYER;
            pg8::Gemm g{(const bf16_t*)(W + ws::Y), (const bf16_t*)(wl + ws::W_O), cfg::M, cfg::D, cfg::D}; pg8::StaticOrder S; S.init(cfg::M, cfg::D, G, bx);
            pg8::EpiResid E{W, 3 * l + 2, 0.0f};
            pg8::gemm_phase<pg8::EpiResid, pg8::StaticOrder, true, true>(lds, g, S, E);
        }
        SEAM(pb + 5);
#endif
        if ((PH_MASK & 2) && IN(pb + 6)) {
            LAUNDER_W(); unsigned char* wl = W + ws::WBASE + (size_t)l * ws::WLAYER;
            pg8::Gemm g{(const bf16_t*)(W + ws::XB), (const bf16_t*)(wl + ws::W_GU2), cfg::M, 2 * cfg::FF, cfg::D}; pg8::StaticOrder S; S.init(cfg::M, 2 * cfg::FF, G, bx);
            const int gid0_ = pg8::rstd_table((LAS float*)(lds + RSTAB_OFF), S, pg8::ssqx_buf(W, 3 * l + 2), (int)threadIdx.x);
            pg8::EpiSwiGLU E{W, 3 * l + 2, (const LAS float*)(lds + RSTAB_OFF), gid0_};
            pg8::gemm_phase<pg8::EpiSwiGLU, pg8::StaticOrder, true, true>(lds, g, S, E);
        }
        SEAM(pb + 6);
        if ((PH_MASK & 4) && IN(pb + 7)) {
            LAUNDER_W(); unsigned char* wl = W + ws::WBASE + (size_t)l * ws::WLAYER;
            pg8::Gemm g{(const bf16_t*)(W + ws::H), (const bf16_t*)(wl + ws::W_D2), cfg::M, cfg::D, cfg::FF}; pg8::StaticOrder S; S.init(cfg::M, cfg::D, G, bx);
            pg8::EpiResid E{W, 3 * l + 3, 0.5f};
            pg8::gemm_phase<pg8::EpiResid, pg8::StaticOrder, true, true>(lds, g, S, E);
        }
        SEAM(pb + 7);
        }
    { constexpr int l = 2;
        const int pb = 1 + 8 * l;
        if ((PH_MASK & 2) && IN(pb + 0)) {
            LAUNDER_W(); unsigned char* wl = W + ws::WBASE + (size_t)l * ws::WLAYER;
            pg8::Gemm g{(const bf16_t*)(W + ws::XB), (const bf16_t*)(wl + ws::W_GU1), cfg::M, 2 * cfg::FF, cfg::D}; pg8::StaticOrder S; S.init(cfg::M, 2 * cfg::FF, G, bx);
            const int gid0_ = pg8::rstd_table((LAS float*)(lds + RSTAB_OFF), S, pg8::ssqx_buf(W, 3 * l), (int)threadIdx.x);
            pg8::EpiSwiGLU E{W, 3 * l, (const LAS float*)(lds + RSTAB_OFF), gid0_};
            pg8::gemm_phase<pg8::EpiSwiGLU, pg8::StaticOrder, true, true>(lds, g, S, E);
        }
        SEAM(pb + 0);
#if PROBE_DOUBLE == 1
        if ((PH_MASK & 2) && IN(pb + 0)) {
            LAUNDER_W(); unsigned char* wl = W + ws::WBASE + (size_t)l * ws::WLAYER;
            pg8::Gemm g{(const bf16_t*)(W + ws::XB), (const bf16_t*)(wl + ws::W_GU1), cfg::M, 2 * cfg::FF, cfg::D}; pg8::StaticOrder S; S.init(cfg::M, 2 * cfg::FF, G, bx);
            const int gid0_ = pg8::rstd_table((LAS float*)(lds + RSTAB_OFF), S, pg8::ssqx_buf(W, 3 * l), (int)threadIdx.x);
            pg8::EpiSwiGLU E{W, 3 * l, (const LAS float*)(lds + RSTAB_OFF), gid0_};
            pg8::gemm_phase<pg8::EpiSwiGLU, pg8::StaticOrder, true, true>(lds, g, S, E);
        }
        SEAM(pb + 0);
#endif
#if PROBE_DOUBLE == 11
        if ((PH_MASK & 2) && IN(pb + 0)) {
            LAUNDER_W(); unsigned char* wl = W + ws::WBASE + (size_t)l * ws::WLAYER;
            pg8::Gemm g{(const bf16_t*)(W + ws::XB), (const bf16_t*)(wl + ws::W_GU1), cfg::M, 2 * cfg::FF, cfg::D}; pg8::StaticOrder S; S.init(cfg::M, 2 * cfg::FF, G, bx);
            pg8::EpiNull E{P.out};
            pg8::gemm_phase<pg8::EpiNull, pg8::StaticOrder, true, true>(lds, g, S, E);
        }
        SEAM(pb + 0);
#endif
        if ((PH_MASK & 4) && IN(pb + 1)) {
            LAUNDER_W(); unsigned char* wl = W + ws::WBASE + (size_t)l * ws::WLAYER;
            pg8::Gemm g{(const bf16_t*)(W + ws::H), (const bf16_t*)(wl + ws::W_D1), cfg::M, cfg::D, cfg::FF}; pg8::StaticOrder S; S.init(cfg::M, cfg::D, G, bx);
            pg8::EpiResid E{W, 3 * l + 1, 0.5f};
            pg8::gemm_phase<pg8::EpiResid, pg8::StaticOrder, true, true>(lds, g, S, E);
        }
        SEAM(pb + 1);
#if PROBE_DOUBLE == 2
        if ((PH_MASK & 4) && IN(pb + 1)) {
            LAUNDER_W(); unsigned char* wl = W + ws::WBASE + (size_t)l * ws::WLAYER;
            pg8::Gemm g{(const bf16_t*)(W + ws::H), (const bf16_t*)(wl + ws::W_D1), cfg::M, cfg::D, cfg::FF}; pg8::StaticOrder S; S.init(cfg::M, cfg::D, G, bx);
            pg8::EpiResid E{W, 3 * l + 1, 0.0f};
            pg8::gemm_phase<pg8::EpiResid, pg8::StaticOrder, true, true>(lds, g, S, E);
        }
        SEAM(pb + 1);
#endif
        if ((PH_MASK & 8) && IN(pb + 2)) {
            LAUNDER_W(); unsigned char* wl = W + ws::WBASE + (size_t)l * ws::WLAYER;
            pg8::Gemm g{(const bf16_t*)(W + ws::XB), (const bf16_t*)(wl + ws::W_IN), cfg::M, cfg::DINP, cfg::D}; pg8::StaticOrder S; S.init(cfg::M, cfg::DINP, G, bx);
            pg8::EpiWin E{W, l};
            pg8::gemm_phase<pg8::EpiWin, pg8::StaticOrder, true, true>(lds, g, S, E);
        }
        SEAM(pb + 2);
#if PROBE_DOUBLE == 3
        if ((PH_MASK & 8) && IN(pb + 2)) {
            LAUNDER_W(); unsigned char* wl = W + ws::WBASE + (size_t)l * ws::WLAYER;
            pg8::Gemm g{(const bf16_t*)(W + ws::XB), (const bf16_t*)(wl + ws::W_IN), cfg::M, cfg::DINP, cfg::D}; pg8::StaticOrder S; S.init(cfg::M, cfg::DINP, G, bx);
            pg8::EpiWin E{W, l};
            pg8::gemm_phase<pg8::EpiWin, pg8::StaticOrder, true, true>(lds, g, S, E);
        }
        SEAM(pb + 2);
#endif
        if ((PH_MASK & (16 | 512 | 1024)) && IN(pb + 3)) {
            if (PH_MASK & 16) { LAUNDER_W(); unsigned char* wl = W + ws::WBASE + (size_t)l * ws::WLAYER;
              pg8::Gemm g{(const bf16_t*)(W + ws::CQ), (const bf16_t*)(wl + ws::W_UQ), cfg::M, 768, 256}; pg8::StaticOrder S; S.init(cfg::M, 768, G, bx);
              pg8::EpiQ E{W, l};
              pg8::gemm_phase<pg8::EpiQ, pg8::StaticOrder, true, true>(lds, g, S, E); }
            if (PH_MASK & 512) { LAUNDER_W(); unsigned char* wl = W + ws::WBASE + (size_t)l * ws::WLAYER;
              pg8::Gemm g{(const bf16_t*)(W + ws::CKV), (const bf16_t*)(wl + ws::W_KV), cfg::M, 512, 128}; pg8::StaticOrder S; S.init(cfg::M, 512, G, bx);
              pg8::EpiKN E{W, l};
              pg8::gemm_phase<pg8::EpiKN, pg8::StaticOrder, true, true>(lds, g, S, E); }
            if (PH_MASK & 1024) { LAUNDER_W(); unsigned char* wl = W + ws::WBASE + (size_t)l * ws::WLAYER;
              pg8::Gemm g{(const bf16_t*)(wl + ws::W_KV) + 512 * 128, (const bf16_t*)(W + ws::CKV), 512, cfg::M, 128}; pg8::StaticOrder S; S.init(512, cfg::M, G, bx);
              pg8::EpiVT E{W, l};
              pg8::gemm_phase<pg8::EpiVT, pg8::StaticOrder, true, true>(lds, g, S, E); }
        }
        SEAM(pb + 3);
#if PROBE_DOUBLE == 4
        if ((PH_MASK & (16 | 512 | 1024)) && IN(pb + 3)) {
            if (PH_MASK & 16) { LAUNDER_W(); unsigned char* wl = W + ws::WBASE + (size_t)l * ws::WLAYER;
              pg8::Gemm g{(const bf16_t*)(W + ws::CQ), (const bf16_t*)(wl + ws::W_UQ), cfg::M, 768, 256}; pg8::StaticOrder S; S.init(cfg::M, 768, G, bx);
              pg8::EpiQ E{W, l};
              pg8::gemm_phase<pg8::EpiQ, pg8::StaticOrder, true, true>(lds, g, S, E); }
            if (PH_MASK & 512) { LAUNDER_W(); unsigned char* wl = W + ws::WBASE + (size_t)l * ws::WLAYER;
              pg8::Gemm g{(const bf16_t*)(W + ws::CKV), (const bf16_t*)(wl + ws::W_KV), cfg::M, 512, 128}; pg8::StaticOrder S; S.init(cfg::M, 512, G, bx);
              pg8::EpiKN E{W, l};
              pg8::gemm_phase<pg8::EpiKN, pg8::StaticOrder, true, true>(lds, g, S, E); }
            if (PH_MASK & 1024) { LAUNDER_W(); unsigned char* wl = W + ws::WBASE + (size_t)l * ws::WLAYER;
              pg8::Gemm g{(const bf16_t*)(wl + ws::W_KV) + 512 * 128, (const bf16_t*)(W + ws::CKV), 512, cfg::M, 128}; pg8::StaticOrder S; S.init(512, cfg::M, G, bx);
              pg8::EpiVT E{W, l};
              pg8::gemm_phase<pg8::EpiVT, pg8::StaticOrder, true, true>(lds, g, S, E); }
        }
        SEAM(pb + 3);
#endif
        if ((PH_MASK & 96) && IN(pb + 4)) {
            LOCAL_TID(); LAUNDER_W(); const float* sp = (const float*)(W + ws::SMALLP) + l * 4096;
            const int x0 = (int)__builtin_amdgcn_readfirstlane((int)(xb_xcc_id() & 7u));
            for (int xs = 0; xs < 8; ++xs) {
                const int x = (x0 + xs) & 7;
                gu32* head = (gu32*)(W + ws::CTL) + ws::CW_QUEUE + (l * 8 + x) * 64 + 0 * 32;
                bool have = false; unsigned kp = 0u;
                for (;;) {
                    if (tid == 0) MISC[0] = have ? kp : __hip_atomic_fetch_add(head, 1u, __ATOMIC_RELAXED, __HIP_MEMORY_SCOPE_AGENT);
                    __syncthreads();
                    const int k = (int)MISC[0] + 0;
                    __syncthreads();
                    have = false;
                    if (k >= 200) break;
                    if (k < 8) { if (PH_MASK & 64) { const int u = x * 8 + k; mls::mlstm_unit(lds, u >> 2, u & 3, (const bf16_t*)(W + ws::QM), (const bf16_t*)(W + ws::KM), (const bf16_t*)(W + ws::VM), (const bf16_t*)(W + ws::OG),
                                                  (const float*)(W + ws::IFG), sp, sp + 2048, (bf16_t*)(W + ws::Y)); } }
                    else if (PH_MASK & 32) { const int a = k - 8; const int bhq = x * 16 + ((a < 64) ? (a & 15) : ((a - 64) & 15)); const int qa = (a < 64) ? (a >> 4) : 11 - ((a - 64) >> 4), qb2 = (a < 64) ? 15 - (a >> 4) : -1; att::attn_unit(lds, bhq, qa, qb2, (const bf16_t*)(W + ws::Q), (const bf16_t*)(W + ws::KF), (const bf16_t*)(W + ws::VT), (bf16_t*)(W + ws::Y), head, kp); have = true; }
                }
            }
        }
        SEAM(pb + 4);
#if PROBE_DOUBLE == 5
        if ((PH_MASK & 96) && IN(pb + 4)) {
            LOCAL_TID(); LAUNDER_W(); const float* sp = (const float*)(W + ws::SMALLP) + l * 4096;
            const int x0 = (int)__builtin_amdgcn_readfirstlane((int)(xb_xcc_id() & 7u));
            for (int xs = 0; xs < 8; ++xs) {
                const int x = (x0 + xs) & 7;
                gu32* head = (gu32*)(W + ws::CTL) + ws::CW_QUEUE + (l * 8 + x) * 64 + 1 * 32;
                for (;;) {
                    if (tid == 0) MISC[0] = __hip_atomic_fetch_add(head, 1u, __ATOMIC_RELAXED, __HIP_MEMORY_SCOPE_AGENT);
                    __syncthreads();
                    const int k = (int)MISC[0] + 0;
                    __syncthreads();
                    if (k >= 200) break;
                    if (k < 8) { if (PH_MASK & 64) { const int u = x * 8 + k; mls::mlstm_unit(lds, u >> 2, u & 3, (const bf16_t*)(W + ws::QM), (const bf16_t*)(W + ws::KM), (const bf16_t*)(W + ws::VM), (const bf16_t*)(W + ws::OG),
                                                  (const float*)(W + ws::IFG), sp, sp + 2048, (bf16_t*)(W + ws::Y)); } }
                    else if (PH_MASK & 32) { const int a = k - 8; const int bhq = x * 16 + ((a < 64) ? (a & 15) : ((a - 64) & 15)); const int qa = (a < 64) ? (a >> 4) : 11 - ((a - 64) >> 4), qb2 = (a < 64) ? 15 - (a >> 4) : -1; { unsigned kd_ = 0u; att::attn_unit(lds, bhq, qa, qb2, (const bf16_t*)(W + ws::Q), (const bf16_t*)(W + ws::KF), (const bf16_t*)(W + ws::VT), (bf16_t*)(W + ws::Y), head, kd_); } }
                }
            }
        }
        SEAM(pb + 4);
#endif
#if PROBE_DOUBLE == 7
        if ((PH_MASK & 96) && IN(pb + 4)) {
            LOCAL_TID(); LAUNDER_W(); const float* sp = (const float*)(W + ws::SMALLP) + l * 4096;
            const int x0 = (int)__builtin_amdgcn_readfirstlane((int)(xb_xcc_id() & 7u));
            for (int xs = 0; xs < 8; ++xs) {
                const int x = (x0 + xs) & 7;
                gu32* head = (gu32*)(W + ws::CTL) + ws::CW_QUEUE + (l * 8 + x) * 64 + 1 * 32;
                for (;;) {
                    if (tid == 0) MISC[0] = __hip_atomic_fetch_add(head, 1u, __ATOMIC_RELAXED, __HIP_MEMORY_SCOPE_AGENT);
                    __syncthreads();
                    const int k = (int)MISC[0] + 0;
                    __syncthreads();
                    if (k >= 8) break;
                    if (k < 8) { if (PH_MASK & 64) { const int u = x * 8 + k; mls::mlstm_unit(lds, u >> 2, u & 3, (const bf16_t*)(W + ws::QM), (const bf16_t*)(W + ws::KM), (const bf16_t*)(W + ws::VM), (const bf16_t*)(W + ws::OG),
                                                  (const float*)(W + ws::IFG), sp, sp + 2048, (bf16_t*)(W + ws::Y)); } }
                    else if (PH_MASK & 32) { const int a = k - 8; const int bhq = x * 16 + ((a < 64) ? (a & 15) : ((a - 64) & 15)); const int qa = (a < 64) ? (a >> 4) : 11 - ((a - 64) >> 4), qb2 = (a < 64) ? 15 - (a >> 4) : -1; { unsigned kd_ = 0u; att::attn_unit(lds, bhq, qa, qb2, (const bf16_t*)(W + ws::Q), (const bf16_t*)(W + ws::KF), (const bf16_t*)(W + ws::VT), (bf16_t*)(W + ws::Y), head, kd_); } }
                }
            }
        }
        SEAM(pb + 4);
#endif
#if PROBE_DOUBLE == 8
        if ((PH_MASK & 96) && IN(pb + 4)) {
            LOCAL_TID(); LAUNDER_W(); const float* sp = (const float*)(W + ws::SMALLP) + l * 4096;
            const int x0 = (int)__builtin_amdgcn_readfirstlane((int)(xb_xcc_id() & 7u));
            for (int xs = 0; xs < 8; ++xs) {
                const int x = (x0 + xs) & 7;
                gu32* head = (gu32*)(W + ws::CTL) + ws::CW_QUEUE + (l * 8 + x) * 64 + 1 * 32;
                for (;;) {
                    if (tid == 0) MISC[0] = __hip_atomic_fetch_add(head, 1u, __ATOMIC_RELAXED, __HIP_MEMORY_SCOPE_AGENT);
                    __syncthreads();
                    const int k = (int)MISC[0] + 8;
                    __syncthreads();
                    if (k >= 200) break;
                    if (k < 8) { if (PH_MASK & 64) { const int u = x * 8 + k; mls::mlstm_unit(lds, u >> 2, u & 3, (const bf16_t*)(W + ws::QM), (const bf16_t*)(W + ws::KM), (const bf16_t*)(W + ws::VM), (const bf16_t*)(W + ws::OG),
                                                  (const float*)(W + ws::IFG), sp, sp + 2048, (bf16_t*)(W + ws::Y)); } }
                    else if (PH_MASK & 32) { const int a = k - 8; const int bhq = x * 16 + ((a < 64) ? (a & 15) : ((a - 64) & 15)); const int qa = (a < 64) ? (a >> 4) : 11 - ((a - 64) >> 4), qb2 = (a < 64) ? 15 - (a >> 4) : -1; { unsigned kd_ = 0u; att::attn_unit(lds, bhq, qa, qb2, (const bf16_t*)(W + ws::Q), (const bf16_t*)(W + ws::KF), (const bf16_t*)(W + ws::VT), (bf16_t*)(W + ws::Y), head, kd_); } }
                }
            }
        }
        SEAM(pb + 4);
#endif
        if ((PH_MASK & 128) && IN(pb + 5)) {
            LAUNDER_W(); unsigned char* wl = W + ws::WBASE + (size_t)l * ws::WLAYER;
            pg8::Gemm g{(const bf16_t*)(W + ws::Y), (const bf16_t*)(wl + ws::W_O), cfg::M, cfg::D, cfg::D}; pg8::StaticOrder S; S.init(cfg::M, cfg::D, G, bx);
            pg8::EpiResid E{W, 3 * l + 2, 1.0f};
            pg8::gemm_phase<pg8::EpiResid, pg8::StaticOrder, true, true>(lds, g, S, E);
        }
        SEAM(pb + 5);
#if PROBE_DOUBLE == 6
        if ((PH_MASK & 128) && IN(pb + 5)) {
            LAUNDER_W(); unsigned char* wl = W + ws::WBASE + (size_t)l * ws::WLAYER;
            pg8::Gemm g{(const bf16_t*)(W + ws::Y), (const bf16_t*)(wl + ws::W_O), cfg::M, cfg::D, cfg::D}; pg8::StaticOrder S; S.init(cfg::M, cfg::D, G, bx);
            pg8::EpiResid E{W, 3 * l + 2, 0.0f};
            pg8::gemm_phase<pg8::EpiResid, pg8::StaticOrder, true, true>(lds, g, S, E);
        }
        SEAM(pb + 5);
#endif
        if ((PH_MASK & 2) && IN(pb + 6)) {
            LAUNDER_W(); unsigned char* wl = W + ws::WBASE + (size_t)l * ws::WLAYER;
            pg8::Gemm g{(const bf16_t*)(W + ws::XB), (const bf16_t*)(wl + ws::W_GU2), cfg::M, 2 * cfg::FF, cfg::D}; pg8::StaticOrder S; S.init(cfg::M, 2 * cfg::FF, G, bx);
            const int gid0_ = pg8::rstd_table((LAS float*)(lds + RSTAB_OFF), S, pg8::ssqx_buf(W, 3 * l + 2), (int)threadIdx.x);
            pg8::EpiSwiGLU E{W, 3 * l + 2, (const LAS float*)(lds + RSTAB_OFF), gid0_};
            pg8::gemm_phase<pg8::EpiSwiGLU, pg8::StaticOrder, true, true>(lds, g, S, E);
        }
        SEAM(pb + 6);
        if ((PH_MASK & 4) && IN(pb + 7)) {
            LAUNDER_W(); unsigned char* wl = W + ws::WBASE + (size_t)l * ws::WLAYER;
            pg8::Gemm g{(const bf16_t*)(W + ws::H), (const bf16_t*)(wl + ws::W_D2), cfg::M, cfg::D, cfg::FF}; pg8::StaticOrder S; S.init(cfg::M, cfg::D, G, bx);
            pg8::EpiResid E{W, 3 * l + 3, 0.5f};
            pg8::gemm_phase<pg8::EpiResid, pg8::StaticOrder, true, true>(lds, g, S, E);
        }
        SEAM(pb + 7);
        }
    { constexpr int l = 3;
        const int pb = 1 + 8 * l;
        if ((PH_MASK & 2) && IN(pb + 0)) {
            LAUNDER_W(); unsigned char* wl = W + ws::WBASE + (size_t)l * ws::WLAYER;
            pg8::Gemm g{(const bf16_t*)(W + ws::XB), (const bf16_t*)(wl + ws::W_GU1), cfg::M, 2 * cfg::FF, cfg::D}; pg8::StaticOrder S; S.init(cfg::M, 2 * cfg::FF, G, bx);
            const int gid0_ = pg8::rstd_table((LAS float*)(lds + RSTAB_OFF), S, pg8::ssqx_buf(W, 3 * l), (int)threadIdx.x);
            pg8::EpiSwiGLU E{W, 3 * l, (const LAS float*)(lds + RSTAB_OFF), gid0_};
            pg8::gemm_phase<pg8::EpiSwiGLU, pg8::StaticOrder, true, true>(lds, g, S, E);
        }
        SEAM(pb + 0);
#if PROBE_DOUBLE == 1
        if ((PH_MASK & 2) && IN(pb + 0)) {
            LAUNDER_W(); unsigned char* wl = W + ws::WBASE + (size_t)l * ws::WLAYER;
            pg8::Gemm g{(const bf16_t*)(W + ws::XB), (const bf16_t*)(wl + ws::W_GU1), cfg::M, 2 * cfg::FF, cfg::D}; pg8::StaticOrder S; S.init(cfg::M, 2 * cfg::FF, G, bx);
            const int gid0_ = pg8::rstd_table((LAS float*)(lds + RSTAB_OFF), S, pg8::ssqx_buf(W, 3 * l), (int)threadIdx.x);
            pg8::EpiSwiGLU E{W, 3 * l, (const LAS float*)(lds + RSTAB_OFF), gid0_};
            pg8::gemm_phase<pg8::EpiSwiGLU, pg8::StaticOrder, true, true>(lds, g, S, E);
        }
        SEAM(pb + 0);
#endif
#if PROBE_DOUBLE == 11
        if ((PH_MASK & 2) && IN(pb + 0)) {
            LAUNDER_W(); unsigned char* wl = W + ws::WBASE + (size_t)l * ws::WLAYER;
            pg8::Gemm g{(const bf16_t*)(W + ws::XB), (const bf16_t*)(wl + ws::W_GU1), cfg::M, 2 * cfg::FF, cfg::D}; pg8::StaticOrder S; S.init(cfg::M, 2 * cfg::FF, G, bx);
            pg8::EpiNull E{P.out};
            pg8::gemm_phase<pg8::EpiNull, pg8::StaticOrder, true, true>(lds, g, S, E);
        }
        SEAM(pb + 0);
#endif
        if ((PH_MASK & 4) && IN(pb + 1)) {
            LAUNDER_W(); unsigned char* wl = W + ws::WBASE + (size_t)l * ws::WLAYER;
            pg8::Gemm g{(const bf16_t*)(W + ws::H), (const bf16_t*)(wl + ws::W_D1), cfg::M, cfg::D, cfg::FF}; pg8::StaticOrder S; S.init(cfg::M, cfg::D, G, bx);
            pg8::EpiResid E{W, 3 * l + 1, 0.5f};
            pg8::gemm_phase<pg8::EpiResid, pg8::StaticOrder, true, true>(lds, g, S, E);
        }
        SEAM(pb + 1);
#if PROBE_DOUBLE == 2
        if ((PH_MASK & 4) && IN(pb + 1)) {
            LAUNDER_W(); unsigned char* wl = W + ws::WBASE + (size_t)l * ws::WLAYER;
            pg8::Gemm g{(const bf16_t*)(W + ws::H), (const bf16_t*)(wl + ws::W_D1), cfg::M, cfg::D, cfg::FF}; pg8::StaticOrder S; S.init(cfg::M, cfg::D, G, bx);
            pg8::EpiResid E{W, 3 * l + 1, 0.0f};
            pg8::gemm_phase<pg8::EpiResid, pg8::StaticOrder, true, true>(lds, g, S, E);
        }
        SEAM(pb + 1);
#endif
        if ((PH_MASK & 8) && IN(pb + 2)) {
            LAUNDER_W(); unsigned char* wl = W + ws::WBASE + (size_t)l * ws::WLAYER;
            pg8::Gemm g{(const bf16_t*)(W + ws::XB), (const bf16_t*)(wl + ws::W_IN), cfg::M, cfg::DINP, cfg::D}; pg8::StaticOrder S; S.init(cfg::M, cfg::DINP, G, bx);
            pg8::EpiWin E{W, l};
            pg8::gemm_phase<pg8::EpiWin, pg8::StaticOrder, true, true>(lds, g, S, E);
        }
        SEAM(pb + 2);
#if PROBE_DOUBLE == 3
        if ((PH_MASK & 8) && IN(pb + 2)) {
            LAUNDER_W(); unsigned char* wl = W + ws::WBASE + (size_t)l * ws::WLAYER;
            pg8::Gemm g{(const bf16_t*)(W + ws::XB), (const bf16_t*)(wl + ws::W_IN), cfg::M, cfg::DINP, cfg::D}; pg8::StaticOrder S; S.init(cfg::M, cfg::DINP, G, bx);
            pg8::EpiWin E{W, l};
            pg8::gemm_phase<pg8::EpiWin, pg8::StaticOrder, true, true>(lds, g, S, E);
        }
        SEAM(pb + 2);
#endif
        if ((PH_MASK & (16 | 512 | 1024)) && IN(pb + 3)) {
            if (PH_MASK & 16) { LAUNDER_W(); unsigned char* wl = W + ws::WBASE + (size_t)l * ws::WLAYER;
              pg8::Gemm g{(const bf16_t*)(W + ws::CQ), (const bf16_t*)(wl + ws::W_UQ), cfg::M, 768, 256}; pg8::StaticOrder S; S.init(cfg::M, 768, G, bx);
              pg8::EpiQ E{W, l};
              pg8::gemm_phase<pg8::EpiQ, pg8::StaticOrder, true, true>(lds, g, S, E); }
            if (PH_MASK & 512) { LAUNDER_W(); unsigned char* wl = W + ws::WBASE + (size_t)l * ws::WLAYER;
              pg8::Gemm g{(const bf16_t*)(W + ws::CKV), (const bf16_t*)(wl + ws::W_KV), cfg::M, 512, 128}; pg8::StaticOrder S; S.init(cfg::M, 512, G, bx);
              pg8::EpiKN E{W, l};
              pg8::gemm_phase<pg8::EpiKN, pg8::StaticOrder, true, true>(lds, g, S, E); }
            if (PH_MASK & 1024) { LAUNDER_W(); unsigned char* wl = W + ws::WBASE + (size_t)l * ws::WLAYER;
              pg8::Gemm g{(const bf16_t*)(wl + ws::W_KV) + 512 * 128, (const bf16_t*)(W + ws::CKV), 512, cfg::M, 128}; pg8::StaticOrder S; S.init(512, cfg::M, G, bx);
              pg8::EpiVT E{W, l};
              pg8::gemm_phase<pg8::EpiVT, pg8::StaticOrder, true, true>(lds, g, S, E); }
        }
        SEAM(pb + 3);
#if PROBE_DOUBLE == 4
        if ((PH_MASK & (16 | 512 | 1024)) && IN(pb + 3)) {
            if (PH_MASK & 16) { LAUNDER_W(); unsigned char* wl = W + ws::WBASE + (size_t)l * ws::WLAYER;
              pg8::Gemm g{(const bf16_t*)(W + ws::CQ), (const bf16_t*)(wl + ws::W_UQ), cfg::M, 768, 256}; pg8::StaticOrder S; S.init(cfg::M, 768, G, bx);
              pg8::EpiQ E{W, l};
              pg8::gemm_phase<pg8::EpiQ, pg8::StaticOrder, true, true>(lds, g, S, E); }
            if (PH_MASK & 512) { LAUNDER_W(); unsigned char* wl = W + ws::WBASE + (size_t)l * ws::WLAYER;
              pg8::Gemm g{(const bf16_t*)(W + ws::CKV), (const bf16_t*)(wl + ws::W_KV), cfg::M, 512, 128}; pg8::StaticOrder S; S.init(cfg::M, 512, G, bx);
              pg8::EpiKN E{W, l};
              pg8::gemm_phase<pg8::EpiKN, pg8::StaticOrder, true, true>(lds, g, S, E); }
            if (PH_MASK & 1024) { LAUNDER_W(); unsigned char* wl = W + ws::WBASE + (size_t)l * ws::WLAYER;
              pg8::Gemm g{(const bf16_t*)(wl + ws::W_KV) + 512 * 128, (const bf16_t*)(W + ws::CKV), 512, cfg::M, 128}; pg8::StaticOrder S; S.init(512, cfg::M, G, bx);
              pg8::EpiVT E{W, l};
              pg8::gemm_phase<pg8::EpiVT, pg8::StaticOrder, true, true>(lds, g, S, E); }
        }
        SEAM(pb + 3);
#endif
        if ((PH_MASK & 96) && IN(pb + 4)) {
            LOCAL_TID(); LAUNDER_W(); const float* sp = (const float*)(W + ws::SMALLP) + l * 4096;
            const int x0 = (int)__builtin_amdgcn_readfirstlane((int)(xb_xcc_id() & 7u));
            for (int xs = 0; xs < 8; ++xs) {
                const int x = (x0 + xs) & 7;
                gu32* head = (gu32*)(W + ws::CTL) + ws::CW_QUEUE + (l * 8 + x) * 64 + 0 * 32;
                bool have = false; unsigned kp = 0u;
                for (;;) {
                    if (tid == 0) MISC[0] = have ? kp : __hip_atomic_fetch_add(head, 1u, __ATOMIC_RELAXED, __HIP_MEMORY_SCOPE_AGENT);
                    __syncthreads();
                    const int k = (int)MISC[0] + 0;
                    __syncthreads();
                    have = false;
                    if (k >= 200) break;
                    if (k < 8) { if (PH_MASK & 64) { const int u = x * 8 + k; mls::mlstm_unit(lds, u >> 2, u & 3, (const bf16_t*)(W + ws::QM), (const bf16_t*)(W + ws::KM), (const bf16_t*)(W + ws::VM), (const bf16_t*)(W + ws::OG),
                                                  (const float*)(W + ws::IFG), sp, sp + 2048, (bf16_t*)(W + ws::Y)); } }
                    else if (PH_MASK & 32) { const int a = k - 8; const int bhq = x * 16 + ((a < 64) ? (a & 15) : ((a - 64) & 15)); const int qa = (a < 64) ? (a >> 4) : 11 - ((a - 64) >> 4), qb2 = (a < 64) ? 15 - (a >> 4) : -1; att::attn_unit(lds, bhq, qa, qb2, (const bf16_t*)(W + ws::Q), (const bf16_t*)(W + ws::KF), (const bf16_t*)(W + ws::VT), (bf16_t*)(W + ws::Y), head, kp); have = true; }
                }
            }
        }
        SEAM(pb + 4);
#if PROBE_DOUBLE == 5
        if ((PH_MASK & 96) && IN(pb + 4)) {
            LOCAL_TID(); LAUNDER_W(); const float* sp = (const float*)(W + ws::SMALLP) + l * 4096;
            const int x0 = (int)__builtin_amdgcn_readfirstlane((int)(xb_xcc_id() & 7u));
            for (int xs = 0; xs < 8; ++xs) {
                const int x = (x0 + xs) & 7;
                gu32* head = (gu32*)(W + ws::CTL) + ws::CW_QUEUE + (l * 8 + x) * 64 + 1 * 32;
                for (;;) {
                    if (tid == 0) MISC[0] = __hip_atomic_fetch_add(head, 1u, __ATOMIC_RELAXED, __HIP_MEMORY_SCOPE_AGENT);
                    __syncthreads();
                    const int k = (int)MISC[0] + 0;
                    __syncthreads();
                    if (k >= 200) break;
                    if (k < 8) { if (PH_MASK & 64) { const int u = x * 8 + k; mls::mlstm_unit(lds, u >> 2, u & 3, (const bf16_t*)(W + ws::QM), (const bf16_t*)(W + ws::KM), (const bf16_t*)(W + ws::VM), (const bf16_t*)(W + ws::OG),
                                                  (const float*)(W + ws::IFG), sp, sp + 2048, (bf16_t*)(W + ws::Y)); } }
                    else if (PH_MASK & 32) { const int a = k - 8; const int bhq = x * 16 + ((a < 64) ? (a & 15) : ((a - 64) & 15)); const int qa = (a < 64) ? (a >> 4) : 11 - ((a - 64) >> 4), qb2 = (a < 64) ? 15 - (a >> 4) : -1; { unsigned kd_ = 0u; att::attn_unit(lds, bhq, qa, qb2, (const bf16_t*)(W + ws::Q), (const bf16_t*)(W + ws::KF), (const bf16_t*)(W + ws::VT), (bf16_t*)(W + ws::Y), head, kd_); } }
                }
            }
        }
        SEAM(pb + 4);
#endif
#if PROBE_DOUBLE == 7
        if ((PH_MASK & 96) && IN(pb + 4)) {
            LOCAL_TID(); LAUNDER_W(); const float* sp = (const float*)(W + ws::SMALLP) + l * 4096;
            const int x0 = (int)__builtin_amdgcn_readfirstlane((int)(xb_xcc_id() & 7u));
            for (int xs = 0; xs < 8; ++xs) {
                const int x = (x0 + xs) & 7;
                gu32* head = (gu32*)(W + ws::CTL) + ws::CW_QUEUE + (l * 8 + x) * 64 + 1 * 32;
                for (;;) {
                    if (tid == 0) MISC[0] = __hip_atomic_fetch_add(head, 1u, __ATOMIC_RELAXED, __HIP_MEMORY_SCOPE_AGENT);
                    __syncthreads();
                    const int k = (int)MISC[0] + 0;
                    __syncthreads();
                    if (k >= 8) break;
                    if (k < 8) { if (PH_MASK & 64) { const int u = x * 8 + k; mls::mlstm_unit(lds, u >> 2, u & 3, (const bf16_t*)(W + ws::QM), (const bf16_t*)(W + ws::KM), (const bf16_t*)(W + ws::VM), (const bf16_t*)(W + ws::OG),
                                                  (const float*)(W + ws::IFG), sp, sp + 2048, (bf16_t*)(W + ws::Y)); } }
                    else if (PH_MASK & 32) { const int a = k - 8; const int bhq = x * 16 + ((a < 64) ? (a & 15) : ((a - 64) & 15)); const int qa = (a < 64) ? (a >> 4) : 11 - ((a - 64) >> 4), qb2 = (a < 64) ? 15 - (a >> 4) : -1; { unsigned kd_ = 0u; att::attn_unit(lds, bhq, qa, qb2, (const bf16_t*)(W + ws::Q), (const bf16_t*)(W + ws::KF), (const bf16_t*)(W + ws::VT), (bf16_t*)(W + ws::Y), head, kd_); } }
                }
            }
        }
        SEAM(pb + 4);
#endif
#if PROBE_DOUBLE == 8
        if ((PH_MASK & 96) && IN(pb + 4)) {
            LOCAL_TID(); LAUNDER_W(); const float* sp = (const float*)(W + ws::SMALLP) + l * 4096;
            const int x0 = (int)__builtin_amdgcn_readfirstlane((int)(xb_xcc_id() & 7u));
            for (int xs = 0; xs < 8; ++xs) {
                const int x = (x0 + xs) & 7;
                gu32* head = (gu32*)(W + ws::CTL) + ws::CW_QUEUE + (l * 8 + x) * 64 + 1 * 32;
                for (;;) {
                    if (tid == 0) MISC[0] = __hip_atomic_fetch_add(head, 1u, __ATOMIC_RELAXED, __HIP_MEMORY_SCOPE_AGENT);
                    __syncthreads();
                    const int k = (int)MISC[0] + 8;
                    __syncthreads();
                    if (k >= 200) break;
                    if (k < 8) { if (PH_MASK & 64) { const int u = x * 8 + k; mls::mlstm_unit(lds, u >> 2, u & 3, (const bf16_t*)(W + ws::QM), (const bf16_t*)(W + ws::KM), (const bf16_t*)(W + ws::VM), (const bf16_t*)(W + ws::OG),
                                                  (const float*)(W + ws::IFG), sp, sp + 2048, (bf16_t*)(W + ws::Y)); } }
                    else if (PH_MASK & 32) { const int a = k - 8; const int bhq = x * 16 + ((a < 64) ? (a & 15) : ((a - 64) & 15)); const int qa = (a < 64) ? (a >> 4) : 11 - ((a - 64) >> 4), qb2 = (a < 64) ? 15 - (a >> 4) : -1; { unsigned kd_ = 0u; att::attn_unit(lds, bhq, qa, qb2, (const bf16_t*)(W + ws::Q), (const bf16_t*)(W + ws::KF), (const bf16_t*)(W + ws::VT), (bf16_t*)(W + ws::Y), head, kd_); } }
                }
            }
        }
        SEAM(pb + 4);
#endif
        if ((PH_MASK & 128) && IN(pb + 5)) {
            LAUNDER_W(); unsigned char* wl = W + ws::WBASE + (size_t)l * ws::WLAYER;
            pg8::Gemm g{(const bf16_t*)(W + ws::Y), (const bf16_t*)(wl + ws::W_O), cfg::M, cfg::D, cfg::D}; pg8::StaticOrder S; S.init(cfg::M, cfg::D, G, bx);
            pg8::EpiResid E{W, 3 * l + 2, 1.0f};
            pg8::gemm_phase<pg8::EpiResid, pg8::StaticOrder, true, true>(lds, g, S, E);
        }
        SEAM(pb + 5);
#if PROBE_DOUBLE == 6
        if ((PH_MASK & 128) && IN(pb + 5)) {
            LAUNDER_W(); unsigned char* wl = W + ws::WBASE + (size_t)l * ws::WLAYER;
            pg8::Gemm g{(const bf16_t*)(W + ws::Y), (const bf16_t*)(wl + ws::W_O), cfg::M, cfg::D, cfg::D}; pg8::StaticOrder S; S.init(cfg::M, cfg::D, G, bx);
            pg8::EpiResid E{W, 3 * l + 2, 0.0f};
            pg8::gemm_phase<pg8::EpiResid, pg8::StaticOrder, true, true>(lds, g, S, E);
        }
        SEAM(pb + 5);
#endif
        if ((PH_MASK & 2) && IN(pb + 6)) {
            LAUNDER_W(); unsigned char* wl = W + ws::WBASE + (size_t)l * ws::WLAYER;
            pg8::Gemm g{(const bf16_t*)(W + ws::XB), (const bf16_t*)(wl + ws::W_GU2), cfg::M, 2 * cfg::FF, cfg::D}; pg8::StaticOrder S; S.init(cfg::M, 2 * cfg::FF, G, bx);
            const int gid0_ = pg8::rstd_table((LAS float*)(lds + RSTAB_OFF), S, pg8::ssqx_buf(W, 3 * l + 2), (int)threadIdx.x);
            pg8::EpiSwiGLU E{W, 3 * l + 2, (const LAS float*)(lds + RSTAB_OFF), gid0_};
            pg8::gemm_phase<pg8::EpiSwiGLU, pg8::StaticOrder, true, true>(lds, g, S, E);
        }
        SEAM(pb + 6);
        if ((PH_MASK & 4) && IN(pb + 7)) {
            LAUNDER_W(); unsigned char* wl = W + ws::WBASE + (size_t)l * ws::WLAYER;
            pg8::Gemm g{(const bf16_t*)(W + ws::H), (const bf16_t*)(wl + ws::W_D2), cfg::M, cfg::D, cfg::FF}; pg8::StaticOrder S; S.init(cfg::M, cfg::D, G, bx);
            pg8::EpiResid E{W, 3 * l + 3, 0.5f};
            pg8::gemm_phase<pg8::EpiResid, pg8::StaticOrder, true, true>(lds, g, S, E);
        }
        SEAM(pb + 7);
        }
    if ((PH_MASK & 256) && IN(33)) {
        LOCAL_TID(); LAUNDER_W(); const float* ssq = (const float*)(W + ws::SSQX);   const f32x4* gp = (const f32x4*)P.in[23] + 4 * lane;
        f32x4 gv[4];
#pragma unroll
        for (int j = 0; j < 4; ++j) gv[j] = gp[j];
        for (int m = gw; m < cfg::M; m += NGW) {
            const float rs = __builtin_amdgcn_rsqf(wave_sum((lane < 16) ? ssq[(size_t)m * 16 + lane] : 0.f, lane) * (1.f / cfg::D) + cfg::EPS);
            const u32x4* xr = (const u32x4*)((const bf16_t*)(W + ws::XB) + (size_t)m * cfg::D) + 2 * lane; f32x4* orow = (f32x4*)(P.out + (size_t)m * cfg::D) + 4 * lane;
            const u32x4 b0 = xr[0], b1 = xr[1];
            orow[0] = (f32x4){bflo(b0.x), bfhi(b0.x), bflo(b0.y), bfhi(b0.y)} * rs * gv[0]; orow[1] = (f32x4){bflo(b0.z), bfhi(b0.z), bflo(b0.w), bfhi(b0.w)} * rs * gv[1];
            orow[2] = (f32x4){bflo(b1.x), bfhi(b1.x), bflo(b1.y), bfhi(b1.y)} * rs * gv[2]; orow[3] = (f32x4){bflo(b1.z), bfhi(b1.z), bflo(b1.w), bfhi(b1.w)} * rs * gv[3];
        }
    }
#if PROBE_DOUBLE == 10
    SEAM(33);
    if ((PH_MASK & 256) && IN(33)) {
        LOCAL_TID(); LAUNDER_W(); const float* ssq = (const float*)(W + ws::SSQX);   const f32x4* gp = (const f32x4*)P.in[23] + lane;
        f32x4 gv[4];
#pragma unroll
        for (int j = 0; j < 4; ++j) gv[j] = gp[64 * j];
        for (int m = gw; m < cfg::M; m += NGW) {
            const float rs = __builtin_amdgcn_rsqf(wave_sum((lane < 16) ? ssq[(size_t)m * 16 + lane] : 0.f, lane) * (1.f / cfg::D) + cfg::EPS);
            const u32x2* xr = (const u32x2*)((const bf16_t*)(W + ws::XB) + (size_t)m * cfg::D) + lane; f32x4* orow = (f32x4*)(P.out + (size_t)m * cfg::D) + lane;
#pragma unroll
            for (int j = 0; j < 4; ++j) { const u32x2 b = xr[64 * j]; f32x4 v; v[0] = bflo(b.x); v[1] = bfhi(b.x); v[2] = bflo(b.y); v[3] = bfhi(b.y); orow[64 * j] = v * rs * gv[j]; }
        }
    }
#endif
#undef IN
#undef SEAM
}

extern "C" void kernel_launch(void* const* d_in, const int* in_sizes, int n_in, void* d_out, int out_size, void* d_ws, size_t ws_size, hipStream_t stream) {
    static int grid = 0;
    if (grid == 0) {
        if (n_in != 24 || in_sizes[0] != cfg::M * cfg::D || out_size != cfg::M * cfg::D || ws_size < ws::END) { fprintf(stderr, "kernel_launch: unexpected shapes / workspace (n_in %d, ws %zu)\n", n_in, ws_size); grid = -1; return; }
        int dev = 0, cus = 0, per_cu = 0;
        if (hipGetDevice(&dev) != hipSuccess || hipDeviceGetAttribute(&cus, hipDeviceAttributeMultiprocessorCount, dev) != hipSuccess) { grid = -1; return; }
        if (hipFuncSetAttribute((const void*)hymba_fwd, hipFuncAttributeMaxDynamicSharedMemorySize, LDS_BYTES) != hipSuccess) { fprintf(stderr, "kernel_launch: hipFuncSetAttribute failed\n"); grid = -1; return; }
        if (hipOccupancyMaxActiveBlocksPerMultiprocessor(&per_cu, (const void*)hymba_fwd, 512, LDS_BYTES) != hipSuccess || per_cu < 1) fprintf(stderr, "kernel_launch: occupancy query reports %d\n", per_cu);
        (void)hipGetLastError();
        if (cus < 256) { fprintf(stderr, "kernel_launch: built for a 256-CU device (MI355X); found %d CUs; nothing launched\n", cus); grid = -1; return; }
        grid = 256;
    }
    if (grid < 0) return;
    (void)hipMemsetAsync((char*)d_ws + ws::CTL, 0, ws::ZERO_BYTES, stream);
    Params p{};
    for (int i = 0; i < 24; ++i) p.in[i] = (const float*)d_in[i];
    p.out = (float*)d_out; p.ws = (unsigned char*)d_ws; p.pad = 0;
#if MK_PER_PHASE
#ifdef BISECT_MASK
    { static bool once = false; if (!once) { once = true; (void)hipFuncSetAttribute((const void*)hymba_fwd_loop, hipFuncAttributeMaxDynamicSharedMemorySize, LDS_BYTES); } }
    for (int ph = 0; ph < NPHASE; ++ph) { p.ph_lo = ph; p.ph_hi = ph + 1; p.li = 0; const int t = (ph == 0) ? 0 : (ph == 33) ? 9 : 1 + ((ph - 1) & 7);
        if ((BISECT_MASK >> t) & 1) hipLaunchKernelGGL(hymba_fwd, dim3(grid), dim3(512), LDS_BYTES, stream, p); else hipLaunchKernelGGL(hymba_fwd_loop, dim3(grid), dim3(512), LDS_BYTES, stream, p); }
#else
    for (int ph = 0; ph < NPHASE; ++ph) { p.ph_lo = ph; p.ph_hi = ph + 1; p.li = 0; hipLaunchKernelGGL(hymba_fwd, dim3(grid), dim3(512), LDS_BYTES, stream, p); }
#endif
#else
    p.ph_lo = 0; p.ph_hi = NPHASE; p.li = 0;
    hipLaunchKernelGGL(hymba_fwd, dim3(grid), dim3(512), LDS_BYTES, stream, p);
#endif
}
```

```cpp
#include <hip/hip_runtime.h>
#include <cstdio>
#include <cstdint>

#define LAS __attribute__((address_space(3)))
#define GAS __attribute__((address_space(1)))
typedef unsigned short bf16_t;
typedef short bf16x8 __attribute__((ext_vector_type(8)));
typedef short s16x4 __attribute__((ext_vector_type(4)));
typedef float f32x2 __attribute__((ext_vector_type(2)));
typedef float f32x4 __attribute__((ext_vector_type(4)));
typedef float f32x16 __attribute__((ext_vector_type(16)));
typedef unsigned u32x2 __attribute__((ext_vector_type(2)));
typedef unsigned u32x4 __attribute__((ext_vector_type(4)));
typedef GAS unsigned gu32;

namespace cfg {
constexpr int NB = 16, S = 4096, M = NB * S, D = 1024, DEPTH = 4, FF = 2816;
constexpr int NH = 8, DQK = 96, DNOPE = 64, DROPE = 32, DVH = 64, QLR = 256, KVLR = 128;
constexpr int MH = 4, MDK = 64, MDV = 128, CHUNK = 64, NCHUNK = S / CHUNK;
constexpr int DIN = 1960, DINP = 2048;
constexpr float EPS = 1e-6f;
constexpr float LOG2E = 1.4426950408889634f;
constexpr float QSCALE = 0.10206207261596575f * LOG2E;
}
namespace ws {
constexpr size_t MiB = 1u << 20;
constexpr size_t CTL = 0, ZERO_BYTES = 1 * MiB;
constexpr size_t SSQKV = 1 * MiB, SSQQ = 2 * MiB;
constexpr size_t SMALLP = 3 * MiB;
constexpr size_t SSQX = 24 * MiB;
constexpr size_t ROPE = 8 * MiB, IFG = 16 * MiB;
constexpr size_t WBASE = 32 * MiB, WLAYER = 40 * MiB;
constexpr size_t W_GU1 = 0, W_D1 = 11 * MiB, W_GU2 = 11 * MiB + 5632 * 1024, W_D2 = 27 * MiB + 512 * 1024, W_IN = 33 * MiB, W_UQ = 37 * MiB, W_KV = 37 * MiB + 512 * 1024, W_O = 38 * MiB;
constexpr size_t XB = 192 * MiB;
constexpr size_t H = 320 * MiB;
constexpr size_t CQ = 320 * MiB, CKV = 352 * MiB, QM = 368 * MiB, KM = 400 * MiB, VM = 432 * MiB, OG = 496 * MiB, Q = 560 * MiB, KF = 656 * MiB, VT = 752 * MiB, Y = 816 * MiB, END = 944 * MiB;
static_assert(W_D1 + 1024 * 2816 * 2 <= W_GU2 && W_GU2 + 5632 * 1024 * 2 <= W_D2 && W_D2 + 1024 * 2816 * 2 <= W_IN && W_IN + 2048 * 1024 * 2 <= W_UQ && W_UQ + 768 * 256 * 2 <= W_KV && W_KV + 1024 * 128 * 2 <= W_O && W_O + 1024 * 1024 * 2 <= WLAYER, "weight map");
static_assert(H + (size_t)cfg::M * cfg::FF * 2 <= Y + (size_t)cfg::M * 1024 * 2 && Y + (size_t)cfg::M * 1024 * 2 == END, "activation map");
constexpr int CW_QUEUE = 1024, CW_BAR = 4096;
}
namespace pg8 {
#define PG8_LAS __attribute__((address_space(3)))
typedef unsigned short bf16_t;
typedef short bf16x8 __attribute__((ext_vector_type(8)));
typedef float f32x4 __attribute__((ext_vector_type(4)));
typedef unsigned u32x4 __attribute__((ext_vector_type(4)));
constexpr int BM = 256, BK = 64, HALF = 128, HTB = HALF * BK * 2  , STAGE_BYTES = 8 * HTB, NXCD = 8, WGM = 8;

__host__ __device__ __forceinline__ int lds_byte(int r, int c) { const int st = (r >> 4) * 2 + (c >> 5), rr = r & 15, cc = c & 31, ob = rr * 64 + cc * 2; return st * 1024 + (ob ^ (((ob >> 9) & 1) << 5)); }
__host__ __device__ __forceinline__ void stage_rc(int b, int& R, int& C) { const int st = b / 1024, sb = b % 1024, swz = sb ^ (((sb >> 9) & 1) << 5); R = (st >> 1) * 16 + swz / 64; C = (st & 1) * 32 + (swz % 64) / 2; }
__host__ __device__ __forceinline__ int perm32(int rho) { const int n = rho >> 4, i = rho & 15; return 8 * (i >> 2) + 4 * n + (i & 3); }

struct Unit { int pm, pn; };
struct Gemm { const bf16_t* A; const bf16_t* Bt; int M, N, K; };

template <bool COLS> struct PanelOrderT {
    int n, c;
    __host__ __device__ void init(int M, int N, int, int c_) { c = c_; n = COLS ? (M / BM) : (N / BM); }
    __host__ __device__ bool next(int i, Unit& u) const { if (i >= n) return false; if (COLS) { u.pm = i; u.pn = c; } else { u.pm = c; u.pn = i; } return true; }
    __device__ __forceinline__ void a_ready(const Unit&) const {}
    __device__ __forceinline__ void done(const Unit&) const {}
};
typedef PanelOrderT<false> PanelOrder;
typedef PanelOrderT<true> PanelOrderC;
struct LatinOrder {
    int x, j, k, r_lo, r_hi;
    __host__ __device__ void init(int bx, int lo, int hi) { x = bx & 7; const int w = bx >> 3; j = w & 7; k = w >> 3; r_lo = lo; r_hi = hi; }
    __host__ __device__ int own_round() const { return (8 - 2 * k) & 7; }
    __host__ __device__ int own_panel() const { return 32 * x + 8 * (own_round() >> 1) + j; }
    __host__ __device__ bool next(int i, Unit& u) const { const int r = r_lo + i; if (r >= r_hi) return false; u.pm = 32 * x + 8 * (r >> 1) + j; u.pn = (2 * k + r) & 7; return true; }
    __device__ __forceinline__ void a_ready(const Unit&) const {}
    __device__ __forceinline__ void done(const Unit&) const {}
};

struct StaticOrder {
    int nM, nN, nwg, G, c;
    __host__ __device__ void init(int M, int N, int G_, int c_) { nM = M / BM; nN = N / BM; nwg = nM * nN; G = G_; c = c_; }
    __host__ __device__ bool next(int i, Unit& u) const {
        const long L = (long)i * G + c; if (L >= nwg) return false;
        int wgid = (int)L; { const int q = nwg / NXCD, r = nwg % NXCD, xcd = wgid % NXCD, off = wgid / NXCD; wgid = (xcd < r ? xcd * (q + 1) : r * (q + 1) + (xcd - r) * q) + off; }
        const int nig = WGM * nN, gid = wgid / nig, fm = gid * WGM, gsz = (nM - fm) < WGM ? (nM - fm) : WGM;
        u.pm = fm + ((wgid % nig) % gsz); u.pn = (wgid % nig) / gsz; return true;
    }
    __device__ __forceinline__ void a_ready(const Unit&) const {}
    __device__ __forceinline__ void done(const Unit&) const {}
};

typedef __bf16 bf16x2v_t __attribute__((ext_vector_type(2)));
__device__ __forceinline__ unsigned cvt_pk_bf16(float lo, float hi) { typedef float f32x2v_t __attribute__((ext_vector_type(2))); const f32x2v_t v = {lo, hi}; const bf16x2v_t b = __builtin_convertvector(v, bf16x2v_t); return __builtin_bit_cast(unsigned, b); }
__device__ __forceinline__ float silu_f(float x) { return x * __builtin_amdgcn_rcpf(1.f + __builtin_amdgcn_exp2f(-cfg::LOG2E * x)); }
__device__ __forceinline__ float sigmoid_f(float x) { return __builtin_amdgcn_rcpf(1.f + __builtin_amdgcn_exp2f(-cfg::LOG2E * x)); }
__device__ __forceinline__ u32x4 pack8(const f32x4 a, const f32x4 b) { u32x4 w; w.x = cvt_pk_bf16(a[0], a[1]); w.y = cvt_pk_bf16(a[2], a[3]); w.z = cvt_pk_bf16(b[0], b[1]); w.w = cvt_pk_bf16(b[2], b[3]); return w; }
__device__ __forceinline__ float sumsq8(const f32x4 a, const f32x4 b) { return (a[0] * a[0] + a[1] * a[1]) + (a[2] * a[2] + a[3] * a[3]) + (b[0] * b[0] + b[1] * b[1]) + (b[2] * b[2] + b[3] * b[3]); }
__device__ __forceinline__ float row_ssq16(const float* buf, int row, int fq);
__device__ __forceinline__ float quad_sum(float v) {
    { const auto r = __builtin_amdgcn_permlane16_swap(__float_as_uint(v), __float_as_uint(v), false, false); v = __uint_as_float(r[0]) + __uint_as_float(r[1]); }
    { const auto r = __builtin_amdgcn_permlane32_swap(__float_as_uint(v), __float_as_uint(v), false, false); v = __uint_as_float(r[0]) + __uint_as_float(r[1]); }
    return v; }

__device__ __forceinline__ float row_ssq16(const float* buf, int row, int fq) { const f32x4 v = *(const f32x4*)(buf + (size_t)row * 16 + 4 * fq); return quad_sum((v[0] + v[1]) + (v[2] + v[3])); }
__device__ __forceinline__ float row_ssq4(const float* buf, int row) { const f32x4 v = *(const f32x4*)(buf + (size_t)row * 4); return (v[0] + v[1]) + (v[2] + v[3]); }
__device__ __forceinline__ const float* ssqx_buf(unsigned char* W, int si) { return (const float*)(W + ws::SSQX) + (size_t)(si & 1) * cfg::M * 16; }

template <class Sched> __device__ __forceinline__ int rstd_table(PG8_LAS float* tab, const Sched& S, const float* ssq, int tid) {
    Unit u; int gid0 = 0, last = -1; asm volatile("" : "+v"(tid));
    for (int i = 0; S.next(i, u); ++i) {
        if (i == 0) gid0 = u.pm >> 3;
        if (u.pm != last) { last = u.pm;
            if (tid < 256) { const f32x4* p = (const f32x4*)(ssq + (size_t)(u.pm * BM + tid) * 16); const f32x4 a = p[0], b = p[1], c = p[2], d = p[3];
                const float t = ((a[0] + a[1]) + (a[2] + a[3])) + ((b[0] + b[1]) + (b[2] + b[3])) + ((c[0] + c[1]) + (c[2] + c[3])) + ((d[0] + d[1]) + (d[2] + d[3]));
                tab[((u.pm >> 3) - gid0) * 256 + tid] = __builtin_amdgcn_rsqf(t * (1.f / cfg::D) + cfg::EPS); } } }
    __syncthreads();
    return gid0;
}

struct EpiSwiGLU {
    static constexpr bool PERM = true, AFTER_DRAIN = false;
    unsigned char* W; int si;
    const PG8_LAS float* rstab; int gid0;
    static constexpr int ND = 2;
    struct Def { u32x4 a[4], b[4]; };
    static __device__ __forceinline__ f32x2 swi2(const f32x2 g, const f32x2 u) {
        const f32x2 t = g * (f32x2){-cfg::LOG2E, -cfg::LOG2E};
        f32x2 s; s[0] = __builtin_amdgcn_exp2f(fminf(t[0], 60.f)); s[1] = __builtin_amdgcn_exp2f(fminf(t[1], 60.f));
        s = s + (f32x2){1.f, 1.f};
        const float r = __builtin_amdgcn_rcpf(s[0] * s[1]);
        const f32x2 sig = (f32x2){s[1], s[0]} * (f32x2){r, r};
        return (g * sig) * u;
    }
    template <bool DEFER_HALF> __device__ __forceinline__ void run(const f32x4 (&acc)[2][2][4][2], const Unit& u_, int wr, int wc, int fr, int fq, Def& D) const {
        Unit u = u_; asm volatile("" : "+s"(u.pm), "+s"(u.pn), "+v"(fr), "+v"(fq));
        bf16_t* const H = (bf16_t*)(W + ws::H);
        const int row0 = u.pm * BM + wr * 64 + fr, hcol = u.pn * 128 + wc * 32 + 8 * fq;
        float rsv[2][4];
        { const PG8_LAS float* tp = rstab + ((u.pm >> 3) - gid0) * 256 + wr * 64 + fr;
#pragma unroll
          for (int ai = 0; ai < 2; ++ai)
#pragma unroll
              for (int m = 0; m < 4; ++m) rsv[ai][m] = tp[ai * HALF + m * 16]; }
#pragma unroll
        for (int ai = 1; ai >= 0; --ai)
#pragma unroll
            for (int m = 3; m >= 0; --m) {
                const int row = row0 + ai * HALF + m * 16;
                const float rs = rsv[ai][m];
                const f32x2 rs2 = {rs, rs};
                if (DEFER_HALF && ai == 1 && m >= 4 - ND) {
                    f32x4 g0, g1, u0, u1;
#pragma unroll
                    for (int e = 0; e < 4; ++e) { g0[e] = acc[1][0][m][0][e] * rs; g1[e] = acc[1][0][m][1][e] * rs; u0[e] = acc[1][1][m][0][e] * rs; u1[e] = acc[1][1][m][1][e] * rs; }
                    D.a[m] = pack8(g0, g1); D.b[m] = pack8(u0, u1);
                } else {
                    f32x4 h0, h1;
#pragma unroll
                    for (int n = 0; n < 2; ++n)
#pragma unroll
                        for (int e = 0; e < 4; e += 2) {
                            const f32x2 ga = {acc[ai][0][m][n][e], acc[ai][0][m][n][e + 1]}, ua = {acc[ai][1][m][n][e], acc[ai][1][m][n][e + 1]};
                            const f32x2 hh = swi2(ga * rs2, ua * rs2);
                            if (n == 0) { h0[e] = hh[0]; h0[e + 1] = hh[1]; } else { h1[e] = hh[0]; h1[e + 1] = hh[1]; }
                        }
                    *(u32x4*)(H + (size_t)row * cfg::FF + hcol) = pack8(h0, h1);
                }
            }
    }
    __device__ __forceinline__ void operator()(const f32x4 (&acc)[2][2][4][2], const Unit& u_, int wr, int wc, int fr, int fq) const { Def D; run<false>(acc, u_, wr, wc, fr, fq, D); }
    __device__ __forceinline__ void later(Def& D, const int q) const {
#pragma unroll
        for (int d = 2 * q; d < 2 * q + 2; ++d) {
            const int m = 4 - ND + (d >> 2), j = d & 3;
            const u32x4 ga = D.a[m], ua = D.b[m];
            const unsigned gw = (j == 0) ? ga.x : (j == 1) ? ga.y : (j == 2) ? ga.z : ga.w, uw = (j == 0) ? ua.x : (j == 1) ? ua.y : (j == 2) ? ua.z : ua.w;
            const f32x2 g = {__uint_as_float(gw << 16), __uint_as_float(gw & 0xffff0000u)}, uu = {__uint_as_float(uw << 16), __uint_as_float(uw & 0xffff0000u)};
            const f32x2 hh = swi2(g, uu);
            const unsigned ow = cvt_pk_bf16(hh[0], hh[1]);
            if (j == 0) D.a[m].x = ow; else if (j == 1) D.a[m].y = ow; else if (j == 2) D.a[m].z = ow; else D.a[m].w = ow;
        }
    }
    __device__ __forceinline__ void pin(Def& D, const int q) const {
#pragma unroll
        for (int d = 2 * q; d < 2 * q + 2; ++d) { const int m = 4 - ND + (d >> 2), j = d & 3;
            if (j == 0) asm volatile("" : "+v"(D.a[m].x)); else if (j == 1) asm volatile("" : "+v"(D.a[m].y)); else if (j == 2) asm volatile("" : "+v"(D.a[m].z)); else asm volatile("" : "+v"(D.a[m].w)); }
    }
    __device__ __forceinline__ void flush(const Def& D, const Unit& u_, int wr, int wc, int fr, int fq) const {
        Unit u = u_; asm volatile("" : "+s"(u.pm), "+s"(u.pn), "+v"(fr), "+v"(fq));
        bf16_t* const H = (bf16_t*)(W + ws::H);
        const int row0 = u.pm * BM + wr * 64 + fr + HALF, hcol = u.pn * 128 + wc * 32 + 8 * fq;
#pragma unroll
        for (int m = 4 - ND; m < 4; ++m) *(u32x4*)(H + (size_t)(row0 + m * 16) * cfg::FF + hcol) = D.a[m];
    }
};

struct EpiResid {
    static constexpr bool PERM = true, AFTER_DRAIN = false;
    unsigned char* W; int si; float alpha;
    __device__ __forceinline__ void prefetch_unused(const Unit& u_, PG8_LAS unsigned char* junk, int tid) const {
        Unit u = u_; asm volatile("" : "+s"(u.pm), "+s"(u.pn), "+v"(tid));
        const unsigned char* base = W + ws::XB + ((size_t)u.pm * BM * cfg::D + (size_t)u.pn * BM) * 2;
#pragma unroll
        for (int i = 0; i < 2; ++i) { const int ln = tid + 512 * i;
            __builtin_amdgcn_global_load_lds((const unsigned*)(base + (size_t)(ln >> 2) * (cfg::D * 2) + (ln & 3) * 128), (PG8_LAS unsigned*)junk, 4, 0, 0); }
    }
    __device__ __forceinline__ void operator()(const f32x4 (&acc)[2][2][4][2], const Unit& u_, int wr, int wc, int fr, int fq) const {
        Unit u = u_; asm volatile("" : "+s"(u.pm), "+s"(u.pn), "+v"(fr), "+v"(fq));
        bf16_t* const xb = (bf16_t*)(W + ws::XB); float* const ssq_out = (float*)ssqx_buf(W, si);
        const int row0 = u.pm * BM + wr * 64 + fr, col0 = u.pn * BM + wc * 32 + 8 * fq;
        u32x4 xin[2][4][2];
#pragma unroll
        for (int ai = 0; ai < 2; ++ai)
#pragma unroll
            for (int m = 0; m < 4; ++m)
#pragma unroll
                for (int bj = 0; bj < 2; ++bj) xin[ai][m][bj] = *(const u32x4*)(xb + (size_t)(row0 + ai * HALF + m * 16) * cfg::D + col0 + bj * HALF);
#pragma unroll
        for (int ai = 0; ai < 2; ++ai)
#pragma unroll
            for (int m = 0; m < 4; ++m) {
                const int row = row0 + ai * HALF + m * 16; const size_t off = (size_t)row * cfg::D + col0; float part = 0.f;
#pragma unroll
                for (int bj = 0; bj < 2; ++bj) {
                    const u32x4 b = xin[ai][m][bj];
                    f32x4 x0, x1;
                    x0[0] = __uint_as_float(b.x << 16); x0[1] = __uint_as_float(b.x & 0xffff0000u); x0[2] = __uint_as_float(b.y << 16); x0[3] = __uint_as_float(b.y & 0xffff0000u);
                    x1[0] = __uint_as_float(b.z << 16); x1[1] = __uint_as_float(b.z & 0xffff0000u); x1[2] = __uint_as_float(b.w << 16); x1[3] = __uint_as_float(b.w & 0xffff0000u);
                    x0 = x0 + acc[ai][bj][m][0] * alpha; x1 = x1 + acc[ai][bj][m][1] * alpha;
                    *(u32x4*)(xb + off + bj * HALF) = pack8(x0, x1);
                    part += sumsq8(x0, x1);
                }
                part = quad_sum(part);
                if (fq == 0) ssq_out[(size_t)row * 16 + u.pn * 4 + wc] = part;
            }
    }
};

struct EpiWin {
    static constexpr bool PERM = true, AFTER_DRAIN = false;
    unsigned char* W; int l;
    __device__ __forceinline__ void operator()(const f32x4 (&acc)[2][2][4][2], const Unit& u_, int wr, int wc, int fr, int fq) const {
        Unit u = u_; asm volatile("" : "+s"(u.pm), "+s"(u.pn), "+v"(fr), "+v"(fq));
        const float* const ssq = ssqx_buf(W, 3 * l + 1);
        bf16_t* const CQ = (bf16_t*)(W + ws::CQ); bf16_t* const CKV = (bf16_t*)(W + ws::CKV); bf16_t* const KF = (bf16_t*)(W + ws::KF); bf16_t* const QM = (bf16_t*)(W + ws::QM);
        bf16_t* const KM = (bf16_t*)(W + ws::KM); bf16_t* const VM = (bf16_t*)(W + ws::VM); bf16_t* const OG = (bf16_t*)(W + ws::OG); float* const IF = (float*)(W + ws::IFG);
        float* const ssq_q = (float*)(W + ws::SSQQ); float* const ssq_kv = (float*)(W + ws::SSQKV);
        const f32x2* const rope = (const f32x2*)(W + ws::ROPE);
        const float* const b_i = (const float*)(W + ws::SMALLP) + l * 4096 + 2560; const float* const b_f = b_i + 4;
        const int row0 = u.pm * BM + wr * 64 + fr, pn = u.pn, cw = wc * 32 + 8 * fq;
        f32x4 pq[2][4]; float rsv[2][4];
#pragma unroll
        for (int ai = 0; ai < 2; ++ai)
#pragma unroll
            for (int m = 0; m < 4; ++m) pq[ai][m] = *(const f32x4*)(ssq + (size_t)(row0 + ai * HALF + m * 16) * 16 + 4 * fq);
#pragma unroll
        for (int ai = 0; ai < 2; ++ai)
#pragma unroll
            for (int m = 0; m < 4; ++m) rsv[ai][m] = __builtin_amdgcn_rsqf(quad_sum((pq[ai][m][0] + pq[ai][m][1]) + (pq[ai][m][2] + pq[ai][m][3])) * (1.f / cfg::D) + cfg::EPS);
        f32x4 bi4 = {0.f, 0.f, 0.f, 0.f}, bf4 = {0.f, 0.f, 0.f, 0.f};
        if (pn == 1 && wc == 1) { bi4 = *(const f32x4*)b_i; bf4 = *(const f32x4*)b_f; }
#pragma unroll
        for (int ai = 0; ai < 2; ++ai) {
            f32x4 csw[4][2];
#pragma unroll
            for (int m = 0; m < 4; ++m) {
                if ((m & 1) == 0 && pn == 1 && wc == 0) {
#pragma unroll
                    for (int mm = m; mm < m + 2; ++mm) { const f32x4* cp = (const f32x4*)(rope + (size_t)(row0 + ai * HALF + mm * 16) * 16 + 4 * fq); csw[mm][0] = cp[0]; csw[mm][1] = cp[1]; }
                }
                const int row = row0 + ai * HALF + m * 16;
                const float rs = rsv[ai][m];
                f32x4 v[2][2];
#pragma unroll
                for (int bj = 0; bj < 2; ++bj) { v[bj][0] = acc[ai][bj][m][0] * rs; v[bj][1] = acc[ai][bj][m][1] * rs; }
                if (pn == 0) {
                    float part = 0.f;
#pragma unroll
                    for (int bj = 0; bj < 2; ++bj) { *(u32x4*)(CQ + (size_t)row * cfg::QLR + bj * HALF + cw) = pack8(v[bj][0], v[bj][1]); part += sumsq8(v[bj][0], v[bj][1]); }
                    part = quad_sum(part); if (fq == 0) ssq_q[(size_t)row * 4 + wc] = part;
                } else if (pn == 1) {
                    *(u32x4*)(CKV + (size_t)row * cfg::KVLR + cw) = pack8(v[0][0], v[0][1]);
                    float part = quad_sum(sumsq8(v[0][0], v[0][1])); if (fq == 0) ssq_kv[(size_t)row * 4 + wc] = part;
                    if (wc == 0) {
                        const f32x4 cs0 = csw[m][0], cs1 = csw[m][1];
                        f32x4 r0, r1;
                        r0[0] = v[1][0][0] * cs0[0] - v[1][0][1] * cs0[1]; r0[1] = v[1][0][1] * cs0[0] + v[1][0][0] * cs0[1];
                        r0[2] = v[1][0][2] * cs0[2] - v[1][0][3] * cs0[3]; r0[3] = v[1][0][3] * cs0[2] + v[1][0][2] * cs0[3];
                        r1[0] = v[1][1][0] * cs1[0] - v[1][1][1] * cs1[1]; r1[1] = v[1][1][1] * cs1[0] + v[1][1][0] * cs1[1];
                        r1[2] = v[1][1][2] * cs1[2] - v[1][1][3] * cs1[3]; r1[3] = v[1][1][3] * cs1[2] + v[1][1][2] * cs1[3];
                        const u32x4 w = pack8(r0, r1);
                        const int b = row >> 12, s = row & 4095;
#pragma unroll
                        for (int h = 0; h < cfg::NH; ++h) *(u32x4*)(KF + ((size_t)(b * cfg::NH + h) * cfg::S + s) * cfg::DQK + cfg::DNOPE + 8 * fq) = w;
                    } else if (wc == 1 && fq == 0) {
                        f32x4 ig, lf;
#pragma unroll
                        for (int e = 0; e < 4; ++e) { ig[e] = v[1][0][e] + bi4[e]; const float z = v[1][1][e] + bf4[e]; lf[e] = fminf(z, 0.f) - log1pf(__expf(-fabsf(z))); }
                        *(f32x4*)(IF + (size_t)row * 8) = ig; *(f32x4*)(IF + (size_t)row * 8 + 4) = lf;
                    }
                } else if (pn < 4) {
                    bf16_t* dst = (pn == 2) ? QM : KM;
#pragma unroll
                    for (int bj = 0; bj < 2; ++bj) *(u32x4*)(dst + (size_t)row * 256 + bj * HALF + cw) = pack8(v[bj][0], v[bj][1]);
                } else if (pn < 6) {
#pragma unroll
                    for (int bj = 0; bj < 2; ++bj) *(u32x4*)(VM + (size_t)row * 512 + (pn - 4) * 256 + bj * HALF + cw) = pack8(v[bj][0], v[bj][1]);
                } else {
#pragma unroll
                    for (int bj = 0; bj < 2; ++bj) { f32x4 a, b;
#pragma unroll
                        for (int e = 0; e < 4; ++e) { a[e] = sigmoid_f(v[bj][0][e]); b[e] = sigmoid_f(v[bj][1][e]); }
                        *(u32x4*)(OG + (size_t)row * 512 + (pn - 6) * 256 + bj * HALF + cw) = pack8(a, b); }
                }
            }
        }
    }
};

struct EpiQ {
    static constexpr bool PERM = true, AFTER_DRAIN = false;
    unsigned char* W; int l;
    __device__ __forceinline__ void operator()(const f32x4 (&acc)[2][2][4][2], const Unit& u_, int wr, int wc, int fr, int fq) const {
        Unit u = u_; asm volatile("" : "+s"(u.pm), "+s"(u.pn), "+v"(fr), "+v"(fq));
        const float* const ssq_q = (const float*)(W + ws::SSQQ); const f32x2* const rope = (const f32x2*)(W + ws::ROPE); bf16_t* const Q = (bf16_t*)(W + ws::Q);
        const int row0 = u.pm * BM + wr * 64 + fr;
        f32x4 pq[2][4]; float rsr[2][4];
#pragma unroll
        for (int ai = 0; ai < 2; ++ai)
#pragma unroll
            for (int m = 0; m < 4; ++m) pq[ai][m] = *(const f32x4*)(ssq_q + (size_t)(row0 + ai * HALF + m * 16) * 4);
#pragma unroll
        for (int ai = 0; ai < 2; ++ai)
#pragma unroll
            for (int m = 0; m < 4; ++m) rsr[ai][m] = __builtin_amdgcn_rsqf(((pq[ai][m][0] + pq[ai][m][1]) + (pq[ai][m][2] + pq[ai][m][3])) * (1.f / cfg::QLR) + cfg::EPS) * cfg::QSCALE;
#pragma unroll
        for (int bj = 0; bj < 2; ++bj) {
            const int col = u.pn * BM + bj * HALF + wc * 32 + 8 * fq, h = col / cfg::DQK, d = col - h * cfg::DQK;
            const bool rp = d >= cfg::DNOPE;
            const int i0 = rp ? ((d - cfg::DNOPE) >> 1) : 0;
#pragma unroll
            for (int ai = 0; ai < 2; ++ai) {
                f32x4 cs[4][2];
#pragma unroll
                for (int m = 0; m < 4; ++m) { const f32x4* cp = (const f32x4*)(rope + (size_t)(row0 + ai * HALF + m * 16) * 16 + i0); cs[m][0] = cp[0]; cs[m][1] = cp[1]; }
#pragma unroll
                for (int m = 0; m < 4; ++m) {
                    const int row = row0 + ai * HALF + m * 16; const int b = row >> 12, s = row & 4095;
                    const float rs = rsr[ai][m];
                    f32x4 v0 = acc[ai][bj][m][0] * rs, v1 = acc[ai][bj][m][1] * rs;
                    if (rp) {
                        const f32x4 cs0 = cs[m][0], cs1 = cs[m][1];
                        f32x4 r0, r1;
                        r0[0] = v0[0] * cs0[0] - v0[1] * cs0[1]; r0[1] = v0[1] * cs0[0] + v0[0] * cs0[1];
                        r0[2] = v0[2] * cs0[2] - v0[3] * cs0[3]; r0[3] = v0[3] * cs0[2] + v0[2] * cs0[3];
                        r1[0] = v1[0] * cs1[0] - v1[1] * cs1[1]; r1[1] = v1[1] * cs1[0] + v1[0] * cs1[1];
                        r1[2] = v1[2] * cs1[2] - v1[3] * cs1[3]; r1[3] = v1[3] * cs1[2] + v1[2] * cs1[3];
                        v0 = r0; v1 = r1;
                    }
                    *(u32x4*)(Q + ((size_t)(b * cfg::NH + h) * cfg::S + s) * cfg::DQK + d) = pack8(v0, v1);
                }
            }
        }
    }
};

struct EpiKN {
    static constexpr bool PERM = true, AFTER_DRAIN = false;
    unsigned char* W; int l;
    __device__ __forceinline__ void operator()(const f32x4 (&acc)[2][2][4][2], const Unit& u_, int wr, int wc, int fr, int fq) const {
        Unit u = u_; asm volatile("" : "+s"(u.pm), "+s"(u.pn), "+v"(fr), "+v"(fq));
        const float* const ssq_kv = (const float*)(W + ws::SSQKV); bf16_t* const KF = (bf16_t*)(W + ws::KF);
        const int row0 = u.pm * BM + wr * 64 + fr;
        f32x4 pq[2][4];
#pragma unroll
        for (int ai = 0; ai < 2; ++ai)
#pragma unroll
            for (int m = 0; m < 4; ++m) pq[ai][m] = *(const f32x4*)(ssq_kv + (size_t)(row0 + ai * HALF + m * 16) * 4);
#pragma unroll
        for (int ai = 0; ai < 2; ++ai)
#pragma unroll
            for (int m = 0; m < 4; ++m) {
                const int row = row0 + ai * HALF + m * 16; const int b = row >> 12, s = row & 4095;
                const float rs = __builtin_amdgcn_rsqf(((pq[ai][m][0] + pq[ai][m][1]) + (pq[ai][m][2] + pq[ai][m][3])) * (1.f / cfg::KVLR) + cfg::EPS);
#pragma unroll
                for (int bj = 0; bj < 2; ++bj) {
                    const int col = u.pn * BM + bj * HALF + wc * 32 + 8 * fq, h = col >> 6, d = col & 63;
                    *(u32x4*)(KF + ((size_t)(b * cfg::NH + h) * cfg::S + s) * cfg::DQK + d) = pack8(acc[ai][bj][m][0] * rs, acc[ai][bj][m][1] * rs);
                }
            }
    }
};

struct EpiVT {
    static constexpr bool PERM = true, AFTER_DRAIN = false;
    unsigned char* W; int l;
    __device__ __forceinline__ void operator()(const f32x4 (&acc)[2][2][4][2], const Unit& u_, int wr, int wc, int fr, int fq) const {
        Unit u = u_; asm volatile("" : "+s"(u.pm), "+s"(u.pn), "+v"(fr), "+v"(fq));
        const float* const ssq_kv = (const float*)(W + ws::SSQKV); bf16_t* const VT = (bf16_t*)(W + ws::VT);
        const int row0 = u.pm * BM + wr * 64 + fr;
        f32x4 rsa[2][2];
#pragma unroll
        for (int bj = 0; bj < 2; ++bj) { const int tok = u.pn * BM + bj * HALF + wc * 32 + 8 * fq;
#pragma unroll
            for (int e = 0; e < 4; ++e) { rsa[bj][0][e] = row_ssq4(ssq_kv, tok + e); rsa[bj][1][e] = row_ssq4(ssq_kv, tok + 4 + e); } }
#pragma unroll
        for (int bj = 0; bj < 2; ++bj) {
            const int tok = u.pn * BM + bj * HALF + wc * 32 + 8 * fq; const int b = tok >> 12, s = tok & 4095;
            f32x4 rs0, rs1;
#pragma unroll
            for (int e = 0; e < 4; ++e) { rs0[e] = __builtin_amdgcn_rsqf(rsa[bj][0][e] * (1.f / cfg::KVLR) + cfg::EPS); rs1[e] = __builtin_amdgcn_rsqf(rsa[bj][1][e] * (1.f / cfg::KVLR) + cfg::EPS); }
#pragma unroll
            for (int ai = 0; ai < 2; ++ai)
#pragma unroll
                for (int m = 0; m < 4; ++m) {
                    const int r = row0 + ai * HALF + m * 16;
                    *(u32x4*)(VT + ((size_t)(b * 512 + r)) * cfg::S + s) = pack8(acc[ai][bj][m][0] * rs0, acc[ai][bj][m][1] * rs1);
                }
        }
    }
};

struct EpiNull {
    static constexpr bool PERM = true, AFTER_DRAIN = false;
    float* dummy;
    __device__ __forceinline__ void operator()(const f32x4 (&acc)[2][2][4][2], const Unit& u, int wr, int wc, int fr, int fq) const {
        f32x4 t = acc[0][0][0][0];
#pragma unroll
        for (int ai = 0; ai < 2; ++ai)
#pragma unroll
            for (int bj = 0; bj < 2; ++bj)
#pragma unroll
                for (int m = 0; m < 4; ++m) { t = t + acc[ai][bj][m][0]; t = t + acc[ai][bj][m][1]; }
        dummy[(size_t)(u.pm * 4 + (u.pn & 3)) * 512 + (wr * 4 + wc) * 64 + fr + 16 * fq] = (t[0] + t[1]) + (t[2] + t[3]);
    }
};
__device__ __forceinline__ void glds16_saddr(const void* sbase, unsigned voff, unsigned lds_dst) {
    asm volatile("s_mov_b32 m0, %2\n\ts_nop 0\n\tglobal_load_lds_dwordx4 %0, %1" : : "v"(voff), "s"(sbase), "s"(lds_dst) : "memory", "m0"); }
constexpr int PF_JUNK_OFF = 131072 + 8192, PF_DIST = 8;
template <class E, class = void> struct HasPrefetch { static constexpr bool v = false; };
template <class E> struct HasPrefetch<E, decltype((void)&E::prefetch)> { static constexpr bool v = true; };
template <class E, class = void> struct HasDefer { static constexpr bool v = false; struct Def {}; };
template <class E> struct HasDefer<E, decltype((void)sizeof(typename E::Def))> { static constexpr bool v = true; typedef typename E::Def Def; };
template <class Epi, class Sched, bool ALIGN_EPI = false, bool SP2 = false>
__device__ __forceinline__ void gemm_phase(PG8_LAS unsigned char* lds, const Gemm g, const Sched& S, const Epi& E) {
    int tid_ = threadIdx.x; asm volatile("" : "+v"(tid_));
    const int tid = tid_, wid = __builtin_amdgcn_readfirstlane(tid >> 6), lane = tid & 63, wr = wid >> 2, wc = wid & 3, fr = lane & 15, fq = lane >> 4;
    int K_ = g.K; asm volatile("" : "+s"(K_));
    const int K = K_, nt = K / BK; const int tpf = (nt > PF_DIST) ? ((nt - PF_DIST) & ~1) : 0; (void)tpf;
    unsigned voffA[2], voffB[2];
#pragma unroll
    for (int i = 0; i < 2; ++i) { int R, C; stage_rc(tid * 16 + i * 8192, R, C); const int Rb = Epi::PERM ? ((R & ~31) + perm32(R & 31)) : R;
        voffA[i] = (unsigned)(R * K + C) * 2u; voffB[i] = (unsigned)(Rb * K + C) * 2u; }
    const size_t kstep = (size_t)(BK * 2);
    const size_t hstep = (size_t)HALF * K * 2;
    const size_t tstep = 2 * hstep;
    const unsigned lds0_ = (unsigned)(uintptr_t)lds;
    const unsigned ldsw = (unsigned)wid * 1024u;
    const int aoff = lds_byte(wr * 64 + fr, fq * 8), boff = lds_byte(wc * 32 + fr, fq * 8);
#define PG8_SA(b, h) (((b) * 2 + (h)) * HTB)
#define PG8_SB(b, h) ((4 + (b) * 2 + (h)) * HTB)
#define PG8_STAGE(bufoff, gbase, voff) do { _Pragma("unroll") for (int _i = 0; _i < 2; ++_i) \
        glds16_saddr((const void*)(gbase), (voff)[_i], lds0_ + (unsigned)((bufoff) + _i * 8192) + ldsw); } while (0)
#define PG8_LDA(dst, b, h) do { _Pragma("unroll") for (int m = 0; m < 4; ++m) _Pragma("unroll") for (int k = 0; k < 2; ++k) dst[m][k] = *(const PG8_LAS bf16x8*)(lds + PG8_SA(b, h) + aoff + m * 2048 + k * 1024); } while (0)
#define PG8_LDB(dst, b, h) do { _Pragma("unroll") for (int n = 0; n < 2; ++n) _Pragma("unroll") for (int k = 0; k < 2; ++k) dst[n][k] = *(const PG8_LAS bf16x8*)(lds + PG8_SB(b, h) + boff + n * 2048 + k * 1024); } while (0)
#define PG8_MMA(ai, bj, At, Bt) do { if (PG8_PRIO) __builtin_amdgcn_s_setprio(1); _Pragma("unroll") for (int m = 0; m < 4; ++m) _Pragma("unroll") for (int n = 0; n < 2; ++n) _Pragma("unroll") for (int k = 0; k < 2; ++k) \
        acc[ai][bj][m][n] = __builtin_amdgcn_mfma_f32_16x16x32_bf16(Bt[n][k], At[m][k], acc[ai][bj][m][n], 0, 0, 0); if (PG8_PRIO) __builtin_amdgcn_s_setprio(0); } while (0)
#define PG8_PIN(q) do { _Pragma("unroll") for (int _q = 0; _q < 32; ++_q) { __builtin_amdgcn_sched_group_barrier(0x008, 1, 0); __builtin_amdgcn_sched_group_barrier(0x002, 1, 0); if ((_q & 3) == 0) __builtin_amdgcn_sched_group_barrier(0x400, 1, 0); } E.pin(DF, q); } while (0)
#define PG8_WAIT_V(n) asm volatile("s_waitcnt vmcnt(" #n ")" ::: "memory")
#define PG8_WAIT_L(n) asm volatile("s_waitcnt lgkmcnt(" #n ")" ::: "memory")
#define PG8_BAR __builtin_amdgcn_s_barrier()
#define PG8_SCHED __builtin_amdgcn_sched_barrier(0)
#define PG8_ITER(F0, F1, F2, F3, G0, G1, G2, G3) \
            if constexpr (HasPrefetch<Epi>::v) { if (t == tpf) E.prefetch(cur, lds + PF_JUNK_OFF + wid * 256, tid); } \
            const bool last = (t == nt - 2); \
            const char* a1 = cA + (size_t)(t + 1) * kstep; \
            const char* a2 = last ? nA : cA + (size_t)(t + 2) * kstep; const char* b2 = last ? nB : cB + (size_t)(t + 2) * kstep; \
            const char* a3 = a2 + kstep; const char* b3 = b2 + kstep; \
            if (last && has_next) S.a_ready(nxt); \
            PG8_LDB(B0, 0, 0); PG8_LDB(B1, 0, 1); PG8_SCHED; PG8_LDA(At, 0, 0); PG8_STAGE(PG8_SA(1, 1), a1 + hstep, voffA); \
            PG8_WAIT_V(8); PG8_WAIT_L(0); PG8_BAR; F0; PG8_MMA(0, 0, At, B0); PG8_MMA(0, 1, At, B1); G0; PG8_BAR; PG8_SCHED; \
            PG8_LDA(At, 0, 1); PG8_STAGE(PG8_SB(0, 0), b2, voffB); PG8_STAGE(PG8_SB(0, 1), b2 + hstep, voffB); PG8_STAGE(PG8_SA(0, 0), a2, voffA); \
            PG8_WAIT_V(8); PG8_WAIT_L(0); PG8_BAR; F1; PG8_MMA(1, 0, At, B0); PG8_MMA(1, 1, At, B1); G1; PG8_BAR; PG8_SCHED; \
            PG8_LDB(B0, 1, 0); PG8_LDB(B1, 1, 1); PG8_SCHED; PG8_LDA(At, 1, 0); PG8_STAGE(PG8_SA(0, 1), a2 + hstep, voffA); \
            PG8_WAIT_V(8); PG8_WAIT_L(0); PG8_BAR; F2; PG8_MMA(0, 0, At, B0); PG8_MMA(0, 1, At, B1); G2; PG8_BAR; PG8_SCHED; \
            PG8_LDA(At, 1, 1); PG8_STAGE(PG8_SB(1, 0), b3, voffB); PG8_STAGE(PG8_SB(1, 1), b3 + hstep, voffB); PG8_STAGE(PG8_SA(1, 0), a3, voffA); \
            PG8_WAIT_V(8); PG8_WAIT_L(0); PG8_BAR; F3; PG8_MMA(1, 0, At, B0); PG8_MMA(1, 1, At, B1); G3; PG8_BAR; PG8_SCHED;
    Unit cur, nxt; int ui = 0;
    if (!S.next(0, cur)) return;
    f32x4 acc[2][2][4][2];
#pragma unroll
    for (int a = 0; a < 2; ++a)
#pragma unroll
        for (int b = 0; b < 2; ++b)
#pragma unroll
            for (int m = 0; m < 4; ++m)
#pragma unroll
                for (int n = 0; n < 2; ++n) acc[a][b][m][n] = (f32x4){0.f, 0.f, 0.f, 0.f};
    bf16x8 At[4][2], B0[2][2], B1[2][2];
    typename HasDefer<Epi>::Def DF; Unit prv = cur; (void)prv;
    if constexpr (HasDefer<Epi>::v) {
#pragma unroll
        for (int m = 0; m < 4; ++m) { DF.a[m] = (u32x4){0u, 0u, 0u, 0u}; DF.b[m] = (u32x4){0u, 0u, 0u, 0u}; } }
    const char* cA = (const char*)g.A + (size_t)cur.pm * tstep; const char* cB = (const char*)g.Bt + (size_t)cur.pn * tstep;
    S.a_ready(cur);
    if constexpr (SP2) {
        PG8_STAGE(PG8_SB(0, 0), cB, voffB); PG8_STAGE(PG8_SB(0, 1), cB + hstep, voffB); PG8_STAGE(PG8_SA(0, 0), cA, voffA); PG8_STAGE(PG8_SA(0, 1), cA + hstep, voffA);
        if (wr == 1) PG8_BAR;
        PG8_WAIT_V(2); PG8_BAR;
        PG8_STAGE(PG8_SB(1, 0), cB + kstep, voffB); PG8_STAGE(PG8_SA(1, 0), cA + kstep, voffA); PG8_STAGE(PG8_SB(1, 1), cB + hstep + kstep, voffB);
        PG8_WAIT_V(6); PG8_BAR;
    } else {
        PG8_STAGE(PG8_SB(0, 0), cB, voffB); PG8_STAGE(PG8_SA(0, 0), cA, voffA); PG8_STAGE(PG8_SB(0, 1), cB + hstep, voffB); PG8_STAGE(PG8_SA(0, 1), cA + hstep, voffA);
        if (wr == 1) PG8_BAR;
        PG8_WAIT_V(4); PG8_BAR;
        PG8_STAGE(PG8_SB(1, 0), cB + kstep, voffB); PG8_STAGE(PG8_SA(1, 0), cA + kstep, voffA); PG8_STAGE(PG8_SB(1, 1), cB + hstep + kstep, voffB);
        PG8_WAIT_V(6); PG8_BAR;
    }
    for (;;) {
        const bool has_next = S.next(ui + 1, nxt);
        const char* nA = has_next ? (const char*)g.A + (size_t)nxt.pm * tstep : cA; const char* nB = has_next ? (const char*)g.Bt + (size_t)nxt.pn * tstep : cB;
        if constexpr (SP2) {
            if constexpr (HasDefer<Epi>::v) {
                { const int t = 0; constexpr bool PG8_PRIO = false; PG8_ITER(PG8_SCHED; E.later(DF, 0), PG8_SCHED; E.later(DF, 1), PG8_SCHED; E.later(DF, 2), PG8_SCHED; E.later(DF, 3), PG8_PIN(0), PG8_PIN(1), PG8_PIN(2), PG8_PIN(3)) }
                if constexpr (Epi::ND == 4) { const int t = 2; constexpr bool PG8_PRIO = false; PG8_ITER(PG8_SCHED; E.later(DF, 4), PG8_SCHED; E.later(DF, 5), PG8_SCHED; E.later(DF, 6), PG8_SCHED; E.later(DF, 7), PG8_PIN(4), PG8_PIN(5), PG8_PIN(6), PG8_PIN(7)) }
                for (int t = Epi::ND; t < nt; t += 2) { constexpr bool PG8_PRIO = true; PG8_ITER((void)0, (void)0, (void)0, (void)0, (void)0, (void)0, (void)0, (void)0) }
            } else {
                for (int t = 0; t < nt; t += 2) { constexpr bool PG8_PRIO = true; PG8_ITER((void)0, (void)0, (void)0, (void)0, (void)0, (void)0, (void)0, (void)0) }
            }
        } else {
        for (int t = 0; t < nt; t += 2) { constexpr bool PG8_PRIO = true;
            if constexpr (HasPrefetch<Epi>::v) { if (t == tpf) E.prefetch(cur, lds + PF_JUNK_OFF + wid * 256, tid); }
            const bool last = (t == nt - 2);
            const char* a1 = cA + (size_t)(t + 1) * kstep;
            const char* a2 = last ? nA : cA + (size_t)(t + 2) * kstep; const char* b2 = last ? nB : cB + (size_t)(t + 2) * kstep;
            const char* a3 = a2 + kstep; const char* b3 = b2 + kstep;
            if (last && has_next) S.a_ready(nxt);
            PG8_LDB(B0, 0, 0); PG8_SCHED; PG8_LDA(At, 0, 0); PG8_STAGE(PG8_SA(1, 1), a1 + hstep, voffA);
            PG8_WAIT_L(8); PG8_BAR; PG8_WAIT_L(0); PG8_MMA(0, 0, At, B0); PG8_BAR; PG8_SCHED;
            PG8_LDB(B1, 0, 1); PG8_STAGE(PG8_SB(0, 0), b2, voffB);
            PG8_BAR; PG8_WAIT_L(0); PG8_MMA(0, 1, At, B1); PG8_BAR;
            PG8_LDA(At, 0, 1); PG8_STAGE(PG8_SA(0, 0), a2, voffA);
            PG8_BAR; PG8_WAIT_L(0); PG8_MMA(1, 0, At, B0); PG8_BAR; PG8_SCHED;
            PG8_STAGE(PG8_SB(0, 1), b2 + hstep, voffB);
            PG8_WAIT_V(6); PG8_BAR; PG8_MMA(1, 1, At, B1); PG8_BAR;
            PG8_LDB(B0, 1, 0); PG8_SCHED; PG8_LDA(At, 1, 0); PG8_STAGE(PG8_SA(0, 1), a2 + hstep, voffA);
            PG8_WAIT_L(8); PG8_BAR; PG8_WAIT_L(0); PG8_MMA(0, 0, At, B0); PG8_BAR; PG8_SCHED;
            PG8_LDB(B1, 1, 1); PG8_STAGE(PG8_SB(1, 0), b3, voffB);
            PG8_BAR; PG8_WAIT_L(0); PG8_MMA(0, 1, At, B1); PG8_BAR;
            PG8_LDA(At, 1, 1); PG8_STAGE(PG8_SA(1, 0), a3, voffA);
            PG8_BAR; PG8_WAIT_L(0); PG8_MMA(1, 0, At, B0); PG8_BAR; PG8_SCHED;
            PG8_STAGE(PG8_SB(1, 1), b3 + hstep, voffB);
            PG8_WAIT_V(6); PG8_BAR; PG8_MMA(1, 1, At, B1); PG8_BAR;
        }
        }
        if constexpr (ALIGN_EPI) { if (wr == 0) PG8_BAR; }
        if constexpr (HasDefer<Epi>::v) {
            if (ui > 0) E.flush(DF, prv, wr, wc, fr, fq);
            if (has_next) { E.template run<true>(acc, cur, wr, wc, fr, fq, DF); prv = cur; } else E.template run<false>(acc, cur, wr, wc, fr, fq, DF);
            S.done(cur);
        } else
        if constexpr (!Epi::AFTER_DRAIN) { E(acc, cur, wr, wc, fr, fq); S.done(cur); }
        if (!has_next) break;
#pragma unroll
        for (int a = 0; a < 2; ++a)
#pragma unroll
            for (int b = 0; b < 2; ++b)
#pragma unroll
                for (int m = 0; m < 4; ++m)
#pragma unroll
                    for (int n = 0; n < 2; ++n) acc[a][b][m][n] = (f32x4){0.f, 0.f, 0.f, 0.f};
        cur = nxt; cA = nA; cB = nB; ++ui;
        if constexpr (ALIGN_EPI) { if (wr == 1) PG8_BAR; }
    }
    PG8_WAIT_V(0);
    if constexpr (!ALIGN_EPI) { if (wr == 0) PG8_BAR; }
    PG8_BAR;
    if constexpr (Epi::AFTER_DRAIN) { E.fused(acc, cur, wr, wc, fr, fq, lds, wid, lane); S.done(cur); }
#undef PG8_SA
#undef PG8_SB
#undef PG8_STAGE
#undef PG8_LDA
#undef PG8_LDB
#undef PG8_MMA
#undef PG8_WAIT_V
#undef PG8_ITER
#undef PG8_PIN
#undef PG8_WAIT_L
#undef PG8_BAR
#undef PG8_SCHED
}
}
#define XB_TMO      128
#define XB_XCNT(j)  (256  + 64 * (j))
#define XB_XSUB(j)  (1280 + 64 * (j))
#define XB_XGEN(j)  (2304 + 64 * (j))
#define XB_TOP      3328
#define XB_TOPGEN   3392
#define XCD_BAR_WORDS 3456
#define XB_SPIN_CAP (1u << 18)

__device__ __forceinline__ unsigned xb_ld(unsigned* p)              { return __hip_atomic_load(p, __ATOMIC_RELAXED, __HIP_MEMORY_SCOPE_AGENT); }
__device__ __forceinline__ unsigned xb_add(unsigned* p, unsigned v) { return __hip_atomic_fetch_add(p, v, __ATOMIC_RELAXED, __HIP_MEMORY_SCOPE_AGENT); }
__device__ __forceinline__ unsigned xb_xcc_id() { return (unsigned)__builtin_amdgcn_s_getreg((3 << 11) | 20) & 0xFu; }
#define XB_SPIN(cond, bar) do { unsigned _sp = 0; while (cond) { __builtin_amdgcn_s_sleep(1); \
    if ((++_sp & 255u) == 0u) { if (xb_ld(&(bar)[XB_TMO])) break; if (_sp > XB_SPIN_CAP) { atomicAdd(&(bar)[XB_TMO], 1u); break; } } } } while (0)

struct XcdBarrier {
    unsigned* bar; unsigned x;
    volatile LAS unsigned* st;
};

__device__ __forceinline__ XcdBarrier xcd_barrier_post(unsigned* bar, volatile LAS unsigned* st) {
    XcdBarrier b; b.bar = bar; b.x = xb_xcc_id(); b.st = st;
    if (threadIdx.x == 0) (void)xb_add(&bar[XB_XCNT(b.x)], 1u);
    return b;
}
__device__ __forceinline__ void xcd_barrier_complete(unsigned* bar, unsigned x, unsigned& nloc, unsigned& nx) {
    const unsigned G = gridDim.x * gridDim.y * gridDim.z;
    unsigned sum, cnt, mine, sp = 0u;
    for (;;) {
        sum = 0u; cnt = 0u; mine = 0u;
#pragma unroll
        for (unsigned j = 0; j < 16; ++j) { const unsigned c = xb_ld(&bar[XB_XCNT(j)]); sum += c; cnt += (c > 0u) ? 1u : 0u; mine = (j == x) ? c : mine; }
        if (sum == G) break;
        __builtin_amdgcn_s_sleep(1);
        if ((++sp & 255u) == 0u) { if (xb_ld(&bar[XB_TMO])) break; if (sp > XB_SPIN_CAP) { atomicAdd(&bar[XB_TMO], 1u); break; } }
    }
    nloc = mine > 0u ? mine : 1u; nx = cnt > 0u ? cnt : 1u;
}

__device__ __forceinline__ void xcd_barrier(const XcdBarrier& b) {
    asm volatile("s_waitcnt vmcnt(0)" ::: "memory");
    __syncthreads();
    if (threadIdx.x == 0) {
        unsigned* bar = b.bar;
        __builtin_amdgcn_s_waitcnt(0);
        unsigned nloc = b.st[0], nx = b.st[1];
        if (nloc == 0u) { xcd_barrier_complete(bar, b.x, nloc, nx); b.st[0] = nloc; b.st[1] = nx; }
        const unsigned old = xb_add(&bar[XB_XSUB(b.x)], 1u);
        const unsigned gen = old / nloc;
        if (old + 1u == (gen + 1u) * nloc) {
            __builtin_amdgcn_fence(__ATOMIC_RELEASE, "agent");
            asm volatile("s_waitcnt vmcnt(0)" ::: "memory");
            const unsigned og = xb_add(&bar[XB_TOP], 1u);
            const unsigned tg = og / nx;
            if (og + 1u == (tg + 1u) * nx) xb_add(&bar[XB_TOPGEN], 1u);
            else XB_SPIN(xb_ld(&bar[XB_TOPGEN]) == tg, bar);
            __builtin_amdgcn_fence(__ATOMIC_ACQUIRE, "agent");
            xb_add(&bar[XB_XGEN(b.x)], 1u);
            asm volatile("s_waitcnt vmcnt(0)" ::: "memory");
        } else {
            XB_SPIN(xb_ld(&bar[XB_XGEN(b.x)]) == gen, bar);
            __builtin_amdgcn_fence(__ATOMIC_ACQUIRE, "agent");
            asm volatile("s_waitcnt vmcnt(0)" ::: "memory");
        }
    }
    __syncthreads();
}
typedef __bf16 bf16x2_t __attribute__((ext_vector_type(2)));
__device__ __forceinline__ unsigned cvtpk(float lo, float hi) { const f32x2 v = {lo, hi}; const bf16x2_t b = __builtin_convertvector(v, bf16x2_t); return __builtin_bit_cast(unsigned, b); }
__device__ __forceinline__ float bf2f(unsigned short b) { return __uint_as_float((unsigned)b << 16); }
__device__ __forceinline__ float bflo(unsigned w) { return __uint_as_float(w << 16); }
__device__ __forceinline__ float bfhi(unsigned w) { return __uint_as_float(w & 0xffff0000u); }
__device__ __forceinline__ void glds16(const void* gsrc, unsigned lds_dst) { unsigned keep;
    asm volatile("s_mov_b32 %0, m0\n\ts_mov_b32 m0, %2\n\ts_nop 0\n\tglobal_load_lds_dwordx4 %1, off\n\ts_mov_b32 m0, %0" : "=&s"(keep) : "v"(gsrc), "s"(lds_dst) : "memory"); }
__device__ __forceinline__ float half_swap_max(float m) { auto rr = __builtin_amdgcn_permlane32_swap(__float_as_uint(m), __float_as_uint(m), false, false); return fmaxf(__uint_as_float(rr[0]), __uint_as_float(rr[1])); }
__device__ __forceinline__ float half_swap_sum(float m) { auto rr = __builtin_amdgcn_permlane32_swap(__float_as_uint(m), __float_as_uint(m), false, false); return __uint_as_float(rr[0]) + __uint_as_float(rr[1]); }

namespace att {
constexpr int KTB = 64 * 192, VTB = 64 * 128, NSTG = 6;
constexpr int L_K = 0, L_V = NSTG * KTB, L_END = L_V + NSTG * VTB;
constexpr float THR = 8.f;
#define ATT_WAITBAR(N) asm volatile("s_waitcnt vmcnt(" #N ") lgkmcnt(0)\n\ts_barrier" ::: "memory")
__device__ __forceinline__ int slot_of(int t) { return t % NSTG; }
__device__ __forceinline__ float max3(float a, float b, float c) { return fmaxf(fmaxf(a, b), c); }

__device__ __forceinline__ void qk_tile(f32x16& p0, f32x16& p1, const LAS unsigned char* kb, const bf16x8 (&qf)[6], const f32x16& negm, int hi, int kc) {
    int g0 = hi + kc; if (g0 >= 12) g0 -= 12;
    bf16x8 ka[2][2];
#pragma unroll
    for (int d = 0; d < 2; ++d) { int g = g0 + 2 * d; if (g >= 12) g -= 12; ka[d][0] = *(const LAS bf16x8*)(kb + g * 16); ka[d][1] = *(const LAS bf16x8*)(kb + 32 * 192 + g * 16); }
#pragma unroll
    for (int d = 0; d < 6; ++d) {
        if (d == 0) { p0 = __builtin_amdgcn_mfma_f32_32x32x16_bf16(ka[0][0], qf[0], negm, 0, 0, 0); p1 = __builtin_amdgcn_mfma_f32_32x32x16_bf16(ka[0][1], qf[0], negm, 0, 0, 0); }
        else { p0 = __builtin_amdgcn_mfma_f32_32x32x16_bf16(ka[d & 1][0], qf[d], p0, 0, 0, 0); p1 = __builtin_amdgcn_mfma_f32_32x32x16_bf16(ka[d & 1][1], qf[d], p1, 0, 0, 0); }
        if (d + 2 < 6) { int g = g0 + 2 * (d + 2); if (g >= 12) g -= 12; if (g >= 12) g -= 12; ka[d & 1][0] = *(const LAS bf16x8*)(kb + g * 16); ka[d & 1][1] = *(const LAS bf16x8*)(kb + 32 * 192 + g * 16); }
    }
}
__device__ __forceinline__ void mask_tile(f32x16& p0, f32x16& p1, int kb0, int qrel) {
#pragma unroll
    for (int r = 0; r < 16; ++r) { const int kv = kb0 + 16 * (r >> 3) + (r & 7); if (kv > qrel) p0[r] = -INFINITY; if (kv + 32 > qrel) p1[r] = -INFINITY; }
}

__device__ __forceinline__ void attn_unit(LAS unsigned char* lds, int bh, int qbA, int qbB, const bf16_t* __restrict__ Q, const bf16_t* __restrict__ KF, const bf16_t* __restrict__ VT, bf16_t* __restrict__ Y, gu32* qhead, unsigned& knext) {
    int tid_ = threadIdx.x; asm volatile("" : "+v"(tid_));
    const int tid = tid_, lane = tid & 63, r32 = lane & 31, hi = lane >> 5;
    const int wid = __builtin_amdgcn_readfirstlane(tid >> 6);
    const unsigned lds0 = (unsigned)(uintptr_t)lds;
    const char* Kg = (const char*)(KF + (size_t)bh * cfg::S * cfg::DQK);
    const char* Vg = (const char*)(VT + (size_t)bh * cfg::DVH * cfg::S);
    const char *s0, *s1, *s2; unsigned d0, d1, d2; int str1, lst1;
    { const int p = wid * 64 + lane, row = p / 12, gq = p - row * 12; int g = gq - ((row >> 2) & 3); if (g < 0) g += 12; s0 = Kg + row * 192 + g * 16; d0 = lds0 + L_K + wid * 1024; }
    if (wid < 4) { const int p = (wid + 8) * 64 + lane, row = p / 12, gq = p - row * 12; int g = gq - ((row >> 2) & 3); if (g < 0) g += 12; s1 = Kg + row * 192 + g * 16; d1 = lds0 + L_K + (wid + 8) * 1024; str1 = KTB; lst1 = KTB; }
    else { const int p = (wid - 4) * 64 + lane, row = p >> 3, gq = p & 7, g = gq ^ ((row >> 1) & 7); s1 = Vg + (size_t)row * (cfg::S * 2) + g * 16; d1 = lds0 + L_V + (wid - 4) * 1024; str1 = 128; lst1 = VTB; }
    { const int p = ((wid & 3) + 4) * 64 + lane, row = p >> 3, gq = p & 7, g = gq ^ ((row >> 1) & 7); s2 = Vg + (size_t)row * (cfg::S * 2) + g * 16; d2 = lds0 + L_V + ((wid & 3) + 4) * 1024; }
#define ATT_ISSUE(t, stg) do { glds16(s0 + (size_t)(t) * KTB, (unsigned)__builtin_amdgcn_readfirstlane(d0 + (stg) * KTB)); \
        glds16(s1 + (size_t)(t) * str1, (unsigned)__builtin_amdgcn_readfirstlane(d1 + (stg) * lst1)); \
        if (wid < 4) glds16(s2 + (size_t)(t) * 128, (unsigned)__builtin_amdgcn_readfirstlane(d2 + (stg) * VTB)); } while (0)
    const int NTA = 4 * (qbA + 1), NTT = NTA + ((qbB >= 0) ? 4 * (qbB + 1) : 0);
#define ATT_ISSUE_T(T) do { const int T_ = (T); ATT_ISSUE((T_ < NTA) ? T_ : T_ - NTA, slot_of(T_)); } while (0)
    ATT_ISSUE_T(0); ATT_ISSUE_T(1); ATT_ISSUE_T(2); ATT_ISSUE_T(3);
    const int krow = (r32 & 0x13) | ((r32 & 4) << 1) | ((r32 & 8) >> 1);
    const int kc = (krow >> 2) & 3;
    const LAS unsigned char* kbase = lds + L_K + krow * 192;
    const LAS unsigned char* vbase = lds + L_V + r32 * 128;
    const int vx = (r32 >> 1) & 7;
    const int qrel = wid * 32 + r32;
  for (int half = 0; half < ((qbB >= 0) ? 2 : 1); ++half) {
    const int qb = half ? qbB : qbA, TO = half ? NTA : 0;
    const int NT = 4 * (qb + 1);
    const bf16_t* Qw = Q + ((size_t)bh * cfg::S + qb * 256 + wid * 32 + r32) * cfg::DQK + hi * 8;
    bf16x8 qf[6];
#pragma unroll
    for (int d = 0; d < 6; ++d) qf[d] = *(const bf16x8*)(Qw + d * 16);
    f32x16 o0, o1, negm;
#pragma unroll
    for (int r = 0; r < 16; ++r) { o0[r] = 0.f; o1[r] = 0.f; negm[r] = 0.f; }
    float mref = 0.f, l_run = 0.f;
    const int qminw = qb * 256 + wid * 32;
    const int tlast = (qminw + 31) >> 6;
    f32x16 pa0, pa1, pb0, pb1;
    if (wid < 4) ATT_WAITBAR(9); else ATT_WAITBAR(6);
    qk_tile(pa0, pa1, kbase + slot_of(TO) * KTB, qf, negm, hi, kc);
    if (63 > qminw) mask_tile(pa0, pa1, -qb * 256 + 8 * hi, qrel);
#define ATT_ROWMAX(c0, c1, rm) float rm; { float ma = max3(c0[0], c0[1], c1[0]), mb = max3(c0[2], c0[3], c1[1]); ma = max3(ma, c1[2], c1[3]); \
        _Pragma("unroll") for (int r = 4; r < 16; r += 4) { ma = max3(ma, c0[r], c0[r + 1]); mb = max3(mb, c0[r + 2], c0[r + 3]); ma = max3(ma, c1[r], c1[r + 1]); mb = max3(mb, c1[r + 2], c1[r + 3]); } \
        rm = half_swap_max(fmaxf(ma, mb)); }
    { ATT_ROWMAX(pa0, pa1, rm0); mref = rm0;
#pragma unroll
      for (int r = 0; r < 16; ++r) { pa0[r] -= rm0; pa1[r] -= rm0; negm[r] = -rm0; } }
#define ATT_RESCALE(c0, c1, rm) if (__builtin_expect(__any(rm > THR), 0)) { const float dl = fmaxf(rm, 0.f); mref += dl; \
        _Pragma("unroll") for (int r = 0; r < 16; ++r) { c0[r] -= dl; c1[r] -= dl; negm[r] = -mref; } \
        const float f = __builtin_amdgcn_exp2f(-dl); l_run *= f; \
        _Pragma("unroll") for (int r = 0; r < 16; ++r) { o0[r] *= f; o1[r] *= f; } }
    u32x4 pw0, pw1, pw2, pw3;
#define ATT_EXPPACK(c0, c1) do { \
        _Pragma("unroll") for (int r = 0; r < 16; ++r) { c0[r] = __builtin_amdgcn_exp2f(c0[r]); c1[r] = __builtin_amdgcn_exp2f(c1[r]); } \
        f32x2 sacc = {0.f, 0.f}; \
        _Pragma("unroll") for (int r = 0; r < 16; r += 2) { sacc += (f32x2){c0[r], c0[r + 1]}; sacc += (f32x2){c1[r], c1[r + 1]}; } \
        l_run += sacc[0] + sacc[1]; \
        pw0 = (u32x4){cvtpk(c0[0], c0[1]), cvtpk(c0[2], c0[3]), cvtpk(c0[4], c0[5]), cvtpk(c0[6], c0[7])}; \
        pw1 = (u32x4){cvtpk(c0[8], c0[9]), cvtpk(c0[10], c0[11]), cvtpk(c0[12], c0[13]), cvtpk(c0[14], c0[15])}; \
        pw2 = (u32x4){cvtpk(c1[0], c1[1]), cvtpk(c1[2], c1[3]), cvtpk(c1[4], c1[5]), cvtpk(c1[6], c1[7])}; \
        pw3 = (u32x4){cvtpk(c1[8], c1[9]), cvtpk(c1[10], c1[11]), cvtpk(c1[12], c1[13]), cvtpk(c1[14], c1[15])}; } while (0)
#define ATT_PV(slot) do { const LAS unsigned char* vb = vbase + (slot) * VTB; \
        _Pragma("unroll") for (int ks = 0; ks < 4; ++ks) { const int g = (2 * ks + hi) ^ vx; \
            const bf16x8 v0 = *(const LAS bf16x8*)(vb + g * 16), v1 = *(const LAS bf16x8*)(vb + 32 * 128 + g * 16); \
            const bf16x8 pf = __builtin_bit_cast(bf16x8, (ks == 0) ? pw0 : (ks == 1) ? pw1 : (ks == 2) ? pw2 : pw3); \
            o0 = __builtin_amdgcn_mfma_f32_32x32x16_bf16(v0, pf, o0, 0, 0, 0); o1 = __builtin_amdgcn_mfma_f32_32x32x16_bf16(v1, pf, o1, 0, 0, 0); } } while (0)
#define ATT_STEADY(cur0, cur1, nxt0, nxt1, t) do { const int t_ = (t); \
        if (wid < 4) ATT_WAITBAR(6); else ATT_WAITBAR(4);            \
        ATT_ISSUE_T(TO + t_ + 4); \
        ATT_ROWMAX(cur0, cur1, rm_); ATT_RESCALE(cur0, cur1, rm_); \
        bf16x8 vf_[2][2];                                              \
        { const LAS unsigned char* vb_ = vbase + slot_of(TO + t_) * VTB; \
          _Pragma("unroll") for (int ks = 0; ks < 2; ++ks) { const int g = (2 * ks + hi) ^ vx; vf_[ks][0] = *(const LAS bf16x8*)(vb_ + g * 16); vf_[ks][1] = *(const LAS bf16x8*)(vb_ + 32 * 128 + g * 16); } } \
        __builtin_amdgcn_sched_barrier(0); \
        qk_tile(nxt0, nxt1, kbase + slot_of(TO + t_ + 1) * KTB, qf, negm, hi, kc); ATT_EXPPACK(cur0, cur1); \
        { const LAS unsigned char* vb_ = vbase + slot_of(TO + t_) * VTB; \
          _Pragma("unroll") for (int ks = 0; ks < 4; ++ks) { const bf16x8 pf = __builtin_bit_cast(bf16x8, (ks == 0) ? pw0 : (ks == 1) ? pw1 : (ks == 2) ? pw2 : pw3); \
            o0 = __builtin_amdgcn_mfma_f32_32x32x16_bf16(vf_[ks & 1][0], pf, o0, 0, 0, 0); o1 = __builtin_amdgcn_mfma_f32_32x32x16_bf16(vf_[ks & 1][1], pf, o1, 0, 0, 0); \
            if (ks < 2) { const int g = (2 * (ks + 2) + hi) ^ vx; vf_[ks][0] = *(const LAS bf16x8*)(vb_ + g * 16); vf_[ks][1] = *(const LAS bf16x8*)(vb_ + 32 * 128 + g * 16); } } } } while (0)
#define ATT_GENERAL(cur0, cur1, nxt0, nxt1, t) do { const int t_ = (t); \
        if (t_ + 1 < NT) { const int left = NTT - (TO + t_) - 2, nfly = (left < 2) ? left : 2;        \
            if (nfly == 2) { if (wid < 4) ATT_WAITBAR(6); else ATT_WAITBAR(4); } else if (nfly == 1) { if (wid < 4) ATT_WAITBAR(3); else ATT_WAITBAR(2); } else ATT_WAITBAR(0); } \
        if (TO + t_ + 4 < NTT) ATT_ISSUE_T(TO + t_ + 4);        \
        const bool do_cur = (t_ <= tlast), do_next = (t_ + 1 < NT) && (t_ + 1 <= tlast); \
        if (do_cur) { ATT_ROWMAX(cur0, cur1, rm_); ATT_RESCALE(cur0, cur1, rm_); } \
        if (do_next) { qk_tile(nxt0, nxt1, kbase + slot_of(TO + t_ + 1) * KTB, qf, negm, hi, kc); \
            if (64 * (t_ + 1) + 63 > qminw) mask_tile(nxt0, nxt1, 64 * (t_ + 1) - qb * 256 + 8 * hi, qrel); } \
        if (do_cur) { ATT_EXPPACK(cur0, cur1); ATT_PV(slot_of(TO + t_)); } } while (0)
    int t = 0;
    for (; t + 3 <= 4 * qb; t += 2) {
        ATT_STEADY(pa0, pa1, pb0, pb1, t);
        ATT_STEADY(pb0, pb1, pa0, pa1, t + 1);
    }
    if (half == ((qbB >= 0) ? 1 : 0) && tid == 0) knext = __hip_atomic_fetch_add(qhead, 1u, __ATOMIC_RELAXED, __HIP_MEMORY_SCOPE_AGENT);
    for (; t < NT; t += 2) {
        ATT_GENERAL(pa0, pa1, pb0, pb1, t);
        ATT_GENERAL(pb0, pb1, pa0, pa1, t + 1);
    }
#undef ATT_STEADY
#undef ATT_GENERAL
#undef ATT_PV
#undef ATT_EXPPACK
#undef ATT_RESCALE
#undef ATT_ROWMAX
    const float l_tot = half_swap_sum(l_run), inv = 1.f / l_tot;
    float ss = 0.f;
#pragma unroll
    for (int r = 0; r < 16; ++r) { o0[r] *= inv; o1[r] *= inv; ss += o0[r] * o0[r] + o1[r] * o1[r]; }
    ss = half_swap_sum(ss);
    const float rs = __builtin_amdgcn_rsqf(ss * (1.f / cfg::DVH) + cfg::EPS);
    bf16_t* yp = Y + ((size_t)(bh >> 3) * cfg::S + qb * 256 + qrel) * cfg::D + (bh & 7) * cfg::DVH + 4 * hi;
#pragma unroll
    for (int rg = 0; rg < 4; ++rg) {
        u32x2 w0, w1; w0.x = cvtpk(o0[4 * rg] * rs, o0[4 * rg + 1] * rs); w0.y = cvtpk(o0[4 * rg + 2] * rs, o0[4 * rg + 3] * rs);
        w1.x = cvtpk(o1[4 * rg] * rs, o1[4 * rg + 1] * rs); w1.y = cvtpk(o1[4 * rg + 2] * rs, o1[4 * rg + 3] * rs);
        *(u32x2*)(yp + 8 * rg) = w0; *(u32x2*)(yp + 32 + 8 * rg) = w1;
    }
  }
    ATT_WAITBAR(0);
#undef ATT_ISSUE_T
#undef ATT_ISSUE
}
}
namespace mls {
constexpr int PITCH = 144, VPITCH = 304;
constexpr int O_QN = 0, O_KN = 64 * PITCH, O_VN = 2 * 64 * PITCH, O_G = O_VN + 64 * VPITCH, STAGE = O_G + 1024;
constexpr int O_HS = 2 * STAGE, O_CW = O_HS + 2 * 8 * 64 * 4, L_END = O_CW + (5 * 128) * 4;
static_assert(STAGE % 16 == 0 && O_G % 16 == 0 && O_VN % 16 == 0, "mls LDS map");
typedef short v4i16_t __attribute__((ext_vector_type(4)));
__device__ __forceinline__ s16x4 trrd(const LAS unsigned char* p) { return __builtin_bit_cast(s16x4, __builtin_amdgcn_ds_read_tr16_b64_v4i16((LAS v4i16_t*)p)); }
__device__ __forceinline__ bf16x8 cat8(const s16x4 a, const s16x4 b) { return (bf16x8){a[0], a[1], a[2], a[3], b[0], b[1], b[2], b[3]}; }

struct StageRegs { bf16x8 rq[4], rk[4], rv[2]; float ig, lf; u32x2 og[4]; };

__device__ __forceinline__ void load_stage(StageRegs& R, int b, int h, int c, const bf16_t* __restrict__ QM, const bf16_t* __restrict__ KM, const bf16_t* __restrict__ VM, const bf16_t* __restrict__ OG,
                                           const float* __restrict__ IF, int tid) {
    const int r = tid >> 3, c8 = tid & 7, lane = tid & 63, wid = tid >> 6;
    const int tok = b * cfg::S + c * 64 + r;
#pragma unroll
    for (int j = 0; j < 4; ++j) {
        const bool ok = (c > 0) || (r - 3 + j >= 0);
        const size_t off = (size_t)(tok - 3 + j) * 256 + h * 64 + c8 * 8;
        R.rq[j] = ok ? *(const bf16x8*)(QM + off) : (bf16x8){0, 0, 0, 0, 0, 0, 0, 0};
        R.rk[j] = ok ? *(const bf16x8*)(KM + off) : (bf16x8){0, 0, 0, 0, 0, 0, 0, 0};
    }
    R.rv[0] = *(const bf16x8*)(VM + (size_t)tok * 512 + h * 128 + c8 * 8);
    R.rv[1] = *(const bf16x8*)(VM + (size_t)tok * 512 + h * 128 + 64 + c8 * 8);
    { const size_t tg = (size_t)b * cfg::S + c * 64 + lane; R.ig = IF[tg * 8 + h]; R.lf = IF[tg * 8 + 4 + h]; }
#pragma unroll
    for (int lb = 0; lb < 4; ++lb) R.og[lb] = *(const u32x2*)(OG + ((size_t)b * cfg::S + c * 64 + 16 * lb + (lane & 15)) * 512 + h * 128 + 16 * wid + 4 * ((lane >> 4) & 3));
}
__device__ __forceinline__ void write_stage(const StageRegs& R, LAS unsigned char* st, const LAS float* cw, int tid) {
    const int r = tid >> 3, c8 = tid & 7, lane = tid & 63, wid = tid >> 6;
    float q[8], k[8];
#pragma unroll
    for (int e = 0; e < 8; ++e) { q[e] = cw[512 + 8 * c8 + e]; k[e] = cw[512 + 64 + 8 * c8 + e]; }
#pragma unroll
    for (int j = 0; j < 4; ++j)
#pragma unroll
        for (int e = 0; e < 8; ++e) { q[e] += cw[j * 128 + 8 * c8 + e] * bf2f((unsigned short)R.rq[j][e]); k[e] += cw[j * 128 + 64 + 8 * c8 + e] * bf2f((unsigned short)R.rk[j][e]); }
#pragma unroll
    for (int e = 0; e < 8; ++e) { q[e] = pg8::silu_f(q[e]) * 0.125f; k[e] = pg8::silu_f(k[e]); }
    u32x4 qw, kw; qw.x = cvtpk(q[0], q[1]); qw.y = cvtpk(q[2], q[3]); qw.z = cvtpk(q[4], q[5]); qw.w = cvtpk(q[6], q[7]);
    kw.x = cvtpk(k[0], k[1]); kw.y = cvtpk(k[2], k[3]); kw.z = cvtpk(k[4], k[5]); kw.w = cvtpk(k[6], k[7]);
    *(LAS u32x4*)(st + O_QN + r * PITCH + c8 * 16) = qw;
    *(LAS u32x4*)(st + O_KN + r * PITCH + c8 * 16) = kw;
    *(LAS bf16x8*)(st + O_VN + r * VPITCH + c8 * 16) = R.rv[0];
    *(LAS bf16x8*)(st + O_VN + r * VPITCH + 128 + c8 * 16) = R.rv[1];
    if (wid == 0) {
        float bsum = R.lf;
#pragma unroll
        for (int o = 1; o < 64; o <<= 1) { const float t = __uint_as_float((unsigned)__builtin_amdgcn_ds_bpermute((lane - o) << 2, (int)__float_as_uint(bsum))); if (lane >= o) bsum += t; }
        const float u = R.ig - bsum; float cm = u;
#pragma unroll
        for (int o = 1; o < 64; o <<= 1) { const float t = __uint_as_float((unsigned)__builtin_amdgcn_ds_bpermute((lane - o) << 2, (int)__float_as_uint(cm))); if (lane >= o) cm = fmaxf(cm, t); }
        LAS float* G = (LAS float*)(st + O_G);
        G[lane] = bsum; G[64 + lane] = u; G[128 + lane] = cm;
        if (lane == 63) { G[192] = bsum; G[193] = cm; }
    }
}

__device__ __forceinline__ void mlstm_unit(LAS unsigned char* lds, int b, int h, const bf16_t* __restrict__ QM, const bf16_t* __restrict__ KM, const bf16_t* __restrict__ VM, const bf16_t* __restrict__ OG,
                                           const float* __restrict__ IF, const float* __restrict__ convw, const float* __restrict__ convb, bf16_t* __restrict__ Y) {
    int tid_ = threadIdx.x; asm volatile("" : "+v"(tid_));
    const int tid = tid_, lane = tid & 63, fr = lane & 15, g = lane >> 4;
    const int wid = __builtin_amdgcn_readfirstlane(tid >> 6);
    LAS float* cw = (LAS float*)(lds + O_CW);
    for (int i = tid; i < 640; i += 512) { const int j = i >> 7, ch = i & 127; const int gch = (ch < 64) ? (h * 64 + ch) : (256 + h * 64 + ch - 64);
        cw[i] = (j < 4) ? convw[j * 512 + gch] : convb[gch]; }
    __syncthreads();
    StageRegs R;
    load_stage(R, b, h, 0, QM, KM, VM, OG, IF, tid);
    write_stage(R, lds, cw, tid);
    __syncthreads();
    f32x4 C[4][2];
#pragma unroll
    for (int kb = 0; kb < 4; ++kb) { C[kb][0] = (f32x4){0.f, 0.f, 0.f, 0.f}; C[kb][1] = (f32x4){0.f, 0.f, 0.f, 0.f}; }
    float m_prev = 0.f;
    const bf16x8 ones = {0x3F80, 0x3F80, 0x3F80, 0x3F80, 0x3F80, 0x3F80, 0x3F80, 0x3F80};
    const int trV = (fr >> 2) * VPITCH + (16 * wid + 4 * (fr & 3)) * 2;
    const int trK = (fr >> 2) * PITCH + (4 * (fr & 3)) * 2;
    for (int c = 0; c < cfg::NCHUNK; ++c) {
        const LAS unsigned char* st = lds + (c & 1) * STAGE;
        LAS unsigned char* stn = lds + ((c + 1) & 1) * STAGE;
        const u32x2 og0 = R.og[0], og1 = R.og[1], og2 = R.og[2], og3 = R.og[3];
        if (c + 1 < cfg::NCHUNK) load_stage(R, b, h, c + 1, QM, KM, VM, OG, IF, tid);
        const LAS float* G = (const LAS float*)(st + O_G);
        const float b_end = G[192], umax = G[193];
        bf16x8 Cf[2][2];
#pragma unroll
        for (int c2 = 0; c2 < 2; ++c2)
#pragma unroll
            for (int p2 = 0; p2 < 2; ++p2) { u32x4 w; w.x = cvtpk(C[2 * p2][c2][0], C[2 * p2][c2][1]); w.y = cvtpk(C[2 * p2][c2][2], C[2 * p2][c2][3]);
                w.z = cvtpk(C[2 * p2 + 1][c2][0], C[2 * p2 + 1][c2][1]); w.w = cvtpk(C[2 * p2 + 1][c2][2], C[2 * p2 + 1][c2][3]); Cf[c2][p2] = __builtin_bit_cast(bf16x8, w); }
        f32x4 hv[4]; float hsq[4];
#pragma unroll
        for (int lb = 0; lb < 4; ++lb) {
            const int l = 16 * lb + fr;
            const float wl = fmaxf(m_prev, G[128 + l]), bl = G[l];
            const LAS unsigned char* qrow = st + O_QN + l * PITCH;
            const bf16x8 qa0 = *(const LAS bf16x8*)(qrow + g * 16), qa1 = *(const LAS bf16x8*)(qrow + 64 + g * 16);
            u32x4 Pw[2] = {(u32x4){0u, 0u, 0u, 0u}, (u32x4){0u, 0u, 0u, 0u}};
#pragma unroll
            for (int sb = 0; sb <= lb; ++sb) {
                const LAS unsigned char* krow = st + O_KN + (16 * sb + fr) * PITCH;
                const bf16x8 ka0 = *(const LAS bf16x8*)(krow + g * 16), ka1 = *(const LAS bf16x8*)(krow + 64 + g * 16);
                f32x4 s4 = (f32x4){0.f, 0.f, 0.f, 0.f};
                s4 = __builtin_amdgcn_mfma_f32_16x16x32_bf16(ka0, qa0, s4, 0, 0, 0); s4 = __builtin_amdgcn_mfma_f32_16x16x32_bf16(ka1, qa1, s4, 0, 0, 0);
                const f32x4 u4 = *(const LAS f32x4*)(st + O_G + (64 + 16 * sb + 4 * g) * 4);
                float pv[4];
#pragma unroll
                for (int r = 0; r < 4; ++r) { float e = __builtin_amdgcn_exp2f((u4[r] - wl) * cfg::LOG2E) * s4[r]; if (sb == lb && 4 * g + r > fr) e = 0.f; pv[r] = e; }
                if (sb & 1) { Pw[sb >> 1].z = cvtpk(pv[0], pv[1]); Pw[sb >> 1].w = cvtpk(pv[2], pv[3]); } else { Pw[sb >> 1].x = cvtpk(pv[0], pv[1]); Pw[sb >> 1].y = cvtpk(pv[2], pv[3]); }
            }
            f32x4 H0 = (f32x4){0.f, 0.f, 0.f, 0.f}, H1 = H0, I0 = H0, I1 = H0;
#pragma unroll
            for (int p = 0; p <= (lb >> 1); ++p) {
                const LAS unsigned char* vblk = st + O_VN + (32 * p + 4 * g) * VPITCH + trV;
                const bf16x8 vf = cat8(trrd(vblk), trrd(vblk + 16 * VPITCH));
                const bf16x8 pf = __builtin_bit_cast(bf16x8, Pw[p]);
                H0 = __builtin_amdgcn_mfma_f32_16x16x32_bf16(vf, pf, H0, 0, 0, 0); H1 = __builtin_amdgcn_mfma_f32_16x16x32_bf16(ones, pf, H1, 0, 0, 0);
            }
#pragma unroll
            for (int p2 = 0; p2 < 2; ++p2) {
                const u32x2 qa = *(const LAS u32x2*)(qrow + (32 * p2 + 4 * g) * 2), qb2 = *(const LAS u32x2*)(qrow + (32 * p2 + 16 + 4 * g) * 2);
                const bf16x8 qp = __builtin_bit_cast(bf16x8, (u32x4){qa.x, qa.y, qb2.x, qb2.y});
                I0 = __builtin_amdgcn_mfma_f32_16x16x32_bf16(Cf[0][p2], qp, I0, 0, 0, 0); I1 = __builtin_amdgcn_mfma_f32_16x16x32_bf16(Cf[1][p2], qp, I1, 0, 0, 0);
            }
            const float ei = __builtin_amdgcn_exp2f((m_prev - wl) * cfg::LOG2E);
            const float den = ei * I1[0] + H1[0];
            const float bound = __builtin_amdgcn_exp2f(-(bl + wl) * cfg::LOG2E);
            const float rden = 1.f / fmaxf(fabsf(den), bound);
            float sq = 0.f;
#pragma unroll
            for (int r = 0; r < 4; ++r) { hv[lb][r] = (ei * I0[r] + H0[r]) * rden; sq += hv[lb][r] * hv[lb][r]; }
            hsq[lb] = pg8::quad_sum(sq);
        }
        { LAS float* hs = (LAS float*)(lds + O_HS) + (c & 1) * 512 + wid * 64;
          if (g == 0) {
#pragma unroll
              for (int lb = 0; lb < 4; ++lb) hs[16 * lb + fr] = hsq[lb]; } }
        { const float mx = fmaxf(m_prev, umax);
          const float d_old = __builtin_amdgcn_exp2f((m_prev - mx) * cfg::LOG2E), d_new = __builtin_amdgcn_exp2f((umax - mx) * cfg::LOG2E);
          m_prev = b_end + mx;
#pragma unroll
          for (int kb = 0; kb < 4; ++kb) { C[kb][0] = C[kb][0] * d_old; C[kb][1] = C[kb][1] * d_old; }
#pragma unroll
          for (int ks = 0; ks < 2; ++ks) {
              const f32x4 ua = *(const LAS f32x4*)(st + O_G + (64 + 32 * ks + 8 * g) * 4), ub = *(const LAS f32x4*)(st + O_G + (64 + 32 * ks + 8 * g + 4) * 4);
              float ee[8];
#pragma unroll
              for (int j = 0; j < 4; ++j) { ee[j] = __builtin_amdgcn_exp2f((ua[j] - umax) * cfg::LOG2E) * d_new; ee[4 + j] = __builtin_amdgcn_exp2f((ub[j] - umax) * cfg::LOG2E) * d_new; }
              const LAS unsigned char* vblk = st + O_VN + (32 * ks + 8 * g) * VPITCH + trV;
              const s16x4 va = trrd(vblk), vb4 = trrd(vblk + 4 * VPITCH);
              u32x4 ve, eo;
              ve.x = cvtpk(bf2f((unsigned short)va[0]) * ee[0], bf2f((unsigned short)va[1]) * ee[1]); ve.y = cvtpk(bf2f((unsigned short)va[2]) * ee[2], bf2f((unsigned short)va[3]) * ee[3]);
              ve.z = cvtpk(bf2f((unsigned short)vb4[0]) * ee[4], bf2f((unsigned short)vb4[1]) * ee[5]); ve.w = cvtpk(bf2f((unsigned short)vb4[2]) * ee[6], bf2f((unsigned short)vb4[3]) * ee[7]);
              eo.x = cvtpk(ee[0], ee[1]); eo.y = cvtpk(ee[2], ee[3]); eo.z = cvtpk(ee[4], ee[5]); eo.w = cvtpk(ee[6], ee[7]);
              const bf16x8 vef = __builtin_bit_cast(bf16x8, ve), eof = __builtin_bit_cast(bf16x8, eo);
#pragma unroll
              for (int kb = 0; kb < 4; ++kb) {
                  const LAS unsigned char* kblk = st + O_KN + (32 * ks + 8 * g) * PITCH + 32 * kb + trK;
                  const bf16x8 kt = cat8(trrd(kblk), trrd(kblk + 4 * PITCH));
                  C[kb][0] = __builtin_amdgcn_mfma_f32_16x16x32_bf16(kt, vef, C[kb][0], 0, 0, 0); C[kb][1] = __builtin_amdgcn_mfma_f32_16x16x32_bf16(kt, eof, C[kb][1], 0, 0, 0);
              }
          } }
        if (c + 1 < cfg::NCHUNK) write_stage(R, stn, cw, tid);
        asm volatile("s_waitcnt lgkmcnt(0)\n\ts_barrier" ::: "memory");
        { const LAS float* hsr = (const LAS float*)(lds + O_HS) + (c & 1) * 512;
          const size_t tok0 = (size_t)b * cfg::S + c * 64;
#pragma unroll
          for (int lb = 0; lb < 4; ++lb) { const int l = 16 * lb + fr; float tot = 0.f;
#pragma unroll
              for (int w = 0; w < 8; ++w) tot += hsr[w * 64 + l];
              const float rs = __builtin_amdgcn_rsqf(tot * (1.f / cfg::MDV) + cfg::EPS);
              const u32x2 og = (lb == 0) ? og0 : (lb == 1) ? og1 : (lb == 2) ? og2 : og3;
              u32x2 o; o.x = cvtpk(hv[lb][0] * rs * bflo(og.x), hv[lb][1] * rs * bfhi(og.x)); o.y = cvtpk(hv[lb][2] * rs * bflo(og.y), hv[lb][3] * rs * bfhi(og.y));
              *(u32x2*)(Y + (tok0 + l) * cfg::D + 512 + h * 128 + 16 * wid + 4 * g) = o; } }
    }
    __syncthreads();
}
}
#ifndef MK_PER_PHASE
#define MK_PER_PHASE 0
#endif
constexpr int LDS_BYTES = 147456, MISC_OFF = 131072 + 320, RSTAB_OFF = 131072 + 1024;
constexpr int NPHASE = 34;

struct Params { const float* in[24]; float* out; unsigned char* ws; int ph_lo, ph_hi, li, pad; };

struct MapId { __device__ __forceinline__ int operator()(int n) const { return n; } };
struct MapGate { int up; __device__ __forceinline__ int operator()(int n) const { return ((n >> 7) << 8) + up * 128 + (n & 127); } };
struct MapWin { __device__ __forceinline__ int operator()(int n) const {
    if (n < 384) return n;
    if (n < 416) { const int i = n - 384; return 384 + ((i < 16) ? 2 * i : 2 * (i - 16) + 1); }
    if (n < 1952) return n + 96;
    return n - 1952 + 416; } };
struct MapUq { __device__ __forceinline__ int operator()(int n) const { const int h = n / 96, d = n - h * 96; if (d < 64) return n; const int i = d - 64; return h * 96 + 64 + ((i < 16) ? 2 * i : 2 * (i - 16) + 1); } };
struct MapKv { __device__ __forceinline__ int operator()(int n) const { const int h = n >> 7, j = n & 127; return (j < 64) ? (h * 64 + j) : (512 + h * 64 + j - 64); } };
template <class Map> __device__ __forceinline__ void conv_item(const float* __restrict__ W, int K, int N, bf16_t* WT, const float* gA, const float* gB, int gsplit, const Map dst, LAS float* scr, int item, int lane) {
    const int nblk = (N + 31) >> 5, kb = item / nblk, nb = item - kb * nblk, k0 = 64 * kb, n0 = 32 * nb, n = n0 + 4 * (lane & 7);
#pragma unroll
    for (int i = 0; i < 8; ++i) { const int kk = 8 * i + (lane >> 3), k = k0 + kk; float gv = 1.f; if (gA) gv = (k < gsplit) ? gA[k] : gB[k - gsplit];
        f32x4 v = (f32x4){0.f, 0.f, 0.f, 0.f}; if (n < N) v = *(const f32x4*)(W + (size_t)k * N + n);
        LAS float* d = scr + kk * 33 + 4 * (lane & 7); d[0] = v[0] * gv; d[1] = v[1] * gv; d[2] = v[2] * gv; d[3] = v[3] * gv; }
    asm volatile("s_waitcnt lgkmcnt(0)" ::: "memory");
    const int c = lane & 7;
#pragma unroll
    for (int j = 0; j < 4; ++j) { const int nn = (lane >> 3) + 8 * j, nd = n0 + nn; const LAS float* s = scr + (8 * c) * 33 + nn;
        if (nd < N) { u32x4 o; o.x = cvtpk(s[0 * 33], s[1 * 33]); o.y = cvtpk(s[2 * 33], s[3 * 33]); o.z = cvtpk(s[4 * 33], s[5 * 33]); o.w = cvtpk(s[6 * 33], s[7 * 33]);
            *(u32x4*)(WT + (size_t)dst(nd) * K + k0 + 8 * c) = o; } }
    asm volatile("s_waitcnt lgkmcnt(0)" ::: "memory");
}
__device__ __forceinline__ float wave_sum(float v, int lane) {
#pragma unroll
    for (int o = 1; o < 64; o <<= 1) v += __uint_as_float((unsigned)__builtin_amdgcn_ds_bpermute((lane ^ o) << 2, (int)__float_as_uint(v)));
    return v;
}

__global__ void __launch_bounds__(512, 2) hymba_fwd(Params P) {
    extern __shared__ __attribute__((aligned(16))) unsigned char lds_raw[];
    LAS unsigned char* lds = (LAS unsigned char*)lds_raw;
    volatile LAS unsigned* MISC = (volatile LAS unsigned*)(lds + MISC_OFF);
    const int G = gridDim.x, bx = blockIdx.x;
#define LOCAL_TID() int tid = threadIdx.x; asm volatile("" : "+v"(tid)); const int lane = tid & 63, wave = __builtin_amdgcn_readfirstlane(tid >> 6), gw = bx * 8 + wave, NGW = G * 8; (void)lane; (void)gw; (void)NGW
    gu32* ctl = (gu32*)(P.ws + ws::CTL);
    { LOCAL_TID(); for (int u = tid; u < 32; u += 512) MISC[u] = 0u; }
    __syncthreads();
#if MK_PER_PHASE
    const int lo = P.ph_lo;
#else
    (void)xcd_barrier_post((unsigned*)ctl + ws::CW_BAR, MISC + 8);
#endif
#ifndef ATT_PROBE_VAR
#define ATT_PROBE_VAR 0
#endif
#ifndef PROBE_DOUBLE
#define PROBE_DOUBLE 0
#endif
#ifndef PH_MASK
#define PH_MASK 0xffff
#endif
#if MK_PER_PHASE
#define IN(k) (lo == (k))
#define SEAM(k) do { } while (0)
#else
#define IN(k) true
#define SEAM(k) do { XcdBarrier b_; unsigned* bp_ = (unsigned*)(P.ws + ws::CTL) + ws::CW_BAR; asm volatile("" : "+s"(bp_)); b_.bar = bp_; b_.x = (unsigned)__builtin_amdgcn_readfirstlane((int)xb_xcc_id()); b_.st = MISC + 8; xcd_barrier(b_); } while (0)
#endif
#define LAUNDER_W() GAS unsigned char* Wg_ = (GAS unsigned char*)P.ws; asm volatile("" : "+s"(Wg_)); unsigned char* W = (unsigned char*)Wg_

    if ((PH_MASK & 1) && IN(0)) {
        LOCAL_TID(); LAUNDER_W(); float* const ssqx = (float*)(W + ws::SSQX); bf16_t* const XBp = (bf16_t*)(W + ws::XB);
        LAS float* scr = (LAS float*)(lds + wave * 16384);
        constexpr int I_FF = 16 * 88, I_DN = 44 * 32, I_IN = 16 * 62, I_UQ = 4 * 24, I_KV = 2 * 32, I_O = 16 * 32;
        constexpr int I_LAYER = 4 * I_FF + 2 * I_DN + I_IN + I_UQ + I_KV + I_O;
        for (int it = gw; it < cfg::DEPTH * I_LAYER; it += NGW) {
            const int l = it / I_LAYER; int r = it - l * I_LAYER;
            unsigned char* wl = W + ws::WBASE + (size_t)l * ws::WLAYER;
            const size_t oFF = (size_t)l * cfg::D * cfg::FF;
            if (r < I_FF) { conv_item(P.in[3] + oFF, 1024, 2816, (bf16_t*)(wl + ws::W_GU1), P.in[2] + l * 1024, nullptr, 1024, MapGate{0}, scr, r, lane); continue; } r -= I_FF;
            if (r < I_FF) { conv_item(P.in[4] + oFF, 1024, 2816, (bf16_t*)(wl + ws::W_GU1), P.in[2] + l * 1024, nullptr, 1024, MapGate{1}, scr, r, lane); continue; } r -= I_FF;
            if (r < I_DN) { conv_item(P.in[5] + oFF, 2816, 1024, (bf16_t*)(wl + ws::W_D1), nullptr, nullptr, 0, MapId{}, scr, r, lane); continue; } r -= I_DN;
            if (r < I_FF) { conv_item(P.in[20] + oFF, 1024, 2816, (bf16_t*)(wl + ws::W_GU2), P.in[19] + l * 1024, nullptr, 1024, MapGate{0}, scr, r, lane); continue; } r -= I_FF;
            if (r < I_FF) { conv_item(P.in[21] + oFF, 1024, 2816, (bf16_t*)(wl + ws::W_GU2), P.in[19] + l * 1024, nullptr, 1024, MapGate{1}, scr, r, lane); continue; } r -= I_FF;
            if (r < I_DN) { conv_item(P.in[22] + oFF, 2816, 1024, (bf16_t*)(wl + ws::W_D2), nullptr, nullptr, 0, MapId{}, scr, r, lane); continue; } r -= I_DN;
            if (r < I_IN) { conv_item(P.in[7] + (size_t)l * 1024 * cfg::DIN, 1024, cfg::DIN, (bf16_t*)(wl + ws::W_IN), P.in[6] + l * 1024, nullptr, 1024, MapWin{}, scr, r, lane); continue; } r -= I_IN;
            if (r < I_UQ) { conv_item(P.in[9] + (size_t)l * 256 * 768, 256, 768, (bf16_t*)(wl + ws::W_UQ), P.in[8] + l * 256, nullptr, 256, MapUq{}, scr, r, lane); continue; } r -= I_UQ;
            if (r < I_KV) { conv_item(P.in[11] + (size_t)l * 128 * 1024, 128, 1024, (bf16_t*)(wl + ws::W_KV), P.in[10] + l * 128, nullptr, 128, MapKv{}, scr, r, lane); continue; } r -= I_KV;
            conv_item(P.in[18] + (size_t)l * 1024 * 1024, 1024, 1024, (bf16_t*)(wl + ws::W_O), P.in[16] + l * 512, P.in[17] + l * 512, 512, MapId{}, scr, r, lane);
        }
        for (int i = bx * 512 + tid; i < cfg::DEPTH * 88 * 128; i += G * 512) { const int l = i / (88 * 128), r = i - l * (88 * 128);
            *(u32x4*)(W + ws::WBASE + (size_t)l * ws::WLAYER + ws::W_IN + (size_t)424 * 2048 + (size_t)r * 16) = (u32x4){0u, 0u, 0u, 0u}; }
#ifdef NANFILL
        for (size_t i = (size_t)bx * 512 + tid; i < (NANFILL_BYTES >> 4); i += (size_t)G * 512) *(u32x4*)(W + NANFILL_OFF + i * 16) = (u32x4){0xffffffffu, 0xffffffffu, 0xffffffffu, 0xffffffffu};
#endif
        for (int i = bx * 512 + tid; i < cfg::DEPTH * 2568; i += G * 512) { const int l = i / 2568, r = i - l * 2568;
            const float v = (r < 2048) ? P.in[12][l * 2048 + r] : (r < 2560) ? P.in[13][l * 512 + r - 2048] : (r < 2564) ? P.in[14][l * 4 + r - 2560] : P.in[15][l * 4 + r - 2564];
            ((float*)(W + ws::SMALLP))[l * 4096 + r] = v; }
        for (int i = bx * 512 + tid; i < cfg::M * 16; i += G * 512) { const int tok = i >> 4, k = i & 15;
            const float inv = exp2f(-(float)k * (13.287712379549449f / 16.f)); const float ang = (float)((const int*)P.in[1])[tok] * inv;
            float sn, cs; sincosf(ang, &sn, &cs); ((f32x2*)(W + ws::ROPE))[i] = (f32x2){cs, sn}; }
        for (int m = gw; m < cfg::M; m += NGW) {
            const f32x4* xr = (const f32x4*)(P.in[0] + (size_t)m * cfg::D) + 4 * lane; f32x4 v[4]; float s = 0.f;
#pragma unroll
            for (int j = 0; j < 4; ++j) { v[j] = xr[j]; s += (v[j][0] * v[j][0] + v[j][1] * v[j][1]) + (v[j][2] * v[j][2] + v[j][3] * v[j][3]); }
            s = wave_sum(s, lane);
            u32x4* o16 = (u32x4*)(XBp + (size_t)m * cfg::D) + 2 * lane;
            o16[0] = (u32x4){cvtpk(v[0][0], v[0][1]), cvtpk(v[0][2], v[0][3]), cvtpk(v[1][0], v[1][1]), cvtpk(v[1][2], v[1][3])};
            o16[1] = (u32x4){cvtpk(v[2][0], v[2][1]), cvtpk(v[2][2], v[2][3]), cvtpk(v[3][0], v[3][1]), cvtpk(v[3][2], v[3][3])};
            if (lane < 16) ssqx[(size_t)m * 16 + lane] = (lane == 0) ? s : 0.f;
        }
        __syncthreads();
    }
    SEAM(0);
#if PROBE_DOUBLE == 9
    if ((PH_MASK & 1) && IN(0)) {
        LOCAL_TID(); LAUNDER_W(); float* const ssqx = (float*)(W + ws::SSQX); bf16_t* const XBp = (bf16_t*)(W + ws::XB);
        LAS float* scr = (LAS float*)(lds + wave * 16384);
        constexpr int I_FF = 16 * 88, I_DN = 44 * 32, I_IN = 16 * 62, I_UQ = 4 * 24, I_KV = 2 * 32, I_O = 16 * 32;
        constexpr int I_LAYER = 4 * I_FF + 2 * I_DN + I_IN + I_UQ + I_KV + I_O;
        for (int it = gw; it < cfg::DEPTH * I_LAYER; it += NGW) {
            const int l = it / I_LAYER; int r = it - l * I_LAYER;
            unsigned char* wl = W + ws::WBASE + (size_t)l * ws::WLAYER;
            const size_t oFF = (size_t)l * cfg::D * cfg::FF;
            if (r < I_FF) { conv_item(P.in[3] + oFF, 1024, 2816, (bf16_t*)(wl + ws::W_GU1), P.in[2] + l * 1024, nullptr, 1024, MapGate{0}, scr, r, lane); continue; } r -= I_FF;
            if (r < I_FF) { conv_item(P.in[4] + oFF, 1024, 2816, (bf16_t*)(wl + ws::W_GU1), P.in[2] + l * 1024, nullptr, 1024, MapGate{1}, scr, r, lane); continue; } r -= I_FF;
            if (r < I_DN) { conv_item(P.in[5] + oFF, 2816, 1024, (bf16_t*)(wl + ws::W_D1), nullptr, nullptr, 0, MapId{}, scr, r, lane); continue; } r -= I_DN;
            if (r < I_FF) { conv_item(P.in[20] + oFF, 1024, 2816, (bf16_t*)(wl + ws::W_GU2), P.in[19] + l * 1024, nullptr, 1024, MapGate{0}, scr, r, lane); continue; } r -= I_FF;
            if (r < I_FF) { conv_item(P.in[21] + oFF, 1024, 2816, (bf16_t*)(wl + ws::W_GU2), P.in[19] + l * 1024, nullptr, 1024, MapGate{1}, scr, r, lane); continue; } r -= I_FF;
            if (r < I_DN) { conv_item(P.in[22] + oFF, 2816, 1024, (bf16_t*)(wl + ws::W_D2), nullptr, nullptr, 0, MapId{}, scr, r, lane); continue; } r -= I_DN;
            if (r < I_IN) { conv_item(P.in[7] + (size_t)l * 1024 * cfg::DIN, 1024, cfg::DIN, (bf16_t*)(wl + ws::W_IN), P.in[6] + l * 1024, nullptr, 1024, MapWin{}, scr, r, lane); continue; } r -= I_IN;
            if (r < I_UQ) { conv_item(P.in[9] + (size_t)l * 256 * 768, 256, 768, (bf16_t*)(wl + ws::W_UQ), P.in[8] + l * 256, nullptr, 256, MapUq{}, scr, r, lane); continue; } r -= I_UQ;
            if (r < I_KV) { conv_item(P.in[11] + (size_t)l * 128 * 1024, 128, 1024, (bf16_t*)(wl + ws::W_KV), P.in[10] + l * 128, nullptr, 128, MapKv{}, scr, r, lane); continue; } r -= I_KV;
            conv_item(P.in[18] + (size_t)l * 1024 * 1024, 1024, 1024, (bf16_t*)(wl + ws::W_O), P.in[16] + l * 512, P.in[17] + l * 512, 512, MapId{}, scr, r, lane);
        }
        for (int i = bx * 512 + tid; i < cfg::DEPTH * 88 * 128; i += G * 512) { const int l = i / (88 * 128), r = i - l * (88 * 128);
            *(u32x4*)(W + ws::WBASE + (size_t)l * ws::WLAYER + ws::W_IN + (size_t)424 * 2048 + (size_t)r * 16) = (u32x4){0u, 0u, 0u, 0u}; }
#ifdef NANFILL
        for (size_t i = (size_t)bx * 512 + tid; i < (NANFILL_BYTES >> 4); i += (size_t)G * 512) *(u32x4*)(W + NANFILL_OFF + i * 16) = (u32x4){0xffffffffu, 0xffffffffu, 0xffffffffu, 0xffffffffu};
#endif
        for (int i = bx * 512 + tid; i < cfg::DEPTH * 2568; i += G * 512) { const int l = i / 2568, r = i - l * 2568;
            const float v = (r < 2048) ? P.in[12][l * 2048 + r] : (r < 2560) ? P.in[13][l * 512 + r - 2048] : (r < 2564) ? P.in[14][l * 4 + r - 2560] : P.in[15][l * 4 + r - 2564];
            ((float*)(W + ws::SMALLP))[l * 4096 + r] = v; }
        for (int i = bx * 512 + tid; i < cfg::M * 16; i += G * 512) { const int tok = i >> 4, k = i & 15;
            const float inv = exp2f(-(float)k * (13.287712379549449f / 16.f)); const float ang = (float)((const int*)P.in[1])[tok] * inv;
            float sn, cs; sincosf(ang, &sn, &cs); ((f32x2*)(W + ws::ROPE))[i] = (f32x2){cs, sn}; }
        for (int m = gw; m < cfg::M; m += NGW) {
            const f32x4* xr = (const f32x4*)(P.in[0] + (size_t)m * cfg::D) + lane; f32x4 v[4]; float s = 0.f;
#pragma unroll
            for (int j = 0; j < 4; ++j) { v[j] = xr[64 * j]; s += (v[j][0] * v[j][0] + v[j][1] * v[j][1]) + (v[j][2] * v[j][2] + v[j][3] * v[j][3]); }
            s = wave_sum(s, lane);
            u32x2* o8 = (u32x2*)(XBp + (size_t)m * cfg::D) + lane;
#pragma unroll
            for (int j = 0; j < 4; ++j) { u32x2 w; w.x = cvtpk(v[j][0], v[j][1]); w.y = cvtpk(v[j][2], v[j][3]); o8[64 * j] = w; }
            if (lane < 16) ssqx[(size_t)m * 16 + lane] = (lane == 0) ? s : 0.f;
        }
        __syncthreads();
    }
    SEAM(0);
#endif

    { constexpr int l = 0;
        const int pb = 1 + 8 * l;
        if ((PH_MASK & 2) && IN(pb + 0)) {
            LAUNDER_W(); unsigned char* wl = W + ws::WBASE + (size_t)l * ws::WLAYER;
            pg8::Gemm g{(const bf16_t*)(W + ws::XB), (const bf16_t*)(wl + ws::W_GU1), cfg::M, 2 * cfg::FF, cfg::D}; pg8::StaticOrder S; S.init(cfg::M, 2 * cfg::FF, G, bx);
            const int gid0_ = pg8::rstd_table((LAS float*)(lds + RSTAB_OFF), S, pg8::ssqx_buf(W, 3 * l), (int)threadIdx.x);
            pg8::EpiSwiGLU E{W, 3 * l, (const LAS float*)(lds + RSTAB_OFF), gid0_};
            pg8::gemm_phase<pg8::EpiSwiGLU, pg8::StaticOrder, true, true>(lds, g, S, E);
        }
        SEAM(pb + 0);
#if PROBE_DOUBLE == 1
        if ((PH_MASK & 2) && IN(pb + 0)) {
            LAUNDER_W(); unsigned char* wl = W + ws::WBASE + (size_t)l * ws::WLAYER;
            pg8::Gemm g{(const bf16_t*)(W + ws::XB), (const bf16_t*)(wl + ws::W_GU1), cfg::M, 2 * cfg::FF, cfg::D}; pg8::StaticOrder S; S.init(cfg::M, 2 * cfg::FF, G, bx);
            const int gid0_ = pg8::rstd_table((LAS float*)(lds + RSTAB_OFF), S, pg8::ssqx_buf(W, 3 * l), (int)threadIdx.x);
            pg8::EpiSwiGLU E{W, 3 * l, (const LAS float*)(lds + RSTAB_OFF), gid0_};
            pg8::gemm_phase<pg8::EpiSwiGLU, pg8::StaticOrder, true, true>(lds, g, S, E);
        }
        SEAM(pb + 0);
#endif
#if PROBE_DOUBLE == 11
        if ((PH_MASK & 2) && IN(pb + 0)) {
            LAUNDER_W(); unsigned char* wl = W + ws::WBASE + (size_t)l * ws::WLAYER;
            pg8::Gemm g{(const bf16_t*)(W + ws::XB), (const bf16_t*)(wl + ws::W_GU1), cfg::M, 2 * cfg::FF, cfg::D}; pg8::StaticOrder S; S.init(cfg::M, 2 * cfg::FF, G, bx);
            pg8::EpiNull E{P.out};
            pg8::gemm_phase<pg8::EpiNull, pg8::StaticOrder, true, true>(lds, g, S, E);
        }
        SEAM(pb + 0);
#endif
        if ((PH_MASK & 4) && IN(pb + 1)) {
            LAUNDER_W(); unsigned char* wl = W + ws::WBASE + (size_t)l * ws::WLAYER;
            pg8::Gemm g{(const bf16_t*)(W + ws::H), (const bf16_t*)(wl + ws::W_D1), cfg::M, cfg::D, cfg::FF}; pg8::StaticOrder S; S.init(cfg::M, cfg::D, G, bx);
            pg8::EpiResid E{W, 3 * l + 1, 0.5f};
            pg8::gemm_phase<pg8::EpiResid, pg8::StaticOrder, true, true>(lds, g, S, E);
        }
        SEAM(pb + 1);
#if PROBE_DOUBLE == 2
        if ((PH_MASK & 4) && IN(pb + 1)) {
            LAUNDER_W(); unsigned char* wl = W + ws::WBASE + (size_t)l * ws::WLAYER;
            pg8::Gemm g{(const bf16_t*)(W + ws::H), (const bf16_t*)(wl + ws::W_D1), cfg::M, cfg::D, cfg::FF}; pg8::StaticOrder S; S.init(cfg::M, cfg::D, G, bx);
            pg8::EpiResid E{W, 3 * l + 1, 0.0f};
            pg8::gemm_phase<pg8::EpiResid, pg8::StaticOrder, true, true>(lds, g, S, E);
        }
        SEAM(pb + 1);
#endif
        if ((PH_MASK & 8) && IN(pb + 2)) {
            LAUNDER_W(); unsigned char* wl = W + ws::WBASE + (size_t)l * ws::WLAYER;
            pg8::Gemm g{(const bf16_t*)(W + ws::XB), (const bf16_t*)(wl + ws::W_IN), cfg::M, cfg::DINP, cfg::D}; pg8::StaticOrder S; S.init(cfg::M, cfg::DINP, G, bx);
            pg8::EpiWin E{W, l};
            pg8::gemm_phase<pg8::EpiWin, pg8::StaticOrder, true, true>(lds, g, S, E);
        }
        SEAM(pb + 2);
#if PROBE_DOUBLE == 3
        if ((PH_MASK & 8) && IN(pb + 2)) {
            LAUNDER_W(); unsigned char* wl = W + ws::WBASE + (size_t)l * ws::WLAYER;
            pg8::Gemm g{(const bf16_t*)(W + ws::XB), (const bf16_t*)(wl + ws::W_IN), cfg::M, cfg::DINP, cfg::D}; pg8::StaticOrder S; S.init(cfg::M, cfg::DINP, G, bx);
            pg8::EpiWin E{W, l};
            pg8::gemm_phase<pg8::EpiWin, pg8::StaticOrder, true, true>(lds, g, S, E);
        }
        SEAM(pb + 2);
#endif
        if ((PH_MASK & (16 | 512 | 1024)) && IN(pb + 3)) {
            if (PH_MASK & 16) { LAUNDER_W(); unsigned char* wl = W + ws::WBASE + (size_t)l * ws::WLAYER;
              pg8::Gemm g{(const bf16_t*)(W + ws::CQ), (const bf16_t*)(wl + ws::W_UQ), cfg::M, 768, 256}; pg8::StaticOrder S; S.init(cfg::M, 768, G, bx);
              pg8::EpiQ E{W, l};
              pg8::gemm_phase<pg8::EpiQ, pg8::StaticOrder, true, true>(lds, g, S, E); }
            if (PH_MASK & 512) { LAUNDER_W(); unsigned char* wl = W + ws::WBASE + (size_t)l * ws::WLAYER;
              pg8::Gemm g{(const bf16_t*)(W + ws::CKV), (const bf16_t*)(wl + ws::W_KV), cfg::M, 512, 128}; pg8::StaticOrder S; S.init(cfg::M, 512, G, bx);
              pg8::EpiKN E{W, l};
              pg8::gemm_phase<pg8::EpiKN, pg8::StaticOrder, true, true>(lds, g, S, E); }
            if (PH_MASK & 1024) { LAUNDER_W(); unsigned char* wl = W + ws::WBASE + (size_t)l * ws::WLAYER;
              pg8::Gemm g{(const bf16_t*)(wl + ws::W_KV) + 512 * 128, (const bf16_t*)(W + ws::CKV), 512, cfg::M, 128}; pg8::StaticOrder S; S.init(512, cfg::M, G, bx);
              pg8::EpiVT E{W, l};
              pg8::gemm_phase<pg8::EpiVT, pg8::StaticOrder, true, true>(lds, g, S, E); }
        }
        SEAM(pb + 3);
#if PROBE_DOUBLE == 4
        if ((PH_MASK & (16 | 512 | 1024)) && IN(pb + 3)) {
            if (PH_MASK & 16) { LAUNDER_W(); unsigned char* wl = W + ws::WBASE + (size_t)l * ws::WLAYER;
              pg8::Gemm g{(const bf16_t*)(W + ws::CQ), (const bf16_t*)(wl + ws::W_UQ), cfg::M, 768, 256}; pg8::StaticOrder S; S.init(cfg::M, 768, G, bx);
              pg8::EpiQ E{W, l};
              pg8::gemm_phase<pg8::EpiQ, pg8::StaticOrder, true, true>(lds, g, S, E); }
            if (PH_MASK & 512) { LAUNDER_W(); unsigned char* wl = W + ws::WBASE + (size_t)l * ws::WLAYER;
              pg8::Gemm g{(const bf16_t*)(W + ws::CKV), (const bf16_t*)(wl + ws::W_KV), cfg::M, 512, 128}; pg8::StaticOrder S; S.init(cfg::M, 512, G, bx);
              pg8::EpiKN E{W, l};
              pg8::gemm_phase<pg8::EpiKN, pg8::StaticOrder, true, true>(lds, g, S, E); }
            if (PH_MASK & 1024) { LAUNDER_W(); unsigned char* wl = W + ws::WBASE + (size_t)l * ws::WLAYER;
              pg8::Gemm g{(const bf16_t*)(wl + ws::W_KV) + 512 * 128, (const bf16_t*)(W + ws::CKV), 512, cfg::M, 128}; pg8::StaticOrder S; S.init(512, cfg::M, G, bx);
              pg8::EpiVT E{W, l};
              pg8::gemm_phase<pg8::EpiVT, pg8::StaticOrder, true, true>(lds, g, S, E); }
        }
        SEAM(pb + 3);
#endif
        if ((PH_MASK & 96) && IN(pb + 4)) {
            LOCAL_TID(); LAUNDER_W(); const float* sp = (const float*)(W + ws::SMALLP) + l * 4096;
            const int x0 = (int)__builtin_amdgcn_readfirstlane((int)(xb_xcc_id() & 7u));
            for (int xs = 0; xs < 8; ++xs) {
                const int x = (x0 + xs) & 7;
                gu32* head = (gu32*)(W + ws::CTL) + ws::CW_QUEUE + (l * 8 + x) * 64 + 0 * 32;
                bool have = false; unsigned kp = 0u;
                for (;;) {
                    if (tid == 0) MISC[0] = have ? kp : __hip_atomic_fetch_add(head, 1u, __ATOMIC_RELAXED, __HIP_MEMORY_SCOPE_AGENT);
                    __syncthreads();
                    const int k = (int)MISC[0] + 0;
                    __syncthreads();
                    have = false;
                    if (k >= 200) break;
                    if (k < 8) { if (PH_MASK & 64) { const int u = x * 8 + k; mls::mlstm_unit(lds, u >> 2, u & 3, (const bf16_t*)(W + ws::QM), (const bf16_t*)(W + ws::KM), (const bf16_t*)(W + ws::VM), (const bf16_t*)(W + ws::OG),
                                                  (const float*)(W + ws::IFG), sp, sp + 2048, (bf16_t*)(W + ws::Y)); } }
                    else if (PH_MASK & 32) { const int a = k - 8; const int bhq = x * 16 + ((a < 64) ? (a & 15) : ((a - 64) & 15)); const int qa = (a < 64) ? (a >> 4) : 11 - ((a - 64) >> 4), qb2 = (a < 64) ? 15 - (a >> 4) : -1; att::attn_unit(lds, bhq, qa, qb2, (const bf16_t*)(W + ws::Q), (const bf16_t*)(W + ws::KF), (const bf16_t*)(W + ws::VT), (bf16_t*)(W + ws::Y), head, kp); have = true; }
                }
            }
        }
        SEAM(pb + 4);
#if PROBE_DOUBLE == 5
        if ((PH_MASK & 96) && IN(pb + 4)) {
            LOCAL_TID(); LAUNDER_W(); const float* sp = (const float*)(W + ws::SMALLP) + l * 4096;
            const int x0 = (int)__builtin_amdgcn_readfirstlane((int)(xb_xcc_id() & 7u));
            for (int xs = 0; xs < 8; ++xs) {
                const int x = (x0 + xs) & 7;
                gu32* head = (gu32*)(W + ws::CTL) + ws::CW_QUEUE + (l * 8 + x) * 64 + 1 * 32;
                for (;;) {
                    if (tid == 0) MISC[0] = __hip_atomic_fetch_add(head, 1u, __ATOMIC_RELAXED, __HIP_MEMORY_SCOPE_AGENT);
                    __syncthreads();
                    const int k = (int)MISC[0] + 0;
                    __syncthreads();
                    if (k >= 200) break;
                    if (k < 8) { if (PH_MASK & 64) { const int u = x * 8 + k; mls::mlstm_unit(lds, u >> 2, u & 3, (const bf16_t*)(W + ws::QM), (const bf16_t*)(W + ws::KM), (const bf16_t*)(W + ws::VM), (const bf16_t*)(W + ws::OG),
                                                  (const float*)(W + ws::IFG), sp, sp + 2048, (bf16_t*)(W + ws::Y)); } }
                    else if (PH_MASK & 32) { const int a = k - 8; const int bhq = x * 16 + ((a < 64) ? (a & 15) : ((a - 64) & 15)); const int qa = (a < 64) ? (a >> 4) : 11 - ((a - 64) >> 4), qb2 = (a < 64) ? 15 - (a >> 4) : -1; { unsigned kd_ = 0u; att::attn_unit(lds, bhq, qa, qb2, (const bf16_t*)(W + ws::Q), (const bf16_t*)(W + ws::KF), (const bf16_t*)(W + ws::VT), (bf16_t*)(W + ws::Y), head, kd_); } }
                }
            }
        }
        SEAM(pb + 4);
#endif
#if PROBE_DOUBLE == 7
        if ((PH_MASK & 96) && IN(pb + 4)) {
            LOCAL_TID(); LAUNDER_W(); const float* sp = (const float*)(W + ws::SMALLP) + l * 4096;
            const int x0 = (int)__builtin_amdgcn_readfirstlane((int)(xb_xcc_id() & 7u));
            for (int xs = 0; xs < 8; ++xs) {
                const int x = (x0 + xs) & 7;
                gu32* head = (gu32*)(W + ws::CTL) + ws::CW_QUEUE + (l * 8 + x) * 64 + 1 * 32;
                for (;;) {
                    if (tid == 0) MISC[0] = __hip_atomic_fetch_add(head, 1u, __ATOMIC_RELAXED, __HIP_MEMORY_SCOPE_AGENT);
                    __syncthreads();
                    const int k = (int)MISC[0] + 0;
                    __syncthreads();
                    if (k >= 8) break;
                    if (k < 8) { if (PH_MASK & 64) { const int u = x * 8 + k; mls::mlstm_unit(lds, u >> 2, u & 3, (const bf16_t*)(W + ws::QM), (const bf16_t*)(W + ws::KM), (const bf16_t*)(W + ws::VM), (const bf16_t*)(W + ws::OG),
                                                  (const float*)(W + ws::IFG), sp, sp + 2048, (bf16_t*)(W + ws::Y)); } }
                    else if (PH_MASK & 32) { const int a = k - 8; const int bhq = x * 16 + ((a < 64) ? (a & 15) : ((a - 64) & 15)); const int qa = (a < 64) ? (a >> 4) : 11 - ((a - 64) >> 4), qb2 = (a < 64) ? 15 - (a >> 4) : -1; { unsigned kd_ = 0u; att::attn_unit(lds, bhq, qa, qb2, (const bf16_t*)(W + ws::Q), (const bf16_t*)(W + ws::KF), (const bf16_t*)(W + ws::VT), (bf16_t*)(W + ws::Y), head, kd_); } }
                }
            }
        }
        SEAM(pb + 4);
#endif
#if PROBE_DOUBLE == 8
        if ((PH_MASK & 96) && IN(pb + 4)) {
            LOCAL_TID(); LAUNDER_W(); const float* sp = (const float*)(W + ws::SMALLP) + l * 4096;
            const int x0 = (int)__builtin_amdgcn_readfirstlane((int)(xb_xcc_id() & 7u));
            for (int xs = 0; xs < 8; ++xs) {
                const int x = (x0 + xs) & 7;
                gu32* head = (gu32*)(W + ws::CTL) + ws::CW_QUEUE + (l * 8 + x) * 64 + 1 * 32;
                for (;;) {
                    if (tid == 0) MISC[0] = __hip_atomic_fetch_add(head, 1u, __ATOMIC_RELAXED, __HIP_MEMORY_SCOPE_AGENT);
                    __syncthreads();
                    const int k = (int)MISC[0] + 8;
                    __syncthreads();
                    if (k >= 200) break;
                    if (k < 8) { if (PH_MASK & 64) { const int u = x * 8 + k; mls::mlstm_unit(lds, u >> 2, u & 3, (const bf16_t*)(W + ws::QM), (const bf16_t*)(W + ws::KM), (const bf16_t*)(W + ws::VM), (const bf16_t*)(W + ws::OG),
                                                  (const float*)(W + ws::IFG), sp, sp + 2048, (bf16_t*)(W + ws::Y)); } }
                    else if (PH_MASK & 32) { const int a = k - 8; const int bhq = x * 16 + ((a < 64) ? (a & 15) : ((a - 64) & 15)); const int qa = (a < 64) ? (a >> 4) : 11 - ((a - 64) >> 4), qb2 = (a < 64) ? 15 - (a >> 4) : -1; { unsigned kd_ = 0u; att::attn_unit(lds, bhq, qa, qb2, (const bf16_t*)(W + ws::Q), (const bf16_t*)(W + ws::KF), (const bf16_t*)(W + ws::VT), (bf16_t*)(W + ws::Y), head, kd_); } }
                }
            }
        }
        SEAM(pb + 4);
#endif
        if ((PH_MASK & 128) && IN(pb + 5)) {
            LAUNDER_W(); unsigned char* wl = W + ws::WBASE + (size_t)l * ws::WLAYER;
            pg8::Gemm g{(const bf16_t*)(W + ws::Y), (const bf16_t*)(wl + ws::W_O), cfg::M, cfg::D, cfg::D}; pg8::StaticOrder S; S.init(cfg::M, cfg::D, G, bx);
            pg8::EpiResid E{W, 3 * l + 2, 1.0f};
            pg8::gemm_phase<pg8::EpiResid, pg8::StaticOrder, true, true>(lds, g, S, E);
        }
        SEAM(pb + 5);
#if PROBE_DOUBLE == 6
        if ((PH_MASK & 128) && IN(pb + 5)) {
            LAUNDER_W(); unsigned char* wl = W + ws::WBASE + (size_t)l * ws::WLAYER;
            pg8::Gemm g{(const bf16_t*)(W + ws::Y), (const bf16_t*)(wl + ws::W_O), cfg::M, cfg::D, cfg::D}; pg8::StaticOrder S; S.init(cfg::M, cfg::D, G, bx);
            pg8::EpiResid E{W, 3 * l + 2, 0.0f};
            pg8::gemm_phase<pg8::EpiResid, pg8::StaticOrder, true, true>(lds, g, S, E);
        }
        SEAM(pb + 5);
#endif
        if ((PH_MASK & 2) && IN(pb + 6)) {
            LAUNDER_W(); unsigned char* wl = W + ws::WBASE + (size_t)l * ws::WLAYER;
            pg8::Gemm g{(const bf16_t*)(W + ws::XB), (const bf16_t*)(wl + ws::W_GU2), cfg::M, 2 * cfg::FF, cfg::D}; pg8::StaticOrder S; S.init(cfg::M, 2 * cfg::FF, G, bx);
            const int gid0_ = pg8::rstd_table((LAS float*)(lds + RSTAB_OFF), S, pg8::ssqx_buf(W, 3 * l + 2), (int)threadIdx.x);
            pg8::EpiSwiGLU E{W, 3 * l + 2, (const LAS float*)(lds + RSTAB_OFF), gid0_};
            pg8::gemm_phase<pg8::EpiSwiGLU, pg8::StaticOrder, true, true>(lds, g, S, E);
        }
        SEAM(pb + 6);
        if ((PH_MASK & 4) && IN(pb + 7)) {
            LAUNDER_W(); unsigned char* wl = W + ws::WBASE + (size_t)l * ws::WLAYER;
            pg8::Gemm g{(const bf16_t*)(W + ws::H), (const bf16_t*)(wl + ws::W_D2), cfg::M, cfg::D, cfg::FF}; pg8::StaticOrder S; S.init(cfg::M, cfg::D, G, bx);
            pg8::EpiResid E{W, 3 * l + 3, 0.5f};
            pg8::gemm_phase<pg8::EpiResid, pg8::StaticOrder, true, true>(lds, g, S, E);
        }
        SEAM(pb + 7);
        }
    { constexpr int l = 1;
        const int pb = 1 + 8 * l;
        if ((PH_MASK & 2) && IN(pb + 0)) {
            LAUNDER_W(); unsigned char* wl = W + ws::WBASE + (size_t)l * ws::WLAYER;
            pg8::Gemm g{(const bf16_t*)(W + ws::XB), (const bf16_t*)(wl + ws::W_GU1), cfg::M, 2 * cfg::FF, cfg::D}; pg8::StaticOrder S; S.init(cfg::M, 2 * cfg::FF, G, bx);
            const int gid0_ = pg8::rstd_table((LAS float*)(lds + RSTAB_OFF), S, pg8::ssqx_buf(W, 3 * l), (int)threadIdx.x);
            pg8::EpiSwiGLU E{W, 3 * l, (const LAS float*)(lds + RSTAB_OFF), gid0_};
            pg8::gemm_phase<pg8::EpiSwiGLU, pg8::StaticOrder, true, true>(lds, g, S, E);
        }
        SEAM(pb + 0);
#if PROBE_DOUBLE == 1
        if ((PH_MASK & 2) && IN(pb + 0)) {
            LAUNDER_W(); unsigned char* wl = W + ws::WBASE + (size_t)l * ws::WLAYER;
            pg8::Gemm g{(const bf16_t*)(W + ws::XB), (const bf16_t*)(wl + ws::W_GU1), cfg::M, 2 * cfg::FF, cfg::D}; pg8::StaticOrder S; S.init(cfg::M, 2 * cfg::FF, G, bx);
            const int gid0_ = pg8::rstd_table((LAS float*)(lds + RSTAB_OFF), S, pg8::ssqx_buf(W, 3 * l), (int)threadIdx.x);
            pg8::EpiSwiGLU E{W, 3 * l, (const LAS float*)(lds + RSTAB_OFF), gid0_};
            pg8::gemm_phase<pg8::EpiSwiGLU, pg8::StaticOrder, true, true>(lds, g, S, E);
        }
        SEAM(pb + 0);
#endif
#if PROBE_DOUBLE == 11
        if ((PH_MASK & 2) && IN(pb + 0)) {
            LAUNDER_W(); unsigned char* wl = W + ws::WBASE + (size_t)l * ws::WLAYER;
            pg8::Gemm g{(const bf16_t*)(W + ws::XB), (const bf16_t*)(wl + ws::W_GU1), cfg::M, 2 * cfg::FF, cfg::D}; pg8::StaticOrder S; S.init(cfg::M, 2 * cfg::FF, G, bx);
            pg8::EpiNull E{P.out};
            pg8::gemm_phase<pg8::EpiNull, pg8::StaticOrder, true, true>(lds, g, S, E);
        }
        SEAM(pb + 0);
#endif
        if ((PH_MASK & 4) && IN(pb + 1)) {
            LAUNDER_W(); unsigned char* wl = W + ws::WBASE + (size_t)l * ws::WLAYER;
            pg8::Gemm g{(const bf16_t*)(W + ws::H), (const bf16_t*)(wl + ws::W_D1), cfg::M, cfg::D, cfg::FF}; pg8::StaticOrder S; S.init(cfg::M, cfg::D, G, bx);
            pg8::EpiResid E{W, 3 * l + 1, 0.5f};
            pg8::gemm_phase<pg8::EpiResid, pg8::StaticOrder, true, true>(lds, g, S, E);
        }
        SEAM(pb + 1);
#if PROBE_DOUBLE == 2
        if ((PH_MASK & 4) && IN(pb + 1)) {
            LAUNDER_W(); unsigned char* wl = W + ws::WBASE + (size_t)l * ws::WLAYER;
            pg8::Gemm g{(const bf16_t*)(W + ws::H), (const bf16_t*)(wl + ws::W_D1), cfg::M, cfg::D, cfg::FF}; pg8::StaticOrder S; S.init(cfg::M, cfg::D, G, bx);
            pg8::EpiResid E{W, 3 * l + 1, 0.0f};
            pg8::gemm_phase<pg8::EpiResid, pg8::StaticOrder, true, true>(lds, g, S, E);
        }
        SEAM(pb + 1);
#endif
        if ((PH_MASK & 8) && IN(pb + 2)) {
            LAUNDER_W(); unsigned char* wl = W + ws::WBASE + (size_t)l * ws::WLAYER;
            pg8::Gemm g{(const bf16_t*)(W + ws::XB), (const bf16_t*)(wl + ws::W_IN), cfg::M, cfg::DINP, cfg::D}; pg8::StaticOrder S; S.init(cfg::M, cfg::DINP, G, bx);
            pg8::EpiWin E{W, l};
            pg8::gemm_phase<pg8::EpiWin, pg8::StaticOrder, true, true>(lds, g, S, E);
        }
        SEAM(pb + 2);
#if PROBE_DOUBLE == 3
        if ((PH_MASK & 8) && IN(pb + 2)) {
            LAUNDER_W(); unsigned char* wl = W + ws::WBASE + (size_t)l * ws::WLAYER;
            pg8::Gemm g{(const bf16_t*)(W + ws::XB), (const bf16_t*)(wl + ws::W_IN), cfg::M, cfg::DINP, cfg::D}; pg8::StaticOrder S; S.init(cfg::M, cfg::DINP, G, bx);
            pg8::EpiWin E{W, l};
            pg8::gemm_phase<pg8::EpiWin, pg8::StaticOrder, true, true>(lds, g, S, E);
        }
        SEAM(pb + 2);
#endif
        if ((PH_MASK & (16 | 512 | 1024)) && IN(pb + 3)) {
            if (PH_MASK & 16) { LAUNDER_W(); unsigned char* wl = W + ws::WBASE + (size_t)l * ws::WLAYER;
              pg8::Gemm g{(const bf16_t*)(W + ws::CQ), (const bf16_t*)(wl + ws::W_UQ), cfg::M, 768, 256}; pg8::StaticOrder S; S.init(cfg::M, 768, G, bx);
              pg8::EpiQ E{W, l};
              pg8::gemm_phase<pg8::EpiQ, pg8::StaticOrder, true, true>(lds, g, S, E); }
            if (PH_MASK & 512) { LAUNDER_W(); unsigned char* wl = W + ws::WBASE + (size_t)l * ws::WLAYER;
              pg8::Gemm g{(const bf16_t*)(W + ws::CKV), (const bf16_t*)(wl + ws::W_KV), cfg::M, 512, 128}; pg8::StaticOrder S; S.init(cfg::M, 512, G, bx);
              pg8::EpiKN E{W, l};
              pg8::gemm_phase<pg8::EpiKN, pg8::StaticOrder, true, true>(lds, g, S, E); }
            if (PH_MASK & 1024) { LAUNDER_W(); unsigned char* wl = W + ws::WBASE + (size_t)l * ws::WLAYER;
              pg8::Gemm g{(const bf16_t*)(wl + ws::W_KV) + 512 * 128, (const bf16_t*)(W + ws::CKV), 512, cfg::M, 128}; pg8::StaticOrder S; S.init(512, cfg::M, G, bx);
              pg8::EpiVT E{W, l};
              pg8::gemm_phase<pg8::EpiVT, pg8::StaticOrder, true, true>(lds, g, S, E); }
        }
        SEAM(pb + 3);
#if PROBE_DOUBLE == 4
        if ((PH_MASK & (16 | 512 | 1024)) && IN(pb + 3)) {
            if (PH_MASK & 16) { LAUNDER_W(); unsigned char* wl = W + ws::WBASE + (size_t)l * ws::WLAYER;
              pg8::Gemm g{(const bf16_t*)(W + ws::CQ), (const bf16_t*)(wl + ws::W_UQ), cfg::M, 768, 256}; pg8::StaticOrder S; S.init(cfg::M, 768, G, bx);
              pg8::EpiQ E{W, l};
              pg8::gemm_phase<pg8::EpiQ, pg8::StaticOrder, true, true>(lds, g, S, E); }
            if (PH_MASK & 512) { LAUNDER_W(); unsigned char* wl = W + ws::WBASE + (size_t)l * ws::WLAYER;
              pg8::Gemm g{(const bf16_t*)(W + ws::CKV), (const bf16_t*)(wl + ws::W_KV), cfg::M, 512, 128}; pg8::StaticOrder S; S.init(cfg::M, 512, G, bx);
              pg8::EpiKN E{W, l};
              pg8::gemm_phase<pg8::EpiKN, pg8::StaticOrder, true, true>(lds, g, S, E); }
            if (PH_MASK & 1024) { LAUNDER_W(); unsigned char* wl = W + ws::WBASE + (size_t)l * ws::WLAYER;
              pg8::Gemm g{(const bf16_t*)(wl + ws::W_KV) + 512 * 128, (const bf16_t*)(W + ws::CKV), 512, cfg::M, 128}; pg8::StaticOrder S; S.init(512, cfg::M, G, bx);
              pg8::EpiVT E{W, l};
              pg8::gemm_phase<pg8::EpiVT, pg8::StaticOrder, true, true>(lds, g, S, E); }
        }
        SEAM(pb + 3);
#endif
        if ((PH_MASK & 96) && IN(pb + 4)) {
            LOCAL_TID(); LAUNDER_W(); const float* sp = (const float*)(W + ws::SMALLP) + l * 4096;
            const int x0 = (int)__builtin_amdgcn_readfirstlane((int)(xb_xcc_id() & 7u));
            for (int xs = 0; xs < 8; ++xs) {
                const int x = (x0 + xs) & 7;
                gu32* head = (gu32*)(W + ws::CTL) + ws::CW_QUEUE + (l * 8 + x) * 64 + 0 * 32;
                bool have = false; unsigned kp = 0u;
                for (;;) {
                    if (tid == 0) MISC[0] = have ? kp : __hip_atomic_fetch_add(head, 1u, __ATOMIC_RELAXED, __HIP_MEMORY_SCOPE_AGENT);
                    __syncthreads();
                    const int k = (int)MISC[0] + 0;
                    __syncthreads();
                    have = false;
                    if (k >= 200) break;
                    if (k < 8) { if (PH_MASK & 64) { const int u = x * 8 + k; mls::mlstm_unit(lds, u >> 2, u & 3, (const bf16_t*)(W + ws::QM), (const bf16_t*)(W + ws::KM), (const bf16_t*)(W + ws::VM), (const bf16_t*)(W + ws::OG),
                                                  (const float*)(W + ws::IFG), sp, sp + 2048, (bf16_t*)(W + ws::Y)); } }
                    else if (PH_MASK & 32) { const int a = k - 8; const int bhq = x * 16 + ((a < 64) ? (a & 15) : ((a - 64) & 15)); const int qa = (a < 64) ? (a >> 4) : 11 - ((a - 64) >> 4), qb2 = (a < 64) ? 15 - (a >> 4) : -1; att::attn_unit(lds, bhq, qa, qb2, (const bf16_t*)(W + ws::Q), (const bf16_t*)(W + ws::KF), (const bf16_t*)(W + ws::VT), (bf16_t*)(W + ws::Y), head, kp); have = true; }
                }
            }
        }
        SEAM(pb + 4);
#if PROBE_DOUBLE == 5
        if ((PH_MASK & 96) && IN(pb + 4)) {
            LOCAL_TID(); LAUNDER_W(); const float* sp = (const float*)(W + ws::SMALLP) + l * 4096;
            const int x0 = (int)__builtin_amdgcn_readfirstlane((int)(xb_xcc_id() & 7u));
            for (int xs = 0; xs < 8; ++xs) {
                const int x = (x0 + xs) & 7;
                gu32* head = (gu32*)(W + ws::CTL) + ws::CW_QUEUE + (l * 8 + x) * 64 + 1 * 32;
                for (;;) {
                    if (tid == 0) MISC[0] = __hip_atomic_fetch_add(head, 1u, __ATOMIC_RELAXED, __HIP_MEMORY_SCOPE_AGENT);
                    __syncthreads();
                    const int k = (int)MISC[0] + 0;
                    __syncthreads();
                    if (k >= 200) break;
                    if (k < 8) { if (PH_MASK & 64) { const int u = x * 8 + k; mls::mlstm_unit(lds, u >> 2, u & 3, (const bf16_t*)(W + ws::QM), (const bf16_t*)(W + ws::KM), (const bf16_t*)(W + ws::VM), (const bf16_t*)(W + ws::OG),
                                                  (const float*)(W + ws::IFG), sp, sp + 2048, (bf16_t*)(W + ws::Y)); } }
                    else if (PH_MASK & 32) { const int a = k - 8; const int bhq = x * 16 + ((a < 64) ? (a & 15) : ((a - 64) & 15)); const int qa = (a < 64) ? (a >> 4) : 11 - ((a - 64) >> 4), qb2 = (a < 64) ? 15 - (a >> 4) : -1; { unsigned kd_ = 0u; att::attn_unit(lds, bhq, qa, qb2, (const bf16_t*)(W + ws::Q), (const bf16_t*)(W + ws::KF), (const bf16_t*)(W + ws::VT), (bf16_t*)(W + ws::Y), head, kd_); } }
                }
            }
        }
        SEAM(pb + 4);
#endif
#if PROBE_DOUBLE == 7
        if ((PH_MASK & 96) && IN(pb + 4)) {
            LOCAL_TID(); LAUNDER_W(); const float* sp = (const float*)(W + ws::SMALLP) + l * 4096;
            const int x0 = (int)__builtin_amdgcn_readfirstlane((int)(xb_xcc_id() & 7u));
            for (int xs = 0; xs < 8; ++xs) {
                const int x = (x0 + xs) & 7;
                gu32* head = (gu32*)(W + ws::CTL) + ws::CW_QUEUE + (l * 8 + x) * 64 + 1 * 32;
                for (;;) {
                    if (tid == 0) MISC[0] = __hip_atomic_fetch_add(head, 1u, __ATOMIC_RELAXED, __HIP_MEMORY_SCOPE_AGENT);
                    __syncthreads();
                    const int k = (int)MISC[0] + 0;
                    __syncthreads();
                    if (k >= 8) break;
                    if (k < 8) { if (PH_MASK & 64) { const int u = x * 8 + k; mls::mlstm_unit(lds, u >> 2, u & 3, (const bf16_t*)(W + ws::QM), (const bf16_t*)(W + ws::KM), (const bf16_t*)(W + ws::VM), (const bf16_t*)(W + ws::OG),
                                                  (const float*)(W + ws::IFG), sp, sp + 2048, (bf16_t*)(W + ws::Y)); } }
                    else if (PH_MASK & 32) { const int a = k - 8; const int bhq = x * 16 + ((a < 64) ? (a & 15) : ((a - 64) & 15)); const int qa = (a < 64) ? (a >> 4) : 11 - ((a - 64) >> 4), qb2 = (a < 64) ? 15 - (a >> 4) : -1; { unsigned kd_ = 0u; att::attn_unit(lds, bhq, qa, qb2, (const bf16_t*)(W + ws::Q), (const bf16_t*)(W + ws::KF), (const bf16_t*)(W + ws::VT), (bf16_t*)(W + ws::Y), head, kd_); } }
                }
            }
        }
        SEAM(pb + 4);
#endif
#if PROBE_DOUBLE == 8
        if ((PH_MASK & 96) && IN(pb + 4)) {
            LOCAL_TID(); LAUNDER_W(); const float* sp = (const float*)(W + ws::SMALLP) + l * 4096;
            const int x0 = (int)__builtin_amdgcn_readfirstlane((int)(xb_xcc_id() & 7u));
            for (int xs = 0; xs < 8; ++xs) {
                const int x = (x0 + xs) & 7;
                gu32* head = (gu32*)(W + ws::CTL) + ws::CW_QUEUE + (l * 8 + x) * 64 + 1 * 32;
                for (;;) {
                    if (tid == 0) MISC[0] = __hip_atomic_fetch_add(head, 1u, __ATOMIC_RELAXED, __HIP_MEMORY_SCOPE_AGENT);
                    __syncthreads();
                    const int k = (int)MISC[0] + 8;
                    __syncthreads();
                    if (k >= 200) break;
                    if (k < 8) { if (PH_MASK & 64) { const int u = x * 8 + k; mls::mlstm_unit(lds, u >> 2, u & 3, (const bf16_t*)(W + ws::QM), (const bf16_t*)(W + ws::KM), (const bf16_t*)(W + ws::VM), (const bf16_t*)(W + ws::OG),
                                                  (const float*)(W + ws::IFG), sp, sp + 2048, (bf16_t*)(W + ws::Y)); } }
                    else if (PH_MASK & 32) { const int a = k - 8; const int bhq = x * 16 + ((a < 64) ? (a & 15) : ((a - 64) & 15)); const int qa = (a < 64) ? (a >> 4) : 11 - ((a - 64) >> 4), qb2 = (a < 64) ? 15 - (a >> 4) : -1; { unsigned kd_ = 0u; att::attn_unit(lds, bhq, qa, qb2, (const bf16_t*)(W + ws::Q), (const bf16_t*)(W + ws::KF), (const bf16_t*)(W + ws::VT), (bf16_t*)(W + ws::Y), head, kd_); } }
                }
            }
        }
        SEAM(pb + 4);
#endif
        if ((PH_MASK & 128) && IN(pb + 5)) {
            LAUNDER_W(); unsigned char* wl = W + ws::WBASE + (size_t)l * ws::WLAYER;
            pg8::Gemm g{(const bf16_t*)(W + ws::Y), (const bf16_t*)(wl + ws::W_O), cfg::M, cfg::D, cfg::D}; pg8::StaticOrder S; S.init(cfg::M, cfg::D, G, bx);
            pg8::EpiResid E{W, 3 * l + 2, 1.0f};
            pg8::gemm_phase<pg8::EpiResid, pg8::StaticOrder, true, true>(lds, g, S, E);
        }
        SEAM(pb + 5);
#if PROBE_DOUBLE == 6
        if ((PH_MASK & 128) && IN(pb + 5)) {
            LAUNDER_W(); unsigned char* wl = W + ws::WBASE + (size_t)l * ws::WLAYER;
            pg8::Gemm g{(const bf16_t*)(W + ws::Y), (const bf16_t*)(wl + ws::W_O), cfg::M, cfg::D, cfg::D}; pg8::StaticOrder S; S.init(cfg::M, cfg::D, G, bx);
            pg8::EpiResid E{W, 3 * l + 2, 0.0f};
            pg8::gemm_phase<pg8::EpiResid, pg8::StaticOrder, true, true>(lds, g, S, E);
        }
        SEAM(pb + 5);
#endif
        if ((PH_MASK & 2) && IN(pb + 6)) {
            LAUNDER_W(); unsigned char* wl = W + ws::WBASE + (size_t)l * ws::WLAYER;
            pg8::Gemm g{(const bf16_t*)(W + ws::XB), (const bf16_t*)(wl + ws::W_GU2), cfg::M, 2 * cfg::FF, cfg::D}; pg8::StaticOrder S; S.init(cfg::M, 2 * cfg::FF, G, bx);
            const int gid0_ = pg8::rstd_table((LAS float*)(lds + RSTAB_OFF), S, pg8::ssqx_buf(W, 3 * l + 2), (int)threadIdx.x);
            pg8::EpiSwiGLU E{W, 3 * l + 2, (const LAS float*)(lds + RSTAB_OFF), gid0_};
            pg8::gemm_phase<pg8::EpiSwiGLU, pg8::StaticOrder, true, true>(lds, g, S, E);
        }
        SEAM(pb + 6);
        if ((PH_MASK & 4) && IN(pb + 7)) {
            LAUNDER_W(); unsigned char* wl = W + ws::WBASE + (size_t)l * ws::WLAYER;
            pg8::Gemm g{(const bf16_t*)(W + ws::H), (const bf16_t*)(wl + ws::W_D2), cfg::M, cfg::D, cfg::FF}; pg8::StaticOrder S; S.init(cfg::M, cfg::D, G, bx);
            pg8::EpiResid E{W, 3 * l + 3, 0.5f};
            pg8::gemm_phase<pg8::EpiResid, pg8::StaticOrder, true, true>(lds, g, S, E);
        }
        SEAM(pb + 7);
        }
    { constexpr int l = 2;
        const int pb = 1 + 8 * l;
        if ((PH_MASK & 2) && IN(pb + 0)) {
            LAUNDER_W(); unsigned char* wl = W + ws::WBASE + (size_t)l * ws::WLAYER;
            pg8::Gemm g{(const bf16_t*)(W + ws::XB), (const bf16_t*)(wl + ws::W_GU1), cfg::M, 2 * cfg::FF, cfg::D}; pg8::StaticOrder S; S.init(cfg::M, 2 * cfg::FF, G, bx);
            const int gid0_ = pg8::rstd_table((LAS float*)(lds + RSTAB_OFF), S, pg8::ssqx_buf(W, 3 * l), (int)threadIdx.x);
            pg8::EpiSwiGLU E{W, 3 * l, (const LAS float*)(lds + RSTAB_OFF), gid0_};
            pg8::gemm_phase<pg8::EpiSwiGLU, pg8::StaticOrder, true, true>(lds, g, S, E);
        }
        SEAM(pb + 0);
#if PROBE_DOUBLE == 1
        if ((PH_MASK & 2) && IN(pb + 0)) {
            LAUNDER_W(); unsigned char* wl = W + ws::WBASE + (size_t)l * ws::WLAYER;
            pg8::Gemm g{(const bf16_t*)(W + ws::XB), (const bf16_t*)(wl + ws::W_GU1), cfg::M, 2 * cfg::FF, cfg::D}; pg8::StaticOrder S; S.init(cfg::M, 2 * cfg::FF, G, bx);
            const int gid0_ = pg8::rstd_table((LAS float*)(lds + RSTAB_OFF), S, pg8::ssqx_buf(W, 3 * l), (int)threadIdx.x);
            pg8::EpiSwiGLU E{W, 3 * l, (const LAS float*)(lds + RSTAB_OFF), gid0_};
            pg8::gemm_phase<pg8::EpiSwiGLU, pg8::StaticOrder, true, true>(lds, g, S, E);
        }
        SEAM(pb + 0);
#endif
#if PROBE_DOUBLE == 11
        if ((PH_MASK & 2) && IN(pb + 0)) {
            LAUNDER_W(); unsigned char* wl = W + ws::WBASE + (size_t)l * ws::WLAYER;
            pg8::Gemm g{(const bf16_t*)(W + ws::XB), (const bf16_t*)(wl + ws::W_GU1), cfg::M, 2 * cfg::FF, cfg::D}; pg8::StaticOrder S; S.init(cfg::M, 2 * cfg::FF, G, bx);
            pg8::EpiNull E{P.out};
            pg8::gemm_phase<pg8::EpiNull, pg8::StaticOrder, true, true>(lds, g, S, E);
        }
        SEAM(pb + 0);
#endif
        if ((PH_MASK & 4) && IN(pb + 1)) {
            LAUNDER_W(); unsigned char* wl = W + ws::WBASE + (size_t)l * ws::WLAYER;
            pg8::Gemm g{(const bf16_t*)(W + ws::H), (const bf16_t*)(wl + ws::W_D1), cfg::M, cfg::D, cfg::FF}; pg8::StaticOrder S; S.init(cfg::M, cfg::D, G, bx);
            pg8::EpiResid E{W, 3 * l + 1, 0.5f};
            pg8::gemm_phase<pg8::EpiResid, pg8::StaticOrder, true, true>(lds, g, S, E);
        }
        SEAM(pb + 1);
#if PROBE_DOUBLE == 2
        if ((PH_MASK & 4) && IN(pb + 1)) {
            LAUNDER_W(); unsigned char* wl = W + ws::WBASE + (size_t)l * ws::WLAYER;
            pg8::Gemm g{(const bf16_t*)(W + ws::H), (const bf16_t*)(wl + ws::W_D1), cfg::M, cfg::D, cfg::FF}; pg8::StaticOrder S; S.init(cfg::M, cfg::D, G, bx);
            pg8::EpiResid E{W, 3 * l + 1, 0.0f};
            pg8::gemm_phase<pg8::EpiResid, pg8::StaticOrder, true, true>(lds, g, S, E);
        }
        SEAM(pb + 1);
#endif
        if ((PH_MASK & 8) && IN(pb + 2)) {
            LAUNDER_W(); unsigned char* wl = W + ws::WBASE + (size_t)l * ws::WLAYER;
            pg8::Gemm g{(const bf16_t*)(W + ws::XB), (const bf16_t*)(wl + ws::W_IN), cfg::M, cfg::DINP, cfg::D}; pg8::StaticOrder S; S.init(cfg::M, cfg::DINP, G, bx);
            pg8::EpiWin E{W, l};
            pg8::gemm_phase<pg8::EpiWin, pg8::StaticOrder, true, true>(lds, g, S, E);
        }
        SEAM(pb + 2);
#if PROBE_DOUBLE == 3
        if ((PH_MASK & 8) && IN(pb + 2)) {
            LAUNDER_W(); unsigned char* wl = W + ws::WBASE + (size_t)l * ws::WLAYER;
            pg8::Gemm g{(const bf16_t*)(W + ws::XB), (const bf16_t*)(wl + ws::W_IN), cfg::M, cfg::DINP, cfg::D}; pg8::StaticOrder S; S.init(cfg::M, cfg::DINP, G, bx);
            pg8::EpiWin E{W, l};
            pg8::gemm_phase<pg8::EpiWin, pg8::StaticOrder, true, true>(lds, g, S, E);
        }
        SEAM(pb + 2);
#endif
        if ((PH_MASK & (16 | 512 | 1024)) && IN(pb + 3)) {
            if (PH_MASK & 16) { LAUNDER_W(); unsigned char* wl = W + ws::WBASE + (size_t)l * ws::WLAYER;
              pg8::Gemm g{(const bf16_t*)(W + ws::CQ), (const bf16_t*)(wl + ws::W_UQ), cfg::M, 768, 256}; pg8::StaticOrder S; S.init(cfg::M, 768, G, bx);
              pg8::EpiQ E{W, l};
              pg8::gemm_phase<pg8::EpiQ, pg8::StaticOrder, true, true>(lds, g, S, E); }
            if (PH_MASK & 512) { LAUNDER_W(); unsigned char* wl = W + ws::WBASE + (size_t)l * ws::WLAYER;
              pg8::Gemm g{(const bf16_t*)(W + ws::CKV), (const bf16_t*)(wl + ws::W_KV), cfg::M, 512, 128}; pg8::StaticOrder S; S.init(cfg::M, 512, G, bx);
              pg8::EpiKN E{W, l};
              pg8::gemm_phase<pg8::EpiKN, pg8::StaticOrder, true, true>(lds, g, S, E); }
            if (PH_MASK & 1024) { LAUNDER_W(); unsigned char* wl = W + ws::WBASE + (size_t)l * ws::WLAYER;
              pg8::Gemm g{(const bf16_t*)(wl + ws::W_KV) + 512 * 128, (const bf16_t*)(W + ws::CKV), 512, cfg::M, 128}; pg8::StaticOrder S; S.init(512, cfg::M, G, bx);
              pg8::EpiVT E{W, l};
              pg8::gemm_phase<pg8::EpiVT, pg8::StaticOrder, true, true>(lds, g, S, E); }
        }
        SEAM(pb + 3);
#if PROBE_DOUBLE == 4
        if ((PH_MASK & (16 | 512 | 1024)) && IN(pb + 3)) {
            if (PH_MASK & 16) { LAUNDER_W(); unsigned char* wl = W + ws::WBASE + (size_t)l * ws::WLAYER;
              pg8::Gemm g{(const bf16_t*)(W + ws::CQ), (const bf16_t*)(wl + ws::W_UQ), cfg::M, 768, 256}; pg8::StaticOrder S; S.init(cfg::M, 768, G, bx);
              pg8::EpiQ E{W, l};
              pg8::gemm_phase<pg8::EpiQ, pg8::StaticOrder, true, true>(lds, g, S, E); }
            if (PH_MASK & 512) { LAUNDER_W(); unsigned char* wl = W + ws::WBASE + (size_t)l * ws::WLAYER;
              pg8::Gemm g{(const bf16_t*)(W + ws::CKV), (const bf16_t*)(wl + ws::W_KV), cfg::M, 512, 128}; pg8::StaticOrder S; S.init(cfg::M, 512, G, bx);
              pg8::EpiKN E{W, l};
              pg8::gemm_phase<pg8::EpiKN, pg8::StaticOrder, true, true>(lds, g, S, E); }
            if (PH_MASK & 1024) { LAUNDER_W(); unsigned char* wl = W + ws::WBASE + (size_t)l * ws::WLAYER;
              pg8::Gemm g{(const bf16_t*)(wl + ws::W_KV) + 512 * 128, (const bf16_t*)(W + ws::CKV), 512, cfg::M, 128}; pg8::StaticOrder S; S.init(512, cfg::M, G, bx);
              pg8::EpiVT E{W, l};
              pg8::gemm_phase<pg8::EpiVT, pg8::StaticOrder, true, true>(lds, g, S, E); }
        }
        SEAM(pb + 3);
#endif
        if ((PH_MASK & 96) && IN(pb + 4)) {
            LOCAL_TID(); LAUNDER_W(); const float* sp = (const float*)(W + ws::SMALLP) + l * 4096;
            const int x0 = (int)__builtin_amdgcn_readfirstlane((int)(xb_xcc_id() & 7u));
            for (int xs = 0; xs < 8; ++xs) {
                const int x = (x0 + xs) & 7;
                gu32* head = (gu32*)(W + ws::CTL) + ws::CW_QUEUE + (l * 8 + x) * 64 + 0 * 32;
                bool have = false; unsigned kp = 0u;
                for (;;) {
                    if (tid == 0) MISC[0] = have ? kp : __hip_atomic_fetch_add(head, 1u, __ATOMIC_RELAXED, __HIP_MEMORY_SCOPE_AGENT);
                    __syncthreads();
                    const int k = (int)MISC[0] + 0;
                    __syncthreads();
                    have = false;
                    if (k >= 200) break;
                    if (k < 8) { if (PH_MASK & 64) { const int u = x * 8 + k; mls::mlstm_unit(lds, u >> 2, u & 3, (const bf16_t*)(W + ws::QM), (const bf16_t*)(W + ws::KM), (const bf16_t*)(W + ws::VM), (const bf16_t*)(W + ws::OG),
                                                  (const float*)(W + ws::IFG), sp, sp + 2048, (bf16_t*)(W + ws::Y)); } }
                    else if (PH_MASK & 32) { const int a = k - 8; const int bhq = x * 16 + ((a < 64) ? (a & 15) : ((a - 64) & 15)); const int qa = (a < 64) ? (a >> 4) : 11 - ((a - 64) >> 4), qb2 = (a < 64) ? 15 - (a >> 4) : -1; att::attn_unit(lds, bhq, qa, qb2, (const bf16_t*)(W + ws::Q), (const bf16_t*)(W + ws::KF), (const bf16_t*)(W + ws::VT), (bf16_t*)(W + ws::Y), head, kp); have = true; }
                }
            }
        }
        SEAM(pb + 4);
#if PROBE_DOUBLE == 5
        if ((PH_MASK & 96) && IN(pb + 4)) {
            LOCAL_TID(); LAUNDER_W(); const float* sp = (const float*)(W + ws::SMALLP) + l * 4096;
            const int x0 = (int)__builtin_amdgcn_readfirstlane((int)(xb_xcc_id() & 7u));
            for (int xs = 0; xs < 8; ++xs) {
                const int x = (x0 + xs) & 7;
                gu32* head = (gu32*)(W + ws::CTL) + ws::CW_QUEUE + (l * 8 + x) * 64 + 1 * 32;
                for (;;) {
                    if (tid == 0) MISC[0] = __hip_atomic_fetch_add(head, 1u, __ATOMIC_RELAXED, __HIP_MEMORY_SCOPE_AGENT);
                    __syncthreads();
                    const int k = (int)MISC[0] + 0;
                    __syncthreads();
                    if (k >= 200) break;
                    if (k < 8) { if (PH_MASK & 64) { const int u = x * 8 + k; mls::mlstm_unit(lds, u >> 2, u & 3, (const bf16_t*)(W + ws::QM), (const bf16_t*)(W + ws::KM), (const bf16_t*)(W + ws::VM), (const bf16_t*)(W + ws::OG),
                                                  (const float*)(W + ws::IFG), sp, sp + 2048, (bf16_t*)(W + ws::Y)); } }
                    else if (PH_MASK & 32) { const int a = k - 8; const int bhq = x * 16 + ((a < 64) ? (a & 15) : ((a - 64) & 15)); const int qa = (a < 64) ? (a >> 4) : 11 - ((a - 64) >> 4), qb2 = (a < 64) ? 15 - (a >> 4) : -1; { unsigned kd_ = 0u; att::attn_unit(lds, bhq, qa, qb2, (const bf16_t*)(W + ws::Q), (const bf16_t*)(W + ws::KF), (const bf16_t*)(W + ws::VT), (bf16_t*)(W + ws::Y), head, kd_); } }
                }
            }
        }
        SEAM(pb + 4);
#endif
#if PROBE_DOUBLE == 7
        if ((PH_MASK & 96) && IN(pb + 4)) {
            LOCAL_TID(); LAUNDER_W(); const float* sp = (const float*)(W + ws::SMALLP) + l * 4096;
            const int x0 = (int)__builtin_amdgcn_readfirstlane((int)(xb_xcc_id() & 7u));
            for (int xs = 0; xs < 8; ++xs) {
                const int x = (x0 + xs) & 7;
                gu32* head = (gu32*)(W + ws::CTL) + ws::CW_QUEUE + (l * 8 + x) * 64 + 1 * 32;
                for (;;) {
                    if (tid == 0) MISC[0] = __hip_atomic_fetch_add(head, 1u, __ATOMIC_RELAXED, __HIP_MEMORY_SCOPE_AGENT);
                    __syncthreads();
                    const int k = (int)MISC[0] + 0;
                    __syncthreads();
                    if (k >= 8) break;
                    if (k < 8) { if (PH_MASK & 64) { const int u = x * 8 + k; mls::mlstm_unit(lds, u >> 2, u & 3, (const bf16_t*)(W + ws::QM), (const bf16_t*)(W + ws::KM), (const bf16_t*)(W + ws::VM), (const bf16_t*)(W + ws::OG),
                                                  (const float*)(W + ws::IFG), sp, sp + 2048, (bf16_t*)(W + ws::Y)); } }
                    else if (PH_MASK & 32) { const int a = k - 8; const int bhq = x * 16 + ((a < 64) ? (a & 15) : ((a - 64) & 15)); const int qa = (a < 64) ? (a >> 4) : 11 - ((a - 64) >> 4), qb2 = (a < 64) ? 15 - (a >> 4) : -1; { unsigned kd_ = 0u; att::attn_unit(lds, bhq, qa, qb2, (const bf16_t*)(W + ws::Q), (const bf16_t*)(W + ws::KF), (const bf16_t*)(W + ws::VT), (bf16_t*)(W + ws::Y), head, kd_); } }
                }
            }
        }
        SEAM(pb + 4);
#endif
#if PROBE_DOUBLE == 8
        if ((PH_MASK & 96) && IN(pb + 4)) {
            LOCAL_TID(); LAUNDER_W(); const float* sp = (const float*)(W + ws::SMALLP) + l * 4096;
            const int x0 = (int)__builtin_amdgcn_readfirstlane((int)(xb_xcc_id() & 7u));
            for (int xs = 0; xs < 8; ++xs) {
                const int x = (x0 + xs) & 7;
                gu32* head = (gu32*)(W + ws::CTL) + ws::CW_QUEUE + (l * 8 + x) * 64 + 1 * 32;
                for (;;) {
                    if (tid == 0) MISC[0] = __hip_atomic_fetch_add(head, 1u, __ATOMIC_RELAXED, __HIP_MEMORY_SCOPE_AGENT);
                    __syncthreads();
                    const int k = (int)MISC[0] + 8;
                    __syncthreads();
                    if (k >= 200) break;
                    if (k < 8) { if (PH_MASK & 64) { const int u = x * 8 + k; mls::mlstm_unit(lds, u >> 2, u & 3, (const bf16_t*)(W + ws::QM), (const bf16_t*)(W + ws::KM), (const bf16_t*)(W + ws::VM), (const bf16_t*)(W + ws::OG),
                                                  (const float*)(W + ws::IFG), sp, sp + 2048, (bf16_t*)(W + ws::Y)); } }
                    else if (PH_MASK & 32) { const int a = k - 8; const int bhq = x * 16 + ((a < 64) ? (a & 15) : ((a - 64) & 15)); const int qa = (a < 64) ? (a >> 4) : 11 - ((a - 64) >> 4), qb2 = (a < 64) ? 15 - (a >> 4) : -1; { unsigned kd_ = 0u; att::attn_unit(lds, bhq, qa, qb2, (const bf16_t*)(W + ws::Q), (const bf16_t*)(W + ws::KF), (const bf16_t*)(W + ws::VT), (bf16_t*)(W + ws::Y), head, kd_); } }
                }
            }
        }
        SEAM(pb + 4);
#endif
        if ((PH_MASK & 128) && IN(pb + 5)) {
            LAUNDER_W(); unsigned char* wl = W + ws::WBASE + (size_t)l * ws::WLAYER;
            pg8::Gemm g{(const bf16_t*)(W + ws::Y), (const bf16_t*)(wl + ws::W_O), cfg::M, cfg::D, cfg::D}; pg8::StaticOrder S; S.init(cfg::M, cfg::D, G, bx);
            pg8::EpiResid E{W, 3 * l + 2, 1.0f};
            pg8::gemm_phase<pg8::EpiResid, pg8::StaticOrder, true, true>(lds, g, S, E);
        }
        SEAM(pb + 5);
#if PROBE_DOUBLE == 6
        if ((PH_MASK & 128) && IN(pb + 5)) {
            LAUNDER_W(); unsigned char* wl = W + ws::WBASE + (size_t)l * ws::WLAYER;
            pg8::Gemm g{(const bf16_t*)(W + ws::Y), (const bf16_t*)(wl + ws::W_O), cfg::M, cfg::D, cfg::D}; pg8::StaticOrder S; S.init(cfg::M, cfg::D, G, bx);
            pg8::EpiResid E{W, 3 * l + 2, 0.0f};
            pg8::gemm_phase<pg8::EpiResid, pg8::StaticOrder, true, true>(lds, g, S, E);
        }
        SEAM(pb + 5);
#endif
        if ((PH_MASK & 2) && IN(pb + 6)) {
            LAUNDER_W(); unsigned char* wl = W + ws::WBASE + (size_t)l * ws::WLAYER;
            pg8::Gemm g{(const bf16_t*)(W + ws::XB), (const bf16_t*)(wl + ws::W_GU2), cfg::M, 2 * cfg::FF, cfg::D}; pg8::StaticOrder S; S.init(cfg::M, 2 * cfg::FF, G, bx);
            const int gid0_ = pg8::rstd_table((LAS float*)(lds + RSTAB_OFF), S, pg8::ssqx_buf(W, 3 * l + 2), (int)threadIdx.x);
            pg8::EpiSwiGLU E{W, 3 * l + 2, (const LAS float*)(lds + RSTAB_OFF), gid0_};
            pg8::gemm_phase<pg8::EpiSwiGLU, pg8::StaticOrder, true, true>(lds, g, S, E);
        }
        SEAM(pb + 6);
        if ((PH_MASK & 4) && IN(pb + 7)) {
            LAUNDER_W(); unsigned char* wl = W + ws::WBASE + (size_t)l * ws::WLAYER;
            pg8::Gemm g{(const bf16_t*)(W + ws::H), (const bf16_t*)(wl + ws::W_D2), cfg::M, cfg::D, cfg::FF}; pg8::StaticOrder S; S.init(cfg::M, cfg::D, G, bx);
            pg8::EpiResid E{W, 3 * l + 3, 0.5f};
            pg8::gemm_phase<pg8::EpiResid, pg8::StaticOrder, true, true>(lds, g, S, E);
        }
        SEAM(pb + 7);
        }
    { constexpr int l = 3;
        const int pb = 1 + 8 * l;
        if ((PH_MASK & 2) && IN(pb + 0)) {
            LAUNDER_W(); unsigned char* wl = W + ws::WBASE + (size_t)l * ws::WLAYER;
            pg8::Gemm g{(const bf16_t*)(W + ws::XB), (const bf16_t*)(wl + ws::W_GU1), cfg::M, 2 * cfg::FF, cfg::D}; pg8::StaticOrder S; S.init(cfg::M, 2 * cfg::FF, G, bx);
            const int gid0_ = pg8::rstd_table((LAS float*)(lds + RSTAB_OFF), S, pg8::ssqx_buf(W, 3 * l), (int)threadIdx.x);
            pg8::EpiSwiGLU E{W, 3 * l, (const LAS float*)(lds + RSTAB_OFF), gid0_};
            pg8::gemm_phase<pg8::EpiSwiGLU, pg8::StaticOrder, true, true>(lds, g, S, E);
        }
        SEAM(pb + 0);
#if PROBE_DOUBLE == 1
        if ((PH_MASK & 2) && IN(pb + 0)) {
            LAUNDER_W(); unsigned char* wl = W + ws::WBASE + (size_t)l * ws::WLAYER;
            pg8::Gemm g{(const bf16_t*)(W + ws::XB), (const bf16_t*)(wl + ws::W_GU1), cfg::M, 2 * cfg::FF, cfg::D}; pg8::StaticOrder S; S.init(cfg::M, 2 * cfg::FF, G, bx);
            const int gid0_ = pg8::rstd_table((LAS float*)(lds + RSTAB_OFF), S, pg8::ssqx_buf(W, 3 * l), (int)threadIdx.x);
            pg8::EpiSwiGLU E{W, 3 * l, (const LAS float*)(lds + RSTAB_OFF), gid0_};
            pg8::gemm_phase<pg8::EpiSwiGLU, pg8::StaticOrder, true, true>(lds, g, S, E);
        }
        SEAM(pb + 0);
#endif
#if PROBE_DOUBLE == 11
        if ((PH_MASK & 2) && IN(pb + 0)) {
            LAUNDER_W(); unsigned char* wl = W + ws::WBASE + (size_t)l * ws::WLAYER;
            pg8::Gemm g{(const bf16_t*)(W + ws::XB), (const bf16_t*)(wl + ws::W_GU1), cfg::M, 2 * cfg::FF, cfg::D}; pg8::StaticOrder S; S.init(cfg::M, 2 * cfg::FF, G, bx);
            pg8::EpiNull E{P.out};
            pg8::gemm_phase<pg8::EpiNull, pg8::StaticOrder, true, true>(lds, g, S, E);
        }
        SEAM(pb + 0);
#endif
        if ((PH_MASK & 4) && IN(pb + 1)) {
            LAUNDER_W(); unsigned char* wl = W + ws::WBASE + (size_t)l * ws::WLAYER;
            pg8::Gemm g{(const bf16_t*)(W + ws::H), (const bf16_t*)(wl + ws::W_D1), cfg::M, cfg::D, cfg::FF}; pg8::StaticOrder S; S.init(cfg::M, cfg::D, G, bx);
            pg8::EpiResid E{W, 3 * l + 1, 0.5f};
            pg8::gemm_phase<pg8::EpiResid, pg8::StaticOrder, true, true>(lds, g, S, E);
        }
        SEAM(pb + 1);
#if PROBE_DOUBLE == 2
        if ((PH_MASK & 4) && IN(pb + 1)) {
            LAUNDER_W(); unsigned char* wl = W + ws::WBASE + (size_t)l * ws::WLAYER;
            pg8::Gemm g{(const bf16_t*)(W + ws::H), (const bf16_t*)(wl + ws::W_D1), cfg::M, cfg::D, cfg::FF}; pg8::StaticOrder S; S.init(cfg::M, cfg::D, G, bx);
            pg8::EpiResid E{W, 3 * l + 1, 0.0f};
            pg8::gemm_phase<pg8::EpiResid, pg8::StaticOrder, true, true>(lds, g, S, E);
        }
        SEAM(pb + 1);
#endif
        if ((PH_MASK & 8) && IN(pb + 2)) {
            LAUNDER_W(); unsigned char* wl = W + ws::WBASE + (size_t)l * ws::WLAYER;
            pg8::Gemm g{(const bf16_t*)(W + ws::XB), (const bf16_t*)(wl + ws::W_IN), cfg::M, cfg::DINP, cfg::D}; pg8::StaticOrder S; S.init(cfg::M, cfg::DINP, G, bx);
            pg8::EpiWin E{W, l};
            pg8::gemm_phase<pg8::EpiWin, pg8::StaticOrder, true, true>(lds, g, S, E);
        }
        SEAM(pb + 2);
#if PROBE_DOUBLE == 3
        if ((PH_MASK & 8) && IN(pb + 2)) {
            LAUNDER_W(); unsigned char* wl = W + ws::WBASE + (size_t)l * ws::WLAYER;
            pg8::Gemm g{(const bf16_t*)(W + ws::XB), (const bf16_t*)(wl + ws::W_IN), cfg::M, cfg::DINP, cfg::D}; pg8::StaticOrder S; S.init(cfg::M, cfg::DINP, G, bx);
            pg8::EpiWin E{W, l};
            pg8::gemm_phase<pg8::EpiWin, pg8::StaticOrder, true, true>(lds, g, S, E);
        }
        SEAM(pb + 2);
#endif
        if ((PH_MASK & (16 | 512 | 1024)) && IN(pb + 3)) {
            if (PH_MASK & 16) { LAUNDER_W(); unsigned char* wl = W + ws::WBASE + (size_t)l * ws::WLAYER;
              pg8::Gemm g{(const bf16_t*)(W + ws::CQ), (const bf16_t*)(wl + ws::W_UQ), cfg::M, 768, 256}; pg8::StaticOrder S; S.init(cfg::M, 768, G, bx);
              pg8::EpiQ E{W, l};
              pg8::gemm_phase<pg8::EpiQ, pg8::StaticOrder, true, true>(lds, g, S, E); }
            if (PH_MASK & 512) { LAUNDER_W(); unsigned char* wl = W + ws::WBASE + (size_t)l * ws::WLAYER;
              pg8::Gemm g{(const bf16_t*)(W + ws::CKV), (const bf16_t*)(wl + ws::W_KV), cfg::M, 512, 128}; pg8::StaticOrder S; S.init(cfg::M, 512, G, bx);
              pg8::EpiKN E{W, l};
              pg8::gemm_phase<pg8::EpiKN, pg8::StaticOrder, true, true>(lds, g, S, E); }
            if (PH_MASK & 1024) { LAUNDER_W(); unsigned char* wl = W + ws::WBASE + (size_t)l * ws::WLAYER;
              pg8::Gemm g{(const bf16_t*)(wl + ws::W_KV) + 512 * 128, (const bf16_t*)(W + ws::CKV), 512, cfg::M, 128}; pg8::StaticOrder S; S.init(512, cfg::M, G, bx);
              pg8::EpiVT E{W, l};
              pg8::gemm_phase<pg8::EpiVT, pg8::StaticOrder, true, true>(lds, g, S, E); }
        }
        SEAM(pb + 3);
#if PROBE_DOUBLE == 4
        if ((PH_MASK & (16 | 512 | 1024)) && IN(pb + 3)) {
            if (PH_MASK & 16) { LAUNDER_W(); unsigned char* wl = W + ws::WBASE + (size_t)l * ws::WLAYER;
              pg8::Gemm g{(const bf16_t*)(W + ws::CQ), (const bf16_t*)(wl + ws::W_UQ), cfg::M, 768, 256}; pg8::StaticOrder S; S.init(cfg::M, 768, G, bx);
              pg8::EpiQ E{W, l};
              pg8::gemm_phase<pg8::EpiQ, pg8::StaticOrder, true, true>(lds, g, S, E); }
            if (PH_MASK & 512) { LAUNDER_W(); unsigned char* wl = W + ws::WBASE + (size_t)l * ws::WLAYER;
              pg8::Gemm g{(const bf16_t*)(W + ws::CKV), (const bf16_t*)(wl + ws::W_KV), cfg::M, 512, 128}; pg8::StaticOrder S; S.init(cfg::M, 512, G, bx);
              pg8::EpiKN E{W, l};
              pg8::gemm_phase<pg8::EpiKN, pg8::StaticOrder, true, true>(lds, g, S, E); }
            if (PH_MASK & 1024) { LAUNDER_W(); unsigned char* wl = W + ws::WBASE + (size_t)l * ws::WLAYER;
              pg8::Gemm g{(const bf16_t*)(wl + ws::W_KV) + 512 * 128, (const bf16_t*)(W + ws::CKV), 512, cfg::M, 128}; pg8::StaticOrder S; S.init(512, cfg::M, G, bx);
              pg8::EpiVT E{W, l};
              pg8::gemm_phase<pg8::EpiVT, pg8::StaticOrder, true, true>(lds, g, S, E); }
        }
        SEAM(pb + 3);
#endif
        if ((PH_MASK & 96) && IN(pb + 4)) {
            LOCAL_TID(); LAUNDER_W(); const float* sp = (const float*)(W + ws::SMALLP) + l * 4096;
            const int x0 = (int)__builtin_amdgcn_readfirstlane((int)(xb_xcc_id() & 7u));
            for (int xs = 0; xs < 8; ++xs) {
                const int x = (x0 + xs) & 7;
                gu32* head = (gu32*)(W + ws::CTL) + ws::CW_QUEUE + (l * 8 + x) * 64 + 0 * 32;
                bool have = false; unsigned kp = 0u;
                for (;;) {
                    if (tid == 0) MISC[0] = have ? kp : __hip_atomic_fetch_add(head, 1u, __ATOMIC_RELAXED, __HIP_MEMORY_SCOPE_AGENT);
                    __syncthreads();
                    const int k = (int)MISC[0] + 0;
                    __syncthreads();
                    have = false;
                    if (k >= 200) break;
                    if (k < 8) { if (PH_MASK & 64) { const int u = x * 8 + k; mls::mlstm_unit(lds, u >> 2, u & 3, (const bf16_t*)(W + ws::QM), (const bf16_t*)(W + ws::KM), (const bf16_t*)(W + ws::VM), (const bf16_t*)(W + ws::OG),
                                                  (const float*)(W + ws::IFG), sp, sp + 2048, (bf16_t*)(W + ws::Y)); } }
                    else if (PH_MASK & 32) { const int a = k - 8; const int bhq = x * 16 + ((a < 64) ? (a & 15) : ((a - 64) & 15)); const int qa = (a < 64) ? (a >> 4) : 11 - ((a - 64) >> 4), qb2 = (a < 64) ? 15 - (a >> 4) : -1; att::attn_unit(lds, bhq, qa, qb2, (const bf16_t*)(W + ws::Q), (const bf16_t*)(W + ws::KF), (const bf16_t*)(W + ws::VT), (bf16_t*)(W + ws::Y), head, kp); have = true; }
                }
            }
        }
        SEAM(pb + 4);
#if PROBE_DOUBLE == 5
        if ((PH_MASK & 96) && IN(pb + 4)) {
            LOCAL_TID(); LAUNDER_W(); const float* sp = (const float*)(W + ws::SMALLP) + l * 4096;
            const int x0 = (int)__builtin_amdgcn_readfirstlane((int)(xb_xcc_id() & 7u));
            for (int xs = 0; xs < 8; ++xs) {
                const int x = (x0 + xs) & 7;
                gu32* head = (gu32*)(W + ws::CTL) + ws::CW_QUEUE + (l * 8 + x) * 64 + 1 * 32;
                for (;;) {
                    if (tid == 0) MISC[0] = __hip_atomic_fetch_add(head, 1u, __ATOMIC_RELAXED, __HIP_MEMORY_SCOPE_AGENT);
                    __syncthreads();
                    const int k = (int)MISC[0] + 0;
                    __syncthreads();
                    if (k >= 200) break;
                    if (k < 8) { if (PH_MASK & 64) { const int u = x * 8 + k; mls::mlstm_unit(lds, u >> 2, u & 3, (const bf16_t*)(W + ws::QM), (const bf16_t*)(W + ws::KM), (const bf16_t*)(W + ws::VM), (const bf16_t*)(W + ws::OG),
                                                  (const float*)(W + ws::IFG), sp, sp + 2048, (bf16_t*)(W + ws::Y)); } }
                    else if (PH_MASK & 32) { const int a = k - 8; const int bhq = x * 16 + ((a < 64) ? (a & 15) : ((a - 64) & 15)); const int qa = (a < 64) ? (a >> 4) : 11 - ((a - 64) >> 4), qb2 = (a < 64) ? 15 - (a >> 4) : -1; { unsigned kd_ = 0u; att::attn_unit(lds, bhq, qa, qb2, (const bf16_t*)(W + ws::Q), (const bf16_t*)(W + ws::KF), (const bf16_t*)(W + ws::VT), (bf16_t*)(W + ws::Y), head, kd_); } }
                }
            }
        }
        SEAM(pb + 4);
#endif
#if PROBE_DOUBLE == 7
        if ((PH_MASK & 96) && IN(pb + 4)) {
            LOCAL_TID(); LAUNDER_W(); const float* sp = (const float*)(W + ws::SMALLP) + l * 4096;
            const int x0 = (int)__builtin_amdgcn_readfirstlane((int)(xb_xcc_id() & 7u));
            for (int xs = 0; xs < 8; ++xs) {
                const int x = (x0 + xs) & 7;
                gu32* head = (gu32*)(W + ws::CTL) + ws::CW_QUEUE + (l * 8 + x) * 64 + 1 * 32;
                for (;;) {
                    if (tid == 0) MISC[0] = __hip_atomic_fetch_add(head, 1u, __ATOMIC_RELAXED, __HIP_MEMORY_SCOPE_AGENT);
                    __syncthreads();
                    const int k = (int)MISC[0] + 0;
                    __syncthreads();
                    if (k >= 8) break;
                    if (k < 8) { if (PH_MASK & 64) { const int u = x * 8 + k; mls::mlstm_unit(lds, u >> 2, u & 3, (const bf16_t*)(W + ws::QM), (const bf16_t*)(W + ws::KM), (const bf16_t*)(W + ws::VM), (const bf16_t*)(W + ws::OG),
                                                  (const float*)(W + ws::IFG), sp, sp + 2048, (bf16_t*)(W + ws::Y)); } }
                    else if (PH_MASK & 32) { const int a = k - 8; const int bhq = x * 16 + ((a < 64) ? (a & 15) : ((a - 64) & 15)); const int qa = (a < 64) ? (a >> 4) : 11 - ((a - 64) >> 4), qb2 = (a < 64) ? 15 - (a >> 4) : -1; { unsigned kd_ = 0u; att::attn_unit(lds, bhq, qa, qb2, (const bf16_t*)(W + ws::Q), (const bf16_t*)(W + ws::KF), (const bf16_t*)(W + ws::VT), (bf16_t*)(W + ws::Y), head, kd_); } }
                }
            }
        }
        SEAM(pb + 4);
#endif
#if PROBE_DOUBLE == 8
        if ((PH_MASK & 96) && IN(pb + 4)) {
            LOCAL_TID(); LAUNDER_W(); const float* sp = (const float*)(W + ws::SMALLP) + l * 4096;
            const int x0 = (int)__builtin_amdgcn_readfirstlane((int)(xb_xcc_id() & 7u));
            for (int xs = 0; xs < 8; ++xs) {
                const int x = (x0 + xs) & 7;
                gu32* head = (gu32*)(W + ws::CTL) + ws::CW_QUEUE + (l * 8 + x) * 64 + 1 * 32;
                for (;;) {
                    if (tid == 0) MISC[0] = __hip_atomic_fetch_add(head, 1u, __ATOMIC_RELAXED, __HIP_MEMORY_SCOPE_AGENT);
                    __syncthreads();
                    const int k = (int)MISC[0] + 8;
                    __syncthreads();
                    if (k >= 200) break;
                    if (k < 8) { if (PH_MASK & 64) { const int u = x * 8 + k; mls::mlstm_unit(lds, u >> 2, u & 3, (const bf16_t*)(W + ws::QM), (const bf16_t*)(W + ws::KM), (const bf16_t*)(W + ws::VM), (const bf16_t*)(W + ws::OG),
                                                  (const float*)(W + ws::IFG), sp, sp + 2048, (bf16_t*)(W + ws::Y)); } }
                    else if (PH_MASK & 32) { const int a = k - 8; const int bhq = x * 16 + ((a < 64) ? (a & 15) : ((a - 64) & 15)); const int qa = (a < 64) ? (a >> 4) : 11 - ((a - 64) >> 4), qb2 = (a < 64) ? 15 - (a >> 4) : -1; { unsigned kd_ = 0u; att::attn_unit(lds, bhq, qa, qb2, (const bf16_t*)(W + ws::Q), (const bf16_t*)(W + ws::KF), (const bf16_t*)(W + ws::VT), (bf16_t*)(W + ws::Y), head, kd_); } }
                }
            }
        }
        SEAM(pb + 4);
#endif
        if ((PH_MASK & 128) && IN(pb + 5)) {
            LAUNDER_W(); unsigned char* wl = W + ws::WBASE + (size_t)l * ws::WLAYER;
            pg8::Gemm g{(const bf16_t*)(W + ws::Y), (const bf16_t*)(wl + ws::W_O), cfg::M, cfg::D, cfg::D}; pg8::StaticOrder S; S.init(cfg::M, cfg::D, G, bx);
            pg8::EpiResid E{W, 3 * l + 2, 1.0f};
            pg8::gemm_phase<pg8::EpiResid, pg8::StaticOrder, true, true>(lds, g, S, E);
        }
        SEAM(pb + 5);
#if PROBE_DOUBLE == 6
        if ((PH_MASK & 128) && IN(pb + 5)) {
            LAUNDER_W(); unsigned char* wl = W + ws::WBASE + (size_t)l * ws::WLAYER;
            pg8::Gemm g{(const bf16_t*)(W + ws::Y), (const bf16_t*)(wl + ws::W_O), cfg::M, cfg::D, cfg::D}; pg8::StaticOrder S; S.init(cfg::M, cfg::D, G, bx);
            pg8::EpiResid E{W, 3 * l + 2, 0.0f};
            pg8::gemm_phase<pg8::EpiResid, pg8::StaticOrder, true, true>(lds, g, S, E);
        }
        SEAM(pb + 5);
#endif
        if ((PH_MASK & 2) && IN(pb + 6)) {
            LAUNDER_W(); unsigned char* wl = W + ws::WBASE + (size_t)l * ws::WLAYER;
            pg8::Gemm g{(const bf16_t*)(W + ws::XB), (const bf16_t*)(wl + ws::W_GU2), cfg::M, 2 * cfg::FF, cfg::D}; pg8::StaticOrder S; S.init(cfg::M, 2 * cfg::FF, G, bx);
            const int gid0_ = pg8::rstd_table((LAS float*)(lds + RSTAB_OFF), S, pg8::ssqx_buf(W, 3 * l + 2), (int)threadIdx.x);
            pg8::EpiSwiGLU E{W, 3 * l + 2, (const LAS float*)(lds + RSTAB_OFF), gid0_};
            pg8::gemm_phase<pg8::EpiSwiGLU, pg8::StaticOrder, true, true>(lds, g, S, E);
        }
        SEAM(pb + 6);
        if ((PH_MASK & 4) && IN(pb + 7)) {
            LAUNDER_W(); unsigned char* wl = W + ws::WBASE + (size_t)l * ws::WLAYER;
            pg8::Gemm g{(const bf16_t*)(W + ws::H), (const bf16_t*)(wl + ws::W_D2), cfg::M, cfg::D, cfg::FF}; pg8::StaticOrder S; S.init(cfg::M, cfg::D, G, bx);
            pg8::EpiResid E{W, 3 * l + 3, 0.5f};
            pg8::gemm_phase<pg8::EpiResid, pg8::StaticOrder, true, true>(lds, g, S, E);
        }
        SEAM(pb + 7);
        }
    if ((PH_MASK & 256) && IN(33)) {
        LOCAL_TID(); LAUNDER_W(); const float* ssq = (const float*)(W + ws::SSQX);   const f32x4* gp = (const f32x4*)P.in[23] + 4 * lane;
        f32x4 gv[4];
#pragma unroll
        for (int j = 0; j < 4; ++j) gv[j] = gp[j];
        for (int m = gw; m < cfg::M; m += NGW) {
            const float rs = __builtin_amdgcn_rsqf(wave_sum((lane < 16) ? ssq[(size_t)m * 16 + lane] : 0.f, lane) * (1.f / cfg::D) + cfg::EPS);
            const u32x4* xr = (const u32x4*)((const bf16_t*)(W + ws::XB) + (size_t)m * cfg::D) + 2 * lane; f32x4* orow = (f32x4*)(P.out + (size_t)m * cfg::D) + 4 * lane;
            const u32x4 b0 = xr[0], b1 = xr[1];
            orow[0] = (f32x4){bflo(b0.x), bfhi(b0.x), bflo(b0.y), bfhi(b0.y)} * rs * gv[0]; orow[1] = (f32x4){bflo(b0.z), bfhi(b0.z), bflo(b0.w), bfhi(b0.w)} * rs * gv[1];
            orow[2] = (f32x4){bflo(b1.x), bfhi(b1.x), bflo(b1.y), bfhi(b1.y)} * rs * gv[2]; orow[3] = (f32x4){bflo(b1.z), bfhi(b1.z), bflo(b1.w), bfhi(b1.w)} * rs * gv[3];
        }
    }
#if PROBE_DOUBLE == 10
    SEAM(33);
    if ((PH_MASK & 256) && IN(33)) {
        LOCAL_TID(); LAUNDER_W(); const float* ssq = (const float*)(W + ws::SSQX);   const f32x4* gp = (const f32x4*)P.in[23] + lane;
        f32x4 gv[4];
#pragma unroll
        for (int j = 0; j < 4; ++j) gv[j] = gp[64 * j];
        for (int m = gw; m < cfg::M; m += NGW) {
            const float rs = __builtin_amdgcn_rsqf(wave_sum((lane < 16) ? ssq[(size_t)m * 16 + lane] : 0.f, lane) * (1.f / cfg::D) + cfg::EPS);
            const u32x2* xr = (const u32x2*)((const bf16_t*)(W + ws::XB) + (size_t)m * cfg::D) + lane; f32x4* orow = (f32x4*)(P.out + (size_t)m * cfg::D) + lane;
#pragma unroll
            for (int j = 0; j < 4; ++j) { const u32x2 b = xr[64 * j]; f32x4 v; v[0] = bflo(b.x); v[1] = bfhi(b.x); v[2] = bflo(b.y); v[3] = bfhi(b.y); orow[64 * j] = v * rs * gv[j]; }
        }
    }
#endif
#undef IN
#undef SEAM
}

extern "C" void kernel_launch(void* const* d_in, const int* in_sizes, int n_in, void* d_out, int out_size, void* d_ws, size_t ws_size, hipStream_t stream) {
    static int grid = 0;
    if (grid == 0) {
        if (n_in != 24 || in_sizes[0] != cfg::M * cfg::D || out_size != cfg::M * cfg::D || ws_size < ws::END) { fprintf(stderr, "kernel_launch: unexpected shapes / workspace (n_in %d, ws %zu)\n", n_in, ws_size); grid = -1; return; }
        int dev = 0, cus = 0, per_cu = 0;
        if (hipGetDevice(&dev) != hipSuccess || hipDeviceGetAttribute(&cus, hipDeviceAttributeMultiprocessorCount, dev) != hipSuccess) { grid = -1; return; }
        if (hipFuncSetAttribute((const void*)hymba_fwd, hipFuncAttributeMaxDynamicSharedMemorySize, LDS_BYTES) != hipSuccess) { fprintf(stderr, "kernel_launch: hipFuncSetAttribute failed\n"); grid = -1; return; }
        if (hipOccupancyMaxActiveBlocksPerMultiprocessor(&per_cu, (const void*)hymba_fwd, 512, LDS_BYTES) != hipSuccess || per_cu < 1) fprintf(stderr, "kernel_launch: occupancy query reports %d\n", per_cu);
        (void)hipGetLastError();
        if (cus < 256) { fprintf(stderr, "kernel_launch: built for a 256-CU device (MI355X); found %d CUs; nothing launched\n", cus); grid = -1; return; }
        grid = 256;
    }
    if (grid < 0) return;
    (void)hipMemsetAsync((char*)d_ws + ws::CTL, 0, ws::ZERO_BYTES, stream);
    Params p{};
    for (int i = 0; i < 24; ++i) p.in[i] = (const float*)d_in[i];
    p.out = (float*)d_out; p.ws = (unsigned char*)d_ws; p.pad = 0;
#if MK_PER_PHASE
#ifdef BISECT_MASK
    { static bool once = false; if (!once) { once = true; (void)hipFuncSetAttribute((const void*)hymba_fwd_loop, hipFuncAttributeMaxDynamicSharedMemorySize, LDS_BYTES); } }
    for (int ph = 0; ph < NPHASE; ++ph) { p.ph_lo = ph; p.ph_hi = ph + 1; p.li = 0; const int t = (ph == 0) ? 0 : (ph == 33) ? 9 : 1 + ((ph - 1) & 7);
        if ((BISECT_MASK >> t) & 1) hipLaunchKernelGGL(hymba_fwd, dim3(grid), dim3(512), LDS_BYTES, stream, p); else hipLaunchKernelGGL(hymba_fwd_loop, dim3(grid), dim3(512), LDS_BYTES, stream, p); }
#else
    for (int ph = 0; ph < NPHASE; ++ph) { p.ph_lo = ph; p.ph_hi = ph + 1; p.li = 0; hipLaunchKernelGGL(hymba_fwd, dim3(grid), dim3(512), LDS_BYTES, stream, p); }
#endif
#else
    p.ph_lo = 0; p.ph_hi = NPHASE; p.li = 0;
    hipLaunchKernelGGL(hymba_fwd, dim3(grid), dim3(512), LDS_BYTES, stream, p);
#endif
}
```

```cpp
#include <hip/hip_runtime.h>
#include <cstdio>
#include <cstdint>

#define LAS __attribute__((address_space(3)))
#define GAS __attribute__((address_space(1)))
typedef unsigned short bf16_t;
typedef short bf16x8 __attribute__((ext_vector_type(8)));
typedef short s16x4 __attribute__((ext_vector_type(4)));
typedef float f32x2 __attribute__((ext_vector_type(2)));
typedef float f32x4 __attribute__((ext_vector_type(4)));
typedef float f32x16 __attribute__((ext_vector_type(16)));
typedef unsigned u32x2 __attribute__((ext_vector_type(2)));
typedef unsigned u32x4 __attribute__((ext_vector_type(4)));
typedef GAS unsigned gu32;

namespace cfg {
constexpr int NB = 16, S = 4096, M = NB * S, D = 1024, DEPTH = 4, FF = 2816;
constexpr int NH = 8, DQK = 96, DNOPE = 64, DROPE = 32, DVH = 64, QLR = 256, KVLR = 128;
constexpr int MH = 4, MDK = 64, MDV = 128, CHUNK = 64, NCHUNK = S / CHUNK;
constexpr int DIN = 1960, DINP = 2048;
constexpr float EPS = 1e-6f;
constexpr float LOG2E = 1.4426950408889634f;
constexpr float QSCALE = 0.10206207261596575f * LOG2E;
}
namespace ws {
constexpr size_t MiB = 1u << 20;
constexpr size_t CTL = 0, ZERO_BYTES = 1 * MiB;
constexpr size_t SSQKV = 1 * MiB, SSQQ = 2 * MiB;
constexpr size_t SMALLP = 3 * MiB;
constexpr size_t SSQX = 24 * MiB;
constexpr size_t ROPE = 8 * MiB, IFG = 16 * MiB;
constexpr size_t WBASE = 32 * MiB, WLAYER = 40 * MiB;
constexpr size_t W_GU1 = 0, W_D1 = 11 * MiB, W_GU2 = 11 * MiB + 5632 * 1024, W_D2 = 27 * MiB + 512 * 1024, W_IN = 33 * MiB, W_UQ = 37 * MiB, W_KV = 37 * MiB + 512 * 1024, W_O = 38 * MiB;
constexpr size_t XB = 192 * MiB;
constexpr size_t H = 320 * MiB;
constexpr size_t CQ = 320 * MiB, CKV = 352 * MiB, QM = 368 * MiB, KM = 400 * MiB, VM = 432 * MiB, OG = 496 * MiB, Q = 560 * MiB, KF = 656 * MiB, VT = 752 * MiB, Y = 816 * MiB, END = 944 * MiB;
static_assert(W_D1 + 1024 * 2816 * 2 <= W_GU2 && W_GU2 + 5632 * 1024 * 2 <= W_D2 && W_D2 + 1024 * 2816 * 2 <= W_IN && W_IN + 2048 * 1024 * 2 <= W_UQ && W_UQ + 768 * 256 * 2 <= W_KV && W_KV + 1024 * 128 * 2 <= W_O && W_O + 1024 * 1024 * 2 <= WLAYER, "weight map");
static_assert(H + (size_t)cfg::M * cfg::FF * 2 <= Y + (size_t)cfg::M * 1024 * 2 && Y + (size_t)cfg::M * 1024 * 2 == END, "activation map");
constexpr int CW_QUEUE = 1024, CW_BAR = 4096;
}
namespace pg8 {
#define PG8_LAS __attribute__((address_space(3)))
typedef unsigned short bf16_t;
typedef short bf16x8 __attribute__((ext_vector_type(8)));
typedef float f32x4 __attribute__((ext_vector_type(4)));
typedef unsigned u32x4 __attribute__((ext_vector_type(4)));
constexpr int BM = 256, BK = 64, HALF = 128, HTB = HALF * BK * 2  , STAGE_BYTES = 8 * HTB, NXCD = 8, WGM = 8;

__host__ __device__ __forceinline__ int lds_byte(int r, int c) { const int st = (r >> 4) * 2 + (c >> 5), rr = r & 15, cc = c & 31, ob = rr * 64 + cc * 2; return st * 1024 + (ob ^ (((ob >> 9) & 1) << 5)); }
__host__ __device__ __forceinline__ void stage_rc(int b, int& R, int& C) { const int st = b / 1024, sb = b % 1024, swz = sb ^ (((sb >> 9) & 1) << 5); R = (st >> 1) * 16 + swz / 64; C = (st & 1) * 32 + (swz % 64) / 2; }
__host__ __device__ __forceinline__ int perm32(int rho) { const int n = rho >> 4, i = rho & 15; return 8 * (i >> 2) + 4 * n + (i & 3); }

struct Unit { int pm, pn; };
struct Gemm { const bf16_t* A; const bf16_t* Bt; int M, N, K; };

template <bool COLS> struct PanelOrderT {
    int n, c;
    __host__ __device__ void init(int M, int N, int, int c_) { c = c_; n = COLS ? (M / BM) : (N / BM); }
    __host__ __device__ bool next(int i, Unit& u) const { if (i >= n) return false; if (COLS) { u.pm = i; u.pn = c; } else { u.pm = c; u.pn = i; } return true; }
    __device__ __forceinline__ void a_ready(const Unit&) const {}
    __device__ __forceinline__ void done(const Unit&) const {}
};
typedef PanelOrderT<false> PanelOrder;
typedef PanelOrderT<true> PanelOrderC;
struct LatinOrder {
    int x, j, k, r_lo, r_hi;
    __host__ __device__ void init(int bx, int lo, int hi) { x = bx & 7; const int w = bx >> 3; j = w & 7; k = w >> 3; r_lo = lo; r_hi = hi; }
    __host__ __device__ int own_round() const { return (8 - 2 * k) & 7; }
    __host__ __device__ int own_panel() const { return 32 * x + 8 * (own_round() >> 1) + j; }
    __host__ __device__ bool next(int i, Unit& u) const { const int r = r_lo + i; if (r >= r_hi) return false; u.pm = 32 * x + 8 * (r >> 1) + j; u.pn = (2 * k + r) & 7; return true; }
    __device__ __forceinline__ void a_ready(const Unit&) const {}
    __device__ __forceinline__ void done(const Unit&) const {}
};

struct StaticOrder {
    int nM, nN, nwg, G, c;
    __host__ __device__ void init(int M, int N, int G_, int c_) { nM = M / BM; nN = N / BM; nwg = nM * nN; G = G_; c = c_; }
    __host__ __device__ bool next(int i, Unit& u) const {
        const long L = (long)i * G + c; if (L >= nwg) return false;
        int wgid = (int)L; { const int q = nwg / NXCD, r = nwg % NXCD, xcd = wgid % NXCD, off = wgid / NXCD; wgid = (xcd < r ? xcd * (q + 1) : r * (q + 1) + (xcd - r) * q) + off; }
        const int nig = WGM * nN, gid = wgid / nig, fm = gid * WGM, gsz = (nM - fm) < WGM ? (nM - fm) : WGM;
        u.pm = fm + ((wgid % nig) % gsz); u.pn = (wgid % nig) / gsz; return true;
    }
    __device__ __forceinline__ void a_ready(const Unit&) const {}
    __device__ __forceinline__ void done(const Unit&) const {}
};

typedef __bf16 bf16x2v_t __attribute__((ext_vector_type(2)));
__device__ __forceinline__ unsigned cvt_pk_bf16(float lo, float hi) { typedef float f32x2v_t __attribute__((ext_vector_type(2))); const f32x2v_t v = {lo, hi}; const bf16x2v_t b = __builtin_convertvector(v, bf16x2v_t); return __builtin_bit_cast(unsigned, b); }
__device__ __forceinline__ float silu_f(float x) { return x * __builtin_amdgcn_rcpf(1.f + __builtin_amdgcn_exp2f(-cfg::LOG2E * x)); }
__device__ __forceinline__ float sigmoid_f(float x) { return __builtin_amdgcn_rcpf(1.f + __builtin_amdgcn_exp2f(-cfg::LOG2E * x)); }
__device__ __forceinline__ u32x4 pack8(const f32x4 a, const f32x4 b) { u32x4 w; w.x = cvt_pk_bf16(a[0], a[1]); w.y = cvt_pk_bf16(a[2], a[3]); w.z = cvt_pk_bf16(b[0], b[1]); w.w = cvt_pk_bf16(b[2], b[3]); return w; }
__device__ __forceinline__ float sumsq8(const f32x4 a, const f32x4 b) { return (a[0] * a[0] + a[1] * a[1]) + (a[2] * a[2] + a[3] * a[3]) + (b[0] * b[0] + b[1] * b[1]) + (b[2] * b[2] + b[3] * b[3]); }
__device__ __forceinline__ float row_ssq16(const float* buf, int row, int fq);
__device__ __forceinline__ float quad_sum(float v) {
    { const auto r = __builtin_amdgcn_permlane16_swap(__float_as_uint(v), __float_as_uint(v), false, false); v = __uint_as_float(r[0]) + __uint_as_float(r[1]); }
    { const auto r = __builtin_amdgcn_permlane32_swap(__float_as_uint(v), __float_as_uint(v), false, false); v = __uint_as_float(r[0]) + __uint_as_float(r[1]); }
    return v; }

__device__ __forceinline__ float row_ssq16(const float* buf, int row, int fq) { const f32x4 v = *(const f32x4*)(buf + (size_t)row * 16 + 4 * fq); return quad_sum((v[0] + v[1]) + (v[2] + v[3])); }
__device__ __forceinline__ float row_ssq4(const float* buf, int row) { const f32x4 v = *(const f32x4*)(buf + (size_t)row * 4); return (v[0] + v[1]) + (v[2] + v[3]); }
__device__ __forceinline__ const float* ssqx_buf(unsigned char* W, int si) { return (const float*)(W + ws::SSQX) + (size_t)(si & 1) * cfg::M * 16; }

template <class Sched> __device__ __forceinline__ int rstd_table(PG8_LAS float* tab, const Sched& S, const float* ssq, int tid) {
    Unit u; int gid0 = 0, last = -1; asm volatile("" : "+v"(tid));
    for (int i = 0; S.next(i, u); ++i) {
        if (i == 0) gid0 = u.pm >> 3;
        if (u.pm != last) { last = u.pm;
            if (tid < 256) { const f32x4* p = (const f32x4*)(ssq + (size_t)(u.pm * BM + tid) * 16); const f32x4 a = p[0], b = p[1], c = p[2], d = p[3];
                const float t = ((a[0] + a[1]) + (a[2] + a[3])) + ((b[0] + b[1]) + (b[2] + b[3])) + ((c[0] + c[1]) + (c[2] + c[3])) + ((d[0] + d[1]) + (d[2] + d[3]));
                tab[((u.pm >> 3) - gid0) * 256 + tid] = __builtin_amdgcn_rsqf(t * (1.f / cfg::D) + cfg::EPS); } } }
    __syncthreads();
    return gid0;
}

struct EpiSwiGLU {
    static constexpr bool PERM = true, AFTER_DRAIN = false;
    unsigned char* W; int si;
    const PG8_LAS float* rstab; int gid0;
    static constexpr int ND = 2;
    struct Def { u32x4 a[4], b[4]; };
    static __device__ __forceinline__ f32x2 swi2(const f32x2 g, const f32x2 u) {
        const f32x2 t = g * (f32x2){-cfg::LOG2E, -cfg::LOG2E};
        f32x2 s; s[0] = __builtin_amdgcn_exp2f(fminf(t[0], 60.f)); s[1] = __builtin_amdgcn_exp2f(fminf(t[1], 60.f));
        s = s + (f32x2){1.f, 1.f};
        const float r = __builtin_amdgcn_rcpf(s[0] * s[1]);
        const f32x2 sig = (f32x2){s[1], s[0]} * (f32x2){r, r};
        return (g * sig) * u;
    }
    template <bool DEFER_HALF> __device__ __forceinline__ void run(const f32x4 (&acc)[2][2][4][2], const Unit& u_, int wr, int wc, int fr, int fq, Def& D) const {
        Unit u = u_; asm volatile("" : "+s"(u.pm), "+s"(u.pn), "+v"(fr), "+v"(fq));
        bf16_t* const H = (bf16_t*)(W + ws::H);
        const int row0 = u.pm * BM + wr * 64 + fr, hcol = u.pn * 128 + wc * 32 + 8 * fq;
        float rsv[2][4];
        { const PG8_LAS float* tp = rstab + ((u.pm >> 3) - gid0) * 256 + wr * 64 + fr;
#pragma unroll
          for (int ai = 0; ai < 2; ++ai)
#pragma unroll
              for (int m = 0; m < 4; ++m) rsv[ai][m] = tp[ai * HALF + m * 16]; }
#pragma unroll
        for (int ai = 1; ai >= 0; --ai)
#pragma unroll
            for (int m = 3; m >= 0; --m) {
                const int row = row0 + ai * HALF + m * 16;
                const float rs = rsv[ai][m];
                const f32x2 rs2 = {rs, rs};
                if (DEFER_HALF && ai == 1 && m >= 4 - ND) {
                    f32x4 g0, g1, u0, u1;
#pragma unroll
                    for (int e = 0; e < 4; ++e) { g0[e] = acc[1][0][m][0][e] * rs; g1[e] = acc[1][0][m][1][e] * rs; u0[e] = acc[1][1][m][0][e] * rs; u1[e] = acc[1][1][m][1][e] * rs; }
                    D.a[m] = pack8(g0, g1); D.b[m] = pack8(u0, u1);
                } else {
                    f32x4 h0, h1;
#pragma unroll
                    for (int n = 0; n < 2; ++n)
#pragma unroll
                        for (int e = 0; e < 4; e += 2) {
                            const f32x2 ga = {acc[ai][0][m][n][e], acc[ai][0][m][n][e + 1]}, ua = {acc[ai][1][m][n][e], acc[ai][1][m][n][e + 1]};
                            const f32x2 hh = swi2(ga * rs2, ua * rs2);
                            if (n == 0) { h0[e] = hh[0]; h0[e + 1] = hh[1]; } else { h1[e] = hh[0]; h1[e + 1] = hh[1]; }
                        }
                    *(u32x4*)(H + (size_t)row * cfg::FF + hcol) = pack8(h0, h1);
                }
            }
    }
    __device__ __forceinline__ void operator()(const f32x4 (&acc)[2][2][4][2], const Unit& u_, int wr, int wc, int fr, int fq) const { Def D; run<false>(acc, u_, wr, wc, fr, fq, D); }
    __device__ __forceinline__ void later(Def& D, const int q) const {
#pragma unroll
        for (int d = 2 * q; d < 2 * q + 2; ++d) {
            const int m = 4 - ND + (d >> 2), j = d & 3;
            const u32x4 ga = D.a[m], ua = D.b[m];
            const unsigned gw = (j == 0) ? ga.x : (j == 1) ? ga.y : (j == 2) ? ga.z : ga.w, uw = (j == 0) ? ua.x : (j == 1) ? ua.y : (j == 2) ? ua.z : ua.w;
            const f32x2 g = {__uint_as_float(gw << 16), __uint_as_float(gw & 0xffff0000u)}, uu = {__uint_as_float(uw << 16), __uint_as_float(uw & 0xffff0000u)};
            const f32x2 hh = swi2(g, uu);
            const unsigned ow = cvt_pk_bf16(hh[0], hh[1]);
            if (j == 0) D.a[m].x = ow; else if (j == 1) D.a[m].y = ow; else if (j == 2) D.a[m].z = ow; else D.a[m].w = ow;
        }
    }
    __device__ __forceinline__ void pin(Def& D, const int q) const {
#pragma unroll
        for (int d = 2 * q; d < 2 * q + 2; ++d) { const int m = 4 - ND + (d >> 2), j = d & 3;
            if (j == 0) asm volatile("" : "+v"(D.a[m].x)); else if (j == 1) asm volatile("" : "+v"(D.a[m].y)); else if (j == 2) asm volatile("" : "+v"(D.a[m].z)); else asm volatile("" : "+v"(D.a[m].w)); }
    }
    __device__ __forceinline__ void flush(const Def& D, const Unit& u_, int wr, int wc, int fr, int fq) const {
        Unit u = u_; asm volatile("" : "+s"(u.pm), "+s"(u.pn), "+v"(fr), "+v"(fq));
        bf16_t* const H = (bf16_t*)(W + ws::H);
        const int row0 = u.pm * BM + wr * 64 + fr + HALF, hcol = u.pn * 128 + wc * 32 + 8 * fq;
#pragma unroll
        for (int m = 4 - ND; m < 4; ++m) *(u32x4*)(H + (size_t)(row0 + m * 16) * cfg::FF + hcol) = D.a[m];
    }
};

struct EpiResid {
    static constexpr bool PERM = true, AFTER_DRAIN = false;
    unsigned char* W; int si; float alpha;
    __device__ __forceinline__ void prefetch_unused(const Unit& u_, PG8_LAS unsigned char* junk, int tid) const {
        Unit u = u_; asm volatile("" : "+s"(u.pm), "+s"(u.pn), "+v"(tid));
        const unsigned char* base = W + ws::XB + ((size_t)u.pm * BM * cfg::D + (size_t)u.pn * BM) * 2;
#pragma unroll
        for (int i = 0; i < 2; ++i) { const int ln = tid + 512 * i;
            __builtin_amdgcn_global_load_lds((const unsigned*)(base + (size_t)(ln >> 2) * (cfg::D * 2) + (ln & 3) * 128), (PG8_LAS unsigned*)junk, 4, 0, 0); }
    }
    __device__ __forceinline__ void operator()(const f32x4 (&acc)[2][2][4][2], const Unit& u_, int wr, int wc, int fr, int fq) const {
        Unit u = u_; asm volatile("" : "+s"(u.pm), "+s"(u.pn), "+v"(fr), "+v"(fq));
        bf16_t* const xb = (bf16_t*)(W + ws::XB); float* const ssq_out = (float*)ssqx_buf(W, si);
        const int row0 = u.pm * BM + wr * 64 + fr, col0 = u.pn * BM + wc * 32 + 8 * fq;
        u32x4 xin[2][4][2];
#pragma unroll
        for (int ai = 0; ai < 2; ++ai)
#pragma unroll
            for (int m = 0; m < 4; ++m)
#pragma unroll
                for (int bj = 0; bj < 2; ++bj) xin[ai][m][bj] = *(const u32x4*)(xb + (size_t)(row0 + ai * HALF + m * 16) * cfg::D + col0 + bj * HALF);
#pragma unroll
        for (int ai = 0; ai < 2; ++ai)
#pragma unroll
            for (int m = 0; m < 4; ++m) {
                const int row = row0 + ai * HALF + m * 16; const size_t off = (size_t)row * cfg::D + col0; float part = 0.f;
#pragma unroll
                for (int bj = 0; bj < 2; ++bj) {
                    const u32x4 b = xin[ai][m][bj];
                    f32x4 x0, x1;
                    x0[0] = __uint_as_float(b.x << 16); x0[1] = __uint_as_float(b.x & 0xffff0000u); x0[2] = __uint_as_float(b.y << 16); x0[3] = __uint_as_float(b.y & 0xffff0000u);
                    x1[0] = __uint_as_float(b.z << 16); x1[1] = __uint_as_float(b.z & 0xffff0000u); x1[2] = __uint_as_float(b.w << 16); x1[3] = __uint_as_float(b.w & 0xffff0000u);
                    x0 = x0 + acc[ai][bj][m][0] * alpha; x1 = x1 + acc[ai][bj][m][1] * alpha;
                    *(u32x4*)(xb + off + bj * HALF) = pack8(x0, x1);
                    part += sumsq8(x0, x1);
                }
                part = quad_sum(part);
                if (fq == 0) ssq_out[(size_t)row * 16 + u.pn * 4 + wc] = part;
            }
    }
};

struct EpiWin {
    static constexpr bool PERM = true, AFTER_DRAIN = false;
    unsigned char* W; int l;
    __device__ __forceinline__ void operator()(const f32x4 (&acc)[2][2][4][2], const Unit& u_, int wr, int wc, int fr, int fq) const {
        Unit u = u_; asm volatile("" : "+s"(u.pm), "+s"(u.pn), "+v"(fr), "+v"(fq));
        const float* const ssq = ssqx_buf(W, 3 * l + 1);
        bf16_t* const CQ = (bf16_t*)(W + ws::CQ); bf16_t* const CKV = (bf16_t*)(W + ws::CKV); bf16_t* const KF = (bf16_t*)(W + ws::KF); bf16_t* const QM = (bf16_t*)(W + ws::QM);
        bf16_t* const KM = (bf16_t*)(W + ws::KM); bf16_t* const VM = (bf16_t*)(W + ws::VM); bf16_t* const OG = (bf16_t*)(W + ws::OG); float* const IF = (float*)(W + ws::IFG);
        float* const ssq_q = (float*)(W + ws::SSQQ); float* const ssq_kv = (float*)(W + ws::SSQKV);
        const f32x2* const rope = (const f32x2*)(W + ws::ROPE);
        const float* const b_i = (const float*)(W + ws::SMALLP) + l * 4096 + 2560; const float* const b_f = b_i + 4;
        const int row0 = u.pm * BM + wr * 64 + fr, pn = u.pn, cw = wc * 32 + 8 * fq;
        f32x4 pq[2][4]; float rsv[2][4];
#pragma unroll
        for (int ai = 0; ai < 2; ++ai)
#pragma unroll
            for (int m = 0; m < 4; ++m) pq[ai][m] = *(const f32x4*)(ssq + (size_t)(row0 + ai * HALF + m * 16) * 16 + 4 * fq);
#pragma unroll
        for (int ai = 0; ai < 2; ++ai)
#pragma unroll
            for (int m = 0; m < 4; ++m) rsv[ai][m] = __builtin_amdgcn_rsqf(quad_sum((pq[ai][m][0] + pq[ai][m][1]) + (pq[ai][m][2] + pq[ai][m][3])) * (1.f / cfg::D) + cfg::EPS);
#pragma unroll
        for (int ai = 0; ai < 2; ++ai)
#pragma unroll
            for (int m = 0; m < 4; ++m) {
                const int row = row0 + ai * HALF + m * 16;
                const float rs = rsv[ai][m];
                f32x4 v[2][2];
#pragma unroll
                for (int bj = 0; bj < 2; ++bj) { v[bj][0] = acc[ai][bj][m][0] * rs; v[bj][1] = acc[ai][bj][m][1] * rs; }
                if (pn == 0) {
                    float part = 0.f;
#pragma unroll
                    for (int bj = 0; bj < 2; ++bj) { *(u32x4*)(CQ + (size_t)row * cfg::QLR + bj * HALF + cw) = pack8(v[bj][0], v[bj][1]); part += sumsq8(v[bj][0], v[bj][1]); }
                    part = quad_sum(part); if (fq == 0) ssq_q[(size_t)row * 4 + wc] = part;
                } else if (pn == 1) {
                    *(u32x4*)(CKV + (size_t)row * cfg::KVLR + cw) = pack8(v[0][0], v[0][1]);
                    float part = quad_sum(sumsq8(v[0][0], v[0][1])); if (fq == 0) ssq_kv[(size_t)row * 4 + wc] = part;
                    if (wc == 0) {
                        const f32x4 cs0 = *(const f32x4*)(rope + (size_t)row * 16 + 4 * fq), cs1 = *(const f32x4*)(rope + (size_t)row * 16 + 4 * fq + 2);
                        f32x4 r0, r1;
                        r0[0] = v[1][0][0] * cs0[0] - v[1][0][1] * cs0[1]; r0[1] = v[1][0][1] * cs0[0] + v[1][0][0] * cs0[1];
                        r0[2] = v[1][0][2] * cs0[2] - v[1][0][3] * cs0[3]; r0[3] = v[1][0][3] * cs0[2] + v[1][0][2] * cs0[3];
                        r1[0] = v[1][1][0] * cs1[0] - v[1][1][1] * cs1[1]; r1[1] = v[1][1][1] * cs1[0] + v[1][1][0] * cs1[1];
                        r1[2] = v[1][1][2] * cs1[2] - v[1][1][3] * cs1[3]; r1[3] = v[1][1][3] * cs1[2] + v[1][1][2] * cs1[3];
                        const u32x4 w = pack8(r0, r1);
                        const int b = row >> 12, s = row & 4095;
#pragma unroll
                        for (int h = 0; h < cfg::NH; ++h) *(u32x4*)(KF + ((size_t)(b * cfg::NH + h) * cfg::S + s) * cfg::DQK + cfg::DNOPE + 8 * fq) = w;
                    } else if (wc == 1 && fq == 0) {
                        f32x4 ig, lf;
#pragma unroll
                        for (int e = 0; e < 4; ++e) { ig[e] = v[1][0][e] + b_i[e]; const float z = v[1][1][e] + b_f[e]; lf[e] = fminf(z, 0.f) - log1pf(__expf(-fabsf(z))); }
                        *(f32x4*)(IF + (size_t)row * 8) = ig; *(f32x4*)(IF + (size_t)row * 8 + 4) = lf;
                    }
                } else if (pn < 4) {
                    bf16_t* dst = (pn == 2) ? QM : KM;
#pragma unroll
                    for (int bj = 0; bj < 2; ++bj) *(u32x4*)(dst + (size_t)row * 256 + bj * HALF + cw) = pack8(v[bj][0], v[bj][1]);
                } else if (pn < 6) {
#pragma unroll
                    for (int bj = 0; bj < 2; ++bj) *(u32x4*)(VM + (size_t)row * 512 + (pn - 4) * 256 + bj * HALF + cw) = pack8(v[bj][0], v[bj][1]);
                } else {
#pragma unroll
                    for (int bj = 0; bj < 2; ++bj) { f32x4 a, b;
#pragma unroll
                        for (int e = 0; e < 4; ++e) { a[e] = sigmoid_f(v[bj][0][e]); b[e] = sigmoid_f(v[bj][1][e]); }
                        *(u32x4*)(OG + (size_t)row * 512 + (pn - 6) * 256 + bj * HALF + cw) = pack8(a, b); }
                }
            }
    }
};

struct EpiQ {
    static constexpr bool PERM = true, AFTER_DRAIN = false;
    unsigned char* W; int l;
    __device__ __forceinline__ void operator()(const f32x4 (&acc)[2][2][4][2], const Unit& u_, int wr, int wc, int fr, int fq) const {
        Unit u = u_; asm volatile("" : "+s"(u.pm), "+s"(u.pn), "+v"(fr), "+v"(fq));
        const float* const ssq_q = (const float*)(W + ws::SSQQ); const f32x2* const rope = (const f32x2*)(W + ws::ROPE); bf16_t* const Q = (bf16_t*)(W + ws::Q);
        const int row0 = u.pm * BM + wr * 64 + fr;
        f32x4 pq[2][4];
#pragma unroll
        for (int ai = 0; ai < 2; ++ai)
#pragma unroll
            for (int m = 0; m < 4; ++m) pq[ai][m] = *(const f32x4*)(ssq_q + (size_t)(row0 + ai * HALF + m * 16) * 4);
#pragma unroll
        for (int ai = 0; ai < 2; ++ai)
#pragma unroll
            for (int m = 0; m < 4; ++m) {
                const int row = row0 + ai * HALF + m * 16; const int b = row >> 12, s = row & 4095;
                const float rs = __builtin_amdgcn_rsqf(((pq[ai][m][0] + pq[ai][m][1]) + (pq[ai][m][2] + pq[ai][m][3])) * (1.f / cfg::QLR) + cfg::EPS) * cfg::QSCALE;
#pragma unroll
                for (int bj = 0; bj < 2; ++bj) {
                    const int col = u.pn * BM + bj * HALF + wc * 32 + 8 * fq, h = col / cfg::DQK, d = col - h * cfg::DQK;
                    f32x4 v0 = acc[ai][bj][m][0] * rs, v1 = acc[ai][bj][m][1] * rs;
                    if (d >= cfg::DNOPE) {
                        const int i0 = (d - cfg::DNOPE) >> 1;
                        const f32x4 cs0 = *(const f32x4*)(rope + (size_t)row * 16 + i0), cs1 = *(const f32x4*)(rope + (size_t)row * 16 + i0 + 2);
                        f32x4 r0, r1;
                        r0[0] = v0[0] * cs0[0] - v0[1] * cs0[1]; r0[1] = v0[1] * cs0[0] + v0[0] * cs0[1];
                        r0[2] = v0[2] * cs0[2] - v0[3] * cs0[3]; r0[3] = v0[3] * cs0[2] + v0[2] * cs0[3];
                        r1[0] = v1[0] * cs1[0] - v1[1] * cs1[1]; r1[1] = v1[1] * cs1[0] + v1[0] * cs1[1];
                        r1[2] = v1[2] * cs1[2] - v1[3] * cs1[3]; r1[3] = v1[3] * cs1[2] + v1[2] * cs1[3];
                        v0 = r0; v1 = r1;
                    }
                    *(u32x4*)(Q + ((size_t)(b * cfg::NH + h) * cfg::S + s) * cfg::DQK + d) = pack8(v0, v1);
                }
            }
    }
};

struct EpiKN {
    static constexpr bool PERM = true, AFTER_DRAIN = false;
    unsigned char* W; int l;
    __device__ __forceinline__ void operator()(const f32x4 (&acc)[2][2][4][2], const Unit& u_, int wr, int wc, int fr, int fq) const {
        Unit u = u_; asm volatile("" : "+s"(u.pm), "+s"(u.pn), "+v"(fr), "+v"(fq));
        const float* const ssq_kv = (const float*)(W + ws::SSQKV); bf16_t* const KF = (bf16_t*)(W + ws::KF);
        const int row0 = u.pm * BM + wr * 64 + fr;
        f32x4 pq[2][4];
#pragma unroll
        for (int ai = 0; ai < 2; ++ai)
#pragma unroll
            for (int m = 0; m < 4; ++m) pq[ai][m] = *(const f32x4*)(ssq_kv + (size_t)(row0 + ai * HALF + m * 16) * 4);
#pragma unroll
        for (int ai = 0; ai < 2; ++ai)
#pragma unroll
            for (int m = 0; m < 4; ++m) {
                const int row = row0 + ai * HALF + m * 16; const int b = row >> 12, s = row & 4095;
                const float rs = __builtin_amdgcn_rsqf(((pq[ai][m][0] + pq[ai][m][1]) + (pq[ai][m][2] + pq[ai][m][3])) * (1.f / cfg::KVLR) + cfg::EPS);
#pragma unroll
                for (int bj = 0; bj < 2; ++bj) {
                    const int col = u.pn * BM + bj * HALF + wc * 32 + 8 * fq, h = col >> 6, d = col & 63;
                    *(u32x4*)(KF + ((size_t)(b * cfg::NH + h) * cfg::S + s) * cfg::DQK + d) = pack8(acc[ai][bj][m][0] * rs, acc[ai][bj][m][1] * rs);
                }
            }
    }
};

struct EpiVT {
    static constexpr bool PERM = true, AFTER_DRAIN = false;
    unsigned char* W; int l;
    __device__ __forceinline__ void operator()(const f32x4 (&acc)[2][2][4][2], const Unit& u_, int wr, int wc, int fr, int fq) const {
        Unit u = u_; asm volatile("" : "+s"(u.pm), "+s"(u.pn), "+v"(fr), "+v"(fq));
        const float* const ssq_kv = (const float*)(W + ws::SSQKV); bf16_t* const VT = (bf16_t*)(W + ws::VT);
        const int row0 = u.pm * BM + wr * 64 + fr;
#pragma unroll
        for (int bj = 0; bj < 2; ++bj) {
            const int tok = u.pn * BM + bj * HALF + wc * 32 + 8 * fq; const int b = tok >> 12, s = tok & 4095;
            f32x4 rs0, rs1;
#pragma unroll
            for (int e = 0; e < 4; ++e) { rs0[e] = __builtin_amdgcn_rsqf(row_ssq4(ssq_kv, tok + e) * (1.f / cfg::KVLR) + cfg::EPS); rs1[e] = __builtin_amdgcn_rsqf(row_ssq4(ssq_kv, tok + 4 + e) * (1.f / cfg::KVLR) + cfg::EPS); }
#pragma unroll
            for (int ai = 0; ai < 2; ++ai)
#pragma unroll
                for (int m = 0; m < 4; ++m) {
                    const int r = row0 + ai * HALF + m * 16;
                    *(u32x4*)(VT + ((size_t)(b * 512 + r)) * cfg::S + s) = pack8(acc[ai][bj][m][0] * rs0, acc[ai][bj][m][1] * rs1);
                }
        }
    }
};

struct EpiNull {
    static constexpr bool PERM = true, AFTER_DRAIN = false;
    float* dummy;
    __device__ __forceinline__ void operator()(const f32x4 (&acc)[2][2][4][2], const Unit& u, int wr, int wc, int fr, int fq) const {
        f32x4 t = acc[0][0][0][0];
#pragma unroll
        for (int ai = 0; ai < 2; ++ai)
#pragma unroll
            for (int bj = 0; bj < 2; ++bj)
#pragma unroll
                for (int m = 0; m < 4; ++m) { t = t + acc[ai][bj][m][0]; t = t + acc[ai][bj][m][1]; }
        dummy[(size_t)(u.pm * 4 + (u.pn & 3)) * 512 + (wr * 4 + wc) * 64 + fr + 16 * fq] = (t[0] + t[1]) + (t[2] + t[3]);
    }
};
__device__ __forceinline__ void glds16_saddr(const void* sbase, unsigned voff, unsigned lds_dst) {
    asm volatile("s_mov_b32 m0, %2\n\ts_nop 0\n\tglobal_load_lds_dwordx4 %0, %1" : : "v"(voff), "s"(sbase), "s"(lds_dst) : "memory", "m0"); }
constexpr int PF_JUNK_OFF = 131072 + 8192, PF_DIST = 8;
template <class E, class = void> struct HasPrefetch { static constexpr bool v = false; };
template <class E> struct HasPrefetch<E, decltype((void)&E::prefetch)> { static constexpr bool v = true; };
template <class E, class = void> struct HasDefer { static constexpr bool v = false; struct Def {}; };
template <class E> struct HasDefer<E, decltype((void)sizeof(typename E::Def))> { static constexpr bool v = true; typedef typename E::Def Def; };
template <class Epi, class Sched, bool ALIGN_EPI = false, bool SP2 = false>
__device__ __forceinline__ void gemm_phase(PG8_LAS unsigned char* lds, const Gemm g, const Sched& S, const Epi& E) {
    int tid_ = threadIdx.x; asm volatile("" : "+v"(tid_));
    const int tid = tid_, wid = __builtin_amdgcn_readfirstlane(tid >> 6), lane = tid & 63, wr = wid >> 2, wc = wid & 3, fr = lane & 15, fq = lane >> 4;
    int K_ = g.K; asm volatile("" : "+s"(K_));
    const int K = K_, nt = K / BK; const int tpf = (nt > PF_DIST) ? ((nt - PF_DIST) & ~1) : 0; (void)tpf;
    unsigned voffA[2], voffB[2];
#pragma unroll
    for (int i = 0; i < 2; ++i) { int R, C; stage_rc(tid * 16 + i * 8192, R, C); const int Rb = Epi::PERM ? ((R & ~31) + perm32(R & 31)) : R;
        voffA[i] = (unsigned)(R * K + C) * 2u; voffB[i] = (unsigned)(Rb * K + C) * 2u; }
    const size_t kstep = (size_t)(BK * 2);
    const size_t hstep = (size_t)HALF * K * 2;
    const size_t tstep = 2 * hstep;
    const unsigned lds0_ = (unsigned)(uintptr_t)lds;
    const unsigned ldsw = (unsigned)wid * 1024u;
    const int aoff = lds_byte(wr * 64 + fr, fq * 8), boff = lds_byte(wc * 32 + fr, fq * 8);
#define PG8_SA(b, h) (((b) * 2 + (h)) * HTB)
#define PG8_SB(b, h) ((4 + (b) * 2 + (h)) * HTB)
#define PG8_STAGE(bufoff, gbase, voff) do { _Pragma("unroll") for (int _i = 0; _i < 2; ++_i) \
        glds16_saddr((const void*)(gbase), (voff)[_i], lds0_ + (unsigned)((bufoff) + _i * 8192) + ldsw); } while (0)
#define PG8_LDA(dst, b, h) do { _Pragma("unroll") for (int m = 0; m < 4; ++m) _Pragma("unroll") for (int k = 0; k < 2; ++k) dst[m][k] = *(const PG8_LAS bf16x8*)(lds + PG8_SA(b, h) + aoff + m * 2048 + k * 1024); } while (0)
#define PG8_LDB(dst, b, h) do { _Pragma("unroll") for (int n = 0; n < 2; ++n) _Pragma("unroll") for (int k = 0; k < 2; ++k) dst[n][k] = *(const PG8_LAS bf16x8*)(lds + PG8_SB(b, h) + boff + n * 2048 + k * 1024); } while (0)
#define PG8_MMA(ai, bj, At, Bt) do { if (PG8_PRIO) __builtin_amdgcn_s_setprio(1); _Pragma("unroll") for (int m = 0; m < 4; ++m) _Pragma("unroll") for (int n = 0; n < 2; ++n) _Pragma("unroll") for (int k = 0; k < 2; ++k) \
        acc[ai][bj][m][n] = __builtin_amdgcn_mfma_f32_16x16x32_bf16(Bt[n][k], At[m][k], acc[ai][bj][m][n], 0, 0, 0); if (PG8_PRIO) __builtin_amdgcn_s_setprio(0); } while (0)
#define PG8_PIN(q) do { _Pragma("unroll") for (int _q = 0; _q < 32; ++_q) { __builtin_amdgcn_sched_group_barrier(0x008, 1, 0); __builtin_amdgcn_sched_group_barrier(0x002, 1, 0); if ((_q & 3) == 0) __builtin_amdgcn_sched_group_barrier(0x400, 1, 0); } E.pin(DF, q); } while (0)
#define PG8_WAIT_V(n) asm volatile("s_waitcnt vmcnt(" #n ")" ::: "memory")
#define PG8_WAIT_L(n) asm volatile("s_waitcnt lgkmcnt(" #n ")" ::: "memory")
#define PG8_BAR __builtin_amdgcn_s_barrier()
#define PG8_SCHED __builtin_amdgcn_sched_barrier(0)
#define PG8_ITER(F0, F1, F2, F3, G0, G1, G2, G3) \
            if constexpr (HasPrefetch<Epi>::v) { if (t == tpf) E.prefetch(cur, lds + PF_JUNK_OFF + wid * 256, tid); } \
            const bool last = (t == nt - 2); \
            const char* a1 = cA + (size_t)(t + 1) * kstep; \
            const char* a2 = last ? nA : cA + (size_t)(t + 2) * kstep; const char* b2 = last ? nB : cB + (size_t)(t + 2) * kstep; \
            const char* a3 = a2 + kstep; const char* b3 = b2 + kstep; \
            if (last && has_next) S.a_ready(nxt); \
            PG8_LDB(B0, 0, 0); PG8_LDB(B1, 0, 1); PG8_SCHED; PG8_LDA(At, 0, 0); PG8_STAGE(PG8_SA(1, 1), a1 + hstep, voffA); \
            PG8_WAIT_V(8); PG8_WAIT_L(0); PG8_BAR; F0; PG8_MMA(0, 0, At, B0); PG8_MMA(0, 1, At, B1); G0; PG8_BAR; PG8_SCHED; \
            PG8_LDA(At, 0, 1); PG8_STAGE(PG8_SB(0, 0), b2, voffB); PG8_STAGE(PG8_SB(0, 1), b2 + hstep, voffB); PG8_STAGE(PG8_SA(0, 0), a2, voffA); \
            PG8_WAIT_V(8); PG8_WAIT_L(0); PG8_BAR; F1; PG8_MMA(1, 0, At, B0); PG8_MMA(1, 1, At, B1); G1; PG8_BAR; PG8_SCHED; \
            PG8_LDB(B0, 1, 0); PG8_LDB(B1, 1, 1); PG8_SCHED; PG8_LDA(At, 1, 0); PG8_STAGE(PG8_SA(0, 1), a2 + hstep, voffA); \
            PG8_WAIT_V(8); PG8_WAIT_L(0); PG8_BAR; F2; PG8_MMA(0, 0, At, B0); PG8_MMA(0, 1, At, B1); G2; PG8_BAR; PG8_SCHED; \
            PG8_LDA(At, 1, 1); PG8_STAGE(PG8_SB(1, 0), b3, voffB); PG8_STAGE(PG8_SB(1, 1), b3 + hstep, voffB); PG8_STAGE(PG8_SA(1, 0), a3, voffA); \
            PG8_WAIT_V(8); PG8_WAIT_L(0); PG8_BAR; F3; PG8_MMA(1, 0, At, B0); PG8_MMA(1, 1, At, B1); G3; PG8_BAR; PG8_SCHED;
    Unit cur, nxt; int ui = 0;
    if (!S.next(0, cur)) return;
    f32x4 acc[2][2][4][2];
#pragma unroll
    for (int a = 0; a < 2; ++a)
#pragma unroll
        for (int b = 0; b < 2; ++b)
#pragma unroll
            for (int m = 0; m < 4; ++m)
#pragma unroll
                for (int n = 0; n < 2; ++n) acc[a][b][m][n] = (f32x4){0.f, 0.f, 0.f, 0.f};
    bf16x8 At[4][2], B0[2][2], B1[2][2];
    typename HasDefer<Epi>::Def DF; Unit prv = cur; (void)prv;
    if constexpr (HasDefer<Epi>::v) {
#pragma unroll
        for (int m = 0; m < 4; ++m) { DF.a[m] = (u32x4){0u, 0u, 0u, 0u}; DF.b[m] = (u32x4){0u, 0u, 0u, 0u}; } }
    const char* cA = (const char*)g.A + (size_t)cur.pm * tstep; const char* cB = (const char*)g.Bt + (size_t)cur.pn * tstep;
    S.a_ready(cur);
    if constexpr (SP2) {
        PG8_STAGE(PG8_SB(0, 0), cB, voffB); PG8_STAGE(PG8_SB(0, 1), cB + hstep, voffB); PG8_STAGE(PG8_SA(0, 0), cA, voffA); PG8_STAGE(PG8_SA(0, 1), cA + hstep, voffA);
        if (wr == 1) PG8_BAR;
        PG8_WAIT_V(2); PG8_BAR;
        PG8_STAGE(PG8_SB(1, 0), cB + kstep, voffB); PG8_STAGE(PG8_SA(1, 0), cA + kstep, voffA); PG8_STAGE(PG8_SB(1, 1), cB + hstep + kstep, voffB);
        PG8_WAIT_V(6); PG8_BAR;
    } else {
        PG8_STAGE(PG8_SB(0, 0), cB, voffB); PG8_STAGE(PG8_SA(0, 0), cA, voffA); PG8_STAGE(PG8_SB(0, 1), cB + hstep, voffB); PG8_STAGE(PG8_SA(0, 1), cA + hstep, voffA);
        if (wr == 1) PG8_BAR;
        PG8_WAIT_V(4); PG8_BAR;
        PG8_STAGE(PG8_SB(1, 0), cB + kstep, voffB); PG8_STAGE(PG8_SA(1, 0), cA + kstep, voffA); PG8_STAGE(PG8_SB(1, 1), cB + hstep + kstep, voffB);
        PG8_WAIT_V(6); PG8_BAR;
    }
    for (;;) {
        const bool has_next = S.next(ui + 1, nxt);
        const char* nA = has_next ? (const char*)g.A + (size_t)nxt.pm * tstep : cA; const char* nB = has_next ? (const char*)g.Bt + (size_t)nxt.pn * tstep : cB;
        if constexpr (SP2) {
            if constexpr (HasDefer<Epi>::v) {
                { const int t = 0; constexpr bool PG8_PRIO = false; PG8_ITER(PG8_SCHED; E.later(DF, 0), PG8_SCHED; E.later(DF, 1), PG8_SCHED; E.later(DF, 2), PG8_SCHED; E.later(DF, 3), PG8_PIN(0), PG8_PIN(1), PG8_PIN(2), PG8_PIN(3)) }
                if constexpr (Epi::ND == 4) { const int t = 2; constexpr bool PG8_PRIO = false; PG8_ITER(PG8_SCHED; E.later(DF, 4), PG8_SCHED; E.later(DF, 5), PG8_SCHED; E.later(DF, 6), PG8_SCHED; E.later(DF, 7), PG8_PIN(4), PG8_PIN(5), PG8_PIN(6), PG8_PIN(7)) }
                for (int t = Epi::ND; t < nt; t += 2) { constexpr bool PG8_PRIO = true; PG8_ITER((void)0, (void)0, (void)0, (void)0, (void)0, (void)0, (void)0, (void)0) }
            } else {
                for (int t = 0; t < nt; t += 2) { constexpr bool PG8_PRIO = true; PG8_ITER((void)0, (void)0, (void)0, (void)0, (void)0, (void)0, (void)0, (void)0) }
            }
        } else {
        for (int t = 0; t < nt; t += 2) { constexpr bool PG8_PRIO = true;
            if constexpr (HasPrefetch<Epi>::v) { if (t == tpf) E.prefetch(cur, lds + PF_JUNK_OFF + wid * 256, tid); }
            const bool last = (t == nt - 2);
            const char* a1 = cA + (size_t)(t + 1) * kstep;
            const char* a2 = last ? nA : cA + (size_t)(t + 2) * kstep; const char* b2 = last ? nB : cB + (size_t)(t + 2) * kstep;
            const char* a3 = a2 + kstep; const char* b3 = b2 + kstep;
            if (last && has_next) S.a_ready(nxt);
            PG8_LDB(B0, 0, 0); PG8_SCHED; PG8_LDA(At, 0, 0); PG8_STAGE(PG8_SA(1, 1), a1 + hstep, voffA);
            PG8_WAIT_L(8); PG8_BAR; PG8_WAIT_L(0); PG8_MMA(0, 0, At, B0); PG8_BAR; PG8_SCHED;
            PG8_LDB(B1, 0, 1); PG8_STAGE(PG8_SB(0, 0), b2, voffB);
            PG8_BAR; PG8_WAIT_L(0); PG8_MMA(0, 1, At, B1); PG8_BAR;
            PG8_LDA(At, 0, 1); PG8_STAGE(PG8_SA(0, 0), a2, voffA);
            PG8_BAR; PG8_WAIT_L(0); PG8_MMA(1, 0, At, B0); PG8_BAR; PG8_SCHED;
            PG8_STAGE(PG8_SB(0, 1), b2 + hstep, voffB);
            PG8_WAIT_V(6); PG8_BAR; PG8_MMA(1, 1, At, B1); PG8_BAR;
            PG8_LDB(B0, 1, 0); PG8_SCHED; PG8_LDA(At, 1, 0); PG8_STAGE(PG8_SA(0, 1), a2 + hstep, voffA);
            PG8_WAIT_L(8); PG8_BAR; PG8_WAIT_L(0); PG8_MMA(0, 0, At, B0); PG8_BAR; PG8_SCHED;
            PG8_LDB(B1, 1, 1); PG8_STAGE(PG8_SB(1, 0), b3, voffB);
            PG8_BAR; PG8_WAIT_L(0); PG8_MMA(0, 1, At, B1); PG8_BAR;
            PG8_LDA(At, 1, 1); PG8_STAGE(PG8_SA(1, 0), a3, voffA);
            PG8_BAR; PG8_WAIT_L(0); PG8_MMA(1, 0, At, B0); PG8_BAR; PG8_SCHED;
            PG8_STAGE(PG8_SB(1, 1), b3 + hstep, voffB);
            PG8_WAIT_V(6); PG8_BAR; PG8_MMA(1, 1, At, B1); PG8_BAR;
        }
        }
        if constexpr (ALIGN_EPI) { if (wr == 0) PG8_BAR; }
        if constexpr (HasDefer<Epi>::v) {
            if (ui > 0) E.flush(DF, prv, wr, wc, fr, fq);
            if (has_next) { E.template run<true>(acc, cur, wr, wc, fr, fq, DF); prv = cur; } else E.template run<false>(acc, cur, wr, wc, fr, fq, DF);
            S.done(cur);
        } else
        if constexpr (!Epi::AFTER_DRAIN) { E(acc, cur, wr, wc, fr, fq); S.done(cur); }
        if (!has_next) break;
#pragma unroll
        for (int a = 0; a < 2; ++a)
#pragma unroll
            for (int b = 0; b < 2; ++b)
#pragma unroll
                for (int m = 0; m < 4; ++m)
#pragma unroll
                    for (int n = 0; n < 2; ++n) acc[a][b][m][n] = (f32x4){0.f, 0.f, 0.f, 0.f};
        cur = nxt; cA = nA; cB = nB; ++ui;
        if constexpr (ALIGN_EPI) { if (wr == 1) PG8_BAR; }
    }
    PG8_WAIT_V(0);
    if constexpr (!ALIGN_EPI) { if (wr == 0) PG8_BAR; }
    PG8_BAR;
    if constexpr (Epi::AFTER_DRAIN) { E.fused(acc, cur, wr, wc, fr, fq, lds, wid, lane); S.done(cur); }
#undef PG8_SA
#undef PG8_SB
#undef PG8_STAGE
#undef PG8_LDA
#undef PG8_LDB
#undef PG8_MMA
#undef PG8_WAIT_V
#undef PG8_ITER
#undef PG8_PIN
#undef PG8_WAIT_L
#undef PG8_BAR
#undef PG8_SCHED
}
}
#define XB_TMO      128
#define XB_XCNT(j)  (256  + 64 * (j))
#define XB_XSUB(j)  (1280 + 64 * (j))
#define XB_XGEN(j)  (2304 + 64 * (j))
#define XB_TOP      3328
#define XB_TOPGEN   3392
#define XCD_BAR_WORDS 3456
#define XB_SPIN_CAP (1u << 18)

__device__ __forceinline__ unsigned xb_ld(unsigned* p)              { return __hip_atomic_load(p, __ATOMIC_RELAXED, __HIP_MEMORY_SCOPE_AGENT); }
__device__ __forceinline__ unsigned xb_add(unsigned* p, unsigned v) { return __hip_atomic_fetch_add(p, v, __ATOMIC_RELAXED, __HIP_MEMORY_SCOPE_AGENT); }
__device__ __forceinline__ unsigned xb_xcc_id() { return (unsigned)__builtin_amdgcn_s_getreg((3 << 11) | 20) & 0xFu; }
#define XB_SPIN(cond, bar) do { unsigned _sp = 0; while (cond) { __builtin_amdgcn_s_sleep(1); \
    if ((++_sp & 255u) == 0u) { if (xb_ld(&(bar)[XB_TMO])) break; if (_sp > XB_SPIN_CAP) { atomicAdd(&(bar)[XB_TMO], 1u); break; } } } } while (0)

struct XcdBarrier {
    unsigned* bar; unsigned x;
    volatile LAS unsigned* st;
};

__device__ __forceinline__ XcdBarrier xcd_barrier_post(unsigned* bar, volatile LAS unsigned* st) {
    XcdBarrier b; b.bar = bar; b.x = xb_xcc_id(); b.st = st;
    if (threadIdx.x == 0) (void)xb_add(&bar[XB_XCNT(b.x)], 1u);
    return b;
}
__device__ __forceinline__ void xcd_barrier_complete(unsigned* bar, unsigned x, unsigned& nloc, unsigned& nx) {
    const unsigned G = gridDim.x * gridDim.y * gridDim.z;
    unsigned sum, cnt, mine, sp = 0u;
    for (;;) {
        sum = 0u; cnt = 0u; mine = 0u;
#pragma unroll
        for (unsigned j = 0; j < 16; ++j) { const unsigned c = xb_ld(&bar[XB_XCNT(j)]); sum += c; cnt += (c > 0u) ? 1u : 0u; mine = (j == x) ? c : mine; }
        if (sum == G) break;
        __builtin_amdgcn_s_sleep(1);
        if ((++sp & 255u) == 0u) { if (xb_ld(&bar[XB_TMO])) break; if (sp > XB_SPIN_CAP) { atomicAdd(&bar[XB_TMO], 1u); break; } }
    }
    nloc = mine > 0u ? mine : 1u; nx = cnt > 0u ? cnt : 1u;
}

__device__ __forceinline__ void xcd_barrier(const XcdBarrier& b) {
    asm volatile("s_waitcnt vmcnt(0)" ::: "memory");
    __syncthreads();
    if (threadIdx.x == 0) {
        unsigned* bar = b.bar;
        __builtin_amdgcn_s_waitcnt(0);
        unsigned nloc = b.st[0], nx = b.st[1];
        if (nloc == 0u) { xcd_barrier_complete(bar, b.x, nloc, nx); b.st[0] = nloc; b.st[1] = nx; }
        const unsigned old = xb_add(&bar[XB_XSUB(b.x)], 1u);
        const unsigned gen = old / nloc;
        if (old + 1u == (gen + 1u) * nloc) {
            __builtin_amdgcn_fence(__ATOMIC_RELEASE, "agent");
            asm volatile("s_waitcnt vmcnt(0)" ::: "memory");
            const unsigned og = xb_add(&bar[XB_TOP], 1u);
            const unsigned tg = og / nx;
            if (og + 1u == (tg + 1u) * nx) xb_add(&bar[XB_TOPGEN], 1u);
            else XB_SPIN(xb_ld(&bar[XB_TOPGEN]) == tg, bar);
            __builtin_amdgcn_fence(__ATOMIC_ACQUIRE, "agent");
            xb_add(&bar[XB_XGEN(b.x)], 1u);
            asm volatile("s_waitcnt vmcnt(0)" ::: "memory");
        } else {
            XB_SPIN(xb_ld(&bar[XB_XGEN(b.x)]) == gen, bar);
            __builtin_amdgcn_fence(__ATOMIC_ACQUIRE, "agent");
            asm volatile("s_waitcnt vmcnt(0)" ::: "memory");
        }
    }
    __syncthreads();
}
typedef __bf16 bf16x2_t __attribute__((ext_vector_type(2)));
__device__ __forceinline__ unsigned cvtpk(float lo, float hi) { const f32x2 v = {lo, hi}; const bf16x2_t b = __builtin_convertvector(v, bf16x2_t); return __builtin_bit_cast(unsigned, b); }
__device__ __forceinline__ float bf2f(unsigned short b) { return __uint_as_float((unsigned)b << 16); }
__device__ __forceinline__ float bflo(unsigned w) { return __uint_as_float(w << 16); }
__device__ __forceinline__ float bfhi(unsigned w) { return __uint_as_float(w & 0xffff0000u); }
__device__ __forceinline__ void glds16(const void* gsrc, unsigned lds_dst) { unsigned keep;
    asm volatile("s_mov_b32 %0, m0\n\ts_mov_b32 m0, %2\n\ts_nop 0\n\tglobal_load_lds_dwordx4 %1, off\n\ts_mov_b32 m0, %0" : "=&s"(keep) : "v"(gsrc), "s"(lds_dst) : "memory"); }
__device__ __forceinline__ float half_swap_max(float m) { auto rr = __builtin_amdgcn_permlane32_swap(__float_as_uint(m), __float_as_uint(m), false, false); return fmaxf(__uint_as_float(rr[0]), __uint_as_float(rr[1])); }
__device__ __forceinline__ float half_swap_sum(float m) { auto rr = __builtin_amdgcn_permlane32_swap(__float_as_uint(m), __float_as_uint(m), false, false); return __uint_as_float(rr[0]) + __uint_as_float(rr[1]); }

namespace att {
constexpr int KTB = 64 * 192, VTB = 64 * 128, NSTG = 6;
constexpr int L_K = 0, L_V = NSTG * KTB, L_END = L_V + NSTG * VTB;
constexpr float THR = 8.f;
#define ATT_WAITBAR(N) asm volatile("s_waitcnt vmcnt(" #N ") lgkmcnt(0)\n\ts_barrier" ::: "memory")
__device__ __forceinline__ int slot_of(int t) { return t % NSTG; }
__device__ __forceinline__ float max3(float a, float b, float c) { return fmaxf(fmaxf(a, b), c); }

__device__ __forceinline__ void qk_tile(f32x16& p0, f32x16& p1, const LAS unsigned char* kb, const bf16x8 (&qf)[6], const f32x16& negm, int hi, int kc) {
    int g0 = hi + kc; if (g0 >= 12) g0 -= 12;
    bf16x8 ka[2][2];
#pragma unroll
    for (int d = 0; d < 2; ++d) { int g = g0 + 2 * d; if (g >= 12) g -= 12; ka[d][0] = *(const LAS bf16x8*)(kb + g * 16); ka[d][1] = *(const LAS bf16x8*)(kb + 32 * 192 + g * 16); }
#pragma unroll
    for (int d = 0; d < 6; ++d) {
        if (d == 0) { p0 = __builtin_amdgcn_mfma_f32_32x32x16_bf16(ka[0][0], qf[0], negm, 0, 0, 0); p1 = __builtin_amdgcn_mfma_f32_32x32x16_bf16(ka[0][1], qf[0], negm, 0, 0, 0); }
        else { p0 = __builtin_amdgcn_mfma_f32_32x32x16_bf16(ka[d & 1][0], qf[d], p0, 0, 0, 0); p1 = __builtin_amdgcn_mfma_f32_32x32x16_bf16(ka[d & 1][1], qf[d], p1, 0, 0, 0); }
        if (d + 2 < 6) { int g = g0 + 2 * (d + 2); if (g >= 12) g -= 12; if (g >= 12) g -= 12; ka[d & 1][0] = *(const LAS bf16x8*)(kb + g * 16); ka[d & 1][1] = *(const LAS bf16x8*)(kb + 32 * 192 + g * 16); }
    }
}
__device__ __forceinline__ void mask_tile(f32x16& p0, f32x16& p1, int kb0, int qrel) {
#pragma unroll
    for (int r = 0; r < 16; ++r) { const int kv = kb0 + 16 * (r >> 3) + (r & 7); if (kv > qrel) p0[r] = -INFINITY; if (kv + 32 > qrel) p1[r] = -INFINITY; }
}

__device__ __forceinline__ void attn_unit(LAS unsigned char* lds, int bh, int qbA, int qbB, const bf16_t* __restrict__ Q, const bf16_t* __restrict__ KF, const bf16_t* __restrict__ VT, bf16_t* __restrict__ Y, gu32* qhead, unsigned& knext) {
    int tid_ = threadIdx.x; asm volatile("" : "+v"(tid_));
    const int tid = tid_, lane = tid & 63, r32 = lane & 31, hi = lane >> 5;
    const int wid = __builtin_amdgcn_readfirstlane(tid >> 6);
    const unsigned lds0 = (unsigned)(uintptr_t)lds;
    const char* Kg = (const char*)(KF + (size_t)bh * cfg::S * cfg::DQK);
    const char* Vg = (const char*)(VT + (size_t)bh * cfg::DVH * cfg::S);
    const char *s0, *s1, *s2; unsigned d0, d1, d2; int str1, lst1;
    { const int p = wid * 64 + lane, row = p / 12, gq = p - row * 12; int g = gq - ((row >> 2) & 3); if (g < 0) g += 12; s0 = Kg + row * 192 + g * 16; d0 = lds0 + L_K + wid * 1024; }
    if (wid < 4) { const int p = (wid + 8) * 64 + lane, row = p / 12, gq = p - row * 12; int g = gq - ((row >> 2) & 3); if (g < 0) g += 12; s1 = Kg + row * 192 + g * 16; d1 = lds0 + L_K + (wid + 8) * 1024; str1 = KTB; lst1 = KTB; }
    else { const int p = (wid - 4) * 64 + lane, row = p >> 3, gq = p & 7, g = gq ^ ((row >> 1) & 7); s1 = Vg + (size_t)row * (cfg::S * 2) + g * 16; d1 = lds0 + L_V + (wid - 4) * 1024; str1 = 128; lst1 = VTB; }
    { const int p = ((wid & 3) + 4) * 64 + lane, row = p >> 3, gq = p & 7, g = gq ^ ((row >> 1) & 7); s2 = Vg + (size_t)row * (cfg::S * 2) + g * 16; d2 = lds0 + L_V + ((wid & 3) + 4) * 1024; }
#define ATT_ISSUE(t, stg) do { glds16(s0 + (size_t)(t) * KTB, (unsigned)__builtin_amdgcn_readfirstlane(d0 + (stg) * KTB)); \
        glds16(s1 + (size_t)(t) * str1, (unsigned)__builtin_amdgcn_readfirstlane(d1 + (stg) * lst1)); \
        if (wid < 4) glds16(s2 + (size_t)(t) * 128, (unsigned)__builtin_amdgcn_readfirstlane(d2 + (stg) * VTB)); } while (0)
    const int NTA = 4 * (qbA + 1), NTT = NTA + ((qbB >= 0) ? 4 * (qbB + 1) : 0);
#define ATT_ISSUE_T(T) do { const int T_ = (T); ATT_ISSUE((T_ < NTA) ? T_ : T_ - NTA, slot_of(T_)); } while (0)
    ATT_ISSUE_T(0); ATT_ISSUE_T(1); ATT_ISSUE_T(2); ATT_ISSUE_T(3);
    const int krow = (r32 & 0x13) | ((r32 & 4) << 1) | ((r32 & 8) >> 1);
    const int kc = (krow >> 2) & 3;
    const LAS unsigned char* kbase = lds + L_K + krow * 192;
    const LAS unsigned char* vbase = lds + L_V + r32 * 128;
    const int vx = (r32 >> 1) & 7;
    const int qrel = wid * 32 + r32;
  for (int half = 0; half < ((qbB >= 0) ? 2 : 1); ++half) {
    const int qb = half ? qbB : qbA, TO = half ? NTA : 0;
    const int NT = 4 * (qb + 1);
    const bf16_t* Qw = Q + ((size_t)bh * cfg::S + qb * 256 + wid * 32 + r32) * cfg::DQK + hi * 8;
    bf16x8 qf[6];
#pragma unroll
    for (int d = 0; d < 6; ++d) qf[d] = *(const bf16x8*)(Qw + d * 16);
    f32x16 o0, o1, negm;
#pragma unroll
    for (int r = 0; r < 16; ++r) { o0[r] = 0.f; o1[r] = 0.f; negm[r] = 0.f; }
    float mref = 0.f, l_run = 0.f;
    const int qminw = qb * 256 + wid * 32;
    const int tlast = (qminw + 31) >> 6;
    f32x16 pa0, pa1, pb0, pb1;
    if (wid < 4) ATT_WAITBAR(9); else ATT_WAITBAR(6);
    qk_tile(pa0, pa1, kbase + slot_of(TO) * KTB, qf, negm, hi, kc);
    if (63 > qminw) mask_tile(pa0, pa1, -qb * 256 + 8 * hi, qrel);
#define ATT_ROWMAX(c0, c1, rm) float rm; { float ma = max3(c0[0], c0[1], c1[0]), mb = max3(c0[2], c0[3], c1[1]); ma = max3(ma, c1[2], c1[3]); \
        _Pragma("unroll") for (int r = 4; r < 16; r += 4) { ma = max3(ma, c0[r], c0[r + 1]); mb = max3(mb, c0[r + 2], c0[r + 3]); ma = max3(ma, c1[r], c1[r + 1]); mb = max3(mb, c1[r + 2], c1[r + 3]); } \
        rm = half_swap_max(fmaxf(ma, mb)); }
    { ATT_ROWMAX(pa0, pa1, rm0); mref = rm0;
#pragma unroll
      for (int r = 0; r < 16; ++r) { pa0[r] -= rm0; pa1[r] -= rm0; negm[r] = -rm0; } }
#define ATT_RESCALE(c0, c1, rm) if (__builtin_expect(__any(rm > THR), 0)) { const float dl = fmaxf(rm, 0.f); mref += dl; \
        _Pragma("unroll") for (int r = 0; r < 16; ++r) { c0[r] -= dl; c1[r] -= dl; negm[r] = -mref; } \
        const float f = __builtin_amdgcn_exp2f(-dl); l_run *= f; \
        _Pragma("unroll") for (int r = 0; r < 16; ++r) { o0[r] *= f; o1[r] *= f; } }
    u32x4 pw0, pw1, pw2, pw3;
#define ATT_EXPPACK(c0, c1) do { \
        _Pragma("unroll") for (int r = 0; r < 16; ++r) { c0[r] = __builtin_amdgcn_exp2f(c0[r]); c1[r] = __builtin_amdgcn_exp2f(c1[r]); } \
        f32x2 sacc = {0.f, 0.f}; \
        _Pragma("unroll") for (int r = 0; r < 16; r += 2) { sacc += (f32x2){c0[r], c0[r + 1]}; sacc += (f32x2){c1[r], c1[r + 1]}; } \
        l_run += sacc[0] + sacc[1]; \
        pw0 = (u32x4){cvtpk(c0[0], c0[1]), cvtpk(c0[2], c0[3]), cvtpk(c0[4], c0[5]), cvtpk(c0[6], c0[7])}; \
        pw1 = (u32x4){cvtpk(c0[8], c0[9]), cvtpk(c0[10], c0[11]), cvtpk(c0[12], c0[13]), cvtpk(c0[14], c0[15])}; \
        pw2 = (u32x4){cvtpk(c1[0], c1[1]), cvtpk(c1[2], c1[3]), cvtpk(c1[4], c1[5]), cvtpk(c1[6], c1[7])}; \
        pw3 = (u32x4){cvtpk(c1[8], c1[9]), cvtpk(c1[10], c1[11]), cvtpk(c1[12], c1[13]), cvtpk(c1[14], c1[15])}; } while (0)
#define ATT_PV(slot) do { const LAS unsigned char* vb = vbase + (slot) * VTB; \
        _Pragma("unroll") for (int ks = 0; ks < 4; ++ks) { const int g = (2 * ks + hi) ^ vx; \
            const bf16x8 v0 = *(const LAS bf16x8*)(vb + g * 16), v1 = *(const LAS bf16x8*)(vb + 32 * 128 + g * 16); \
            const bf16x8 pf = __builtin_bit_cast(bf16x8, (ks == 0) ? pw0 : (ks == 1) ? pw1 : (ks == 2) ? pw2 : pw3); \
            o0 = __builtin_amdgcn_mfma_f32_32x32x16_bf16(v0, pf, o0, 0, 0, 0); o1 = __builtin_amdgcn_mfma_f32_32x32x16_bf16(v1, pf, o1, 0, 0, 0); } } while (0)
#define ATT_STEADY(cur0, cur1, nxt0, nxt1, t) do { const int t_ = (t); \
        if (wid < 4) ATT_WAITBAR(6); else ATT_WAITBAR(4);            \
        ATT_ISSUE_T(TO + t_ + 4); \
        ATT_ROWMAX(cur0, cur1, rm_); ATT_RESCALE(cur0, cur1, rm_); \
        bf16x8 vf_[2][2];                                              \
        { const LAS unsigned char* vb_ = vbase + slot_of(TO + t_) * VTB; \
          _Pragma("unroll") for (int ks = 0; ks < 2; ++ks) { const int g = (2 * ks + hi) ^ vx; vf_[ks][0] = *(const LAS bf16x8*)(vb_ + g * 16); vf_[ks][1] = *(const LAS bf16x8*)(vb_ + 32 * 128 + g * 16); } } \
        __builtin_amdgcn_sched_barrier(0); \
        qk_tile(nxt0, nxt1, kbase + slot_of(TO + t_ + 1) * KTB, qf, negm, hi, kc); ATT_EXPPACK(cur0, cur1); \
        { const LAS unsigned char* vb_ = vbase + slot_of(TO + t_) * VTB; \
          _Pragma("unroll") for (int ks = 0; ks < 4; ++ks) { const bf16x8 pf = __builtin_bit_cast(bf16x8, (ks == 0) ? pw0 : (ks == 1) ? pw1 : (ks == 2) ? pw2 : pw3); \
            o0 = __builtin_amdgcn_mfma_f32_32x32x16_bf16(vf_[ks & 1][0], pf, o0, 0, 0, 0); o1 = __builtin_amdgcn_mfma_f32_32x32x16_bf16(vf_[ks & 1][1], pf, o1, 0, 0, 0); \
            if (ks < 2) { const int g = (2 * (ks + 2) + hi) ^ vx; vf_[ks][0] = *(const LAS bf16x8*)(vb_ + g * 16); vf_[ks][1] = *(const LAS bf16x8*)(vb_ + 32 * 128 + g * 16); } } } } while (0)
#define ATT_GENERAL(cur0, cur1, nxt0, nxt1, t) do { const int t_ = (t); \
        if (t_ + 1 < NT) { const int left = NTT - (TO + t_) - 2, nfly = (left < 2) ? left : 2;        \
            if (nfly == 2) { if (wid < 4) ATT_WAITBAR(6); else ATT_WAITBAR(4); } else if (nfly == 1) { if (wid < 4) ATT_WAITBAR(3); else ATT_WAITBAR(2); } else ATT_WAITBAR(0); } \
        if (TO + t_ + 4 < NTT) ATT_ISSUE_T(TO + t_ + 4);        \
        const bool do_cur = (t_ <= tlast), do_next = (t_ + 1 < NT) && (t_ + 1 <= tlast); \
        if (do_cur) { ATT_ROWMAX(cur0, cur1, rm_); ATT_RESCALE(cur0, cur1, rm_); } \
        if (do_next) { qk_tile(nxt0, nxt1, kbase + slot_of(TO + t_ + 1) * KTB, qf, negm, hi, kc); \
            if (64 * (t_ + 1) + 63 > qminw) mask_tile(nxt0, nxt1, 64 * (t_ + 1) - qb * 256 + 8 * hi, qrel); } \
        if (do_cur) { ATT_EXPPACK(cur0, cur1); ATT_PV(slot_of(TO + t_)); } } while (0)
    int t = 0;
    for (; t + 3 <= 4 * qb; t += 2) {
        ATT_STEADY(pa0, pa1, pb0, pb1, t);
        ATT_STEADY(pb0, pb1, pa0, pa1, t + 1);
    }
    if (half == ((qbB >= 0) ? 1 : 0) && tid == 0) knext = __hip_atomic_fetch_add(qhead, 1u, __ATOMIC_RELAXED, __HIP_MEMORY_SCOPE_AGENT);
    for (; t < NT; t += 2) {
        ATT_GENERAL(pa0, pa1, pb0, pb1, t);
        ATT_GENERAL(pb0, pb1, pa0, pa1, t + 1);
    }
#undef ATT_STEADY
#undef ATT_GENERAL
#undef ATT_PV
#undef ATT_EXPPACK
#undef ATT_RESCALE
#undef ATT_ROWMAX
    const float l_tot = half_swap_sum(l_run), inv = 1.f / l_tot;
    float ss = 0.f;
#pragma unroll
    for (int r = 0; r < 16; ++r) { o0[r] *= inv; o1[r] *= inv; ss += o0[r] * o0[r] + o1[r] * o1[r]; }
    ss = half_swap_sum(ss);
    const float rs = __builtin_amdgcn_rsqf(ss * (1.f / cfg::DVH) + cfg::EPS);
    bf16_t* yp = Y + ((size_t)(bh >> 3) * cfg::S + qb * 256 + qrel) * cfg::D + (bh & 7) * cfg::DVH + 4 * hi;
#pragma unroll
    for (int rg = 0; rg < 4; ++rg) {
        u32x2 w0, w1; w0.x = cvtpk(o0[4 * rg] * rs, o0[4 * rg + 1] * rs); w0.y = cvtpk(o0[4 * rg + 2] * rs, o0[4 * rg + 3] * rs);
        w1.x = cvtpk(o1[4 * rg] * rs, o1[4 * rg + 1] * rs); w1.y = cvtpk(o1[4 * rg + 2] * rs, o1[4 * rg + 3] * rs);
        *(u32x2*)(yp + 8 * rg) = w0; *(u32x2*)(yp + 32 + 8 * rg) = w1;
    }
  }
    ATT_WAITBAR(0);
#undef ATT_ISSUE_T
#undef ATT_ISSUE
}
}
namespace mls {
constexpr int PITCH = 144, VPITCH = 304;
constexpr int O_QN = 0, O_KN = 64 * PITCH, O_VN = 2 * 64 * PITCH, O_G = O_VN + 64 * VPITCH, STAGE = O_G + 1024;
constexpr int O_HS = 2 * STAGE, O_CW = O_HS + 2 * 8 * 64 * 4, L_END = O_CW + (5 * 128) * 4;
static_assert(STAGE % 16 == 0 && O_G % 16 == 0 && O_VN % 16 == 0, "mls LDS map");
typedef short v4i16_t __attribute__((ext_vector_type(4)));
__device__ __forceinline__ s16x4 trrd(const LAS unsigned char* p) { return __builtin_bit_cast(s16x4, __builtin_amdgcn_ds_read_tr16_b64_v4i16((LAS v4i16_t*)p)); }
__device__ __forceinline__ bf16x8 cat8(const s16x4 a, const s16x4 b) { return (bf16x8){a[0], a[1], a[2], a[3], b[0], b[1], b[2], b[3]}; }

struct StageRegs { bf16x8 rq[4], rk[4], rv[2]; float ig, lf; u32x2 og[4]; };

__device__ __forceinline__ void load_stage(StageRegs& R, int b, int h, int c, const bf16_t* __restrict__ QM, const bf16_t* __restrict__ KM, const bf16_t* __restrict__ VM, const bf16_t* __restrict__ OG,
                                           const float* __restrict__ IF, int tid) {
    const int r = tid >> 3, c8 = tid & 7, lane = tid & 63, wid = tid >> 6;
    const int tok = b * cfg::S + c * 64 + r;
#pragma unroll
    for (int j = 0; j < 4; ++j) {
        const bool ok = (c > 0) || (r - 3 + j >= 0);
        const size_t off = (size_t)(tok - 3 + j) * 256 + h * 64 + c8 * 8;
        R.rq[j] = ok ? *(const bf16x8*)(QM + off) : (bf16x8){0, 0, 0, 0, 0, 0, 0, 0};
        R.rk[j] = ok ? *(const bf16x8*)(KM + off) : (bf16x8){0, 0, 0, 0, 0, 0, 0, 0};
    }
    R.rv[0] = *(const bf16x8*)(VM + (size_t)tok * 512 + h * 128 + c8 * 8);
    R.rv[1] = *(const bf16x8*)(VM + (size_t)tok * 512 + h * 128 + 64 + c8 * 8);
    { const size_t tg = (size_t)b * cfg::S + c * 64 + lane; R.ig = IF[tg * 8 + h]; R.lf = IF[tg * 8 + 4 + h]; }
#pragma unroll
    for (int lb = 0; lb < 4; ++lb) R.og[lb] = *(const u32x2*)(OG + ((size_t)b * cfg::S + c * 64 + 16 * lb + (lane & 15)) * 512 + h * 128 + 16 * wid + 4 * ((lane >> 4) & 3));
}
__device__ __forceinline__ void write_stage(const StageRegs& R, LAS unsigned char* st, const LAS float* cw, int tid) {
    const int r = tid >> 3, c8 = tid & 7, lane = tid & 63, wid = tid >> 6;
    float q[8], k[8];
#pragma unroll
    for (int e = 0; e < 8; ++e) { q[e] = cw[512 + 8 * c8 + e]; k[e] = cw[512 + 64 + 8 * c8 + e]; }
#pragma unroll
    for (int j = 0; j < 4; ++j)
#pragma unroll
        for (int e = 0; e < 8; ++e) { q[e] += cw[j * 128 + 8 * c8 + e] * bf2f((unsigned short)R.rq[j][e]); k[e] += cw[j * 128 + 64 + 8 * c8 + e] * bf2f((unsigned short)R.rk[j][e]); }
#pragma unroll
    for (int e = 0; e < 8; ++e) { q[e] = pg8::silu_f(q[e]) * 0.125f; k[e] = pg8::silu_f(k[e]); }
    u32x4 qw, kw; qw.x = cvtpk(q[0], q[1]); qw.y = cvtpk(q[2], q[3]); qw.z = cvtpk(q[4], q[5]); qw.w = cvtpk(q[6], q[7]);
    kw.x = cvtpk(k[0], k[1]); kw.y = cvtpk(k[2], k[3]); kw.z = cvtpk(k[4], k[5]); kw.w = cvtpk(k[6], k[7]);
    *(LAS u32x4*)(st + O_QN + r * PITCH + c8 * 16) = qw;
    *(LAS u32x4*)(st + O_KN + r * PITCH + c8 * 16) = kw;
    *(LAS bf16x8*)(st + O_VN + r * VPITCH + c8 * 16) = R.rv[0];
    *(LAS bf16x8*)(st + O_VN + r * VPITCH + 128 + c8 * 16) = R.rv[1];
    if (wid == 0) {
        float bsum = R.lf;
#pragma unroll
        for (int o = 1; o < 64; o <<= 1) { const float t = __uint_as_float((unsigned)__builtin_amdgcn_ds_bpermute((lane - o) << 2, (int)__float_as_uint(bsum))); if (lane >= o) bsum += t; }
        const float u = R.ig - bsum; float cm = u;
#pragma unroll
        for (int o = 1; o < 64; o <<= 1) { const float t = __uint_as_float((unsigned)__builtin_amdgcn_ds_bpermute((lane - o) << 2, (int)__float_as_uint(cm))); if (lane >= o) cm = fmaxf(cm, t); }
        LAS float* G = (LAS float*)(st + O_G);
        G[lane] = bsum; G[64 + lane] = u; G[128 + lane] = cm;
        if (lane == 63) { G[192] = bsum; G[193] = cm; }
    }
}

__device__ __forceinline__ void mlstm_unit(LAS unsigned char* lds, int b, int h, const bf16_t* __restrict__ QM, const bf16_t* __restrict__ KM, const bf16_t* __restrict__ VM, const bf16_t* __restrict__ OG,
                                           const float* __restrict__ IF, const float* __restrict__ convw, const float* __restrict__ convb, bf16_t* __restrict__ Y) {
    int tid_ = threadIdx.x; asm volatile("" : "+v"(tid_));
    const int tid = tid_, lane = tid & 63, fr = lane & 15, g = lane >> 4;
    const int wid = __builtin_amdgcn_readfirstlane(tid >> 6);
    LAS float* cw = (LAS float*)(lds + O_CW);
    for (int i = tid; i < 640; i += 512) { const int j = i >> 7, ch = i & 127; const int gch = (ch < 64) ? (h * 64 + ch) : (256 + h * 64 + ch - 64);
        cw[i] = (j < 4) ? convw[j * 512 + gch] : convb[gch]; }
    __syncthreads();
    StageRegs R;
    load_stage(R, b, h, 0, QM, KM, VM, OG, IF, tid);
    write_stage(R, lds, cw, tid);
    __syncthreads();
    f32x4 C[4][2];
#pragma unroll
    for (int kb = 0; kb < 4; ++kb) { C[kb][0] = (f32x4){0.f, 0.f, 0.f, 0.f}; C[kb][1] = (f32x4){0.f, 0.f, 0.f, 0.f}; }
    float m_prev = 0.f;
    const bf16x8 ones = {0x3F80, 0x3F80, 0x3F80, 0x3F80, 0x3F80, 0x3F80, 0x3F80, 0x3F80};
    const int trV = (fr >> 2) * VPITCH + (16 * wid + 4 * (fr & 3)) * 2;
    const int trK = (fr >> 2) * PITCH + (4 * (fr & 3)) * 2;
    for (int c = 0; c < cfg::NCHUNK; ++c) {
        const LAS unsigned char* st = lds + (c & 1) * STAGE;
        LAS unsigned char* stn = lds + ((c + 1) & 1) * STAGE;
        const u32x2 og0 = R.og[0], og1 = R.og[1], og2 = R.og[2], og3 = R.og[3];
        if (c + 1 < cfg::NCHUNK) load_stage(R, b, h, c + 1, QM, KM, VM, OG, IF, tid);
        const LAS float* G = (const LAS float*)(st + O_G);
        const float b_end = G[192], umax = G[193];
        bf16x8 Cf[2][2];
#pragma unroll
        for (int c2 = 0; c2 < 2; ++c2)
#pragma unroll
            for (int p2 = 0; p2 < 2; ++p2) { u32x4 w; w.x = cvtpk(C[2 * p2][c2][0], C[2 * p2][c2][1]); w.y = cvtpk(C[2 * p2][c2][2], C[2 * p2][c2][3]);
                w.z = cvtpk(C[2 * p2 + 1][c2][0], C[2 * p2 + 1][c2][1]); w.w = cvtpk(C[2 * p2 + 1][c2][2], C[2 * p2 + 1][c2][3]); Cf[c2][p2] = __builtin_bit_cast(bf16x8, w); }
        f32x4 hv[4]; float hsq[4];
#pragma unroll
        for (int lb = 0; lb < 4; ++lb) {
            const int l = 16 * lb + fr;
            const float wl = fmaxf(m_prev, G[128 + l]), bl = G[l];
            const LAS unsigned char* qrow = st + O_QN + l * PITCH;
            const bf16x8 qa0 = *(const LAS bf16x8*)(qrow + g * 16), qa1 = *(const LAS bf16x8*)(qrow + 64 + g * 16);
            u32x4 Pw[2] = {(u32x4){0u, 0u, 0u, 0u}, (u32x4){0u, 0u, 0u, 0u}};
#pragma unroll
            for (int sb = 0; sb <= lb; ++sb) {
                const LAS unsigned char* krow = st + O_KN + (16 * sb + fr) * PITCH;
                const bf16x8 ka0 = *(const LAS bf16x8*)(krow + g * 16), ka1 = *(const LAS bf16x8*)(krow + 64 + g * 16);
                f32x4 s4 = (f32x4){0.f, 0.f, 0.f, 0.f};
                s4 = __builtin_amdgcn_mfma_f32_16x16x32_bf16(ka0, qa0, s4, 0, 0, 0); s4 = __builtin_amdgcn_mfma_f32_16x16x32_bf16(ka1, qa1, s4, 0, 0, 0);
                const f32x4 u4 = *(const LAS f32x4*)(st + O_G + (64 + 16 * sb + 4 * g) * 4);
                float pv[4];
#pragma unroll
                for (int r = 0; r < 4; ++r) { float e = __builtin_amdgcn_exp2f((u4[r] - wl) * cfg::LOG2E) * s4[r]; if (sb == lb && 4 * g + r > fr) e = 0.f; pv[r] = e; }
                if (sb & 1) { Pw[sb >> 1].z = cvtpk(pv[0], pv[1]); Pw[sb >> 1].w = cvtpk(pv[2], pv[3]); } else { Pw[sb >> 1].x = cvtpk(pv[0], pv[1]); Pw[sb >> 1].y = cvtpk(pv[2], pv[3]); }
            }
            f32x4 H0 = (f32x4){0.f, 0.f, 0.f, 0.f}, H1 = H0, I0 = H0, I1 = H0;
#pragma unroll
            for (int p = 0; p <= (lb >> 1); ++p) {
                const LAS unsigned char* vblk = st + O_VN + (32 * p + 4 * g) * VPITCH + trV;
                const bf16x8 vf = cat8(trrd(vblk), trrd(vblk + 16 * VPITCH));
                const bf16x8 pf = __builtin_bit_cast(bf16x8, Pw[p]);
                H0 = __builtin_amdgcn_mfma_f32_16x16x32_bf16(vf, pf, H0, 0, 0, 0); H1 = __builtin_amdgcn_mfma_f32_16x16x32_bf16(ones, pf, H1, 0, 0, 0);
            }
#pragma unroll
            for (int p2 = 0; p2 < 2; ++p2) {
                const u32x2 qa = *(const LAS u32x2*)(qrow + (32 * p2 + 4 * g) * 2), qb2 = *(const LAS u32x2*)(qrow + (32 * p2 + 16 + 4 * g) * 2);
                const bf16x8 qp = __builtin_bit_cast(bf16x8, (u32x4){qa.x, qa.y, qb2.x, qb2.y});
                I0 = __builtin_amdgcn_mfma_f32_16x16x32_bf16(Cf[0][p2], qp, I0, 0, 0, 0); I1 = __builtin_amdgcn_mfma_f32_16x16x32_bf16(Cf[1][p2], qp, I1, 0, 0, 0);
            }
            const float ei = __builtin_amdgcn_exp2f((m_prev - wl) * cfg::LOG2E);
            const float den = ei * I1[0] + H1[0];
            const float bound = __builtin_amdgcn_exp2f(-(bl + wl) * cfg::LOG2E);
            const float rden = 1.f / fmaxf(fabsf(den), bound);
            float sq = 0.f;
#pragma unroll
            for (int r = 0; r < 4; ++r) { hv[lb][r] = (ei * I0[r] + H0[r]) * rden; sq += hv[lb][r] * hv[lb][r]; }
            hsq[lb] = pg8::quad_sum(sq);
        }
        { LAS float* hs = (LAS float*)(lds + O_HS) + (c & 1) * 512 + wid * 64;
          if (g == 0) {
#pragma unroll
              for (int lb = 0; lb < 4; ++lb) hs[16 * lb + fr] = hsq[lb]; } }
        { const float mx = fmaxf(m_prev, umax);
          const float d_old = __builtin_amdgcn_exp2f((m_prev - mx) * cfg::LOG2E), d_new = __builtin_amdgcn_exp2f((umax - mx) * cfg::LOG2E);
          m_prev = b_end + mx;
#pragma unroll
          for (int kb = 0; kb < 4; ++kb) { C[kb][0] = C[kb][0] * d_old; C[kb][1] = C[kb][1] * d_old; }
#pragma unroll
          for (int ks = 0; ks < 2; ++ks) {
              const f32x4 ua = *(const LAS f32x4*)(st + O_G + (64 + 32 * ks + 8 * g) * 4), ub = *(const LAS f32x4*)(st + O_G + (64 + 32 * ks + 8 * g + 4) * 4);
              float ee[8];
#pragma unroll
              for (int j = 0; j < 4; ++j) { ee[j] = __builtin_amdgcn_exp2f((ua[j] - umax) * cfg::LOG2E) * d_new; ee[4 + j] = __builtin_amdgcn_exp2f((ub[j] - umax) * cfg::LOG2E) * d_new; }
              const LAS unsigned char* vblk = st + O_VN + (32 * ks + 8 * g) * VPITCH + trV;
              const s16x4 va = trrd(vblk), vb4 = trrd(vblk + 4 * VPITCH);
              u32x4 ve, eo;
              ve.x = cvtpk(bf2f((unsigned short)va[0]) * ee[0], bf2f((unsigned short)va[1]) * ee[1]); ve.y = cvtpk(bf2f((unsigned short)va[2]) * ee[2], bf2f((unsigned short)va[3]) * ee[3]);
              ve.z = cvtpk(bf2f((unsigned short)vb4[0]) * ee[4], bf2f((unsigned short)vb4[1]) * ee[5]); ve.w = cvtpk(bf2f((unsigned short)vb4[2]) * ee[6], bf2f((unsigned short)vb4[3]) * ee[7]);
              eo.x = cvtpk(ee[0], ee[1]); eo.y = cvtpk(ee[2], ee[3]); eo.z = cvtpk(ee[4], ee[5]); eo.w = cvtpk(ee[6], ee[7]);
              const bf16x8 vef = __builtin_bit_cast(bf16x8, ve), eof = __builtin_bit_cast(bf16x8, eo);
#pragma unroll
              for (int kb = 0; kb < 4; ++kb) {
                  const LAS unsigned char* kblk = st + O_KN + (32 * ks + 8 * g) * PITCH + 32 * kb + trK;
                  const bf16x8 kt = cat8(trrd(kblk), trrd(kblk + 4 * PITCH));
                  C[kb][0] = __builtin_amdgcn_mfma_f32_16x16x32_bf16(kt, vef, C[kb][0], 0, 0, 0); C[kb][1] = __builtin_amdgcn_mfma_f32_16x16x32_bf16(kt, eof, C[kb][1], 0, 0, 0);
              }
          } }
        if (c + 1 < cfg::NCHUNK) write_stage(R, stn, cw, tid);
        asm volatile("s_waitcnt lgkmcnt(0)\n\ts_barrier" ::: "memory");
        { const LAS float* hsr = (const LAS float*)(lds + O_HS) + (c & 1) * 512;
          const size_t tok0 = (size_t)b * cfg::S + c * 64;
#pragma unroll
          for (int lb = 0; lb < 4; ++lb) { const int l = 16 * lb + fr; float tot = 0.f;
#pragma unroll
              for (int w = 0; w < 8; ++w) tot += hsr[w * 64 + l];
              const float rs = __builtin_amdgcn_rsqf(tot * (1.f / cfg::MDV) + cfg::EPS);
              const u32x2 og = (lb == 0) ? og0 : (lb == 1) ? og1 : (lb == 2) ? og2 : og3;
              u32x2 o; o.x = cvtpk(hv[lb][0] * rs * bflo(og.x), hv[lb][1] * rs * bfhi(og.x)); o.y = cvtpk(hv[lb][2] * rs * bflo(og.y), hv[lb][3] * rs * bfhi(og.y));
              *(u32x2*)(Y + (tok0 + l) * cfg::D + 512 + h * 128 + 16 * wid + 4 * g) = o; } }
    }
    __syncthreads();
}
}
#ifndef MK_PER_PHASE
#define MK_PER_PHASE 0
#endif
constexpr int LDS_BYTES = 147456, MISC_OFF = 131072 + 320, RSTAB_OFF = 131072 + 1024;
constexpr int NPHASE = 34;

struct Params { const float* in[24]; float* out; unsigned char* ws; int ph_lo, ph_hi, li, pad; };

struct MapId { __device__ __forceinline__ int operator()(int n) const { return n; } };
struct MapGate { int up; __device__ __forceinline__ int operator()(int n) const { return ((n >> 7) << 8) + up * 128 + (n & 127); } };
struct MapWin { __device__ __forceinline__ int operator()(int n) const {
    if (n < 384) return n;
    if (n < 416) { const int i = n - 384; return 384 + ((i < 16) ? 2 * i : 2 * (i - 16) + 1); }
    if (n < 1952) return n + 96;
    return n - 1952 + 416; } };
struct MapUq { __device__ __forceinline__ int operator()(int n) const { const int h = n / 96, d = n - h * 96; if (d < 64) return n; const int i = d - 64; return h * 96 + 64 + ((i < 16) ? 2 * i : 2 * (i - 16) + 1); } };
struct MapKv { __device__ __forceinline__ int operator()(int n) const { const int h = n >> 7, j = n & 127; return (j < 64) ? (h * 64 + j) : (512 + h * 64 + j - 64); } };
template <class Map> __device__ __forceinline__ void conv_item(const float* __restrict__ W, int K, int N, bf16_t* WT, const float* gA, const float* gB, int gsplit, const Map dst, LAS float* scr, int item, int lane) {
    const int nblk = (N + 31) >> 5, kb = item / nblk, nb = item - kb * nblk, k0 = 64 * kb, n0 = 32 * nb, n = n0 + 4 * (lane & 7);
#pragma unroll
    for (int i = 0; i < 8; ++i) { const int kk = 8 * i + (lane >> 3), k = k0 + kk; float gv = 1.f; if (gA) gv = (k < gsplit) ? gA[k] : gB[k - gsplit];
        f32x4 v = (f32x4){0.f, 0.f, 0.f, 0.f}; if (n < N) v = *(const f32x4*)(W + (size_t)k * N + n);
        LAS float* d = scr + kk * 33 + 4 * (lane & 7); d[0] = v[0] * gv; d[1] = v[1] * gv; d[2] = v[2] * gv; d[3] = v[3] * gv; }
    asm volatile("s_waitcnt lgkmcnt(0)" ::: "memory");
    const int c = lane & 7;
#pragma unroll
    for (int j = 0; j < 4; ++j) { const int nn = (lane >> 3) + 8 * j, nd = n0 + nn; const LAS float* s = scr + (8 * c) * 33 + nn;
        if (nd < N) { u32x4 o; o.x = cvtpk(s[0 * 33], s[1 * 33]); o.y = cvtpk(s[2 * 33], s[3 * 33]); o.z = cvtpk(s[4 * 33], s[5 * 33]); o.w = cvtpk(s[6 * 33], s[7 * 33]);
            *(u32x4*)(WT + (size_t)dst(nd) * K + k0 + 8 * c) = o; } }
    asm volatile("s_waitcnt lgkmcnt(0)" ::: "memory");
}
__device__ __forceinline__ float wave_sum(float v, int lane) {
#pragma unroll
    for (int o = 1; o < 64; o <<= 1) v += __uint_as_float((unsigned)__builtin_amdgcn_ds_bpermute((lane ^ o) << 2, (int)__float_as_uint(v)));
    return v;
}

__global__ void __launch_bounds__(512, 2) hymba_fwd(Params P) {
    extern __shared__ __attribute__((aligned(16))) unsigned char lds_raw[];
    LAS unsigned char* lds = (LAS unsigned char*)lds_raw;
    volatile LAS unsigned* MISC = (volatile LAS unsigned*)(lds + MISC_OFF);
    const int G = gridDim.x, bx = blockIdx.x;
#define LOCAL_TID() int tid = threadIdx.x; asm volatile("" : "+v"(tid)); const int lane = tid & 63, wave = __builtin_amdgcn_readfirstlane(tid >> 6), gw = bx * 8 + wave, NGW = G * 8; (void)lane; (void)gw; (void)NGW
    gu32* ctl = (gu32*)(P.ws + ws::CTL);
    { LOCAL_TID(); for (int u = tid; u < 32; u += 512) MISC[u] = 0u; }
    __syncthreads();
#if MK_PER_PHASE
    const int lo = P.ph_lo;
#else
    (void)xcd_barrier_post((unsigned*)ctl + ws::CW_BAR, MISC + 8);
#endif
#ifndef ATT_PROBE_VAR
#define ATT_PROBE_VAR 0
#endif
#ifndef PROBE_DOUBLE
#define PROBE_DOUBLE 0
#endif
#ifndef PH_MASK
#define PH_MASK 0xffff
#endif
#if MK_PER_PHASE
#define IN(k) (lo == (k))
#define SEAM(k) do { } while (0)
#else
#define IN(k) true
#define SEAM(k) do { XcdBarrier b_; unsigned* bp_ = (unsigned*)(P.ws + ws::CTL) + ws::CW_BAR; asm volatile("" : "+s"(bp_)); b_.bar = bp_; b_.x = (unsigned)__builtin_amdgcn_readfirstlane((int)xb_xcc_id()); b_.st = MISC + 8; xcd_barrier(b_); } while (0)
#endif
#define LAUNDER_W() GAS unsigned char* Wg_ = (GAS unsigned char*)P.ws; asm volatile("" : "+s"(Wg_)); unsigned char* W = (unsigned char*)Wg_

    if ((PH_MASK & 1) && IN(0)) {
        LOCAL_TID(); LAUNDER_W(); float* const ssqx = (float*)(W + ws::SSQX); bf16_t* const XBp = (bf16_t*)(W + ws::XB);
        LAS float* scr = (LAS float*)(lds + wave * 16384);
        constexpr int I_FF = 16 * 88, I_DN = 44 * 32, I_IN = 16 * 62, I_UQ = 4 * 24, I_KV = 2 * 32, I_O = 16 * 32;
        constexpr int I_LAYER = 4 * I_FF + 2 * I_DN + I_IN + I_UQ + I_KV + I_O;
        for (int it = gw; it < cfg::DEPTH * I_LAYER; it += NGW) {
            const int l = it / I_LAYER; int r = it - l * I_LAYER;
            unsigned char* wl = W + ws::WBASE + (size_t)l * ws::WLAYER;
            const size_t oFF = (size_t)l * cfg::D * cfg::FF;
            if (r < I_FF) { conv_item(P.in[3] + oFF, 1024, 2816, (bf16_t*)(wl + ws::W_GU1), P.in[2] + l * 1024, nullptr, 1024, MapGate{0}, scr, r, lane); continue; } r -= I_FF;
            if (r < I_FF) { conv_item(P.in[4] + oFF, 1024, 2816, (bf16_t*)(wl + ws::W_GU1), P.in[2] + l * 1024, nullptr, 1024, MapGate{1}, scr, r, lane); continue; } r -= I_FF;
            if (r < I_DN) { conv_item(P.in[5] + oFF, 2816, 1024, (bf16_t*)(wl + ws::W_D1), nullptr, nullptr, 0, MapId{}, scr, r, lane); continue; } r -= I_DN;
            if (r < I_FF) { conv_item(P.in[20] + oFF, 1024, 2816, (bf16_t*)(wl + ws::W_GU2), P.in[19] + l * 1024, nullptr, 1024, MapGate{0}, scr, r, lane); continue; } r -= I_FF;
            if (r < I_FF) { conv_item(P.in[21] + oFF, 1024, 2816, (bf16_t*)(wl + ws::W_GU2), P.in[19] + l * 1024, nullptr, 1024, MapGate{1}, scr, r, lane); continue; } r -= I_FF;
            if (r < I_DN) { conv_item(P.in[22] + oFF, 2816, 1024, (bf16_t*)(wl + ws::W_D2), nullptr, nullptr, 0, MapId{}, scr, r, lane); continue; } r -= I_DN;
            if (r < I_IN) { conv_item(P.in[7] + (size_t)l * 1024 * cfg::DIN, 1024, cfg::DIN, (bf16_t*)(wl + ws::W_IN), P.in[6] + l * 1024, nullptr, 1024, MapWin{}, scr, r, lane); continue; } r -= I_IN;
            if (r < I_UQ) { conv_item(P.in[9] + (size_t)l * 256 * 768, 256, 768, (bf16_t*)(wl + ws::W_UQ), P.in[8] + l * 256, nullptr, 256, MapUq{}, scr, r, lane); continue; } r -= I_UQ;
            if (r < I_KV) { conv_item(P.in[11] + (size_t)l * 128 * 1024, 128, 1024, (bf16_t*)(wl + ws::W_KV), P.in[10] + l * 128, nullptr, 128, MapKv{}, scr, r, lane); continue; } r -= I_KV;
            conv_item(P.in[18] + (size_t)l * 1024 * 1024, 1024, 1024, (bf16_t*)(wl + ws::W_O), P.in[16] + l * 512, P.in[17] + l * 512, 512, MapId{}, scr, r, lane);
        }
        for (int i = bx * 512 + tid; i < cfg::DEPTH * 88 * 128; i += G * 512) { const int l = i / (88 * 128), r = i - l * (88 * 128);
            *(u32x4*)(W + ws::WBASE + (size_t)l * ws::WLAYER + ws::W_IN + (size_t)424 * 2048 + (size_t)r * 16) = (u32x4){0u, 0u, 0u, 0u}; }
#ifdef NANFILL
        for (size_t i = (size_t)bx * 512 + tid; i < (NANFILL_BYTES >> 4); i += (size_t)G * 512) *(u32x4*)(W + NANFILL_OFF + i * 16) = (u32x4){0xffffffffu, 0xffffffffu, 0xffffffffu, 0xffffffffu};
#endif
        for (int i = bx * 512 + tid; i < cfg::DEPTH * 2568; i += G * 512) { const int l = i / 2568, r = i - l * 2568;
            const float v = (r < 2048) ? P.in[12][l * 2048 + r] : (r < 2560) ? P.in[13][l * 512 + r - 2048] : (r < 2564) ? P.in[14][l * 4 + r - 2560] : P.in[15][l * 4 + r - 2564];
            ((float*)(W + ws::SMALLP))[l * 4096 + r] = v; }
        for (int i = bx * 512 + tid; i < cfg::M * 16; i += G * 512) { const int tok = i >> 4, k = i & 15;
            const float inv = exp2f(-(float)k * (13.287712379549449f / 16.f)); const float ang = (float)((const int*)P.in[1])[tok] * inv;
            float sn, cs; sincosf(ang, &sn, &cs); ((f32x2*)(W + ws::ROPE))[i] = (f32x2){cs, sn}; }
        for (int m = gw; m < cfg::M; m += NGW) {
            const f32x4* xr = (const f32x4*)(P.in[0] + (size_t)m * cfg::D) + 4 * lane; f32x4 v[4]; float s = 0.f;
#pragma unroll
            for (int j = 0; j < 4; ++j) { v[j] = xr[j]; s += (v[j][0] * v[j][0] + v[j][1] * v[j][1]) + (v[j][2] * v[j][2] + v[j][3] * v[j][3]); }
            s = wave_sum(s, lane);
            u32x4* o16 = (u32x4*)(XBp + (size_t)m * cfg::D) + 2 * lane;
            o16[0] = (u32x4){cvtpk(v[0][0], v[0][1]), cvtpk(v[0][2], v[0][3]), cvtpk(v[1][0], v[1][1]), cvtpk(v[1][2], v[1][3])};
            o16[1] = (u32x4){cvtpk(v[2][0], v[2][1]), cvtpk(v[2][2], v[2][3]), cvtpk(v[3][0], v[3][1]), cvtpk(v[3][2], v[3][3])};
            if (lane < 16) ssqx[(size_t)m * 16 + lane] = (lane == 0) ? s : 0.f;
        }
        __syncthreads();
    }
    SEAM(0);
#if PROBE_DOUBLE == 9
    if ((PH_MASK & 1) && IN(0)) {
        LOCAL_TID(); LAUNDER_W(); float* const ssqx = (float*)(W + ws::SSQX); bf16_t* const XBp = (bf16_t*)(W + ws::XB);
        LAS float* scr = (LAS float*)(lds + wave * 16384);
        constexpr int I_FF = 16 * 88, I_DN = 44 * 32, I_IN = 16 * 62, I_UQ = 4 * 24, I_KV = 2 * 32, I_O = 16 * 32;
        constexpr int I_LAYER = 4 * I_FF + 2 * I_DN + I_IN + I_UQ + I_KV + I_O;
        for (int it = gw; it < cfg::DEPTH * I_LAYER; it += NGW) {
            const int l = it / I_LAYER; int r = it - l * I_LAYER;
            unsigned char* wl = W + ws::WBASE + (size_t)l * ws::WLAYER;
            const size_t oFF = (size_t)l * cfg::D * cfg::FF;
            if (r < I_FF) { conv_item(P.in[3] + oFF, 1024, 2816, (bf16_t*)(wl + ws::W_GU1), P.in[2] + l * 1024, nullptr, 1024, MapGate{0}, scr, r, lane); continue; } r -= I_FF;
            if (r < I_FF) { conv_item(P.in[4] + oFF, 1024, 2816, (bf16_t*)(wl + ws::W_GU1), P.in[2] + l * 1024, nullptr, 1024, MapGate{1}, scr, r, lane); continue; } r -= I_FF;
            if (r < I_DN) { conv_item(P.in[5] + oFF, 2816, 1024, (bf16_t*)(wl + ws::W_D1), nullptr, nullptr, 0, MapId{}, scr, r, lane); continue; } r -= I_DN;
            if (r < I_FF) { conv_item(P.in[20] + oFF, 1024, 2816, (bf16_t*)(wl + ws::W_GU2), P.in[19] + l * 1024, nullptr, 1024, MapGate{0}, scr, r, lane); continue; } r -= I_FF;
            if (r < I_FF) { conv_item(P.in[21] + oFF, 1024, 2816, (bf16_t*)(wl + ws::W_GU2), P.in[19] + l * 1024, nullptr, 1024, MapGate{1}, scr, r, lane); continue; } r -= I_FF;
            if (r < I_DN) { conv_item(P.in[22] + oFF, 2816, 1024, (bf16_t*)(wl + ws::W_D2), nullptr, nullptr, 0, MapId{}, scr, r, lane); continue; } r -= I_DN;
            if (r < I_IN) { conv_item(P.in[7] + (size_t)l * 1024 * cfg::DIN, 1024, cfg::DIN, (bf16_t*)(wl + ws::W_IN), P.in[6] + l * 1024, nullptr, 1024, MapWin{}, scr, r, lane); continue; } r -= I_IN;
            if (r < I_UQ) { conv_item(P.in[9] + (size_t)l * 256 * 768, 256, 768, (bf16_t*)(wl + ws::W_UQ), P.in[8] + l * 256, nullptr, 256, MapUq{}, scr, r, lane); continue; } r -= I_UQ;
            if (r < I_KV) { conv_item(P.in[11] + (size_t)l * 128 * 1024, 128, 1024, (bf16_t*)(wl + ws::W_KV), P.in[10] + l * 128, nullptr, 128, MapKv{}, scr, r, lane); continue; } r -= I_KV;
            conv_item(P.in[18] + (size_t)l * 1024 * 1024, 1024, 1024, (bf16_t*)(wl + ws::W_O), P.in[16] + l * 512, P.in[17] + l * 512, 512, MapId{}, scr, r, lane);
        }
        for (int i = bx * 512 + tid; i < cfg::DEPTH * 88 * 128; i += G * 512) { const int l = i / (88 * 128), r = i - l * (88 * 128);
            *(u32x4*)(W + ws::WBASE + (size_t)l * ws::WLAYER + ws::W_IN + (size_t)424 * 2048 + (size_t)r * 16) = (u32x4){0u, 0u, 0u, 0u}; }
#ifdef NANFILL
        for (size_t i = (size_t)bx * 512 + tid; i < (NANFILL_BYTES >> 4); i += (size_t)G * 512) *(u32x4*)(W + NANFILL_OFF + i * 16) = (u32x4){0xffffffffu, 0xffffffffu, 0xffffffffu, 0xffffffffu};
#endif
        for (int i = bx * 512 + tid; i < cfg::DEPTH * 2568; i += G * 512) { const int l = i / 2568, r = i - l * 2568;
            const float v = (r < 2048) ? P.in[12][l * 2048 + r] : (r < 2560) ? P.in[13][l * 512 + r - 2048] : (r < 2564) ? P.in[14][l * 4 + r - 2560] : P.in[15][l * 4 + r - 2564];
            ((float*)(W + ws::SMALLP))[l * 4096 + r] = v; }
        for (int i = bx * 512 + tid; i < cfg::M * 16; i += G * 512) { const int tok = i >> 4, k = i & 15;
            const float inv = exp2f(-(float)k * (13.287712379549449f / 16.f)); const float ang = (float)((const int*)P.in[1])[tok] * inv;
            float sn, cs; sincosf(ang, &sn, &cs); ((f32x2*)(W + ws::ROPE))[i] = (f32x2){cs, sn}; }
        for (int m = gw; m < cfg::M; m += NGW) {
            const f32x4* xr = (const f32x4*)(P.in[0] + (size_t)m * cfg::D) + lane; f32x4 v[4]; float s = 0.f;
#pragma unroll
            for (int j = 0; j < 4; ++j) { v[j] = xr[64 * j]; s += (v[j][0] * v[j][0] + v[j][1] * v[j][1]) + (v[j][2] * v[j][2] + v[j][3] * v[j][3]); }
            s = wave_sum(s, lane);
            u32x2* o8 = (u32x2*)(XBp + (size_t)m * cfg::D) + lane;
#pragma unroll
            for (int j = 0; j < 4; ++j) { u32x2 w; w.x = cvtpk(v[j][0], v[j][1]); w.y = cvtpk(v[j][2], v[j][3]); o8[64 * j] = w; }
            if (lane < 16) ssqx[(size_t)m * 16 + lane] = (lane == 0) ? s : 0.f;
        }
        __syncthreads();
    }
    SEAM(0);
#endif

    { constexpr int l = 0;
        const int pb = 1 + 8 * l;
        if ((PH_MASK & 2) && IN(pb + 0)) {
            LAUNDER_W(); unsigned char* wl = W + ws::WBASE + (size_t)l * ws::WLAYER;
            pg8::Gemm g{(const bf16_t*)(W + ws::XB), (const bf16_t*)(wl + ws::W_GU1), cfg::M, 2 * cfg::FF, cfg::D}; pg8::StaticOrder S; S.init(cfg::M, 2 * cfg::FF, G, bx);
            const int gid0_ = pg8::rstd_table((LAS float*)(lds + RSTAB_OFF), S, pg8::ssqx_buf(W, 3 * l), (int)threadIdx.x);
            pg8::EpiSwiGLU E{W, 3 * l, (const LAS float*)(lds + RSTAB_OFF), gid0_};
            pg8::gemm_phase<pg8::EpiSwiGLU, pg8::StaticOrder, true, true>(lds, g, S, E);
        }
        SEAM(pb + 0);
#if PROBE_DOUBLE == 1
        if ((PH_MASK & 2) && IN(pb + 0)) {
            LAUNDER_W(); unsigned char* wl = W + ws::WBASE + (size_t)l * ws::WLAYER;
            pg8::Gemm g{(const bf16_t*)(W + ws::XB), (const bf16_t*)(wl + ws::W_GU1), cfg::M, 2 * cfg::FF, cfg::D}; pg8::StaticOrder S; S.init(cfg::M, 2 * cfg::FF, G, bx);
            const int gid0_ = pg8::rstd_table((LAS float*)(lds + RSTAB_OFF), S, pg8::ssqx_buf(W, 3 * l), (int)threadIdx.x);
            pg8::EpiSwiGLU E{W, 3 * l, (const LAS float*)(lds + RSTAB_OFF), gid0_};
            pg8::gemm_phase<pg8::EpiSwiGLU, pg8::StaticOrder, true, true>(lds, g, S, E);
        }
        SEAM(pb + 0);
#endif
#if PROBE_DOUBLE == 11
        if ((PH_MASK & 2) && IN(pb + 0)) {
            LAUNDER_W(); unsigned char* wl = W + ws::WBASE + (size_t)l * ws::WLAYER;
            pg8::Gemm g{(const bf16_t*)(W + ws::XB), (const bf16_t*)(wl + ws::W_GU1), cfg::M, 2 * cfg::FF, cfg::D}; pg8::StaticOrder S; S.init(cfg::M, 2 * cfg::FF, G, bx);
            pg8::EpiNull E{P.out};
            pg8::gemm_phase<pg8::EpiNull, pg8::StaticOrder, true, true>(lds, g, S, E);
        }
        SEAM(pb + 0);
#endif
        if ((PH_MASK & 4) && IN(pb + 1)) {
            LAUNDER_W(); unsigned char* wl = W + ws::WBASE + (size_t)l * ws::WLAYER;
            pg8::Gemm g{(const bf16_t*)(W + ws::H), (const bf16_t*)(wl + ws::W_D1), cfg::M, cfg::D, cfg::FF}; pg8::StaticOrder S; S.init(cfg::M, cfg::D, G, bx);
            pg8::EpiResid E{W, 3 * l + 1, 0.5f};
            pg8::gemm_phase<pg8::EpiResid, pg8::StaticOrder, true, true>(lds, g, S, E);
        }
        SEAM(pb + 1);
#if PROBE_DOUBLE == 2
        if ((PH_MASK & 4) && IN(pb + 1)) {
            LAUNDER_W(); unsigned char* wl = W + ws::WBASE + (size_t)l * ws::WLAYER;
            pg8::Gemm g{(const bf16_t*)(W + ws::H), (const bf16_t*)(wl + ws::W_D1), cfg::M, cfg::D, cfg::FF}; pg8::StaticOrder S; S.init(cfg::M, cfg::D, G, bx);
            pg8::EpiResid E{W, 3 * l + 1, 0.0f};
            pg8::gemm_phase<pg8::EpiResid, pg8::StaticOrder, true, true>(lds, g, S, E);
        }
        SEAM(pb + 1);
#endif
        if ((PH_MASK & 8) && IN(pb + 2)) {
            LAUNDER_W(); unsigned char* wl = W + ws::WBASE + (size_t)l * ws::WLAYER;
            pg8::Gemm g{(const bf16_t*)(W + ws::XB), (const bf16_t*)(wl + ws::W_IN), cfg::M, cfg::DINP, cfg::D}; pg8::LatinOrder S; S.init(bx, 0, 8);
            pg8::EpiWin E{W, l};
            pg8::gemm_phase<pg8::EpiWin, pg8::LatinOrder, true, true>(lds, g, S, E);
        }
        SEAM(pb + 2);
#if PROBE_DOUBLE == 3
        if ((PH_MASK & 8) && IN(pb + 2)) {
            LAUNDER_W(); unsigned char* wl = W + ws::WBASE + (size_t)l * ws::WLAYER;
            pg8::Gemm g{(const bf16_t*)(W + ws::XB), (const bf16_t*)(wl + ws::W_IN), cfg::M, cfg::DINP, cfg::D}; pg8::StaticOrder S; S.init(cfg::M, cfg::DINP, G, bx);
            pg8::EpiWin E{W, l};
            pg8::gemm_phase<pg8::EpiWin, pg8::StaticOrder, true, true>(lds, g, S, E);
        }
        SEAM(pb + 2);
#endif
        if ((PH_MASK & (16 | 512 | 1024)) && IN(pb + 3)) {
            if (PH_MASK & 16) { LAUNDER_W(); unsigned char* wl = W + ws::WBASE + (size_t)l * ws::WLAYER;
              pg8::Gemm g{(const bf16_t*)(W + ws::CQ), (const bf16_t*)(wl + ws::W_UQ), cfg::M, 768, 256}; pg8::StaticOrder S; S.init(cfg::M, 768, G, bx);
              pg8::EpiQ E{W, l};
              pg8::gemm_phase<pg8::EpiQ, pg8::StaticOrder, true, true>(lds, g, S, E); }
            if (PH_MASK & 512) { LAUNDER_W(); unsigned char* wl = W + ws::WBASE + (size_t)l * ws::WLAYER;
              pg8::Gemm g{(const bf16_t*)(W + ws::CKV), (const bf16_t*)(wl + ws::W_KV), cfg::M, 512, 128}; pg8::StaticOrder S; S.init(cfg::M, 512, G, bx);
              pg8::EpiKN E{W, l};
              pg8::gemm_phase<pg8::EpiKN, pg8::StaticOrder, true, true>(lds, g, S, E); }
            if (PH_MASK & 1024) { LAUNDER_W(); unsigned char* wl = W + ws::WBASE + (size_t)l * ws::WLAYER;
              pg8::Gemm g{(const bf16_t*)(wl + ws::W_KV) + 512 * 128, (const bf16_t*)(W + ws::CKV), 512, cfg::M, 128}; pg8::StaticOrder S; S.init(512, cfg::M, G, bx);
              pg8::EpiVT E{W, l};
              pg8::gemm_phase<pg8::EpiVT, pg8::StaticOrder, true, true>(lds, g, S, E); }
        }
        SEAM(pb + 3);
#if PROBE_DOUBLE == 4
        if ((PH_MASK & (16 | 512 | 1024)) && IN(pb + 3)) {
            if (PH_MASK & 16) { LAUNDER_W(); unsigned char* wl = W + ws::WBASE + (size_t)l * ws::WLAYER;
              pg8::Gemm g{(const bf16_t*)(W + ws::CQ), (const bf16_t*)(wl + ws::W_UQ), cfg::M, 768, 256}; pg8::StaticOrder S; S.init(cfg::M, 768, G, bx);
              pg8::EpiQ E{W, l};
              pg8::gemm_phase<pg8::EpiQ, pg8::StaticOrder, true, true>(lds, g, S, E); }
            if (PH_MASK & 512) { LAUNDER_W(); unsigned char* wl = W + ws::WBASE + (size_t)l * ws::WLAYER;
              pg8::Gemm g{(const bf16_t*)(W + ws::CKV), (const bf16_t*)(wl + ws::W_KV), cfg::M, 512, 128}; pg8::StaticOrder S; S.init(cfg::M, 512, G, bx);
              pg8::EpiKN E{W, l};
              pg8::gemm_phase<pg8::EpiKN, pg8::StaticOrder, true, true>(lds, g, S, E); }
            if (PH_MASK & 1024) { LAUNDER_W(); unsigned char* wl = W + ws::WBASE + (size_t)l * ws::WLAYER;
              pg8::Gemm g{(const bf16_t*)(wl + ws::W_KV) + 512 * 128, (const bf16_t*)(W + ws::CKV), 512, cfg::M, 128}; pg8::StaticOrder S; S.init(512, cfg::M, G, bx);
              pg8::EpiVT E{W, l};
              pg8::gemm_phase<pg8::EpiVT, pg8::StaticOrder, true, true>(lds, g, S, E); }
        }
        SEAM(pb + 3);
#endif
        if ((PH_MASK & 96) && IN(pb + 4)) {
            LOCAL_TID(); LAUNDER_W(); const float* sp = (const float*)(W + ws::SMALLP) + l * 4096;
            const int x0 = (int)__builtin_amdgcn_readfirstlane((int)(xb_xcc_id() & 7u));
            for (int xs = 0; xs < 8; ++xs) {
                const int x = (x0 + xs) & 7;
                gu32* head = (gu32*)(W + ws::CTL) + ws::CW_QUEUE + (l * 8 + x) * 64 + 0 * 32;
                bool have = false; unsigned kp = 0u;
                for (;;) {
                    if (tid == 0) MISC[0] = have ? kp : __hip_atomic_fetch_add(head, 1u, __ATOMIC_RELAXED, __HIP_MEMORY_SCOPE_AGENT);
                    __syncthreads();
                    const int k = (int)MISC[0] + 0;
                    __syncthreads();
                    have = false;
                    if (k >= 200) break;
                    if (k < 8) { if (PH_MASK & 64) { const int u = x * 8 + k; mls::mlstm_unit(lds, u >> 2, u & 3, (const bf16_t*)(W + ws::QM), (const bf16_t*)(W + ws::KM), (const bf16_t*)(W + ws::VM), (const bf16_t*)(W + ws::OG),
                                                  (const float*)(W + ws::IFG), sp, sp + 2048, (bf16_t*)(W + ws::Y)); } }
                    else if (PH_MASK & 32) { const int a = k - 8; const int bhq = x * 16 + ((a < 64) ? (a & 15) : ((a - 64) & 15)); const int qa = (a < 64) ? (a >> 4) : 11 - ((a - 64) >> 4), qb2 = (a < 64) ? 15 - (a >> 4) : -1; att::attn_unit(lds, bhq, qa, qb2, (const bf16_t*)(W + ws::Q), (const bf16_t*)(W + ws::KF), (const bf16_t*)(W + ws::VT), (bf16_t*)(W + ws::Y), head, kp); have = true; }
                }
            }
        }
        SEAM(pb + 4);
#if PROBE_DOUBLE == 5
        if ((PH_MASK & 96) && IN(pb + 4)) {
            LOCAL_TID(); LAUNDER_W(); const float* sp = (const float*)(W + ws::SMALLP) + l * 4096;
            const int x0 = (int)__builtin_amdgcn_readfirstlane((int)(xb_xcc_id() & 7u));
            for (int xs = 0; xs < 8; ++xs) {
                const int x = (x0 + xs) & 7;
                gu32* head = (gu32*)(W + ws::CTL) + ws::CW_QUEUE + (l * 8 + x) * 64 + 1 * 32;
                for (;;) {
                    if (tid == 0) MISC[0] = __hip_atomic_fetch_add(head, 1u, __ATOMIC_RELAXED, __HIP_MEMORY_SCOPE_AGENT);
                    __syncthreads();
                    const int k = (int)MISC[0] + 0;
                    __syncthreads();
                    if (k >= 200) break;
                    if (k < 8) { if (PH_MASK & 64) { const int u = x * 8 + k; mls::mlstm_unit(lds, u >> 2, u & 3, (const bf16_t*)(W + ws::QM), (const bf16_t*)(W + ws::KM), (const bf16_t*)(W + ws::VM), (const bf16_t*)(W + ws::OG),
                                                  (const float*)(W + ws::IFG), sp, sp + 2048, (bf16_t*)(W + ws::Y)); } }
                    else if (PH_MASK & 32) { const int a = k - 8; const int bhq = x * 16 + ((a < 64) ? (a & 15) : ((a - 64) & 15)); const int qa = (a < 64) ? (a >> 4) : 11 - ((a - 64) >> 4), qb2 = (a < 64) ? 15 - (a >> 4) : -1; { unsigned kd_ = 0u; att::attn_unit(lds, bhq, qa, qb2, (const bf16_t*)(W + ws::Q), (const bf16_t*)(W + ws::KF), (const bf16_t*)(W + ws::VT), (bf16_t*)(W + ws::Y), head, kd_); } }
                }
            }
        }
        SEAM(pb + 4);
#endif
#if PROBE_DOUBLE == 7
        if ((PH_MASK & 96) && IN(pb + 4)) {
            LOCAL_TID(); LAUNDER_W(); const float* sp = (const float*)(W + ws::SMALLP) + l * 4096;
            const int x0 = (int)__builtin_amdgcn_readfirstlane((int)(xb_xcc_id() & 7u));
            for (int xs = 0; xs < 8; ++xs) {
                const int x = (x0 + xs) & 7;
                gu32* head = (gu32*)(W + ws::CTL) + ws::CW_QUEUE + (l * 8 + x) * 64 + 1 * 32;
                for (;;) {
                    if (tid == 0) MISC[0] = __hip_atomic_fetch_add(head, 1u, __ATOMIC_RELAXED, __HIP_MEMORY_SCOPE_AGENT);
                    __syncthreads();
                    const int k = (int)MISC[0] + 0;
                    __syncthreads();
                    if (k >= 8) break;
                    if (k < 8) { if (PH_MASK & 64) { const int u = x * 8 + k; mls::mlstm_unit(lds, u >> 2, u & 3, (const bf16_t*)(W + ws::QM), (const bf16_t*)(W + ws::KM), (const bf16_t*)(W + ws::VM), (const bf16_t*)(W + ws::OG),
                                                  (const float*)(W + ws::IFG), sp, sp + 2048, (bf16_t*)(W + ws::Y)); } }
                    else if (PH_MASK & 32) { const int a = k - 8; const int bhq = x * 16 + ((a < 64) ? (a & 15) : ((a - 64) & 15)); const int qa = (a < 64) ? (a >> 4) : 11 - ((a - 64) >> 4), qb2 = (a < 64) ? 15 - (a >> 4) : -1; { unsigned kd_ = 0u; att::attn_unit(lds, bhq, qa, qb2, (const bf16_t*)(W + ws::Q), (const bf16_t*)(W + ws::KF), (const bf16_t*)(W + ws::VT), (bf16_t*)(W + ws::Y), head, kd_); } }
                }
            }
        }
        SEAM(pb + 4);
#endif
#if PROBE_DOUBLE == 8
        if ((PH_MASK & 96) && IN(pb + 4)) {
            LOCAL_TID(); LAUNDER_W(); const float* sp = (const float*)(W + ws::SMALLP) + l * 4096;
            const int x0 = (int)__builtin_amdgcn_readfirstlane((int)(xb_xcc_id() & 7u));
            for (int xs = 0; xs < 8; ++xs) {
                const int x = (x0 + xs) & 7;
                gu32* head = (gu32*)(W + ws::CTL) + ws::CW_QUEUE + (l * 8 + x) * 64 + 1 * 32;
                for (;;) {
                    if (tid == 0) MISC[0] = __hip_atomic_fetch_add(head, 1u, __ATOMIC_RELAXED, __HIP_MEMORY_SCOPE_AGENT);
                    __syncthreads();
                    const int k = (int)MISC[0] + 8;
                    __syncthreads();
                    if (k >= 200) break;
                    if (k < 8) { if (PH_MASK & 64) { const int u = x * 8 + k; mls::mlstm_unit(lds, u >> 2, u & 3, (const bf16_t*)(W + ws::QM), (const bf16_t*)(W + ws::KM), (const bf16_t*)(W + ws::VM), (const bf16_t*)(W + ws::OG),
                                                  (const float*)(W + ws::IFG), sp, sp + 2048, (bf16_t*)(W + ws::Y)); } }
                    else if (PH_MASK & 32) { const int a = k - 8; const int bhq = x * 16 + ((a < 64) ? (a & 15) : ((a - 64) & 15)); const int qa = (a < 64) ? (a >> 4) : 11 - ((a - 64) >> 4), qb2 = (a < 64) ? 15 - (a >> 4) : -1; { unsigned kd_ = 0u; att::attn_unit(lds, bhq, qa, qb2, (const bf16_t*)(W + ws::Q), (const bf16_t*)(W + ws::KF), (const bf16_t*)(W + ws::VT), (bf16_t*)(W + ws::Y), head, kd_); } }
                }
            }
        }
        SEAM(pb + 4);
#endif
        if ((PH_MASK & 128) && IN(pb + 5)) {
            LAUNDER_W(); unsigned char* wl = W + ws::WBASE + (size_t)l * ws::WLAYER;
            pg8::Gemm g{(const bf16_t*)(W + ws::Y), (const bf16_t*)(wl + ws::W_O), cfg::M, cfg::D, cfg::D}; pg8::StaticOrder S; S.init(cfg::M, cfg::D, G, bx);
            pg8::EpiResid E{W, 3 * l + 2, 1.0f};
            pg8::gemm_phase<pg8::EpiResid, pg8::StaticOrder, true, true>(lds, g, S, E);
        }
        SEAM(pb + 5);
#if PROBE_DOUBLE == 6
        if ((PH_MASK & 128) && IN(pb + 5)) {
            LAUNDER_W(); unsigned char* wl = W + ws::WBASE + (size_t)l * ws::WLAYER;
            pg8::Gemm g{(const bf16_t*)(W + ws::Y), (const bf16_t*)(wl + ws::W_O), cfg::M, cfg::D, cfg::D}; pg8::StaticOrder S; S.init(cfg::M, cfg::D, G, bx);
            pg8::EpiResid E{W, 3 * l + 2, 0.0f};
            pg8::gemm_phase<pg8::EpiResid, pg8::StaticOrder, true, true>(lds, g, S, E);
        }
        SEAM(pb + 5);
#endif
        if ((PH_MASK & 2) && IN(pb + 6)) {
            LAUNDER_W(); unsigned char* wl = W + ws::WBASE + (size_t)l * ws::WLAYER;
            pg8::Gemm g{(const bf16_t*)(W + ws::XB), (const bf16_t*)(wl + ws::W_GU2), cfg::M, 2 * cfg::FF, cfg::D}; pg8::StaticOrder S; S.init(cfg::M, 2 * cfg::FF, G, bx);
            const int gid0_ = pg8::rstd_table((LAS float*)(lds + RSTAB_OFF), S, pg8::ssqx_buf(W, 3 * l + 2), (int)threadIdx.x);
            pg8::EpiSwiGLU E{W, 3 * l + 2, (const LAS float*)(lds + RSTAB_OFF), gid0_};
            pg8::gemm_phase<pg8::EpiSwiGLU, pg8::StaticOrder, true, true>(lds, g, S, E);
        }
        SEAM(pb + 6);
        if ((PH_MASK & 4) && IN(pb + 7)) {
            LAUNDER_W(); unsigned char* wl = W + ws::WBASE + (size_t)l * ws::WLAYER;
            pg8::Gemm g{(const bf16_t*)(W + ws::H), (const bf16_t*)(wl + ws::W_D2), cfg::M, cfg::D, cfg::FF}; pg8::StaticOrder S; S.init(cfg::M, cfg::D, G, bx);
            pg8::EpiResid E{W, 3 * l + 3, 0.5f};
            pg8::gemm_phase<pg8::EpiResid, pg8::StaticOrder, true, true>(lds, g, S, E);
        }
        SEAM(pb + 7);
        }
    { constexpr int l = 1;
        const int pb = 1 + 8 * l;
        if ((PH_MASK & 2) && IN(pb + 0)) {
            LAUNDER_W(); unsigned char* wl = W + ws::WBASE + (size_t)l * ws::WLAYER;
            pg8::Gemm g{(const bf16_t*)(W + ws::XB), (const bf16_t*)(wl + ws::W_GU1), cfg::M, 2 * cfg::FF, cfg::D}; pg8::StaticOrder S; S.init(cfg::M, 2 * cfg::FF, G, bx);
            const int gid0_ = pg8::rstd_table((LAS float*)(lds + RSTAB_OFF), S, pg8::ssqx_buf(W, 3 * l), (int)threadIdx.x);
            pg8::EpiSwiGLU E{W, 3 * l, (const LAS float*)(lds + RSTAB_OFF), gid0_};
            pg8::gemm_phase<pg8::EpiSwiGLU, pg8::StaticOrder, true, true>(lds, g, S, E);
        }
        SEAM(pb + 0);
#if PROBE_DOUBLE == 1
        if ((PH_MASK & 2) && IN(pb + 0)) {
            LAUNDER_W(); unsigned char* wl = W + ws::WBASE + (size_t)l * ws::WLAYER;
            pg8::Gemm g{(const bf16_t*)(W + ws::XB), (const bf16_t*)(wl + ws::W_GU1), cfg::M, 2 * cfg::FF, cfg::D}; pg8::StaticOrder S; S.init(cfg::M, 2 * cfg::FF, G, bx);
            const int gid0_ = pg8::rstd_table((LAS float*)(lds + RSTAB_OFF), S, pg8::ssqx_buf(W, 3 * l), (int)threadIdx.x);
            pg8::EpiSwiGLU E{W, 3 * l, (const LAS float*)(lds + RSTAB_OFF), gid0_};
            pg8::gemm_phase<pg8::EpiSwiGLU, pg8::StaticOrder, true, true>(lds, g, S, E);
        }
        SEAM(pb + 0);
#endif
#if PROBE_DOUBLE == 11
        if ((PH_MASK & 2) && IN(pb + 0)) {
            LAUNDER_W(); unsigned char* wl = W + ws::WBASE + (size_t)l * ws::WLAYER;
            pg8::Gemm g{(const bf16_t*)(W + ws::XB), (const bf16_t*)(wl + ws::W_GU1), cfg::M, 2 * cfg::FF, cfg::D}; pg8::StaticOrder S; S.init(cfg::M, 2 * cfg::FF, G, bx);
            pg8::EpiNull E{P.out};
            pg8::gemm_phase<pg8::EpiNull, pg8::StaticOrder, true, true>(lds, g, S, E);
        }
        SEAM(pb + 0);
#endif
        if ((PH_MASK & 4) && IN(pb + 1)) {
            LAUNDER_W(); unsigned char* wl = W + ws::WBASE + (size_t)l * ws::WLAYER;
            pg8::Gemm g{(const bf16_t*)(W + ws::H), (const bf16_t*)(wl + ws::W_D1), cfg::M, cfg::D, cfg::FF}; pg8::StaticOrder S; S.init(cfg::M, cfg::D, G, bx);
            pg8::EpiResid E{W, 3 * l + 1, 0.5f};
            pg8::gemm_phase<pg8::EpiResid, pg8::StaticOrder, true, true>(lds, g, S, E);
        }
        SEAM(pb + 1);
#if PROBE_DOUBLE == 2
        if ((PH_MASK & 4) && IN(pb + 1)) {
            LAUNDER_W(); unsigned char* wl = W + ws::WBASE + (size_t)l * ws::WLAYER;
            pg8::Gemm g{(const bf16_t*)(W + ws::H), (const bf16_t*)(wl + ws::W_D1), cfg::M, cfg::D, cfg::FF}; pg8::StaticOrder S; S.init(cfg::M, cfg::D, G, bx);
            pg8::EpiResid E{W, 3 * l + 1, 0.0f};
            pg8::gemm_phase<pg8::EpiResid, pg8::StaticOrder, true, true>(lds, g, S, E);
        }
        SEAM(pb + 1);
#endif
        if ((PH_MASK & 8) && IN(pb + 2)) {
            LAUNDER_W(); unsigned char* wl = W + ws::WBASE + (size_t)l * ws::WLAYER;
            pg8::Gemm g{(const bf16_t*)(W + ws::XB), (const bf16_t*)(wl + ws::W_IN), cfg::M, cfg::DINP, cfg::D}; pg8::LatinOrder S; S.init(bx, 0, 8);
            pg8::EpiWin E{W, l};
            pg8::gemm_phase<pg8::EpiWin, pg8::LatinOrder, true, true>(lds, g, S, E);
        }
        SEAM(pb + 2);
#if PROBE_DOUBLE == 3
        if ((PH_MASK & 8) && IN(pb + 2)) {
            LAUNDER_W(); unsigned char* wl = W + ws::WBASE + (size_t)l * ws::WLAYER;
            pg8::Gemm g{(const bf16_t*)(W + ws::XB), (const bf16_t*)(wl + ws::W_IN), cfg::M, cfg::DINP, cfg::D}; pg8::StaticOrder S; S.init(cfg::M, cfg::DINP, G, bx);
            pg8::EpiWin E{W, l};
            pg8::gemm_phase<pg8::EpiWin, pg8::StaticOrder, true, true>(lds, g, S, E);
        }
        SEAM(pb + 2);
#endif
        if ((PH_MASK & (16 | 512 | 1024)) && IN(pb + 3)) {
            if (PH_MASK & 16) { LAUNDER_W(); unsigned char* wl = W + ws::WBASE + (size_t)l * ws::WLAYER;
              pg8::Gemm g{(const bf16_t*)(W + ws::CQ), (const bf16_t*)(wl + ws::W_UQ), cfg::M, 768, 256}; pg8::StaticOrder S; S.init(cfg::M, 768, G, bx);
              pg8::EpiQ E{W, l};
              pg8::gemm_phase<pg8::EpiQ, pg8::StaticOrder, true, true>(lds, g, S, E); }
            if (PH_MASK & 512) { LAUNDER_W(); unsigned char* wl = W + ws::WBASE + (size_t)l * ws::WLAYER;
              pg8::Gemm g{(const bf16_t*)(W + ws::CKV), (const bf16_t*)(wl + ws::W_KV), cfg::M, 512, 128}; pg8::StaticOrder S; S.init(cfg::M, 512, G, bx);
              pg8::EpiKN E{W, l};
              pg8::gemm_phase<pg8::EpiKN, pg8::StaticOrder, true, true>(lds, g, S, E); }
            if (PH_MASK & 1024) { LAUNDER_W(); unsigned char* wl = W + ws::WBASE + (size_t)l * ws::WLAYER;
              pg8::Gemm g{(const bf16_t*)(wl + ws::W_KV) + 512 * 128, (const bf16_t*)(W + ws::CKV), 512, cfg::M, 128}; pg8::StaticOrder S; S.init(512, cfg::M, G, bx);
              pg8::EpiVT E{W, l};
              pg8::gemm_phase<pg8::EpiVT, pg8::StaticOrder, true, true>(lds, g, S, E); }
        }
        SEAM(pb + 3);
#if PROBE_DOUBLE == 4
        if ((PH_MASK & (16 | 512 | 1024)) && IN(pb + 3)) {
            if (PH_MASK & 16) { LAUNDER_W(); unsigned char* wl = W + ws::WBASE + (size_t)l * ws::WLAYER;
              pg8::Gemm g{(const bf16_t*)(W + ws::CQ), (const bf16_t*)(wl + ws::W_UQ), cfg::M, 768, 256}; pg8::StaticOrder S; S.init(cfg::M, 768, G, bx);
              pg8::EpiQ E{W, l};
              pg8::gemm_phase<pg8::EpiQ, pg8::StaticOrder, true, true>(lds, g, S, E); }
            if (PH_MASK & 512) { LAUNDER_W(); unsigned char* wl = W + ws::WBASE + (size_t)l * ws::WLAYER;
              pg8::Gemm g{(const bf16_t*)(W + ws::CKV), (const bf16_t*)(wl + ws::W_KV), cfg::M, 512, 128}; pg8::StaticOrder S; S.init(cfg::M, 512, G, bx);
              pg8::EpiKN E{W, l};
              pg8::gemm_phase<pg8::EpiKN, pg8::StaticOrder, true, true>(lds, g, S, E); }
            if (PH_MASK & 1024) { LAUNDER_W(); unsigned char* wl = W + ws::WBASE + (size_t)l * ws::WLAYER;
              pg8::Gemm g{(const bf16_t*)(wl + ws::W_KV) + 512 * 128, (const bf16_t*)(W + ws::CKV), 512, cfg::M, 128}; pg8::StaticOrder S; S.init(512, cfg::M, G, bx);
              pg8::EpiVT E{W, l};
              pg8::gemm_phase<pg8::EpiVT, pg8::StaticOrder, true, true>(lds, g, S, E); }
        }
        SEAM(pb + 3);
#endif
        if ((PH_MASK & 96) && IN(pb + 4)) {
            LOCAL_TID(); LAUNDER_W(); const float* sp = (const float*)(W + ws::SMALLP) + l * 4096;
            const int x0 = (int)__builtin_amdgcn_readfirstlane((int)(xb_xcc_id() & 7u));
            for (int xs = 0; xs < 8; ++xs) {
                const int x = (x0 + xs) & 7;
                gu32* head = (gu32*)(W + ws::CTL) + ws::CW_QUEUE + (l * 8 + x) * 64 + 0 * 32;
                bool have = false; unsigned kp = 0u;
                for (;;) {
                    if (tid == 0) MISC[0] = have ? kp : __hip_atomic_fetch_add(head, 1u, __ATOMIC_RELAXED, __HIP_MEMORY_SCOPE_AGENT);
                    __syncthreads();
                    const int k = (int)MISC[0] + 0;
                    __syncthreads();
                    have = false;
                    if (k >= 200) break;
                    if (k < 8) { if (PH_MASK & 64) { const int u = x * 8 + k; mls::mlstm_unit(lds, u >> 2, u & 3, (const bf16_t*)(W + ws::QM), (const bf16_t*)(W + ws::KM), (const bf16_t*)(W + ws::VM), (const bf16_t*)(W + ws::OG),
                                                  (const float*)(W + ws::IFG), sp, sp + 2048, (bf16_t*)(W + ws::Y)); } }
                    else if (PH_MASK & 32) { const int a = k - 8; const int bhq = x * 16 + ((a < 64) ? (a & 15) : ((a - 64) & 15)); const int qa = (a < 64) ? (a >> 4) : 11 - ((a - 64) >> 4), qb2 = (a < 64) ? 15 - (a >> 4) : -1; att::attn_unit(lds, bhq, qa, qb2, (const bf16_t*)(W + ws::Q), (const bf16_t*)(W + ws::KF), (const bf16_t*)(W + ws::VT), (bf16_t*)(W + ws::Y), head, kp); have = true; }
                }
            }
        }
        SEAM(pb + 4);
#if PROBE_DOUBLE == 5
        if ((PH_MASK & 96) && IN(pb + 4)) {
            LOCAL_TID(); LAUNDER_W(); const float* sp = (const float*)(W + ws::SMALLP) + l * 4096;
            const int x0 = (int)__builtin_amdgcn_readfirstlane((int)(xb_xcc_id() & 7u));
            for (int xs = 0; xs < 8; ++xs) {
                const int x = (x0 + xs) & 7;
                gu32* head = (gu32*)(W + ws::CTL) + ws::CW_QUEUE + (l * 8 + x) * 64 + 1 * 32;
                for (;;) {
                    if (tid == 0) MISC[0] = __hip_atomic_fetch_add(head, 1u, __ATOMIC_RELAXED, __HIP_MEMORY_SCOPE_AGENT);
                    __syncthreads();
                    const int k = (int)MISC[0] + 0;
                    __syncthreads();
                    if (k >= 200) break;
                    if (k < 8) { if (PH_MASK & 64) { const int u = x * 8 + k; mls::mlstm_unit(lds, u >> 2, u & 3, (const bf16_t*)(W + ws::QM), (const bf16_t*)(W + ws::KM), (const bf16_t*)(W + ws::VM), (const bf16_t*)(W + ws::OG),
                                                  (const float*)(W + ws::IFG), sp, sp + 2048, (bf16_t*)(W + ws::Y)); } }
                    else if (PH_MASK & 32) { const int a = k - 8; const int bhq = x * 16 + ((a < 64) ? (a & 15) : ((a - 64) & 15)); const int qa = (a < 64) ? (a >> 4) : 11 - ((a - 64) >> 4), qb2 = (a < 64) ? 15 - (a >> 4) : -1; { unsigned kd_ = 0u; att::attn_unit(lds, bhq, qa, qb2, (const bf16_t*)(W + ws::Q), (const bf16_t*)(W + ws::KF), (const bf16_t*)(W + ws::VT), (bf16_t*)(W + ws::Y), head, kd_); } }
                }
            }
        }
        SEAM(pb + 4);
#endif
#if PROBE_DOUBLE == 7
        if ((PH_MASK & 96) && IN(pb + 4)) {
            LOCAL_TID(); LAUNDER_W(); const float* sp = (const float*)(W + ws::SMALLP) + l * 4096;
            const int x0 = (int)__builtin_amdgcn_readfirstlane((int)(xb_xcc_id() & 7u));
            for (int xs = 0; xs < 8; ++xs) {
                const int x = (x0 + xs) & 7;
                gu32* head = (gu32*)(W + ws::CTL) + ws::CW_QUEUE + (l * 8 + x) * 64 + 1 * 32;
                for (;;) {
                    if (tid == 0) MISC[0] = __hip_atomic_fetch_add(head, 1u, __ATOMIC_RELAXED, __HIP_MEMORY_SCOPE_AGENT);
                    __syncthreads();
                    const int k = (int)MISC[0] + 0;
                    __syncthreads();
                    if (k >= 8) break;
                    if (k < 8) { if (PH_MASK & 64) { const int u = x * 8 + k; mls::mlstm_unit(lds, u >> 2, u & 3, (const bf16_t*)(W + ws::QM), (const bf16_t*)(W + ws::KM), (const bf16_t*)(W + ws::VM), (const bf16_t*)(W + ws::OG),
                                                  (const float*)(W + ws::IFG), sp, sp + 2048, (bf16_t*)(W + ws::Y)); } }
                    else if (PH_MASK & 32) { const int a = k - 8; const int bhq = x * 16 + ((a < 64) ? (a & 15) : ((a - 64) & 15)); const int qa = (a < 64) ? (a >> 4) : 11 - ((a - 64) >> 4), qb2 = (a < 64) ? 15 - (a >> 4) : -1; { unsigned kd_ = 0u; att::attn_unit(lds, bhq, qa, qb2, (const bf16_t*)(W + ws::Q), (const bf16_t*)(W + ws::KF), (const bf16_t*)(W + ws::VT), (bf16_t*)(W + ws::Y), head, kd_); } }
                }
            }
        }
        SEAM(pb + 4);
#endif
#if PROBE_DOUBLE == 8
        if ((PH_MASK & 96) && IN(pb + 4)) {
            LOCAL_TID(); LAUNDER_W(); const float* sp = (const float*)(W + ws::SMALLP) + l * 4096;
            const int x0 = (int)__builtin_amdgcn_readfirstlane((int)(xb_xcc_id() & 7u));
            for (int xs = 0; xs < 8; ++xs) {
                const int x = (x0 + xs) & 7;
                gu32* head = (gu32*)(W + ws::CTL) + ws::CW_QUEUE + (l * 8 + x) * 64 + 1 * 32;
                for (;;) {
                    if (tid == 0) MISC[0] = __hip_atomic_fetch_add(head, 1u, __ATOMIC_RELAXED, __HIP_MEMORY_SCOPE_AGENT);
                    __syncthreads();
                    const int k = (int)MISC[0] + 8;
                    __syncthreads();
                    if (k >= 200) break;
                    if (k < 8) { if (PH_MASK & 64) { const int u = x * 8 + k; mls::mlstm_unit(lds, u >> 2, u & 3, (const bf16_t*)(W + ws::QM), (const bf16_t*)(W + ws::KM), (const bf16_t*)(W + ws::VM), (const bf16_t*)(W + ws::OG),
                                                  (const float*)(W + ws::IFG), sp, sp + 2048, (bf16_t*)(W + ws::Y)); } }
                    else if (PH_MASK & 32) { const int a = k - 8; const int bhq = x * 16 + ((a < 64) ? (a & 15) : ((a - 64) & 15)); const int qa = (a < 64) ? (a >> 4) : 11 - ((a - 64) >> 4), qb2 = (a < 64) ? 15 - (a >> 4) : -1; { unsigned kd_ = 0u; att::attn_unit(lds, bhq, qa, qb2, (const bf16_t*)(W + ws::Q), (const bf16_t*)(W + ws::KF), (const bf16_t*)(W + ws::VT), (bf16_t*)(W + ws::Y), head, kd_); } }
                }
            }
        }
        SEAM(pb + 4);
#endif
        if ((PH_MASK & 128) && IN(pb + 5)) {
            LAUNDER_W(); unsigned char* wl = W + ws::WBASE + (size_t)l * ws::WLAYER;
            pg8::Gemm g{(const bf16_t*)(W + ws::Y), (const bf16_t*)(wl + ws::W_O), cfg::M, cfg::D, cfg::D}; pg8::StaticOrder S; S.init(cfg::M, cfg::D, G, bx);
            pg8::EpiResid E{W, 3 * l + 2, 1.0f};
            pg8::gemm_phase<pg8::EpiResid, pg8::StaticOrder, true, true>(lds, g, S, E);
        }
        SEAM(pb + 5);
#if PROBE_DOUBLE == 6
        if ((PH_MASK & 128) && IN(pb + 5)) {
            LAUNDER_W(); unsigned char* wl = W + ws::WBASE + (size_t)l * ws::WLAYER;
            pg8::Gemm g{(const bf16_t*)(W + ws::Y), (const bf16_t*)(wl + ws::W_O), cfg::M, cfg::D, cfg::D}; pg8::StaticOrder S; S.init(cfg::M, cfg::D, G, bx);
            pg8::EpiResid E{W, 3 * l + 2, 0.0f};
            pg8::gemm_phase<pg8::EpiResid, pg8::StaticOrder, true, true>(lds, g, S, E);
        }
        SEAM(pb + 5);
#endif
        if ((PH_MASK & 2) && IN(pb + 6)) {
            LAUNDER_W(); unsigned char* wl = W + ws::WBASE + (size_t)l * ws::WLAYER;
            pg8::Gemm g{(const bf16_t*)(W + ws::XB), (const bf16_t*)(wl + ws::W_GU2), cfg::M, 2 * cfg::FF, cfg::D}; pg8::StaticOrder S; S.init(cfg::M, 2 * cfg::FF, G, bx);
            const int gid0_ = pg8::rstd_table((LAS float*)(lds + RSTAB_OFF), S, pg8::ssqx_buf(W, 3 * l + 2), (int)threadIdx.x);
            pg8::EpiSwiGLU E{W, 3 * l + 2, (const LAS float*)(lds + RSTAB_OFF), gid0_};
            pg8::gemm_phase<pg8::EpiSwiGLU, pg8::StaticOrder, true, true>(lds, g, S, E);
        }
        SEAM(pb + 6);
        if ((PH_MASK & 4) && IN(pb + 7)) {
            LAUNDER_W(); unsigned char* wl = W + ws::WBASE + (size_t)l * ws::WLAYER;
            pg8::Gemm g{(const bf16_t*)(W + ws::H), (const bf16_t*)(wl + ws::W_D2), cfg::M, cfg::D, cfg::FF}; pg8::StaticOrder S; S.init(cfg::M, cfg::D, G, bx);
            pg8::EpiResid E{W, 3 * l + 3, 0.5f};
            pg8::gemm_phase<pg8::EpiResid, pg8::StaticOrder, true, true>(lds, g, S, E);
        }
        SEAM(pb + 7);
        }
    { constexpr int l = 2;
        const int pb = 1 + 8 * l;
        if ((PH_MASK & 2) && IN(pb + 0)) {
            LAUNDER_W(); unsigned char* wl = W + ws::WBASE + (size_t)l * ws::WLAYER;
            pg8::Gemm g{(const bf16_t*)(W + ws::XB), (const bf16_t*)(wl + ws::W_GU1), cfg::M, 2 * cfg::FF, cfg::D}; pg8::StaticOrder S; S.init(cfg::M, 2 * cfg::FF, G, bx);
            const int gid0_ = pg8::rstd_table((LAS float*)(lds + RSTAB_OFF), S, pg8::ssqx_buf(W, 3 * l), (int)threadIdx.x);
            pg8::EpiSwiGLU E{W, 3 * l, (const LAS float*)(lds + RSTAB_OFF), gid0_};
            pg8::gemm_phase<pg8::EpiSwiGLU, pg8::StaticOrder, true, true>(lds, g, S, E);
        }
        SEAM(pb + 0);
#if PROBE_DOUBLE == 1
        if ((PH_MASK & 2) && IN(pb + 0)) {
            LAUNDER_W(); unsigned char* wl = W + ws::WBASE + (size_t)l * ws::WLAYER;
            pg8::Gemm g{(const bf16_t*)(W + ws::XB), (const bf16_t*)(wl + ws::W_GU1), cfg::M, 2 * cfg::FF, cfg::D}; pg8::StaticOrder S; S.init(cfg::M, 2 * cfg::FF, G, bx);
            const int gid0_ = pg8::rstd_table((LAS float*)(lds + RSTAB_OFF), S, pg8::ssqx_buf(W, 3 * l), (int)threadIdx.x);
            pg8::EpiSwiGLU E{W, 3 * l, (const LAS float*)(lds + RSTAB_OFF), gid0_};
            pg8::gemm_phase<pg8::EpiSwiGLU, pg8::StaticOrder, true, true>(lds, g, S, E);
        }
        SEAM(pb + 0);
#endif
#if PROBE_DOUBLE == 11
        if ((PH_MASK & 2) && IN(pb + 0)) {
            LAUNDER_W(); unsigned char* wl = W + ws::WBASE + (size_t)l * ws::WLAYER;
            pg8::Gemm g{(const bf16_t*)(W + ws::XB), (const bf16_t*)(wl + ws::W_GU1), cfg::M, 2 * cfg::FF, cfg::D}; pg8::StaticOrder S; S.init(cfg::M, 2 * cfg::FF, G, bx);
            pg8::EpiNull E{P.out};
            pg8::gemm_phase<pg8::EpiNull, pg8::StaticOrder, true, true>(lds, g, S, E);
        }
        SEAM(pb + 0);
#endif
        if ((PH_MASK & 4) && IN(pb + 1)) {
            LAUNDER_W(); unsigned char* wl = W + ws::WBASE + (size_t)l * ws::WLAYER;
            pg8::Gemm g{(const bf16_t*)(W + ws::H), (const bf16_t*)(wl + ws::W_D1), cfg::M, cfg::D, cfg::FF}; pg8::StaticOrder S; S.init(cfg::M, cfg::D, G, bx);
            pg8::EpiResid E{W, 3 * l + 1, 0.5f};
            pg8::gemm_phase<pg8::EpiResid, pg8::StaticOrder, true, true>(lds, g, S, E);
        }
        SEAM(pb + 1);
#if PROBE_DOUBLE == 2
        if ((PH_MASK & 4) && IN(pb + 1)) {
            LAUNDER_W(); unsigned char* wl = W + ws::WBASE + (size_t)l * ws::WLAYER;
            pg8::Gemm g{(const bf16_t*)(W + ws::H), (const bf16_t*)(wl + ws::W_D1), cfg::M, cfg::D, cfg::FF}; pg8::StaticOrder S; S.init(cfg::M, cfg::D, G, bx);
            pg8::EpiResid E{W, 3 * l + 1, 0.0f};
            pg8::gemm_phase<pg8::EpiResid, pg8::StaticOrder, true, true>(lds, g, S, E);
        }
        SEAM(pb + 1);
#endif
        if ((PH_MASK & 8) && IN(pb + 2)) {
            LAUNDER_W(); unsigned char* wl = W + ws::WBASE + (size_t)l * ws::WLAYER;
            pg8::Gemm g{(const bf16_t*)(W + ws::XB), (const bf16_t*)(wl + ws::W_IN), cfg::M, cfg::DINP, cfg::D}; pg8::LatinOrder S; S.init(bx, 0, 8);
            pg8::EpiWin E{W, l};
            pg8::gemm_phase<pg8::EpiWin, pg8::LatinOrder, true, true>(lds, g, S, E);
        }
        SEAM(pb + 2);
#if PROBE_DOUBLE == 3
        if ((PH_MASK & 8) && IN(pb + 2)) {
            LAUNDER_W(); unsigned char* wl = W + ws::WBASE + (size_t)l * ws::WLAYER;
            pg8::Gemm g{(const bf16_t*)(W + ws::XB), (const bf16_t*)(wl + ws::W_IN), cfg::M, cfg::DINP, cfg::D}; pg8::StaticOrder S; S.init(cfg::M, cfg::DINP, G, bx);
            pg8::EpiWin E{W, l};
            pg8::gemm_phase<pg8::EpiWin, pg8::StaticOrder, true, true>(lds, g, S, E);
        }
        SEAM(pb + 2);
#endif
        if ((PH_MASK & (16 | 512 | 1024)) && IN(pb + 3)) {
            if (PH_MASK & 16) { LAUNDER_W(); unsigned char* wl = W + ws::WBASE + (size_t)l * ws::WLAYER;
              pg8::Gemm g{(const bf16_t*)(W + ws::CQ), (const bf16_t*)(wl + ws::W_UQ), cfg::M, 768, 256}; pg8::StaticOrder S; S.init(cfg::M, 768, G, bx);
              pg8::EpiQ E{W, l};
              pg8::gemm_phase<pg8::EpiQ, pg8::StaticOrder, true, true>(lds, g, S, E); }
            if (PH_MASK & 512) { LAUNDER_W(); unsigned char* wl = W + ws::WBASE + (size_t)l * ws::WLAYER;
              pg8::Gemm g{(const bf16_t*)(W + ws::CKV), (const bf16_t*)(wl + ws::W_KV), cfg::M, 512, 128}; pg8::StaticOrder S; S.init(cfg::M, 512, G, bx);
              pg8::EpiKN E{W, l};
              pg8::gemm_phase<pg8::EpiKN, pg8::StaticOrder, true, true>(lds, g, S, E); }
            if (PH_MASK & 1024) { LAUNDER_W(); unsigned char* wl = W + ws::WBASE + (size_t)l * ws::WLAYER;
              pg8::Gemm g{(const bf16_t*)(wl + ws::W_KV) + 512 * 128, (const bf16_t*)(W + ws::CKV), 512, cfg::M, 128}; pg8::StaticOrder S; S.init(512, cfg::M, G, bx);
              pg8::EpiVT E{W, l};
              pg8::gemm_phase<pg8::EpiVT, pg8::StaticOrder, true, true>(lds, g, S, E); }
        }
        SEAM(pb + 3);
#if PROBE_DOUBLE == 4
        if ((PH_MASK & (16 | 512 | 1024)) && IN(pb + 3)) {
            if (PH_MASK & 16) { LAUNDER_W(); unsigned char* wl = W + ws::WBASE + (size_t)l * ws::WLAYER;
              pg8::Gemm g{(const bf16_t*)(W + ws::CQ), (const bf16_t*)(wl + ws::W_UQ), cfg::M, 768, 256}; pg8::StaticOrder S; S.init(cfg::M, 768, G, bx);
              pg8::EpiQ E{W, l};
              pg8::gemm_phase<pg8::EpiQ, pg8::StaticOrder, true, true>(lds, g, S, E); }
            if (PH_MASK & 512) { LAUNDER_W(); unsigned char* wl = W + ws::WBASE + (size_t)l * ws::WLAYER;
              pg8::Gemm g{(const bf16_t*)(W + ws::CKV), (const bf16_t*)(wl + ws::W_KV), cfg::M, 512, 128}; pg8::StaticOrder S; S.init(cfg::M, 512, G, bx);
              pg8::EpiKN E{W, l};
              pg8::gemm_phase<pg8::EpiKN, pg8::StaticOrder, true, true>(lds, g, S, E); }
            if (PH_MASK & 1024) { LAUNDER_W(); unsigned char* wl = W + ws::WBASE + (size_t)l * ws::WLAYER;
              pg8::Gemm g{(const bf16_t*)(wl + ws::W_KV) + 512 * 128, (const bf16_t*)(W + ws::CKV), 512, cfg::M, 128}; pg8::StaticOrder S; S.init(512, cfg::M, G, bx);
              pg8::EpiVT E{W, l};
              pg8::gemm_phase<pg8::EpiVT, pg8::StaticOrder, true, true>(lds, g, S, E); }
        }
        SEAM(pb + 3);
#endif
        if ((PH_MASK & 96) && IN(pb + 4)) {
            LOCAL_TID(); LAUNDER_W(); const float* sp = (const float*)(W + ws::SMALLP) + l * 4096;
            const int x0 = (int)__builtin_amdgcn_readfirstlane((int)(xb_xcc_id() & 7u));
            for (int xs = 0; xs < 8; ++xs) {
                const int x = (x0 + xs) & 7;
                gu32* head = (gu32*)(W + ws::CTL) + ws::CW_QUEUE + (l * 8 + x) * 64 + 0 * 32;
                bool have = false; unsigned kp = 0u;
                for (;;) {
                    if (tid == 0) MISC[0] = have ? kp : __hip_atomic_fetch_add(head, 1u, __ATOMIC_RELAXED, __HIP_MEMORY_SCOPE_AGENT);
                    __syncthreads();
                    const int k = (int)MISC[0] + 0;
                    __syncthreads();
                    have = false;
                    if (k >= 200) break;
                    if (k < 8) { if (PH_MASK & 64) { const int u = x * 8 + k; mls::mlstm_unit(lds, u >> 2, u & 3, (const bf16_t*)(W + ws::QM), (const bf16_t*)(W + ws::KM), (const bf16_t*)(W + ws::VM), (const bf16_t*)(W + ws::OG),
                                                  (const float*)(W + ws::IFG), sp, sp + 2048, (bf16_t*)(W + ws::Y)); } }
                    else if (PH_MASK & 32) { const int a = k - 8; const int bhq = x * 16 + ((a < 64) ? (a & 15) : ((a - 64) & 15)); const int qa = (a < 64) ? (a >> 4) : 11 - ((a - 64) >> 4), qb2 = (a < 64) ? 15 - (a >> 4) : -1; att::attn_unit(lds, bhq, qa, qb2, (const bf16_t*)(W + ws::Q), (const bf16_t*)(W + ws::KF), (const bf16_t*)(W + ws::VT), (bf16_t*)(W + ws::Y), head, kp); have = true; }
                }
            }
        }
        SEAM(pb + 4);
#if PROBE_DOUBLE == 5
        if ((PH_MASK & 96) && IN(pb + 4)) {
            LOCAL_TID(); LAUNDER_W(); const float* sp = (const float*)(W + ws::SMALLP) + l * 4096;
            const int x0 = (int)__builtin_amdgcn_readfirstlane((int)(xb_xcc_id() & 7u));
            for (int xs = 0; xs < 8; ++xs) {
                const int x = (x0 + xs) & 7;
                gu32* head = (gu32*)(W + ws::CTL) + ws::CW_QUEUE + (l * 8 + x) * 64 + 1 * 32;
                for (;;) {
                    if (tid == 0) MISC[0] = __hip_atomic_fetch_add(head, 1u, __ATOMIC_RELAXED, __HIP_MEMORY_SCOPE_AGENT);
                    __syncthreads();
                    const int k = (int)MISC[0] + 0;
                    __syncthreads();
                    if (k >= 200) break;
                    if (k < 8) { if (PH_MASK & 64) { const int u = x * 8 + k; mls::mlstm_unit(lds, u >> 2, u & 3, (const bf16_t*)(W + ws::QM), (const bf16_t*)(W + ws::KM), (const bf16_t*)(W + ws::VM), (const bf16_t*)(W + ws::OG),
                                                  (const float*)(W + ws::IFG), sp, sp + 2048, (bf16_t*)(W + ws::Y)); } }
                    else if (PH_MASK & 32) { const int a = k - 8; const int bhq = x * 16 + ((a < 64) ? (a & 15) : ((a - 64) & 15)); const int qa = (a < 64) ? (a >> 4) : 11 - ((a - 64) >> 4), qb2 = (a < 64) ? 15 - (a >> 4) : -1; { unsigned kd_ = 0u; att::attn_unit(lds, bhq, qa, qb2, (const bf16_t*)(W + ws::Q), (const bf16_t*)(W + ws::KF), (const bf16_t*)(W + ws::VT), (bf16_t*)(W + ws::Y), head, kd_); } }
                }
            }
        }
        SEAM(pb + 4);
#endif
#if PROBE_DOUBLE == 7
        if ((PH_MASK & 96) && IN(pb + 4)) {
            LOCAL_TID(); LAUNDER_W(); const float* sp = (const float*)(W + ws::SMALLP) + l * 4096;
            const int x0 = (int)__builtin_amdgcn_readfirstlane((int)(xb_xcc_id() & 7u));
            for (int xs = 0; xs < 8; ++xs) {
                const int x = (x0 + xs) & 7;
                gu32* head = (gu32*)(W + ws::CTL) + ws::CW_QUEUE + (l * 8 + x) * 64 + 1 * 32;
                for (;;) {
                    if (tid == 0) MISC[0] = __hip_atomic_fetch_add(head, 1u, __ATOMIC_RELAXED, __HIP_MEMORY_SCOPE_AGENT);
                    __syncthreads();
                    const int k = (int)MISC[0] + 0;
                    __syncthreads();
                    if (k >= 8) break;
                    if (k < 8) { if (PH_MASK & 64) { const int u = x * 8 + k; mls::mlstm_unit(lds, u >> 2, u & 3, (const bf16_t*)(W + ws::QM), (const bf16_t*)(W + ws::KM), (const bf16_t*)(W + ws::VM), (const bf16_t*)(W + ws::OG),
                                                  (const float*)(W + ws::IFG), sp, sp + 2048, (bf16_t*)(W + ws::Y)); } }
                    else if (PH_MASK & 32) { const int a = k - 8; const int bhq = x * 16 + ((a < 64) ? (a & 15) : ((a - 64) & 15)); const int qa = (a < 64) ? (a >> 4) : 11 - ((a - 64) >> 4), qb2 = (a < 64) ? 15 - (a >> 4) : -1; { unsigned kd_ = 0u; att::attn_unit(lds, bhq, qa, qb2, (const bf16_t*)(W + ws::Q), (const bf16_t*)(W + ws::KF), (const bf16_t*)(W + ws::VT), (bf16_t*)(W + ws::Y), head, kd_); } }
                }
            }
        }
        SEAM(pb + 4);
#endif
#if PROBE_DOUBLE == 8
        if ((PH_MASK & 96) && IN(pb + 4)) {
            LOCAL_TID(); LAUNDER_W(); const float* sp = (const float*)(W + ws::SMALLP) + l * 4096;
            const int x0 = (int)__builtin_amdgcn_readfirstlane((int)(xb_xcc_id() & 7u));
            for (int xs = 0; xs < 8; ++xs) {
                const int x = (x0 + xs) & 7;
                gu32* head = (gu32*)(W + ws::CTL) + ws::CW_QUEUE + (l * 8 + x) * 64 + 1 * 32;
                for (;;) {
                    if (tid == 0) MISC[0] = __hip_atomic_fetch_add(head, 1u, __ATOMIC_RELAXED, __HIP_MEMORY_SCOPE_AGENT);
                    __syncthreads();
                    const int k = (int)MISC[0] + 8;
                    __syncthreads();
                    if (k >= 200) break;
                    if (k < 8) { if (PH_MASK & 64) { const int u = x * 8 + k; mls::mlstm_unit(lds, u >> 2, u & 3, (const bf16_t*)(W + ws::QM), (const bf16_t*)(W + ws::KM), (const bf16_t*)(W + ws::VM), (const bf16_t*)(W + ws::OG),
                                                  (const float*)(W + ws::IFG), sp, sp + 2048, (bf16_t*)(W + ws::Y)); } }
                    else if (PH_MASK & 32) { const int a = k - 8; const int bhq = x * 16 + ((a < 64) ? (a & 15) : ((a - 64) & 15)); const int qa = (a < 64) ? (a >> 4) : 11 - ((a - 64) >> 4), qb2 = (a < 64) ? 15 - (a >> 4) : -1; { unsigned kd_ = 0u; att::attn_unit(lds, bhq, qa, qb2, (const bf16_t*)(W + ws::Q), (const bf16_t*)(W + ws::KF), (const bf16_t*)(W + ws::VT), (bf16_t*)(W + ws::Y), head, kd_); } }
                }
            }
        }
        SEAM(pb + 4);
#endif
        if ((PH_MASK & 128) && IN(pb + 5)) {
            LAUNDER_W(); unsigned char* wl = W + ws::WBASE + (size_t)l * ws::WLAYER;
            pg8::Gemm g{(const bf16_t*)(W + ws::Y), (const bf16_t*)(wl + ws::W_O), cfg::M, cfg::D, cfg::D}; pg8::StaticOrder S; S.init(cfg::M, cfg::D, G, bx);
            pg8::EpiResid E{W, 3 * l + 2, 1.0f};
            pg8::gemm_phase<pg8::EpiResid, pg8::StaticOrder, true, true>(lds, g, S, E);
        }
        SEAM(pb + 5);
#if PROBE_DOUBLE == 6
        if ((PH_MASK & 128) && IN(pb + 5)) {
            LAUNDER_W(); unsigned char* wl = W + ws::WBASE + (size_t)l * ws::WLAYER;
            pg8::Gemm g{(const bf16_t*)(W + ws::Y), (const bf16_t*)(wl + ws::W_O), cfg::M, cfg::D, cfg::D}; pg8::StaticOrder S; S.init(cfg::M, cfg::D, G, bx);
            pg8::EpiResid E{W, 3 * l + 2, 0.0f};
            pg8::gemm_phase<pg8::EpiResid, pg8::StaticOrder, true, true>(lds, g, S, E);
        }
        SEAM(pb + 5);
#endif
        if ((PH_MASK & 2) && IN(pb + 6)) {
            LAUNDER_W(); unsigned char* wl = W + ws::WBASE + (size_t)l * ws::WLAYER;
            pg8::Gemm g{(const bf16_t*)(W + ws::XB), (const bf16_t*)(wl + ws::W_GU2), cfg::M, 2 * cfg::FF, cfg::D}; pg8::StaticOrder S; S.init(cfg::M, 2 * cfg::FF, G, bx);
            const int gid0_ = pg8::rstd_table((LAS float*)(lds + RSTAB_OFF), S, pg8::ssqx_buf(W, 3 * l + 2), (int)threadIdx.x);
            pg8::EpiSwiGLU E{W, 3 * l + 2, (const LAS float*)(lds + RSTAB_OFF), gid0_};
            pg8::gemm_phase<pg8::EpiSwiGLU, pg8::StaticOrder, true, true>(lds, g, S, E);
        }
        SEAM(pb + 6);
        if ((PH_MASK & 4) && IN(pb + 7)) {
            LAUNDER_W(); unsigned char* wl = W + ws::WBASE + (size_t)l * ws::WLAYER;
            pg8::Gemm g{(const bf16_t*)(W + ws::H), (const bf16_t*)(wl + ws::W_D2), cfg::M, cfg::D, cfg::FF}; pg8::StaticOrder S; S.init(cfg::M, cfg::D, G, bx);
            pg8::EpiResid E{W, 3 * l + 3, 0.5f};
            pg8::gemm_phase<pg8::EpiResid, pg8::StaticOrder, true, true>(lds, g, S, E);
        }
        SEAM(pb + 7);
        }
    { constexpr int l = 3;
        const int pb = 1 + 8 * l;
        if ((PH_MASK & 2) && IN(pb + 0)) {
            LAUNDER_W(); unsigned char* wl = W + ws::WBASE + (size_t)l * ws::WLAYER;
            pg8::Gemm g{(const bf16_t*)(W + ws::XB), (const bf16_t*)(wl + ws::W_GU1), cfg::M, 2 * cfg::FF, cfg::D}; pg8::StaticOrder S; S.init(cfg::M, 2 * cfg::FF, G, bx);
            const int gid0_ = pg8::rstd_table((LAS float*)(lds + RSTAB_OFF), S, pg8::ssqx_buf(W, 3 * l), (int)threadIdx.x);
            pg8::EpiSwiGLU E{W, 3 * l, (const LAS float*)(lds + RSTAB_OFF), gid0_};
            pg8::gemm_phase<pg8::EpiSwiGLU, pg8::StaticOrder, true, true>(lds, g, S, E);
        }
        SEAM(pb + 0);
#if PROBE_DOUBLE == 1
        if ((PH_MASK & 2) && IN(pb + 0)) {
            LAUNDER_W(); unsigned char* wl = W + ws::WBASE + (size_t)l * ws::WLAYER;
            pg8::Gemm g{(const bf16_t*)(W + ws::XB), (const bf16_t*)(wl + ws::W_GU1), cfg::M, 2 * cfg::FF, cfg::D}; pg8::StaticOrder S; S.init(cfg::M, 2 * cfg::FF, G, bx);
            const int gid0_ = pg8::rstd_table((LAS float*)(lds + RSTAB_OFF), S, pg8::ssqx_buf(W, 3 * l), (int)threadIdx.x);
            pg8::EpiSwiGLU E{W, 3 * l, (const LAS float*)(lds + RSTAB_OFF), gid0_};
            pg8::gemm_phase<pg8::EpiSwiGLU, pg8::StaticOrder, true, true>(lds, g, S, E);
        }
        SEAM(pb + 0);
#endif
#if PROBE_DOUBLE == 11
        if ((PH_MASK & 2) && IN(pb + 0)) {
            LAUNDER_W(); unsigned char* wl = W + ws::WBASE + (size_t)l * ws::WLAYER;
            pg8::Gemm g{(const bf16_t*)(W + ws::XB), (const bf16_t*)(wl + ws::W_GU1), cfg::M, 2 * cfg::FF, cfg::D}; pg8::StaticOrder S; S.init(cfg::M, 2 * cfg::FF, G, bx);
            pg8::EpiNull E{P.out};
            pg8::gemm_phase<pg8::EpiNull, pg8::StaticOrder, true, true>(lds, g, S, E);
        }
        SEAM(pb + 0);
#endif
        if ((PH_MASK & 4) && IN(pb + 1)) {
            LAUNDER_W(); unsigned char* wl = W + ws::WBASE + (size_t)l * ws::WLAYER;
            pg8::Gemm g{(const bf16_t*)(W + ws::H), (const bf16_t*)(wl + ws::W_D1), cfg::M, cfg::D, cfg::FF}; pg8::StaticOrder S; S.init(cfg::M, cfg::D, G, bx);
            pg8::EpiResid E{W, 3 * l + 1, 0.5f};
            pg8::gemm_phase<pg8::EpiResid, pg8::StaticOrder, true, true>(lds, g, S, E);
        }
        SEAM(pb + 1);
#if PROBE_DOUBLE == 2
        if ((PH_MASK & 4) && IN(pb + 1)) {
            LAUNDER_W(); unsigned char* wl = W + ws::WBASE + (size_t)l * ws::WLAYER;
            pg8::Gemm g{(const bf16_t*)(W + ws::H), (const bf16_t*)(wl + ws::W_D1), cfg::M, cfg::D, cfg::FF}; pg8::StaticOrder S; S.init(cfg::M, cfg::D, G, bx);
            pg8::EpiResid E{W, 3 * l + 1, 0.0f};
            pg8::gemm_phase<pg8::EpiResid, pg8::StaticOrder, true, true>(lds, g, S, E);
        }
        SEAM(pb + 1);
#endif
        if ((PH_MASK & 8) && IN(pb + 2)) {
            LAUNDER_W(); unsigned char* wl = W + ws::WBASE + (size_t)l * ws::WLAYER;
            pg8::Gemm g{(const bf16_t*)(W + ws::XB), (const bf16_t*)(wl + ws::W_IN), cfg::M, cfg::DINP, cfg::D}; pg8::LatinOrder S; S.init(bx, 0, 8);
            pg8::EpiWin E{W, l};
            pg8::gemm_phase<pg8::EpiWin, pg8::LatinOrder, true, true>(lds, g, S, E);
        }
        SEAM(pb + 2);
#if PROBE_DOUBLE == 3
        if ((PH_MASK & 8) && IN(pb + 2)) {
            LAUNDER_W(); unsigned char* wl = W + ws::WBASE + (size_t)l * ws::WLAYER;
            pg8::Gemm g{(const bf16_t*)(W + ws::XB), (const bf16_t*)(wl + ws::W_IN), cfg::M, cfg::DINP, cfg::D}; pg8::StaticOrder S; S.init(cfg::M, cfg::DINP, G, bx);
            pg8::EpiWin E{W, l};
            pg8::gemm_phase<pg8::EpiWin, pg8::StaticOrder, true, true>(lds, g, S, E);
        }
        SEAM(pb + 2);
#endif
        if ((PH_MASK & (16 | 512 | 1024)) && IN(pb + 3)) {
            if (PH_MASK & 16) { LAUNDER_W(); unsigned char* wl = W + ws::WBASE + (size_t)l * ws::WLAYER;
              pg8::Gemm g{(const bf16_t*)(W + ws::CQ), (const bf16_t*)(wl + ws::W_UQ), cfg::M, 768, 256}; pg8::StaticOrder S; S.init(cfg::M, 768, G, bx);
              pg8::EpiQ E{W, l};
              pg8::gemm_phase<pg8::EpiQ, pg8::StaticOrder, true, true>(lds, g, S, E); }
            if (PH_MASK & 512) { LAUNDER_W(); unsigned char* wl = W + ws::WBASE + (size_t)l * ws::WLAYER;
              pg8::Gemm g{(const bf16_t*)(W + ws::CKV), (const bf16_t*)(wl + ws::W_KV), cfg::M, 512, 128}; pg8::StaticOrder S; S.init(cfg::M, 512, G, bx);
              pg8::EpiKN E{W, l};
              pg8::gemm_phase<pg8::EpiKN, pg8::StaticOrder, true, true>(lds, g, S, E); }
            if (PH_MASK & 1024) { LAUNDER_W(); unsigned char* wl = W + ws::WBASE + (size_t)l * ws::WLAYER;
              pg8::Gemm g{(const bf16_t*)(wl + ws::W_KV) + 512 * 128, (const bf16_t*)(W + ws::CKV), 512, cfg::M, 128}; pg8::StaticOrder S; S.init(512, cfg::M, G, bx);
              pg8::EpiVT E{W, l};
              pg8::gemm_phase<pg8::EpiVT, pg8::StaticOrder, true, true>(lds, g, S, E); }
        }
        SEAM(pb + 3);
#if PROBE_DOUBLE == 4
        if ((PH_MASK & (16 | 512 | 1024)) && IN(pb + 3)) {
            if (PH_MASK & 16) { LAUNDER_W(); unsigned char* wl = W + ws::WBASE + (size_t)l * ws::WLAYER;
              pg8::Gemm g{(const bf16_t*)(W + ws::CQ), (const bf16_t*)(wl + ws::W_UQ), cfg::M, 768, 256}; pg8::StaticOrder S; S.init(cfg::M, 768, G, bx);
              pg8::EpiQ E{W, l};
              pg8::gemm_phase<pg8::EpiQ, pg8::StaticOrder, true, true>(lds, g, S, E); }
            if (PH_MASK & 512) { LAUNDER_W(); unsigned char* wl = W + ws::WBASE + (size_t)l * ws::WLAYER;
              pg8::Gemm g{(const bf16_t*)(W + ws::CKV), (const bf16_t*)(wl + ws::W_KV), cfg::M, 512, 128}; pg8::StaticOrder S; S.init(cfg::M, 512, G, bx);
              pg8::EpiKN E{W, l};
              pg8::gemm_phase<pg8::EpiKN, pg8::StaticOrder, true, true>(lds, g, S, E); }
            if (PH_MASK & 1024) { LAUNDER_W(); unsigned char* wl = W + ws::WBASE + (size_t)l * ws::WLAYER;
              pg8::Gemm g{(const bf16_t*)(wl + ws::W_KV) + 512 * 128, (const bf16_t*)(W + ws::CKV), 512, cfg::M, 128}; pg8::StaticOrder S; S.init(512, cfg::M, G, bx);
              pg8::EpiVT E{W, l};
              pg8::gemm_phase<pg8::EpiVT, pg8::StaticOrder, true, true>(lds, g, S, E); }
        }
        SEAM(pb + 3);
#endif
        if ((PH_MASK & 96) && IN(pb + 4)) {
            LOCAL_TID(); LAUNDER_W(); const float* sp = (const float*)(W + ws::SMALLP) + l * 4096;
            const int x0 = (int)__builtin_amdgcn_readfirstlane((int)(xb_xcc_id() & 7u));
            for (int xs = 0; xs < 8; ++xs) {
                const int x = (x0 + xs) & 7;
                gu32* head = (gu32*)(W + ws::CTL) + ws::CW_QUEUE + (l * 8 + x) * 64 + 0 * 32;
                bool have = false; unsigned kp = 0u;
                for (;;) {
                    if (tid == 0) MISC[0] = have ? kp : __hip_atomic_fetch_add(head, 1u, __ATOMIC_RELAXED, __HIP_MEMORY_SCOPE_AGENT);
                    __syncthreads();
                    const int k = (int)MISC[0] + 0;
                    __syncthreads();
                    have = false;
                    if (k >= 200) break;
                    if (k < 8) { if (PH_MASK & 64) { const int u = x * 8 + k; mls::mlstm_unit(lds, u >> 2, u & 3, (const bf16_t*)(W + ws::QM), (const bf16_t*)(W + ws::KM), (const bf16_t*)(W + ws::VM), (const bf16_t*)(W + ws::OG),
                                                  (const float*)(W + ws::IFG), sp, sp + 2048, (bf16_t*)(W + ws::Y)); } }
                    else if (PH_MASK & 32) { const int a = k - 8; const int bhq = x * 16 + ((a < 64) ? (a & 15) : ((a - 64) & 15)); const int qa = (a < 64) ? (a >> 4) : 11 - ((a - 64) >> 4), qb2 = (a < 64) ? 15 - (a >> 4) : -1; att::attn_unit(lds, bhq, qa, qb2, (const bf16_t*)(W + ws::Q), (const bf16_t*)(W + ws::KF), (const bf16_t*)(W + ws::VT), (bf16_t*)(W + ws::Y), head, kp); have = true; }
                }
            }
        }
        SEAM(pb + 4);
#if PROBE_DOUBLE == 5
        if ((PH_MASK & 96) && IN(pb + 4)) {
            LOCAL_TID(); LAUNDER_W(); const float* sp = (const float*)(W + ws::SMALLP) + l * 4096;
            const int x0 = (int)__builtin_amdgcn_readfirstlane((int)(xb_xcc_id() & 7u));
            for (int xs = 0; xs < 8; ++xs) {
                const int x = (x0 + xs) & 7;
                gu32* head = (gu32*)(W + ws::CTL) + ws::CW_QUEUE + (l * 8 + x) * 64 + 1 * 32;
                for (;;) {
                    if (tid == 0) MISC[0] = __hip_atomic_fetch_add(head, 1u, __ATOMIC_RELAXED, __HIP_MEMORY_SCOPE_AGENT);
                    __syncthreads();
                    const int k = (int)MISC[0] + 0;
                    __syncthreads();
                    if (k >= 200) break;
                    if (k < 8) { if (PH_MASK & 64) { const int u = x * 8 + k; mls::mlstm_unit(lds, u >> 2, u & 3, (const bf16_t*)(W + ws::QM), (const bf16_t*)(W + ws::KM), (const bf16_t*)(W + ws::VM), (const bf16_t*)(W + ws::OG),
                                                  (const float*)(W + ws::IFG), sp, sp + 2048, (bf16_t*)(W + ws::Y)); } }
                    else if (PH_MASK & 32) { const int a = k - 8; const int bhq = x * 16 + ((a < 64) ? (a & 15) : ((a - 64) & 15)); const int qa = (a < 64) ? (a >> 4) : 11 - ((a - 64) >> 4), qb2 = (a < 64) ? 15 - (a >> 4) : -1; { unsigned kd_ = 0u; att::attn_unit(lds, bhq, qa, qb2, (const bf16_t*)(W + ws::Q), (const bf16_t*)(W + ws::KF), (const bf16_t*)(W + ws::VT), (bf16_t*)(W + ws::Y), head, kd_); } }
                }
            }
        }
        SEAM(pb + 4);
#endif
#if PROBE_DOUBLE == 7
        if ((PH_MASK & 96) && IN(pb + 4)) {
            LOCAL_TID(); LAUNDER_W(); const float* sp = (const float*)(W + ws::SMALLP) + l * 4096;
            const int x0 = (int)__builtin_amdgcn_readfirstlane((int)(xb_xcc_id() & 7u));
            for (int xs = 0; xs < 8; ++xs) {
                const int x = (x0 + xs) & 7;
                gu32* head = (gu32*)(W + ws::CTL) + ws::CW_QUEUE + (l * 8 + x) * 64 + 1 * 32;
                for (;;) {
                    if (tid == 0) MISC[0] = __hip_atomic_fetch_add(head, 1u, __ATOMIC_RELAXED, __HIP_MEMORY_SCOPE_AGENT);
                    __syncthreads();
                    const int k = (int)MISC[0] + 0;
                    __syncthreads();
                    if (k >= 8) break;
                    if (k < 8) { if (PH_MASK & 64) { const int u = x * 8 + k; mls::mlstm_unit(lds, u >> 2, u & 3, (const bf16_t*)(W + ws::QM), (const bf16_t*)(W + ws::KM), (const bf16_t*)(W + ws::VM), (const bf16_t*)(W + ws::OG),
                                                  (const float*)(W + ws::IFG), sp, sp + 2048, (bf16_t*)(W + ws::Y)); } }
                    else if (PH_MASK & 32) { const int a = k - 8; const int bhq = x * 16 + ((a < 64) ? (a & 15) : ((a - 64) & 15)); const int qa = (a < 64) ? (a >> 4) : 11 - ((a - 64) >> 4), qb2 = (a < 64) ? 15 - (a >> 4) : -1; { unsigned kd_ = 0u; att::attn_unit(lds, bhq, qa, qb2, (const bf16_t*)(W + ws::Q), (const bf16_t*)(W + ws::KF), (const bf16_t*)(W + ws::VT), (bf16_t*)(W + ws::Y), head, kd_); } }
                }
            }
        }
        SEAM(pb + 4);
#endif
#if PROBE_DOUBLE == 8
        if ((PH_MASK & 96) && IN(pb + 4)) {
            LOCAL_TID(); LAUNDER_W(); const float* sp = (const float*)(W + ws::SMALLP) + l * 4096;
            const int x0 = (int)__builtin_amdgcn_readfirstlane((int)(xb_xcc_id() & 7u));
            for (int xs = 0; xs < 8; ++xs) {
                const int x = (x0 + xs) & 7;
                gu32* head = (gu32*)(W + ws::CTL) + ws::CW_QUEUE + (l * 8 + x) * 64 + 1 * 32;
                for (;;) {
                    if (tid == 0) MISC[0] = __hip_atomic_fetch_add(head, 1u, __ATOMIC_RELAXED, __HIP_MEMORY_SCOPE_AGENT);
                    __syncthreads();
                    const int k = (int)MISC[0] + 8;
                    __syncthreads();
                    if (k >= 200) break;
                    if (k < 8) { if (PH_MASK & 64) { const int u = x * 8 + k; mls::mlstm_unit(lds, u >> 2, u & 3, (const bf16_t*)(W + ws::QM), (const bf16_t*)(W + ws::KM), (const bf16_t*)(W + ws::VM), (const bf16_t*)(W + ws::OG),
                                                  (const float*)(W + ws::IFG), sp, sp + 2048, (bf16_t*)(W + ws::Y)); } }
                    else if (PH_MASK & 32) { const int a = k - 8; const int bhq = x * 16 + ((a < 64) ? (a & 15) : ((a - 64) & 15)); const int qa = (a < 64) ? (a >> 4) : 11 - ((a - 64) >> 4), qb2 = (a < 64) ? 15 - (a >> 4) : -1; { unsigned kd_ = 0u; att::attn_unit(lds, bhq, qa, qb2, (const bf16_t*)(W + ws::Q), (const bf16_t*)(W + ws::KF), (const bf16_t*)(W + ws::VT), (bf16_t*)(W + ws::Y), head, kd_); } }
                }
            }
        }
        SEAM(pb + 4);
#endif
        if ((PH_MASK & 128) && IN(pb + 5)) {
            LAUNDER_W(); unsigned char* wl = W + ws::WBASE + (size_t)l * ws::WLAYER;
            pg8::Gemm g{(const bf16_t*)(W + ws::Y), (const bf16_t*)(wl + ws::W_O), cfg::M, cfg::D, cfg::D}; pg8::StaticOrder S; S.init(cfg::M, cfg::D, G, bx);
            pg8::EpiResid E{W, 3 * l + 2, 1.0f};
            pg8::gemm_phase<pg8::EpiResid, pg8::StaticOrder, true, true>(lds, g, S, E);
        }
        SEAM(pb + 5);
#if PROBE_DOUBLE == 6
        if ((PH_MASK & 128) && IN(pb + 5)) {
            LAUNDER_W(); unsigned char* wl = W + ws::WBASE + (size_t)l * ws::WLAYER;
            pg8::Gemm g{(const bf16_t*)(W + ws::Y), (const bf16_t*)(wl + ws::W_O), cfg::M, cfg::D, cfg::D}; pg8::StaticOrder S; S.init(cfg::M, cfg::D, G, bx);
            pg8::EpiResid E{W, 3 * l + 2, 0.0f};
            pg8::gemm_phase<pg8::EpiResid, pg8::StaticOrder, true, true>(lds, g, S, E);
        }
        SEAM(pb + 5);
#endif
        if ((PH_MASK & 2) && IN(pb + 6)) {
            LAUNDER_W(); unsigned char* wl = W + ws::WBASE + (size_t)l * ws::WLAYER;
            pg8::Gemm g{(const bf16_t*)(W + ws::XB), (const bf16_t*)(wl + ws::W_GU2), cfg::M, 2 * cfg::FF, cfg::D}; pg8::StaticOrder S; S.init(cfg::M, 2 * cfg::FF, G, bx);
            const int gid0_ = pg8::rstd_table((LAS float*)(lds + RSTAB_OFF), S, pg8::ssqx_buf(W, 3 * l + 2), (int)threadIdx.x);
            pg8::EpiSwiGLU E{W, 3 * l + 2, (const LAS float*)(lds + RSTAB_OFF), gid0_};
            pg8::gemm_phase<pg8::EpiSwiGLU, pg8::StaticOrder, true, true>(lds, g, S, E);
        }
        SEAM(pb + 6);
        if ((PH_MASK & 4) && IN(pb + 7)) {
            LAUNDER_W(); unsigned char* wl = W + ws::WBASE + (size_t)l * ws::WLAYER;
            pg8::Gemm g{(const bf16_t*)(W + ws::H), (const bf16_t*)(wl + ws::W_D2), cfg::M, cfg::D, cfg::FF}; pg8::StaticOrder S; S.init(cfg::M, cfg::D, G, bx);
            pg8::EpiResid E{W, 3 * l + 3, 0.5f};
            pg8::gemm_phase<pg8::EpiResid, pg8::StaticOrder, true, true>(lds, g, S, E);
        }
        SEAM(pb + 7);
        }
    if ((PH_MASK & 256) && IN(33)) {
        LOCAL_TID(); LAUNDER_W(); const float* ssq = (const float*)(W + ws::SSQX);   const f32x4* gp = (const f32x4*)P.in[23] + 4 * lane;
        f32x4 gv[4];
#pragma unroll
        for (int j = 0; j < 4; ++j) gv[j] = gp[j];
        for (int m = gw; m < cfg::M; m += NGW) {
            const float rs = __builtin_amdgcn_rsqf(wave_sum((lane < 16) ? ssq[(size_t)m * 16 + lane] : 0.f, lane) * (1.f / cfg::D) + cfg::EPS);
            const u32x4* xr = (const u32x4*)((const bf16_t*)(W + ws::XB) + (size_t)m * cfg::D) + 2 * lane; f32x4* orow = (f32x4*)(P.out + (size_t)m * cfg::D) + 4 * lane;
            const u32x4 b0 = xr[0], b1 = xr[1];
            orow[0] = (f32x4){bflo(b0.x), bfhi(b0.x), bflo(b0.y), bfhi(b0.y)} * rs * gv[0]; orow[1] = (f32x4){bflo(b0.z), bfhi(b0.z), bflo(b0.w), bfhi(b0.w)} * rs * gv[1];
            orow[2] = (f32x4){bflo(b1.x), bfhi(b1.x), bflo(b1.y), bfhi(b1.y)} * rs * gv[2]; orow[3] = (f32x4){bflo(b1.z), bfhi(b1.z), bflo(b1.w), bfhi(b1.w)} * rs * gv[3];
        }
    }
#if PROBE_DOUBLE == 10
    SEAM(33);
    if ((PH_MASK & 256) && IN(33)) {
        LOCAL_TID(); LAUNDER_W(); const float* ssq = (const float*)(W + ws::SSQX);   const f32x4* gp = (const f32x4*)P.in[23] + lane;
        f32x4 gv[4];
#pragma unroll
        for (int j = 0; j < 4; ++j) gv[j] = gp[64 * j];
        for (int m = gw; m < cfg::M; m += NGW) {
            const float rs = __builtin_amdgcn_rsqf(wave_sum((lane < 16) ? ssq[(size_t)m * 16 + lane] : 0.f, lane) * (1.f / cfg::D) + cfg::EPS);
            const u32x2* xr = (const u32x2*)((const bf16_t*)(W + ws::XB) + (size_t)m * cfg::D) + lane; f32x4* orow = (f32x4*)(P.out + (size_t)m * cfg::D) + lane;
#pragma unroll
            for (int j = 0; j < 4; ++j) { const u32x2 b = xr[64 * j]; f32x4 v; v[0] = bflo(b.x); v[1] = bfhi(b.x); v[2] = bflo(b.y); v[3] = bfhi(b.y); orow[64 * j] = v * rs * gv[j]; }
        }
    }
#endif
#undef IN
#undef SEAM
}

extern "C" void kernel_launch(void* const* d_in, const int* in_sizes, int n_in, void* d_out, int out_size, void* d_ws, size_t ws_size, hipStream_t stream) {
    static int grid = 0;
    if (grid == 0) {
        if (n_in != 24 || in_sizes[0] != cfg::M * cfg::D || out_size != cfg::M * cfg::D || ws_size < ws::END) { fprintf(stderr, "kernel_launch: unexpected shapes / workspace (n_in %d, ws %zu)\n", n_in, ws_size); grid = -1; return; }
        int dev = 0, cus = 0, per_cu = 0;
        if (hipGetDevice(&dev) != hipSuccess || hipDeviceGetAttribute(&cus, hipDeviceAttributeMultiprocessorCount, dev) != hipSuccess) { grid = -1; return; }
        if (hipFuncSetAttribute((const void*)hymba_fwd, hipFuncAttributeMaxDynamicSharedMemorySize, LDS_BYTES) != hipSuccess) { fprintf(stderr, "kernel_launch: hipFuncSetAttribute failed\n"); grid = -1; return; }
        if (hipOccupancyMaxActiveBlocksPerMultiprocessor(&per_cu, (const void*)hymba_fwd, 512, LDS_BYTES) != hipSuccess || per_cu < 1) fprintf(stderr, "kernel_launch: occupancy query reports %d\n", per_cu);
        (void)hipGetLastError();
        if (cus < 256) { fprintf(stderr, "kernel_launch: built for a 256-CU device (MI355X); found %d CUs; nothing launched\n", cus); grid = -1; return; }
        grid = 256;
    }
    if (grid < 0) return;
    (void)hipMemsetAsync((char*)d_ws + ws::CTL, 0, ws::ZERO_BYTES, stream);
    Params p{};
    for (int i = 0; i < 24; ++i) p.in[i] = (const float*)d_in[i];
    p.out = (float*)d_out; p.ws = (unsigned char*)d_ws; p.pad = 0;
#if MK_PER_PHASE
#ifdef BISECT_MASK
    { static bool once = false; if (!once) { once = true; (void)hipFuncSetAttribute((const void*)hymba_fwd_loop, hipFuncAttributeMaxDynamicSharedMemorySize, LDS_BYTES); } }
    for (int ph = 0; ph < NPHASE; ++ph) { p.ph_lo = ph; p.ph_hi = ph + 1; p.li = 0; const int t = (ph == 0) ? 0 : (ph == 33) ? 9 : 1 + ((ph - 1) & 7);
        if ((BISECT_MASK >> t) & 1) hipLaunchKernelGGL(hymba_fwd, dim3(grid), dim3(512), LDS_BYTES, stream, p); else hipLaunchKernelGGL(hymba_fwd_loop, dim3(grid), dim3(512), LDS_BYTES, stream, p); }
#else
    for (int ph = 0; ph < NPHASE; ++ph) { p.ph_lo = ph; p.ph_hi = ph + 1; p.li = 0; hipLaunchKernelGGL(hymba_fwd, dim3(grid), dim3(512), LDS_BYTES, stream, p); }
#endif
#else
    p.ph_lo = 0; p.ph_hi = NPHASE; p.li = 0;
    hipLaunchKernelGGL(hymba_fwd, dim3(grid), dim3(512), LDS_BYTES, stream, p);
#endif
}
```

```cpp
#include <hip/hip_runtime.h>
#include <cstdio>
#include <cstdint>

#define LAS __attribute__((address_space(3)))
#define GAS __attribute__((address_space(1)))
typedef unsigned short bf16_t;
typedef short bf16x8 __attribute__((ext_vector_type(8)));
typedef short s16x4 __attribute__((ext_vector_type(4)));
typedef float f32x2 __attribute__((ext_vector_type(2)));
typedef float f32x4 __attribute__((ext_vector_type(4)));
typedef float f32x16 __attribute__((ext_vector_type(16)));
typedef unsigned u32x2 __attribute__((ext_vector_type(2)));
typedef unsigned u32x4 __attribute__((ext_vector_type(4)));
typedef GAS unsigned gu32;

namespace cfg {
constexpr int NB = 16, S = 4096, M = NB * S, D = 1024, DEPTH = 4, FF = 2816;
constexpr int NH = 8, DQK = 96, DNOPE = 64, DROPE = 32, DVH = 64, QLR = 256, KVLR = 128;
constexpr int MH = 4, MDK = 64, MDV = 128, CHUNK = 64, NCHUNK = S / CHUNK;
constexpr int DIN = 1960, DINP = 2048;
constexpr float EPS = 1e-6f;
constexpr float LOG2E = 1.4426950408889634f;
constexpr float QSCALE = 0.10206207261596575f * LOG2E;
}
namespace ws {
constexpr size_t MiB = 1u << 20;
constexpr size_t CTL = 0, ZERO_BYTES = 1 * MiB;
constexpr size_t SSQKV = 1 * MiB, SSQQ = 2 * MiB;
constexpr size_t SMALLP = 3 * MiB;
constexpr size_t SSQX = 24 * MiB;
constexpr size_t ROPE = 8 * MiB, IFG = 16 * MiB;
constexpr size_t WBASE = 32 * MiB, WLAYER = 40 * MiB;
constexpr size_t W_GU1 = 0, W_D1 = 11 * MiB, W_GU2 = 11 * MiB + 5632 * 1024, W_D2 = 27 * MiB + 512 * 1024, W_IN = 33 * MiB, W_UQ = 37 * MiB, W_KV = 37 * MiB + 512 * 1024, W_O = 38 * MiB;
constexpr size_t XB = 192 * MiB;
constexpr size_t H = 320 * MiB;
constexpr size_t CQ = 320 * MiB, CKV = 352 * MiB, QM = 368 * MiB, KM = 400 * MiB, VM = 432 * MiB, OG = 496 * MiB, Q = 560 * MiB, KF = 656 * MiB, VT = 752 * MiB, Y = 816 * MiB, END = 944 * MiB;
static_assert(W_D1 + 1024 * 2816 * 2 <= W_GU2 && W_GU2 + 5632 * 1024 * 2 <= W_D2 && W_D2 + 1024 * 2816 * 2 <= W_IN && W_IN + 2048 * 1024 * 2 <= W_UQ && W_UQ + 768 * 256 * 2 <= W_KV && W_KV + 1024 * 128 * 2 <= W_O && W_O + 1024 * 1024 * 2 <= WLAYER, "weight map");
static_assert(H + (size_t)cfg::M * cfg::FF * 2 <= Y + (size_t)cfg::M * 1024 * 2 && Y + (size_t)cfg::M * 1024 * 2 == END, "activation map");
constexpr int CW_QUEUE = 1024, CW_BAR = 4096;
}
namespace pg8 {
#define PG8_LAS __attribute__((address_space(3)))
typedef unsigned short bf16_t;
typedef short bf16x8 __attribute__((ext_vector_type(8)));
typedef float f32x4 __attribute__((ext_vector_type(4)));
typedef unsigned u32x4 __attribute__((ext_vector_type(4)));
constexpr int BM = 256, BK = 64, HALF = 128, HTB = HALF * BK * 2  , STAGE_BYTES = 8 * HTB, NXCD = 8, WGM = 8;

__host__ __device__ __forceinline__ int lds_byte(int r, int c) { const int st = (r >> 4) * 2 + (c >> 5), rr = r & 15, cc = c & 31, ob = rr * 64 + cc * 2; return st * 1024 + (ob ^ (((ob >> 9) & 1) << 5)); }
__host__ __device__ __forceinline__ void stage_rc(int b, int& R, int& C) { const int st = b / 1024, sb = b % 1024, swz = sb ^ (((sb >> 9) & 1) << 5); R = (st >> 1) * 16 + swz / 64; C = (st & 1) * 32 + (swz % 64) / 2; }
__host__ __device__ __forceinline__ int perm32(int rho) { const int n = rho >> 4, i = rho & 15; return 8 * (i >> 2) + 4 * n + (i & 3); }

struct Unit { int pm, pn; };
struct Gemm { const bf16_t* A; const bf16_t* Bt; int M, N, K; };

template <bool COLS> struct PanelOrderT {
    int n, c;
    __host__ __device__ void init(int M, int N, int, int c_) { c = c_; n = COLS ? (M / BM) : (N / BM); }
    __host__ __device__ bool next(int i, Unit& u) const { if (i >= n) return false; if (COLS) { u.pm = i; u.pn = c; } else { u.pm = c; u.pn = i; } return true; }
    __device__ __forceinline__ void a_ready(const Unit&) const {}
    __device__ __forceinline__ void done(const Unit&) const {}
};
typedef PanelOrderT<false> PanelOrder;
typedef PanelOrderT<true> PanelOrderC;
struct LatinOrder {
    int x, j, k, r_lo, r_hi;
    __host__ __device__ void init(int bx, int lo, int hi) { x = bx & 7; const int w = bx >> 3; j = w & 7; k = w >> 3; r_lo = lo; r_hi = hi; }
    __host__ __device__ int own_round() const { return (8 - 2 * k) & 7; }
    __host__ __device__ int own_panel() const { return 32 * x + 8 * (own_round() >> 1) + j; }
    __host__ __device__ bool next(int i, Unit& u) const { const int r = r_lo + i; if (r >= r_hi) return false; u.pm = 32 * x + 8 * (r >> 1) + j; u.pn = (2 * k + r) & 7; return true; }
    __device__ __forceinline__ void a_ready(const Unit&) const {}
    __device__ __forceinline__ void done(const Unit&) const {}
};

struct StaticOrder {
    int nM, nN, nwg, G, c;
    __host__ __device__ void init(int M, int N, int G_, int c_) { nM = M / BM; nN = N / BM; nwg = nM * nN; G = G_; c = c_; }
    __host__ __device__ bool next(int i, Unit& u) const {
        const long L = (long)i * G + c; if (L >= nwg) return false;
        int wgid = (int)L; { const int q = nwg / NXCD, r = nwg % NXCD, xcd = wgid % NXCD, off = wgid / NXCD; wgid = (xcd < r ? xcd * (q + 1) : r * (q + 1) + (xcd - r) * q) + off; }
        const int nig = WGM * nN, gid = wgid / nig, fm = gid * WGM, gsz = (nM - fm) < WGM ? (nM - fm) : WGM;
        u.pm = fm + ((wgid % nig) % gsz); u.pn = (wgid % nig) / gsz; return true;
    }
    __device__ __forceinline__ void a_ready(const Unit&) const {}
    __device__ __forceinline__ void done(const Unit&) const {}
};
struct StaticOrderRev {
    StaticOrder S;
    __host__ __device__ void init(int M, int N, int G_, int c_) { S.init(M, N, G_, c_); }
    __host__ __device__ bool next(int i, Unit& u) const { if (!S.next(i, u)) return false; u.pm = (u.pm & ~31) | (31 - (u.pm & 31)); return true; }
    __device__ __forceinline__ void a_ready(const Unit&) const {}
    __device__ __forceinline__ void done(const Unit&) const {}
};

typedef __bf16 bf16x2v_t __attribute__((ext_vector_type(2)));
__device__ __forceinline__ unsigned cvt_pk_bf16(float lo, float hi) { typedef float f32x2v_t __attribute__((ext_vector_type(2))); const f32x2v_t v = {lo, hi}; const bf16x2v_t b = __builtin_convertvector(v, bf16x2v_t); return __builtin_bit_cast(unsigned, b); }
__device__ __forceinline__ float silu_f(float x) { return x * __builtin_amdgcn_rcpf(1.f + __builtin_amdgcn_exp2f(-cfg::LOG2E * x)); }
__device__ __forceinline__ float sigmoid_f(float x) { return __builtin_amdgcn_rcpf(1.f + __builtin_amdgcn_exp2f(-cfg::LOG2E * x)); }
__device__ __forceinline__ u32x4 pack8(const f32x4 a, const f32x4 b) { u32x4 w; w.x = cvt_pk_bf16(a[0], a[1]); w.y = cvt_pk_bf16(a[2], a[3]); w.z = cvt_pk_bf16(b[0], b[1]); w.w = cvt_pk_bf16(b[2], b[3]); return w; }
__device__ __forceinline__ float sumsq8(const f32x4 a, const f32x4 b) { return (a[0] * a[0] + a[1] * a[1]) + (a[2] * a[2] + a[3] * a[3]) + (b[0] * b[0] + b[1] * b[1]) + (b[2] * b[2] + b[3] * b[3]); }
__device__ __forceinline__ float row_ssq16(const float* buf, int row, int fq);
__device__ __forceinline__ float quad_sum(float v) {
    { const auto r = __builtin_amdgcn_permlane16_swap(__float_as_uint(v), __float_as_uint(v), false, false); v = __uint_as_float(r[0]) + __uint_as_float(r[1]); }
    { const auto r = __builtin_amdgcn_permlane32_swap(__float_as_uint(v), __float_as_uint(v), false, false); v = __uint_as_float(r[0]) + __uint_as_float(r[1]); }
    return v; }

__device__ __forceinline__ float row_ssq16(const float* buf, int row, int fq) { const f32x4 v = *(const f32x4*)(buf + (size_t)row * 16 + 4 * fq); return quad_sum((v[0] + v[1]) + (v[2] + v[3])); }
__device__ __forceinline__ float row_ssq4(const float* buf, int row) { const f32x4 v = *(const f32x4*)(buf + (size_t)row * 4); return (v[0] + v[1]) + (v[2] + v[3]); }
__device__ __forceinline__ const float* ssqx_buf(unsigned char* W, int si) { return (const float*)(W + ws::SSQX) + (size_t)(si & 1) * cfg::M * 16; }

template <class Sched> __device__ __forceinline__ int rstd_table(PG8_LAS float* tab, const Sched& S, const float* ssq, int tid) {
    Unit u; int gid0 = 0, last = -1; asm volatile("" : "+v"(tid));
    for (int i = 0; S.next(i, u); ++i) {
        if (i == 0) gid0 = u.pm >> 3;
        if (u.pm != last) { last = u.pm;
            if (tid < 256) { const f32x4* p = (const f32x4*)(ssq + (size_t)(u.pm * BM + tid) * 16); const f32x4 a = p[0], b = p[1], c = p[2], d = p[3];
                const float t = ((a[0] + a[1]) + (a[2] + a[3])) + ((b[0] + b[1]) + (b[2] + b[3])) + ((c[0] + c[1]) + (c[2] + c[3])) + ((d[0] + d[1]) + (d[2] + d[3]));
                tab[((u.pm >> 3) - gid0) * 256 + tid] = __builtin_amdgcn_rsqf(t * (1.f / cfg::D) + cfg::EPS); } } }
    __syncthreads();
    return gid0;
}

struct EpiSwiGLU {
    static constexpr bool PERM = true, AFTER_DRAIN = false;
    unsigned char* W; int si;
    const PG8_LAS float* rstab; int gid0;
    static constexpr int ND = 2;
    struct Def { u32x4 a[4], b[4]; };
    static __device__ __forceinline__ f32x2 swi2(const f32x2 g, const f32x2 u) {
        const f32x2 t = g * (f32x2){-cfg::LOG2E, -cfg::LOG2E};
        f32x2 s; s[0] = __builtin_amdgcn_exp2f(fminf(t[0], 60.f)); s[1] = __builtin_amdgcn_exp2f(fminf(t[1], 60.f));
        s = s + (f32x2){1.f, 1.f};
        const float r = __builtin_amdgcn_rcpf(s[0] * s[1]);
        const f32x2 sig = (f32x2){s[1], s[0]} * (f32x2){r, r};
        return (g * sig) * u;
    }
    template <bool DEFER_HALF> __device__ __forceinline__ void run(const f32x4 (&acc)[2][2][4][2], const Unit& u_, int wr, int wc, int fr, int fq, Def& D) const {
        Unit u = u_; asm volatile("" : "+s"(u.pm), "+s"(u.pn), "+v"(fr), "+v"(fq));
        bf16_t* const H = (bf16_t*)(W + ws::H);
        const int row0 = u.pm * BM + wr * 64 + fr, hcol = u.pn * 128 + wc * 32 + 8 * fq;
        float rsv[2][4];
        { const PG8_LAS float* tp = rstab + ((u.pm >> 3) - gid0) * 256 + wr * 64 + fr;
#pragma unroll
          for (int ai = 0; ai < 2; ++ai)
#pragma unroll
              for (int m = 0; m < 4; ++m) rsv[ai][m] = tp[ai * HALF + m * 16]; }
#pragma unroll
        for (int ai = 1; ai >= 0; --ai)
#pragma unroll
            for (int m = 3; m >= 0; --m) {
                const int row = row0 + ai * HALF + m * 16;
                const float rs = rsv[ai][m];
                const f32x2 rs2 = {rs, rs};
                if (DEFER_HALF && ai == 1 && m >= 4 - ND) {
                    f32x4 g0, g1, u0, u1;
#pragma unroll
                    for (int e = 0; e < 4; ++e) { g0[e] = acc[1][0][m][0][e] * rs; g1[e] = acc[1][0][m][1][e] * rs; u0[e] = acc[1][1][m][0][e] * rs; u1[e] = acc[1][1][m][1][e] * rs; }
                    D.a[m] = pack8(g0, g1); D.b[m] = pack8(u0, u1);
                } else {
                    f32x4 h0, h1;
#pragma unroll
                    for (int n = 0; n < 2; ++n)
#pragma unroll
                        for (int e = 0; e < 4; e += 2) {
                            const f32x2 ga = {acc[ai][0][m][n][e], acc[ai][0][m][n][e + 1]}, ua = {acc[ai][1][m][n][e], acc[ai][1][m][n][e + 1]};
                            const f32x2 hh = swi2(ga * rs2, ua * rs2);
                            if (n == 0) { h0[e] = hh[0]; h0[e + 1] = hh[1]; } else { h1[e] = hh[0]; h1[e + 1] = hh[1]; }
                        }
                    *(u32x4*)(H + (size_t)row * cfg::FF + hcol) = pack8(h0, h1);
                }
            }
    }
    __device__ __forceinline__ void operator()(const f32x4 (&acc)[2][2][4][2], const Unit& u_, int wr, int wc, int fr, int fq) const { Def D; run<false>(acc, u_, wr, wc, fr, fq, D); }
    __device__ __forceinline__ void later(Def& D, const int q) const {
#pragma unroll
        for (int d = 2 * q; d < 2 * q + 2; ++d) {
            const int m = 4 - ND + (d >> 2), j = d & 3;
            const u32x4 ga = D.a[m], ua = D.b[m];
            const unsigned gw = (j == 0) ? ga.x : (j == 1) ? ga.y : (j == 2) ? ga.z : ga.w, uw = (j == 0) ? ua.x : (j == 1) ? ua.y : (j == 2) ? ua.z : ua.w;
            const f32x2 g = {__uint_as_float(gw << 16), __uint_as_float(gw & 0xffff0000u)}, uu = {__uint_as_float(uw << 16), __uint_as_float(uw & 0xffff0000u)};
            const f32x2 hh = swi2(g, uu);
            const unsigned ow = cvt_pk_bf16(hh[0], hh[1]);
            if (j == 0) D.a[m].x = ow; else if (j == 1) D.a[m].y = ow; else if (j == 2) D.a[m].z = ow; else D.a[m].w = ow;
        }
    }
    __device__ __forceinline__ void pin(Def& D, const int q) const {
#pragma unroll
        for (int d = 2 * q; d < 2 * q + 2; ++d) { const int m = 4 - ND + (d >> 2), j = d & 3;
            if (j == 0) asm volatile("" : "+v"(D.a[m].x)); else if (j == 1) asm volatile("" : "+v"(D.a[m].y)); else if (j == 2) asm volatile("" : "+v"(D.a[m].z)); else asm volatile("" : "+v"(D.a[m].w)); }
    }
    __device__ __forceinline__ void flush(const Def& D, const Unit& u_, int wr, int wc, int fr, int fq) const {
        Unit u = u_; asm volatile("" : "+s"(u.pm), "+s"(u.pn), "+v"(fr), "+v"(fq));
        bf16_t* const H = (bf16_t*)(W + ws::H);
        const int row0 = u.pm * BM + wr * 64 + fr + HALF, hcol = u.pn * 128 + wc * 32 + 8 * fq;
#pragma unroll
        for (int m = 4 - ND; m < 4; ++m) *(u32x4*)(H + (size_t)(row0 + m * 16) * cfg::FF + hcol) = D.a[m];
    }
};

struct EpiResid {
    static constexpr bool PERM = true, AFTER_DRAIN = false;
    unsigned char* W; int si; float alpha;
    __device__ __forceinline__ void prefetch_unused(const Unit& u_, PG8_LAS unsigned char* junk, int tid) const {
        Unit u = u_; asm volatile("" : "+s"(u.pm), "+s"(u.pn), "+v"(tid));
        const unsigned char* base = W + ws::XB + ((size_t)u.pm * BM * cfg::D + (size_t)u.pn * BM) * 2;
#pragma unroll
        for (int i = 0; i < 2; ++i) { const int ln = tid + 512 * i;
            __builtin_amdgcn_global_load_lds((const unsigned*)(base + (size_t)(ln >> 2) * (cfg::D * 2) + (ln & 3) * 128), (PG8_LAS unsigned*)junk, 4, 0, 0); }
    }
    __device__ __forceinline__ void operator()(const f32x4 (&acc)[2][2][4][2], const Unit& u_, int wr, int wc, int fr, int fq) const {
        Unit u = u_; asm volatile("" : "+s"(u.pm), "+s"(u.pn), "+v"(fr), "+v"(fq));
        bf16_t* const xb = (bf16_t*)(W + ws::XB); float* const ssq_out = (float*)ssqx_buf(W, si);
        const int row0 = u.pm * BM + wr * 64 + fr, col0 = u.pn * BM + wc * 32 + 8 * fq;
        u32x4 xin[2][4][2];
#pragma unroll
        for (int ai = 0; ai < 2; ++ai)
#pragma unroll
            for (int m = 0; m < 4; ++m)
#pragma unroll
                for (int bj = 0; bj < 2; ++bj) xin[ai][m][bj] = *(const u32x4*)(xb + (size_t)(row0 + ai * HALF + m * 16) * cfg::D + col0 + bj * HALF);
#pragma unroll
        for (int ai = 0; ai < 2; ++ai)
#pragma unroll
            for (int m = 0; m < 4; ++m) {
                const int row = row0 + ai * HALF + m * 16; const size_t off = (size_t)row * cfg::D + col0; float part = 0.f;
#pragma unroll
                for (int bj = 0; bj < 2; ++bj) {
                    const u32x4 b = xin[ai][m][bj];
                    f32x4 x0, x1;
                    x0[0] = __uint_as_float(b.x << 16); x0[1] = __uint_as_float(b.x & 0xffff0000u); x0[2] = __uint_as_float(b.y << 16); x0[3] = __uint_as_float(b.y & 0xffff0000u);
                    x1[0] = __uint_as_float(b.z << 16); x1[1] = __uint_as_float(b.z & 0xffff0000u); x1[2] = __uint_as_float(b.w << 16); x1[3] = __uint_as_float(b.w & 0xffff0000u);
                    x0 = x0 + acc[ai][bj][m][0] * alpha; x1 = x1 + acc[ai][bj][m][1] * alpha;
                    *(u32x4*)(xb + off + bj * HALF) = pack8(x0, x1);
                    part += sumsq8(x0, x1);
                }
                part = quad_sum(part);
                if (fq == 0) ssq_out[(size_t)row * 16 + u.pn * 4 + wc] = part;
            }
    }
};

struct EpiWin {
    static constexpr bool PERM = true, AFTER_DRAIN = false;
    unsigned char* W; int l;
    __device__ __forceinline__ void operator()(const f32x4 (&acc)[2][2][4][2], const Unit& u_, int wr, int wc, int fr, int fq) const {
        Unit u = u_; asm volatile("" : "+s"(u.pm), "+s"(u.pn), "+v"(fr), "+v"(fq));
        const float* const ssq = ssqx_buf(W, 3 * l + 1);
        bf16_t* const CQ = (bf16_t*)(W + ws::CQ); bf16_t* const CKV = (bf16_t*)(W + ws::CKV); bf16_t* const KF = (bf16_t*)(W + ws::KF); bf16_t* const QM = (bf16_t*)(W + ws::QM);
        bf16_t* const KM = (bf16_t*)(W + ws::KM); bf16_t* const VM = (bf16_t*)(W + ws::VM); bf16_t* const OG = (bf16_t*)(W + ws::OG); float* const IF = (float*)(W + ws::IFG);
        float* const ssq_q = (float*)(W + ws::SSQQ); float* const ssq_kv = (float*)(W + ws::SSQKV);
        const f32x2* const rope = (const f32x2*)(W + ws::ROPE);
        const float* const b_i = (const float*)(W + ws::SMALLP) + l * 4096 + 2560; const float* const b_f = b_i + 4;
        const int row0 = u.pm * BM + wr * 64 + fr, pn = u.pn, cw = wc * 32 + 8 * fq;
        f32x4 pq[2][4]; float rsv[2][4];
#pragma unroll
        for (int ai = 0; ai < 2; ++ai)
#pragma unroll
            for (int m = 0; m < 4; ++m) pq[ai][m] = *(const f32x4*)(ssq + (size_t)(row0 + ai * HALF + m * 16) * 16 + 4 * fq);
#pragma unroll
        for (int ai = 0; ai < 2; ++ai)
#pragma unroll
            for (int m = 0; m < 4; ++m) rsv[ai][m] = __builtin_amdgcn_rsqf(quad_sum((pq[ai][m][0] + pq[ai][m][1]) + (pq[ai][m][2] + pq[ai][m][3])) * (1.f / cfg::D) + cfg::EPS);
#pragma unroll
        for (int ai = 0; ai < 2; ++ai)
#pragma unroll
            for (int m = 0; m < 4; ++m) {
                const int row = row0 + ai * HALF + m * 16;
                const float rs = rsv[ai][m];
                f32x4 v[2][2];
#pragma unroll
                for (int bj = 0; bj < 2; ++bj) { v[bj][0] = acc[ai][bj][m][0] * rs; v[bj][1] = acc[ai][bj][m][1] * rs; }
                if (pn == 0) {
                    float part = 0.f;
#pragma unroll
                    for (int bj = 0; bj < 2; ++bj) { *(u32x4*)(CQ + (size_t)row * cfg::QLR + bj * HALF + cw) = pack8(v[bj][0], v[bj][1]); part += sumsq8(v[bj][0], v[bj][1]); }
                    part = quad_sum(part); if (fq == 0) ssq_q[(size_t)row * 4 + wc] = part;
                } else if (pn == 1) {
                    *(u32x4*)(CKV + (size_t)row * cfg::KVLR + cw) = pack8(v[0][0], v[0][1]);
                    float part = quad_sum(sumsq8(v[0][0], v[0][1])); if (fq == 0) ssq_kv[(size_t)row * 4 + wc] = part;
                    if (wc == 0) {
                        const f32x4 cs0 = *(const f32x4*)(rope + (size_t)row * 16 + 4 * fq), cs1 = *(const f32x4*)(rope + (size_t)row * 16 + 4 * fq + 2);
                        f32x4 r0, r1;
                        r0[0] = v[1][0][0] * cs0[0] - v[1][0][1] * cs0[1]; r0[1] = v[1][0][1] * cs0[0] + v[1][0][0] * cs0[1];
                        r0[2] = v[1][0][2] * cs0[2] - v[1][0][3] * cs0[3]; r0[3] = v[1][0][3] * cs0[2] + v[1][0][2] * cs0[3];
                        r1[0] = v[1][1][0] * cs1[0] - v[1][1][1] * cs1[1]; r1[1] = v[1][1][1] * cs1[0] + v[1][1][0] * cs1[1];
                        r1[2] = v[1][1][2] * cs1[2] - v[1][1][3] * cs1[3]; r1[3] = v[1][1][3] * cs1[2] + v[1][1][2] * cs1[3];
                        const u32x4 w = pack8(r0, r1);
                        const int b = row >> 12, s = row & 4095;
#pragma unroll
                        for (int h = 0; h < cfg::NH; ++h) *(u32x4*)(KF + ((size_t)(b * cfg::NH + h) * cfg::S + s) * cfg::DQK + cfg::DNOPE + 8 * fq) = w;
                    } else if (wc == 1 && fq == 0) {
                        f32x4 ig, lf;
#pragma unroll
                        for (int e = 0; e < 4; ++e) { ig[e] = v[1][0][e] + b_i[e]; const float z = v[1][1][e] + b_f[e]; lf[e] = fminf(z, 0.f) - log1pf(__expf(-fabsf(z))); }
                        *(f32x4*)(IF + (size_t)row * 8) = ig; *(f32x4*)(IF + (size_t)row * 8 + 4) = lf;
                    }
                } else if (pn < 4) {
                    bf16_t* dst = (pn == 2) ? QM : KM;
#pragma unroll
                    for (int bj = 0; bj < 2; ++bj) *(u32x4*)(dst + (size_t)row * 256 + bj * HALF + cw) = pack8(v[bj][0], v[bj][1]);
                } else if (pn < 6) {
#pragma unroll
                    for (int bj = 0; bj < 2; ++bj) *(u32x4*)(VM + (size_t)row * 512 + (pn - 4) * 256 + bj * HALF + cw) = pack8(v[bj][0], v[bj][1]);
                } else {
#pragma unroll
                    for (int bj = 0; bj < 2; ++bj) { f32x4 a, b;
#pragma unroll
                        for (int e = 0; e < 4; ++e) { a[e] = sigmoid_f(v[bj][0][e]); b[e] = sigmoid_f(v[bj][1][e]); }
                        *(u32x4*)(OG + (size_t)row * 512 + (pn - 6) * 256 + bj * HALF + cw) = pack8(a, b); }
                }
            }
    }
};

struct EpiQ {
    static constexpr bool PERM = true, AFTER_DRAIN = false;
    unsigned char* W; int l;
    __device__ __forceinline__ void operator()(const f32x4 (&acc)[2][2][4][2], const Unit& u_, int wr, int wc, int fr, int fq) const {
        Unit u = u_; asm volatile("" : "+s"(u.pm), "+s"(u.pn), "+v"(fr), "+v"(fq));
        const float* const ssq_q = (const float*)(W + ws::SSQQ); const f32x2* const rope = (const f32x2*)(W + ws::ROPE); bf16_t* const Q = (bf16_t*)(W + ws::Q);
        const int row0 = u.pm * BM + wr * 64 + fr;
        f32x4 pq[2][4];
#pragma unroll
        for (int ai = 0; ai < 2; ++ai)
#pragma unroll
            for (int m = 0; m < 4; ++m) pq[ai][m] = *(const f32x4*)(ssq_q + (size_t)(row0 + ai * HALF + m * 16) * 4);
#pragma unroll
        for (int ai = 0; ai < 2; ++ai)
#pragma unroll
            for (int m = 0; m < 4; ++m) {
                const int row = row0 + ai * HALF + m * 16; const int b = row >> 12, s = row & 4095;
                const float rs = __builtin_amdgcn_rsqf(((pq[ai][m][0] + pq[ai][m][1]) + (pq[ai][m][2] + pq[ai][m][3])) * (1.f / cfg::QLR) + cfg::EPS) * cfg::QSCALE;
#pragma unroll
                for (int bj = 0; bj < 2; ++bj) {
                    const int col = u.pn * BM + bj * HALF + wc * 32 + 8 * fq, h = col / cfg::DQK, d = col - h * cfg::DQK;
                    f32x4 v0 = acc[ai][bj][m][0] * rs, v1 = acc[ai][bj][m][1] * rs;
                    if (d >= cfg::DNOPE) {
                        const int i0 = (d - cfg::DNOPE) >> 1;
                        const f32x4 cs0 = *(const f32x4*)(rope + (size_t)row * 16 + i0), cs1 = *(const f32x4*)(rope + (size_t)row * 16 + i0 + 2);
                        f32x4 r0, r1;
                        r0[0] = v0[0] * cs0[0] - v0[1] * cs0[1]; r0[1] = v0[1] * cs0[0] + v0[0] * cs0[1];
                        r0[2] = v0[2] * cs0[2] - v0[3] * cs0[3]; r0[3] = v0[3] * cs0[2] + v0[2] * cs0[3];
                        r1[0] = v1[0] * cs1[0] - v1[1] * cs1[1]; r1[1] = v1[1] * cs1[0] + v1[0] * cs1[1];
                        r1[2] = v1[2] * cs1[2] - v1[3] * cs1[3]; r1[3] = v1[3] * cs1[2] + v1[2] * cs1[3];
                        v0 = r0; v1 = r1;
                    }
                    *(u32x4*)(Q + ((size_t)(b * cfg::NH + h) * cfg::S + s) * cfg::DQK + d) = pack8(v0, v1);
                }
            }
    }
};

struct EpiKN {
    static constexpr bool PERM = true, AFTER_DRAIN = false;
    unsigned char* W; int l;
    __device__ __forceinline__ void operator()(const f32x4 (&acc)[2][2][4][2], const Unit& u_, int wr, int wc, int fr, int fq) const {
        Unit u = u_; asm volatile("" : "+s"(u.pm), "+s"(u.pn), "+v"(fr), "+v"(fq));
        const float* const ssq_kv = (const float*)(W + ws::SSQKV); bf16_t* const KF = (bf16_t*)(W + ws::KF);
        const int row0 = u.pm * BM + wr * 64 + fr;
        f32x4 pq[2][4];
#pragma unroll
        for (int ai = 0; ai < 2; ++ai)
#pragma unroll
            for (int m = 0; m < 4; ++m) pq[ai][m] = *(const f32x4*)(ssq_kv + (size_t)(row0 + ai * HALF + m * 16) * 4);
#pragma unroll
        for (int ai = 0; ai < 2; ++ai)
#pragma unroll
            for (int m = 0; m < 4; ++m) {
                const int row = row0 + ai * HALF + m * 16; const int b = row >> 12, s = row & 4095;
                const float rs = __builtin_amdgcn_rsqf(((pq[ai][m][0] + pq[ai][m][1]) + (pq[ai][m][2] + pq[ai][m][3])) * (1.f / cfg::KVLR) + cfg::EPS);
#pragma unroll
                for (int bj = 0; bj < 2; ++bj) {
                    const int col = u.pn * BM + bj * HALF + wc * 32 + 8 * fq, h = col >> 6, d = col & 63;
                    *(u32x4*)(KF + ((size_t)(b * cfg::NH + h) * cfg::S + s) * cfg::DQK + d) = pack8(acc[ai][bj][m][0] * rs, acc[ai][bj][m][1] * rs);
                }
            }
    }
};

struct EpiVT {
    static constexpr bool PERM = true, AFTER_DRAIN = false;
    unsigned char* W; int l;
    __device__ __forceinline__ void operator()(const f32x4 (&acc)[2][2][4][2], const Unit& u_, int wr, int wc, int fr, int fq) const {
        Unit u = u_; asm volatile("" : "+s"(u.pm), "+s"(u.pn), "+v"(fr), "+v"(fq));
        const float* const ssq_kv = (const float*)(W + ws::SSQKV); bf16_t* const VT = (bf16_t*)(W + ws::VT);
        const int row0 = u.pm * BM + wr * 64 + fr;
#pragma unroll
        for (int bj = 0; bj < 2; ++bj) {
            const int tok = u.pn * BM + bj * HALF + wc * 32 + 8 * fq; const int b = tok >> 12, s = tok & 4095;
            f32x4 rs0, rs1;
#pragma unroll
            for (int e = 0; e < 4; ++e) { rs0[e] = __builtin_amdgcn_rsqf(row_ssq4(ssq_kv, tok + e) * (1.f / cfg::KVLR) + cfg::EPS); rs1[e] = __builtin_amdgcn_rsqf(row_ssq4(ssq_kv, tok + 4 + e) * (1.f / cfg::KVLR) + cfg::EPS); }
#pragma unroll
            for (int ai = 0; ai < 2; ++ai)
#pragma unroll
                for (int m = 0; m < 4; ++m) {
                    const int r = row0 + ai * HALF + m * 16;
                    *(u32x4*)(VT + ((size_t)(b * 512 + r)) * cfg::S + s) = pack8(acc[ai][bj][m][0] * rs0, acc[ai][bj][m][1] * rs1);
                }
        }
    }
};

struct EpiNull {
    static constexpr bool PERM = true, AFTER_DRAIN = false;
    float* dummy;
    __device__ __forceinline__ void operator()(const f32x4 (&acc)[2][2][4][2], const Unit& u, int wr, int wc, int fr, int fq) const {
        f32x4 t = acc[0][0][0][0];
#pragma unroll
        for (int ai = 0; ai < 2; ++ai)
#pragma unroll
            for (int bj = 0; bj < 2; ++bj)
#pragma unroll
                for (int m = 0; m < 4; ++m) { t = t + acc[ai][bj][m][0]; t = t + acc[ai][bj][m][1]; }
        dummy[(size_t)(u.pm * 4 + (u.pn & 3)) * 512 + (wr * 4 + wc) * 64 + fr + 16 * fq] = (t[0] + t[1]) + (t[2] + t[3]);
    }
};
__device__ __forceinline__ void glds16_saddr(const void* sbase, unsigned voff, unsigned lds_dst) {
    asm volatile("s_mov_b32 m0, %2\n\ts_nop 0\n\tglobal_load_lds_dwordx4 %0, %1" : : "v"(voff), "s"(sbase), "s"(lds_dst) : "memory", "m0"); }
constexpr int PF_JUNK_OFF = 131072 + 8192, PF_DIST = 8;
template <class E, class = void> struct HasPrefetch { static constexpr bool v = false; };
template <class E> struct HasPrefetch<E, decltype((void)&E::prefetch)> { static constexpr bool v = true; };
template <class E, class = void> struct HasDefer { static constexpr bool v = false; struct Def {}; };
template <class E> struct HasDefer<E, decltype((void)sizeof(typename E::Def))> { static constexpr bool v = true; typedef typename E::Def Def; };
template <class Epi, class Sched, bool ALIGN_EPI = false, bool SP2 = false>
__device__ __forceinline__ void gemm_phase(PG8_LAS unsigned char* lds, const Gemm g, const Sched& S, const Epi& E) {
    int tid_ = threadIdx.x; asm volatile("" : "+v"(tid_));
    const int tid = tid_, wid = __builtin_amdgcn_readfirstlane(tid >> 6), lane = tid & 63, wr = wid >> 2, wc = wid & 3, fr = lane & 15, fq = lane >> 4;
    int K_ = g.K; asm volatile("" : "+s"(K_));
    const int K = K_, nt = K / BK; const int tpf = (nt > PF_DIST) ? ((nt - PF_DIST) & ~1) : 0; (void)tpf;
    unsigned voffA[2], voffB[2];
#pragma unroll
    for (int i = 0; i < 2; ++i) { int R, C; stage_rc(tid * 16 + i * 8192, R, C); const int Rb = Epi::PERM ? ((R & ~31) + perm32(R & 31)) : R;
        voffA[i] = (unsigned)(R * K + C) * 2u; voffB[i] = (unsigned)(Rb * K + C) * 2u; }
    const size_t kstep = (size_t)(BK * 2);
    const size_t hstep = (size_t)HALF * K * 2;
    const size_t tstep = 2 * hstep;
    const unsigned lds0_ = (unsigned)(uintptr_t)lds;
    const unsigned ldsw = (unsigned)wid * 1024u;
    const int aoff = lds_byte(wr * 64 + fr, fq * 8), boff = lds_byte(wc * 32 + fr, fq * 8);
#define PG8_SA(b, h) (((b) * 2 + (h)) * HTB)
#define PG8_SB(b, h) ((4 + (b) * 2 + (h)) * HTB)
#define PG8_STAGE(bufoff, gbase, voff) do { _Pragma("unroll") for (int _i = 0; _i < 2; ++_i) \
        glds16_saddr((const void*)(gbase), (voff)[_i], lds0_ + (unsigned)((bufoff) + _i * 8192) + ldsw); } while (0)
#define PG8_LDA(dst, b, h) do { _Pragma("unroll") for (int m = 0; m < 4; ++m) _Pragma("unroll") for (int k = 0; k < 2; ++k) dst[m][k] = *(const PG8_LAS bf16x8*)(lds + PG8_SA(b, h) + aoff + m * 2048 + k * 1024); } while (0)
#define PG8_LDB(dst, b, h) do { _Pragma("unroll") for (int n = 0; n < 2; ++n) _Pragma("unroll") for (int k = 0; k < 2; ++k) dst[n][k] = *(const PG8_LAS bf16x8*)(lds + PG8_SB(b, h) + boff + n * 2048 + k * 1024); } while (0)
#define PG8_MMA(ai, bj, At, Bt) do { if (PG8_PRIO) __builtin_amdgcn_s_setprio(1); _Pragma("unroll") for (int m = 0; m < 4; ++m) _Pragma("unroll") for (int n = 0; n < 2; ++n) _Pragma("unroll") for (int k = 0; k < 2; ++k) \
        acc[ai][bj][m][n] = __builtin_amdgcn_mfma_f32_16x16x32_bf16(Bt[n][k], At[m][k], acc[ai][bj][m][n], 0, 0, 0); if (PG8_PRIO) __builtin_amdgcn_s_setprio(0); } while (0)
#define PG8_PIN(q) do { _Pragma("unroll") for (int _q = 0; _q < 32; ++_q) { __builtin_amdgcn_sched_group_barrier(0x008, 1, 0); __builtin_amdgcn_sched_group_barrier(0x002, 1, 0); if ((_q & 3) == 0) __builtin_amdgcn_sched_group_barrier(0x400, 1, 0); } E.pin(DF, q); } while (0)
#define PG8_WAIT_V(n) asm volatile("s_waitcnt vmcnt(" #n ")" ::: "memory")
#define PG8_WAIT_L(n) asm volatile("s_waitcnt lgkmcnt(" #n ")" ::: "memory")
#define PG8_BAR __builtin_amdgcn_s_barrier()
#define PG8_SCHED __builtin_amdgcn_sched_barrier(0)
#define PG8_ITER(F0, F1, F2, F3, G0, G1, G2, G3) \
            if constexpr (HasPrefetch<Epi>::v) { if (t == tpf) E.prefetch(cur, lds + PF_JUNK_OFF + wid * 256, tid); } \
            const bool last = (t == nt - 2); \
            const char* a1 = cA + (size_t)(t + 1) * kstep; \
            const char* a2 = last ? nA : cA + (size_t)(t + 2) * kstep; const char* b2 = last ? nB : cB + (size_t)(t + 2) * kstep; \
            const char* a3 = a2 + kstep; const char* b3 = b2 + kstep; \
            if (last && has_next) S.a_ready(nxt); \
            PG8_LDB(B0, 0, 0); PG8_LDB(B1, 0, 1); PG8_SCHED; PG8_LDA(At, 0, 0); PG8_STAGE(PG8_SA(1, 1), a1 + hstep, voffA); \
            PG8_WAIT_V(8); PG8_WAIT_L(0); PG8_BAR; F0; PG8_MMA(0, 0, At, B0); PG8_MMA(0, 1, At, B1); G0; PG8_BAR; PG8_SCHED; \
            PG8_LDA(At, 0, 1); PG8_STAGE(PG8_SB(0, 0), b2, voffB); PG8_STAGE(PG8_SB(0, 1), b2 + hstep, voffB); PG8_STAGE(PG8_SA(0, 0), a2, voffA); \
            PG8_WAIT_V(8); PG8_WAIT_L(0); PG8_BAR; F1; PG8_MMA(1, 0, At, B0); PG8_MMA(1, 1, At, B1); G1; PG8_BAR; PG8_SCHED; \
            PG8_LDB(B0, 1, 0); PG8_LDB(B1, 1, 1); PG8_SCHED; PG8_LDA(At, 1, 0); PG8_STAGE(PG8_SA(0, 1), a2 + hstep, voffA); \
            PG8_WAIT_V(8); PG8_WAIT_L(0); PG8_BAR; F2; PG8_MMA(0, 0, At, B0); PG8_MMA(0, 1, At, B1); G2; PG8_BAR; PG8_SCHED; \
            PG8_LDA(At, 1, 1); PG8_STAGE(PG8_SB(1, 0), b3, voffB); PG8_STAGE(PG8_SB(1, 1), b3 + hstep, voffB); PG8_STAGE(PG8_SA(1, 0), a3, voffA); \
            PG8_WAIT_V(8); PG8_WAIT_L(0); PG8_BAR; F3; PG8_MMA(1, 0, At, B0); PG8_MMA(1, 1, At, B1); G3; PG8_BAR; PG8_SCHED;
    Unit cur, nxt; int ui = 0;
    if (!S.next(0, cur)) return;
    f32x4 acc[2][2][4][2];
#pragma unroll
    for (int a = 0; a < 2; ++a)
#pragma unroll
        for (int b = 0; b < 2; ++b)
#pragma unroll
            for (int m = 0; m < 4; ++m)
#pragma unroll
                for (int n = 0; n < 2; ++n) acc[a][b][m][n] = (f32x4){0.f, 0.f, 0.f, 0.f};
    bf16x8 At[4][2], B0[2][2], B1[2][2];
    typename HasDefer<Epi>::Def DF; Unit prv = cur; (void)prv;
    if constexpr (HasDefer<Epi>::v) {
#pragma unroll
        for (int m = 0; m < 4; ++m) { DF.a[m] = (u32x4){0u, 0u, 0u, 0u}; DF.b[m] = (u32x4){0u, 0u, 0u, 0u}; } }
    const char* cA = (const char*)g.A + (size_t)cur.pm * tstep; const char* cB = (const char*)g.Bt + (size_t)cur.pn * tstep;
    S.a_ready(cur);
    if constexpr (SP2) {
        PG8_STAGE(PG8_SB(0, 0), cB, voffB); PG8_STAGE(PG8_SB(0, 1), cB + hstep, voffB); PG8_STAGE(PG8_SA(0, 0), cA, voffA); PG8_STAGE(PG8_SA(0, 1), cA + hstep, voffA);
        if (wr == 1) PG8_BAR;
        PG8_WAIT_V(2); PG8_BAR;
        PG8_STAGE(PG8_SB(1, 0), cB + kstep, voffB); PG8_STAGE(PG8_SA(1, 0), cA + kstep, voffA); PG8_STAGE(PG8_SB(1, 1), cB + hstep + kstep, voffB);
        PG8_WAIT_V(6); PG8_BAR;
    } else {
        PG8_STAGE(PG8_SB(0, 0), cB, voffB); PG8_STAGE(PG8_SA(0, 0), cA, voffA); PG8_STAGE(PG8_SB(0, 1), cB + hstep, voffB); PG8_STAGE(PG8_SA(0, 1), cA + hstep, voffA);
        if (wr == 1) PG8_BAR;
        PG8_WAIT_V(4); PG8_BAR;
        PG8_STAGE(PG8_SB(1, 0), cB + kstep, voffB); PG8_STAGE(PG8_SA(1, 0), cA + kstep, voffA); PG8_STAGE(PG8_SB(1, 1), cB + hstep + kstep, voffB);
        PG8_WAIT_V(6); PG8_BAR;
    }
    for (;;) {
        const bool has_next = S.next(ui + 1, nxt);
        const char* nA = has_next ? (const char*)g.A + (size_t)nxt.pm * tstep : cA; const char* nB = has_next ? (const char*)g.Bt + (size_t)nxt.pn * tstep : cB;
        if constexpr (SP2) {
            if constexpr (HasDefer<Epi>::v) {
                { const int t = 0; constexpr bool PG8_PRIO = false; PG8_ITER(PG8_SCHED; E.later(DF, 0), PG8_SCHED; E.later(DF, 1), PG8_SCHED; E.later(DF, 2), PG8_SCHED; E.later(DF, 3), PG8_PIN(0), PG8_PIN(1), PG8_PIN(2), PG8_PIN(3)) }
                if constexpr (Epi::ND == 4) { const int t = 2; constexpr bool PG8_PRIO = false; PG8_ITER(PG8_SCHED; E.later(DF, 4), PG8_SCHED; E.later(DF, 5), PG8_SCHED; E.later(DF, 6), PG8_SCHED; E.later(DF, 7), PG8_PIN(4), PG8_PIN(5), PG8_PIN(6), PG8_PIN(7)) }
                for (int t = Epi::ND; t < nt; t += 2) { constexpr bool PG8_PRIO = true; PG8_ITER((void)0, (void)0, (void)0, (void)0, (void)0, (void)0, (void)0, (void)0) }
            } else {
                for (int t = 0; t < nt; t += 2) { constexpr bool PG8_PRIO = true; PG8_ITER((void)0, (void)0, (void)0, (void)0, (void)0, (void)0, (void)0, (void)0) }
            }
        } else {
        for (int t = 0; t < nt; t += 2) { constexpr bool PG8_PRIO = true;
            if constexpr (HasPrefetch<Epi>::v) { if (t == tpf) E.prefetch(cur, lds + PF_JUNK_OFF + wid * 256, tid); }
            const bool last = (t == nt - 2);
            const char* a1 = cA + (size_t)(t + 1) * kstep;
            const char* a2 = last ? nA : cA + (size_t)(t + 2) * kstep; const char* b2 = last ? nB : cB + (size_t)(t + 2) * kstep;
            const char* a3 = a2 + kstep; const char* b3 = b2 + kstep;
            if (last && has_next) S.a_ready(nxt);
            PG8_LDB(B0, 0, 0); PG8_SCHED; PG8_LDA(At, 0, 0); PG8_STAGE(PG8_SA(1, 1), a1 + hstep, voffA);
            PG8_WAIT_L(8); PG8_BAR; PG8_WAIT_L(0); PG8_MMA(0, 0, At, B0); PG8_BAR; PG8_SCHED;
            PG8_LDB(B1, 0, 1); PG8_STAGE(PG8_SB(0, 0), b2, voffB);
            PG8_BAR; PG8_WAIT_L(0); PG8_MMA(0, 1, At, B1); PG8_BAR;
            PG8_LDA(At, 0, 1); PG8_STAGE(PG8_SA(0, 0), a2, voffA);
            PG8_BAR; PG8_WAIT_L(0); PG8_MMA(1, 0, At, B0); PG8_BAR; PG8_SCHED;
            PG8_STAGE(PG8_SB(0, 1), b2 + hstep, voffB);
            PG8_WAIT_V(6); PG8_BAR; PG8_MMA(1, 1, At, B1); PG8_BAR;
            PG8_LDB(B0, 1, 0); PG8_SCHED; PG8_LDA(At, 1, 0); PG8_STAGE(PG8_SA(0, 1), a2 + hstep, voffA);
            PG8_WAIT_L(8); PG8_BAR; PG8_WAIT_L(0); PG8_MMA(0, 0, At, B0); PG8_BAR; PG8_SCHED;
            PG8_LDB(B1, 1, 1); PG8_STAGE(PG8_SB(1, 0), b3, voffB);
            PG8_BAR; PG8_WAIT_L(0); PG8_MMA(0, 1, At, B1); PG8_BAR;
            PG8_LDA(At, 1, 1); PG8_STAGE(PG8_SA(1, 0), a3, voffA);
            PG8_BAR; PG8_WAIT_L(0); PG8_MMA(1, 0, At, B0); PG8_BAR; PG8_SCHED;
            PG8_STAGE(PG8_SB(1, 1), b3 + hstep, voffB);
            PG8_WAIT_V(6); PG8_BAR; PG8_MMA(1, 1, At, B1); PG8_BAR;
        }
        }
        if constexpr (ALIGN_EPI) { if (wr == 0) PG8_BAR; }
        if constexpr (HasDefer<Epi>::v) {
            if (ui > 0) E.flush(DF, prv, wr, wc, fr, fq);
            if (has_next) { E.template run<true>(acc, cur, wr, wc, fr, fq, DF); prv = cur; } else E.template run<false>(acc, cur, wr, wc, fr, fq, DF);
            S.done(cur);
        } else
        if constexpr (!Epi::AFTER_DRAIN) { E(acc, cur, wr, wc, fr, fq); S.done(cur); }
        if (!has_next) break;
#pragma unroll
        for (int a = 0; a < 2; ++a)
#pragma unroll
            for (int b = 0; b < 2; ++b)
#pragma unroll
                for (int m = 0; m < 4; ++m)
#pragma unroll
                    for (int n = 0; n < 2; ++n) acc[a][b][m][n] = (f32x4){0.f, 0.f, 0.f, 0.f};
        cur = nxt; cA = nA; cB = nB; ++ui;
        if constexpr (ALIGN_EPI) { if (wr == 1) PG8_BAR; }
    }
    PG8_WAIT_V(0);
    if constexpr (!ALIGN_EPI) { if (wr == 0) PG8_BAR; }
    PG8_BAR;
    if constexpr (Epi::AFTER_DRAIN) { E.fused(acc, cur, wr, wc, fr, fq, lds, wid, lane); S.done(cur); }
#undef PG8_SA
#undef PG8_SB
#undef PG8_STAGE
#undef PG8_LDA
#undef PG8_LDB
#undef PG8_MMA
#undef PG8_WAIT_V
#undef PG8_ITER
#undef PG8_PIN
#undef PG8_WAIT_L
#undef PG8_BAR
#undef PG8_SCHED
}
}
#define XB_TMO      128
#define XB_XCNT(j)  (256  + 64 * (j))
#define XB_XSUB(j)  (1280 + 64 * (j))
#define XB_XGEN(j)  (2304 + 64 * (j))
#define XB_TOP      3328
#define XB_TOPGEN   3392
#define XCD_BAR_WORDS 3456
#define XB_SPIN_CAP (1u << 18)

__device__ __forceinline__ unsigned xb_ld(unsigned* p)              { return __hip_atomic_load(p, __ATOMIC_RELAXED, __HIP_MEMORY_SCOPE_AGENT); }
__device__ __forceinline__ unsigned xb_add(unsigned* p, unsigned v) { return __hip_atomic_fetch_add(p, v, __ATOMIC_RELAXED, __HIP_MEMORY_SCOPE_AGENT); }
__device__ __forceinline__ unsigned xb_xcc_id() { return (unsigned)__builtin_amdgcn_s_getreg((3 << 11) | 20) & 0xFu; }
#define XB_SPIN(cond, bar) do { unsigned _sp = 0; while (cond) { __builtin_amdgcn_s_sleep(1); \
    if ((++_sp & 255u) == 0u) { if (xb_ld(&(bar)[XB_TMO])) break; if (_sp > XB_SPIN_CAP) { atomicAdd(&(bar)[XB_TMO], 1u); break; } } } } while (0)

struct XcdBarrier {
    unsigned* bar; unsigned x;
    volatile LAS unsigned* st;
};

__device__ __forceinline__ XcdBarrier xcd_barrier_post(unsigned* bar, volatile LAS unsigned* st) {
    XcdBarrier b; b.bar = bar; b.x = xb_xcc_id(); b.st = st;
    if (threadIdx.x == 0) (void)xb_add(&bar[XB_XCNT(b.x)], 1u);
    return b;
}
__device__ __forceinline__ void xcd_barrier_complete(unsigned* bar, unsigned x, unsigned& nloc, unsigned& nx) {
    const unsigned G = gridDim.x * gridDim.y * gridDim.z;
    unsigned sum, cnt, mine, sp = 0u;
    for (;;) {
        sum = 0u; cnt = 0u; mine = 0u;
#pragma unroll
        for (unsigned j = 0; j < 16; ++j) { const unsigned c = xb_ld(&bar[XB_XCNT(j)]); sum += c; cnt += (c > 0u) ? 1u : 0u; mine = (j == x) ? c : mine; }
        if (sum == G) break;
        __builtin_amdgcn_s_sleep(1);
        if ((++sp & 255u) == 0u) { if (xb_ld(&bar[XB_TMO])) break; if (sp > XB_SPIN_CAP) { atomicAdd(&bar[XB_TMO], 1u); break; } }
    }
    nloc = mine > 0u ? mine : 1u; nx = cnt > 0u ? cnt : 1u;
}

__device__ __forceinline__ void xcd_barrier(const XcdBarrier& b) {
    asm volatile("s_waitcnt vmcnt(0)" ::: "memory");
    __syncthreads();
    if (threadIdx.x == 0) {
        unsigned* bar = b.bar;
        __builtin_amdgcn_s_waitcnt(0);
        unsigned nloc = b.st[0], nx = b.st[1];
        if (nloc == 0u) { xcd_barrier_complete(bar, b.x, nloc, nx); b.st[0] = nloc; b.st[1] = nx; }
        const unsigned old = xb_add(&bar[XB_XSUB(b.x)], 1u);
        const unsigned gen = old / nloc;
        if (old + 1u == (gen + 1u) * nloc) {
            __builtin_amdgcn_fence(__ATOMIC_RELEASE, "agent");
            asm volatile("s_waitcnt vmcnt(0)" ::: "memory");
            const unsigned og = xb_add(&bar[XB_TOP], 1u);
            const unsigned tg = og / nx;
            if (og + 1u == (tg + 1u) * nx) xb_add(&bar[XB_TOPGEN], 1u);
            else XB_SPIN(xb_ld(&bar[XB_TOPGEN]) == tg, bar);
            __builtin_amdgcn_fence(__ATOMIC_ACQUIRE, "agent");
            xb_add(&bar[XB_XGEN(b.x)], 1u);
            asm volatile("s_waitcnt vmcnt(0)" ::: "memory");
        } else {
            XB_SPIN(xb_ld(&bar[XB_XGEN(b.x)]) == gen, bar);
            __builtin_amdgcn_fence(__ATOMIC_ACQUIRE, "agent");
            asm volatile("s_waitcnt vmcnt(0)" ::: "memory");
        }
    }
    __syncthreads();
}
typedef __bf16 bf16x2_t __attribute__((ext_vector_type(2)));
__device__ __forceinline__ unsigned cvtpk(float lo, float hi) { const f32x2 v = {lo, hi}; const bf16x2_t b = __builtin_convertvector(v, bf16x2_t); return __builtin_bit_cast(unsigned, b); }
__device__ __forceinline__ float bf2f(unsigned short b) { return __uint_as_float((unsigned)b << 16); }
__device__ __forceinline__ float bflo(unsigned w) { return __uint_as_float(w << 16); }
__device__ __forceinline__ float bfhi(unsigned w) { return __uint_as_float(w & 0xffff0000u); }
__device__ __forceinline__ void glds16(const void* gsrc, unsigned lds_dst) { unsigned keep;
    asm volatile("s_mov_b32 %0, m0\n\ts_mov_b32 m0, %2\n\ts_nop 0\n\tglobal_load_lds_dwordx4 %1, off\n\ts_mov_b32 m0, %0" : "=&s"(keep) : "v"(gsrc), "s"(lds_dst) : "memory"); }
__device__ __forceinline__ float half_swap_max(float m) { auto rr = __builtin_amdgcn_permlane32_swap(__float_as_uint(m), __float_as_uint(m), false, false); return fmaxf(__uint_as_float(rr[0]), __uint_as_float(rr[1])); }
__device__ __forceinline__ float half_swap_sum(float m) { auto rr = __builtin_amdgcn_permlane32_swap(__float_as_uint(m), __float_as_uint(m), false, false); return __uint_as_float(rr[0]) + __uint_as_float(rr[1]); }

namespace att {
constexpr int KTB = 64 * 192, VTB = 64 * 128, NSTG = 6;
constexpr int L_K = 0, L_V = NSTG * KTB, L_END = L_V + NSTG * VTB;
constexpr float THR = 8.f;
#define ATT_WAITBAR(N) asm volatile("s_waitcnt vmcnt(" #N ") lgkmcnt(0)\n\ts_barrier" ::: "memory")
__device__ __forceinline__ int slot_of(int t) { return t % NSTG; }
__device__ __forceinline__ float max3(float a, float b, float c) { return fmaxf(fmaxf(a, b), c); }

__device__ __forceinline__ void qk_tile(f32x16& p0, f32x16& p1, const LAS unsigned char* kb, const bf16x8 (&qf)[6], const f32x16& negm, int hi, int kc) {
    int g0 = hi + kc; if (g0 >= 12) g0 -= 12;
    bf16x8 ka[2][2];
#pragma unroll
    for (int d = 0; d < 2; ++d) { int g = g0 + 2 * d; if (g >= 12) g -= 12; ka[d][0] = *(const LAS bf16x8*)(kb + g * 16); ka[d][1] = *(const LAS bf16x8*)(kb + 32 * 192 + g * 16); }
#pragma unroll
    for (int d = 0; d < 6; ++d) {
        if (d == 0) { p0 = __builtin_amdgcn_mfma_f32_32x32x16_bf16(ka[0][0], qf[0], negm, 0, 0, 0); p1 = __builtin_amdgcn_mfma_f32_32x32x16_bf16(ka[0][1], qf[0], negm, 0, 0, 0); }
        else { p0 = __builtin_amdgcn_mfma_f32_32x32x16_bf16(ka[d & 1][0], qf[d], p0, 0, 0, 0); p1 = __builtin_amdgcn_mfma_f32_32x32x16_bf16(ka[d & 1][1], qf[d], p1, 0, 0, 0); }
        if (d + 2 < 6) { int g = g0 + 2 * (d + 2); if (g >= 12) g -= 12; if (g >= 12) g -= 12; ka[d & 1][0] = *(const LAS bf16x8*)(kb + g * 16); ka[d & 1][1] = *(const LAS bf16x8*)(kb + 32 * 192 + g * 16); }
    }
}
__device__ __forceinline__ void mask_tile(f32x16& p0, f32x16& p1, int kb0, int qrel) {
#pragma unroll
    for (int r = 0; r < 16; ++r) { const int kv = kb0 + 16 * (r >> 3) + (r & 7); if (kv > qrel) p0[r] = -INFINITY; if (kv + 32 > qrel) p1[r] = -INFINITY; }
}

__device__ __forceinline__ void attn_unit(LAS unsigned char* lds, int bh, int qbA, int qbB, const bf16_t* __restrict__ Q, const bf16_t* __restrict__ KF, const bf16_t* __restrict__ VT, bf16_t* __restrict__ Y, gu32* qhead, unsigned& knext) {
    int tid_ = threadIdx.x; asm volatile("" : "+v"(tid_));
    const int tid = tid_, lane = tid & 63, r32 = lane & 31, hi = lane >> 5;
    const int wid = __builtin_amdgcn_readfirstlane(tid >> 6);
    const unsigned lds0 = (unsigned)(uintptr_t)lds;
    const char* Kg = (const char*)(KF + (size_t)bh * cfg::S * cfg::DQK);
    const char* Vg = (const char*)(VT + (size_t)bh * cfg::DVH * cfg::S);
    const char *s0, *s1, *s2; unsigned d0, d1, d2; int str1, lst1;
    { const int p = wid * 64 + lane, row = p / 12, gq = p - row * 12; int g = gq - ((row >> 2) & 3); if (g < 0) g += 12; s0 = Kg + row * 192 + g * 16; d0 = lds0 + L_K + wid * 1024; }
    if (wid < 4) { const int p = (wid + 8) * 64 + lane, row = p / 12, gq = p - row * 12; int g = gq - ((row >> 2) & 3); if (g < 0) g += 12; s1 = Kg + row * 192 + g * 16; d1 = lds0 + L_K + (wid + 8) * 1024; str1 = KTB; lst1 = KTB; }
    else { const int p = (wid - 4) * 64 + lane, row = p >> 3, gq = p & 7, g = gq ^ ((row >> 1) & 7); s1 = Vg + (size_t)row * (cfg::S * 2) + g * 16; d1 = lds0 + L_V + (wid - 4) * 1024; str1 = 128; lst1 = VTB; }
    { const int p = ((wid & 3) + 4) * 64 + lane, row = p >> 3, gq = p & 7, g = gq ^ ((row >> 1) & 7); s2 = Vg + (size_t)row * (cfg::S * 2) + g * 16; d2 = lds0 + L_V + ((wid & 3) + 4) * 1024; }
#define ATT_ISSUE(t, stg) do { glds16(s0 + (size_t)(t) * KTB, (unsigned)__builtin_amdgcn_readfirstlane(d0 + (stg) * KTB)); \
        glds16(s1 + (size_t)(t) * str1, (unsigned)__builtin_amdgcn_readfirstlane(d1 + (stg) * lst1)); \
        if (wid < 4) glds16(s2 + (size_t)(t) * 128, (unsigned)__builtin_amdgcn_readfirstlane(d2 + (stg) * VTB)); } while (0)
    const int NTA = 4 * (qbA + 1), NTT = NTA + ((qbB >= 0) ? 4 * (qbB + 1) : 0);
#define ATT_ISSUE_T(T) do { const int T_ = (T); ATT_ISSUE((T_ < NTA) ? T_ : T_ - NTA, slot_of(T_)); } while (0)
    ATT_ISSUE_T(0); ATT_ISSUE_T(1); ATT_ISSUE_T(2); ATT_ISSUE_T(3);
    const int krow = (r32 & 0x13) | ((r32 & 4) << 1) | ((r32 & 8) >> 1);
    const int kc = (krow >> 2) & 3;
    const LAS unsigned char* kbase = lds + L_K + krow * 192;
    const LAS unsigned char* vbase = lds + L_V + r32 * 128;
    const int vx = (r32 >> 1) & 7;
    const int qrel = wid * 32 + r32;
  for (int half = 0; half < ((qbB >= 0) ? 2 : 1); ++half) {
    const int qb = half ? qbB : qbA, TO = half ? NTA : 0;
    const int NT = 4 * (qb + 1);
    const bf16_t* Qw = Q + ((size_t)bh * cfg::S + qb * 256 + wid * 32 + r32) * cfg::DQK + hi * 8;
    bf16x8 qf[6];
#pragma unroll
    for (int d = 0; d < 6; ++d) qf[d] = *(const bf16x8*)(Qw + d * 16);
    f32x16 o0, o1, negm;
#pragma unroll
    for (int r = 0; r < 16; ++r) { o0[r] = 0.f; o1[r] = 0.f; negm[r] = 0.f; }
    float mref = 0.f, l_run = 0.f;
    const int qminw = qb * 256 + wid * 32;
    const int tlast = (qminw + 31) >> 6;
    f32x16 pa0, pa1, pb0, pb1;
    if (wid < 4) ATT_WAITBAR(9); else ATT_WAITBAR(6);
    qk_tile(pa0, pa1, kbase + slot_of(TO) * KTB, qf, negm, hi, kc);
    if (63 > qminw) mask_tile(pa0, pa1, -qb * 256 + 8 * hi, qrel);
#define ATT_ROWMAX(c0, c1, rm) float rm; { float ma = max3(c0[0], c0[1], c1[0]), mb = max3(c0[2], c0[3], c1[1]); ma = max3(ma, c1[2], c1[3]); \
        _Pragma("unroll") for (int r = 4; r < 16; r += 4) { ma = max3(ma, c0[r], c0[r + 1]); mb = max3(mb, c0[r + 2], c0[r + 3]); ma = max3(ma, c1[r], c1[r + 1]); mb = max3(mb, c1[r + 2], c1[r + 3]); } \
        rm = half_swap_max(fmaxf(ma, mb)); }
    { ATT_ROWMAX(pa0, pa1, rm0); mref = rm0;
#pragma unroll
      for (int r = 0; r < 16; ++r) { pa0[r] -= rm0; pa1[r] -= rm0; negm[r] = -rm0; } }
#define ATT_RESCALE(c0, c1, rm) if (__builtin_expect(__any(rm > THR), 0)) { const float dl = fmaxf(rm, 0.f); mref += dl; \
        _Pragma("unroll") for (int r = 0; r < 16; ++r) { c0[r] -= dl; c1[r] -= dl; negm[r] = -mref; } \
        const float f = __builtin_amdgcn_exp2f(-dl); l_run *= f; \
        _Pragma("unroll") for (int r = 0; r < 16; ++r) { o0[r] *= f; o1[r] *= f; } }
    u32x4 pw0, pw1, pw2, pw3;
#define ATT_EXPPACK(c0, c1) do { \
        _Pragma("unroll") for (int r = 0; r < 16; ++r) { c0[r] = __builtin_amdgcn_exp2f(c0[r]); c1[r] = __builtin_amdgcn_exp2f(c1[r]); } \
        f32x2 sacc = {0.f, 0.f}; \
        _Pragma("unroll") for (int r = 0; r < 16; r += 2) { sacc += (f32x2){c0[r], c0[r + 1]}; sacc += (f32x2){c1[r], c1[r + 1]}; } \
        l_run += sacc[0] + sacc[1]; \
        pw0 = (u32x4){cvtpk(c0[0], c0[1]), cvtpk(c0[2], c0[3]), cvtpk(c0[4], c0[5]), cvtpk(c0[6], c0[7])}; \
        pw1 = (u32x4){cvtpk(c0[8], c0[9]), cvtpk(c0[10], c0[11]), cvtpk(c0[12], c0[13]), cvtpk(c0[14], c0[15])}; \
        pw2 = (u32x4){cvtpk(c1[0], c1[1]), cvtpk(c1[2], c1[3]), cvtpk(c1[4], c1[5]), cvtpk(c1[6], c1[7])}; \
        pw3 = (u32x4){cvtpk(c1[8], c1[9]), cvtpk(c1[10], c1[11]), cvtpk(c1[12], c1[13]), cvtpk(c1[14], c1[15])}; } while (0)
#define ATT_PV(slot) do { const LAS unsigned char* vb = vbase + (slot) * VTB; \
        _Pragma("unroll") for (int ks = 0; ks < 4; ++ks) { const int g = (2 * ks + hi) ^ vx; \
            const bf16x8 v0 = *(const LAS bf16x8*)(vb + g * 16), v1 = *(const LAS bf16x8*)(vb + 32 * 128 + g * 16); \
            const bf16x8 pf = __builtin_bit_cast(bf16x8, (ks == 0) ? pw0 : (ks == 1) ? pw1 : (ks == 2) ? pw2 : pw3); \
            o0 = __builtin_amdgcn_mfma_f32_32x32x16_bf16(v0, pf, o0, 0, 0, 0); o1 = __builtin_amdgcn_mfma_f32_32x32x16_bf16(v1, pf, o1, 0, 0, 0); } } while (0)
#define ATT_STEADY(cur0, cur1, nxt0, nxt1, t) do { const int t_ = (t); \
        if (wid < 4) ATT_WAITBAR(6); else ATT_WAITBAR(4);            \
        ATT_ISSUE_T(TO + t_ + 4); \
        ATT_ROWMAX(cur0, cur1, rm_); ATT_RESCALE(cur0, cur1, rm_); \
        bf16x8 vf_[2][2];                                              \
        { const LAS unsigned char* vb_ = vbase + slot_of(TO + t_) * VTB; \
          _Pragma("unroll") for (int ks = 0; ks < 2; ++ks) { const int g = (2 * ks + hi) ^ vx; vf_[ks][0] = *(const LAS bf16x8*)(vb_ + g * 16); vf_[ks][1] = *(const LAS bf16x8*)(vb_ + 32 * 128 + g * 16); } } \
        __builtin_amdgcn_sched_barrier(0); \
        qk_tile(nxt0, nxt1, kbase + slot_of(TO + t_ + 1) * KTB, qf, negm, hi, kc); ATT_EXPPACK(cur0, cur1); \
        { const LAS unsigned char* vb_ = vbase + slot_of(TO + t_) * VTB; \
          _Pragma("unroll") for (int ks = 0; ks < 4; ++ks) { const bf16x8 pf = __builtin_bit_cast(bf16x8, (ks == 0) ? pw0 : (ks == 1) ? pw1 : (ks == 2) ? pw2 : pw3); \
            o0 = __builtin_amdgcn_mfma_f32_32x32x16_bf16(vf_[ks & 1][0], pf, o0, 0, 0, 0); o1 = __builtin_amdgcn_mfma_f32_32x32x16_bf16(vf_[ks & 1][1], pf, o1, 0, 0, 0); \
            if (ks < 2) { const int g = (2 * (ks + 2) + hi) ^ vx; vf_[ks][0] = *(const LAS bf16x8*)(vb_ + g * 16); vf_[ks][1] = *(const LAS bf16x8*)(vb_ + 32 * 128 + g * 16); } } } } while (0)
#define ATT_GENERAL(cur0, cur1, nxt0, nxt1, t) do { const int t_ = (t); \
        if (t_ + 1 < NT) { const int left = NTT - (TO + t_) - 2, nfly = (left < 2) ? left : 2;        \
            if (nfly == 2) { if (wid < 4) ATT_WAITBAR(6); else ATT_WAITBAR(4); } else if (nfly == 1) { if (wid < 4) ATT_WAITBAR(3); else ATT_WAITBAR(2); } else ATT_WAITBAR(0); } \
        if (TO + t_ + 4 < NTT) ATT_ISSUE_T(TO + t_ + 4);        \
        const bool do_cur = (t_ <= tlast), do_next = (t_ + 1 < NT) && (t_ + 1 <= tlast); \
        if (do_cur) { ATT_ROWMAX(cur0, cur1, rm_); ATT_RESCALE(cur0, cur1, rm_); } \
        if (do_next) { qk_tile(nxt0, nxt1, kbase + slot_of(TO + t_ + 1) * KTB, qf, negm, hi, kc); \
            if (64 * (t_ + 1) + 63 > qminw) mask_tile(nxt0, nxt1, 64 * (t_ + 1) - qb * 256 + 8 * hi, qrel); } \
        if (do_cur) { ATT_EXPPACK(cur0, cur1); ATT_PV(slot_of(TO + t_)); } } while (0)
    int t = 0;
    for (; t + 3 <= 4 * qb; t += 2) {
        ATT_STEADY(pa0, pa1, pb0, pb1, t);
        ATT_STEADY(pb0, pb1, pa0, pa1, t + 1);
    }
    if (half == ((qbB >= 0) ? 1 : 0) && tid == 0) knext = __hip_atomic_fetch_add(qhead, 1u, __ATOMIC_RELAXED, __HIP_MEMORY_SCOPE_AGENT);
    for (; t < NT; t += 2) {
        ATT_GENERAL(pa0, pa1, pb0, pb1, t);
        ATT_GENERAL(pb0, pb1, pa0, pa1, t + 1);
    }
#undef ATT_STEADY
#undef ATT_GENERAL
#undef ATT_PV
#undef ATT_EXPPACK
#undef ATT_RESCALE
#undef ATT_ROWMAX
    const float l_tot = half_swap_sum(l_run), inv = 1.f / l_tot;
    float ss = 0.f;
#pragma unroll
    for (int r = 0; r < 16; ++r) { o0[r] *= inv; o1[r] *= inv; ss += o0[r] * o0[r] + o1[r] * o1[r]; }
    ss = half_swap_sum(ss);
    const float rs = __builtin_amdgcn_rsqf(ss * (1.f / cfg::DVH) + cfg::EPS);
    bf16_t* yp = Y + ((size_t)(bh >> 3) * cfg::S + qb * 256 + qrel) * cfg::D + (bh & 7) * cfg::DVH + 4 * hi;
#pragma unroll
    for (int rg = 0; rg < 4; ++rg) {
        u32x2 w0, w1; w0.x = cvtpk(o0[4 * rg] * rs, o0[4 * rg + 1] * rs); w0.y = cvtpk(o0[4 * rg + 2] * rs, o0[4 * rg + 3] * rs);
        w1.x = cvtpk(o1[4 * rg] * rs, o1[4 * rg + 1] * rs); w1.y = cvtpk(o1[4 * rg + 2] * rs, o1[4 * rg + 3] * rs);
        *(u32x2*)(yp + 8 * rg) = w0; *(u32x2*)(yp + 32 + 8 * rg) = w1;
    }
  }
    ATT_WAITBAR(0);
#undef ATT_ISSUE_T
#undef ATT_ISSUE
}
}
namespace mls {
constexpr int PITCH = 144, VPITCH = 304;
constexpr int O_QN = 0, O_KN = 64 * PITCH, O_VN = 2 * 64 * PITCH, O_G = O_VN + 64 * VPITCH, STAGE = O_G + 1024;
constexpr int O_HS = 2 * STAGE, O_CW = O_HS + 2 * 8 * 64 * 4, L_END = O_CW + (5 * 128) * 4;
static_assert(STAGE % 16 == 0 && O_G % 16 == 0 && O_VN % 16 == 0, "mls LDS map");
typedef short v4i16_t __attribute__((ext_vector_type(4)));
__device__ __forceinline__ s16x4 trrd(const LAS unsigned char* p) { return __builtin_bit_cast(s16x4, __builtin_amdgcn_ds_read_tr16_b64_v4i16((LAS v4i16_t*)p)); }
__device__ __forceinline__ bf16x8 cat8(const s16x4 a, const s16x4 b) { return (bf16x8){a[0], a[1], a[2], a[3], b[0], b[1], b[2], b[3]}; }

struct StageRegs { bf16x8 rq[4], rk[4], rv[2]; float ig, lf; u32x2 og[4]; };

__device__ __forceinline__ void load_stage(StageRegs& R, int b, int h, int c, const bf16_t* __restrict__ QM, const bf16_t* __restrict__ KM, const bf16_t* __restrict__ VM, const bf16_t* __restrict__ OG,
                                           const float* __restrict__ IF, int tid) {
    const int r = tid >> 3, c8 = tid & 7, lane = tid & 63, wid = tid >> 6;
    const int tok = b * cfg::S + c * 64 + r;
#pragma unroll
    for (int j = 0; j < 4; ++j) {
        const bool ok = (c > 0) || (r - 3 + j >= 0);
        const size_t off = (size_t)(tok - 3 + j) * 256 + h * 64 + c8 * 8;
        R.rq[j] = ok ? *(const bf16x8*)(QM + off) : (bf16x8){0, 0, 0, 0, 0, 0, 0, 0};
        R.rk[j] = ok ? *(const bf16x8*)(KM + off) : (bf16x8){0, 0, 0, 0, 0, 0, 0, 0};
    }
    R.rv[0] = *(const bf16x8*)(VM + (size_t)tok * 512 + h * 128 + c8 * 8);
    R.rv[1] = *(const bf16x8*)(VM + (size_t)tok * 512 + h * 128 + 64 + c8 * 8);
    { const size_t tg = (size_t)b * cfg::S + c * 64 + lane; R.ig = IF[tg * 8 + h]; R.lf = IF[tg * 8 + 4 + h]; }
#pragma unroll
    for (int lb = 0; lb < 4; ++lb) R.og[lb] = *(const u32x2*)(OG + ((size_t)b * cfg::S + c * 64 + 16 * lb + (lane & 15)) * 512 + h * 128 + 16 * wid + 4 * ((lane >> 4) & 3));
}
__device__ __forceinline__ void write_stage(const StageRegs& R, LAS unsigned char* st, const LAS float* cw, int tid) {
    const int r = tid >> 3, c8 = tid & 7, lane = tid & 63, wid = tid >> 6;
    float q[8], k[8];
#pragma unroll
    for (int e = 0; e < 8; ++e) { q[e] = cw[512 + 8 * c8 + e]; k[e] = cw[512 + 64 + 8 * c8 + e]; }
#pragma unroll
    for (int j = 0; j < 4; ++j)
#pragma unroll
        for (int e = 0; e < 8; ++e) { q[e] += cw[j * 128 + 8 * c8 + e] * bf2f((unsigned short)R.rq[j][e]); k[e] += cw[j * 128 + 64 + 8 * c8 + e] * bf2f((unsigned short)R.rk[j][e]); }
#pragma unroll
    for (int e = 0; e < 8; ++e) { q[e] = pg8::silu_f(q[e]) * 0.125f; k[e] = pg8::silu_f(k[e]); }
    u32x4 qw, kw; qw.x = cvtpk(q[0], q[1]); qw.y = cvtpk(q[2], q[3]); qw.z = cvtpk(q[4], q[5]); qw.w = cvtpk(q[6], q[7]);
    kw.x = cvtpk(k[0], k[1]); kw.y = cvtpk(k[2], k[3]); kw.z = cvtpk(k[4], k[5]); kw.w = cvtpk(k[6], k[7]);
    *(LAS u32x4*)(st + O_QN + r * PITCH + c8 * 16) = qw;
    *(LAS u32x4*)(st + O_KN + r * PITCH + c8 * 16) = kw;
    *(LAS bf16x8*)(st + O_VN + r * VPITCH + c8 * 16) = R.rv[0];
    *(LAS bf16x8*)(st + O_VN + r * VPITCH + 128 + c8 * 16) = R.rv[1];
    if (wid == 0) {
        float bsum = R.lf;
#pragma unroll
        for (int o = 1; o < 64; o <<= 1) { const float t = __uint_as_float((unsigned)__builtin_amdgcn_ds_bpermute((lane - o) << 2, (int)__float_as_uint(bsum))); if (lane >= o) bsum += t; }
        const float u = R.ig - bsum; float cm = u;
#pragma unroll
        for (int o = 1; o < 64; o <<= 1) { const float t = __uint_as_float((unsigned)__builtin_amdgcn_ds_bpermute((lane - o) << 2, (int)__float_as_uint(cm))); if (lane >= o) cm = fmaxf(cm, t); }
        LAS float* G = (LAS float*)(st + O_G);
        G[lane] = bsum; G[64 + lane] = u; G[128 + lane] = cm;
        if (lane == 63) { G[192] = bsum; G[193] = cm; }
    }
}

__device__ __forceinline__ void mlstm_unit(LAS unsigned char* lds, int b, int h, const bf16_t* __restrict__ QM, const bf16_t* __restrict__ KM, const bf16_t* __restrict__ VM, const bf16_t* __restrict__ OG,
                                           const float* __restrict__ IF, const float* __restrict__ convw, const float* __restrict__ convb, bf16_t* __restrict__ Y) {
    int tid_ = threadIdx.x; asm volatile("" : "+v"(tid_));
    const int tid = tid_, lane = tid & 63, fr = lane & 15, g = lane >> 4;
    const int wid = __builtin_amdgcn_readfirstlane(tid >> 6);
    LAS float* cw = (LAS float*)(lds + O_CW);
    for (int i = tid; i < 640; i += 512) { const int j = i >> 7, ch = i & 127; const int gch = (ch < 64) ? (h * 64 + ch) : (256 + h * 64 + ch - 64);
        cw[i] = (j < 4) ? convw[j * 512 + gch] : convb[gch]; }
    __syncthreads();
    StageRegs R;
    load_stage(R, b, h, 0, QM, KM, VM, OG, IF, tid);
    write_stage(R, lds, cw, tid);
    __syncthreads();
    f32x4 C[4][2];
#pragma unroll
    for (int kb = 0; kb < 4; ++kb) { C[kb][0] = (f32x4){0.f, 0.f, 0.f, 0.f}; C[kb][1] = (f32x4){0.f, 0.f, 0.f, 0.f}; }
    float m_prev = 0.f;
    const bf16x8 ones = {0x3F80, 0x3F80, 0x3F80, 0x3F80, 0x3F80, 0x3F80, 0x3F80, 0x3F80};
    const int trV = (fr >> 2) * VPITCH + (16 * wid + 4 * (fr & 3)) * 2;
    const int trK = (fr >> 2) * PITCH + (4 * (fr & 3)) * 2;
    for (int c = 0; c < cfg::NCHUNK; ++c) {
        const LAS unsigned char* st = lds + (c & 1) * STAGE;
        LAS unsigned char* stn = lds + ((c + 1) & 1) * STAGE;
        const u32x2 og0 = R.og[0], og1 = R.og[1], og2 = R.og[2], og3 = R.og[3];
        if (c + 1 < cfg::NCHUNK) load_stage(R, b, h, c + 1, QM, KM, VM, OG, IF, tid);
        const LAS float* G = (const LAS float*)(st + O_G);
        const float b_end = G[192], umax = G[193];
        bf16x8 Cf[2][2];
#pragma unroll
        for (int c2 = 0; c2 < 2; ++c2)
#pragma unroll
            for (int p2 = 0; p2 < 2; ++p2) { u32x4 w; w.x = cvtpk(C[2 * p2][c2][0], C[2 * p2][c2][1]); w.y = cvtpk(C[2 * p2][c2][2], C[2 * p2][c2][3]);
                w.z = cvtpk(C[2 * p2 + 1][c2][0], C[2 * p2 + 1][c2][1]); w.w = cvtpk(C[2 * p2 + 1][c2][2], C[2 * p2 + 1][c2][3]); Cf[c2][p2] = __builtin_bit_cast(bf16x8, w); }
        f32x4 hv[4]; float hsq[4];
#pragma unroll
        for (int lb = 0; lb < 4; ++lb) {
            const int l = 16 * lb + fr;
            const float wl = fmaxf(m_prev, G[128 + l]), bl = G[l];
            const LAS unsigned char* qrow = st + O_QN + l * PITCH;
            const bf16x8 qa0 = *(const LAS bf16x8*)(qrow + g * 16), qa1 = *(const LAS bf16x8*)(qrow + 64 + g * 16);
            u32x4 Pw[2] = {(u32x4){0u, 0u, 0u, 0u}, (u32x4){0u, 0u, 0u, 0u}};
#pragma unroll
            for (int sb = 0; sb <= lb; ++sb) {
                const LAS unsigned char* krow = st + O_KN + (16 * sb + fr) * PITCH;
                const bf16x8 ka0 = *(const LAS bf16x8*)(krow + g * 16), ka1 = *(const LAS bf16x8*)(krow + 64 + g * 16);
                f32x4 s4 = (f32x4){0.f, 0.f, 0.f, 0.f};
                s4 = __builtin_amdgcn_mfma_f32_16x16x32_bf16(ka0, qa0, s4, 0, 0, 0); s4 = __builtin_amdgcn_mfma_f32_16x16x32_bf16(ka1, qa1, s4, 0, 0, 0);
                const f32x4 u4 = *(const LAS f32x4*)(st + O_G + (64 + 16 * sb + 4 * g) * 4);
                float pv[4];
#pragma unroll
                for (int r = 0; r < 4; ++r) { float e = __builtin_amdgcn_exp2f((u4[r] - wl) * cfg::LOG2E) * s4[r]; if (sb == lb && 4 * g + r > fr) e = 0.f; pv[r] = e; }
                if (sb & 1) { Pw[sb >> 1].z = cvtpk(pv[0], pv[1]); Pw[sb >> 1].w = cvtpk(pv[2], pv[3]); } else { Pw[sb >> 1].x = cvtpk(pv[0], pv[1]); Pw[sb >> 1].y = cvtpk(pv[2], pv[3]); }
            }
            f32x4 H0 = (f32x4){0.f, 0.f, 0.f, 0.f}, H1 = H0, I0 = H0, I1 = H0;
#pragma unroll
            for (int p = 0; p <= (lb >> 1); ++p) {
                const LAS unsigned char* vblk = st + O_VN + (32 * p + 4 * g) * VPITCH + trV;
                const bf16x8 vf = cat8(trrd(vblk), trrd(vblk + 16 * VPITCH));
                const bf16x8 pf = __builtin_bit_cast(bf16x8, Pw[p]);
                H0 = __builtin_amdgcn_mfma_f32_16x16x32_bf16(vf, pf, H0, 0, 0, 0); H1 = __builtin_amdgcn_mfma_f32_16x16x32_bf16(ones, pf, H1, 0, 0, 0);
            }
#pragma unroll
            for (int p2 = 0; p2 < 2; ++p2) {
                const u32x2 qa = *(const LAS u32x2*)(qrow + (32 * p2 + 4 * g) * 2), qb2 = *(const LAS u32x2*)(qrow + (32 * p2 + 16 + 4 * g) * 2);
                const bf16x8 qp = __builtin_bit_cast(bf16x8, (u32x4){qa.x, qa.y, qb2.x, qb2.y});
                I0 = __builtin_amdgcn_mfma_f32_16x16x32_bf16(Cf[0][p2], qp, I0, 0, 0, 0); I1 = __builtin_amdgcn_mfma_f32_16x16x32_bf16(Cf[1][p2], qp, I1, 0, 0, 0);
            }
            const float ei = __builtin_amdgcn_exp2f((m_prev - wl) * cfg::LOG2E);
            const float den = ei * I1[0] + H1[0];
            const float bound = __builtin_amdgcn_exp2f(-(bl + wl) * cfg::LOG2E);
            const float rden = 1.f / fmaxf(fabsf(den), bound);
            float sq = 0.f;
#pragma unroll
            for (int r = 0; r < 4; ++r) { hv[lb][r] = (ei * I0[r] + H0[r]) * rden; sq += hv[lb][r] * hv[lb][r]; }
            hsq[lb] = pg8::quad_sum(sq);
        }
        { LAS float* hs = (LAS float*)(lds + O_HS) + (c & 1) * 512 + wid * 64;
          if (g == 0) {
#pragma unroll
              for (int lb = 0; lb < 4; ++lb) hs[16 * lb + fr] = hsq[lb]; } }
        { const float mx = fmaxf(m_prev, umax);
          const float d_old = __builtin_amdgcn_exp2f((m_prev - mx) * cfg::LOG2E), d_new = __builtin_amdgcn_exp2f((umax - mx) * cfg::LOG2E);
          m_prev = b_end + mx;
#pragma unroll
          for (int kb = 0; kb < 4; ++kb) { C[kb][0] = C[kb][0] * d_old; C[kb][1] = C[kb][1] * d_old; }
#pragma unroll
          for (int ks = 0; ks < 2; ++ks) {
              const f32x4 ua = *(const LAS f32x4*)(st + O_G + (64 + 32 * ks + 8 * g) * 4), ub = *(const LAS f32x4*)(st + O_G + (64 + 32 * ks + 8 * g + 4) * 4);
              float ee[8];
#pragma unroll
              for (int j = 0; j < 4; ++j) { ee[j] = __builtin_amdgcn_exp2f((ua[j] - umax) * cfg::LOG2E) * d_new; ee[4 + j] = __builtin_amdgcn_exp2f((ub[j] - umax) * cfg::LOG2E) * d_new; }
              const LAS unsigned char* vblk = st + O_VN + (32 * ks + 8 * g) * VPITCH + trV;
              const s16x4 va = trrd(vblk), vb4 = trrd(vblk + 4 * VPITCH);
              u32x4 ve, eo;
              ve.x = cvtpk(bf2f((unsigned short)va[0]) * ee[0], bf2f((unsigned short)va[1]) * ee[1]); ve.y = cvtpk(bf2f((unsigned short)va[2]) * ee[2], bf2f((unsigned short)va[3]) * ee[3]);
              ve.z = cvtpk(bf2f((unsigned short)vb4[0]) * ee[4], bf2f((unsigned short)vb4[1]) * ee[5]); ve.w = cvtpk(bf2f((unsigned short)vb4[2]) * ee[6], bf2f((unsigned short)vb4[3]) * ee[7]);
              eo.x = cvtpk(ee[0], ee[1]); eo.y = cvtpk(ee[2], ee[3]); eo.z = cvtpk(ee[4], ee[5]); eo.w = cvtpk(ee[6], ee[7]);
              const bf16x8 vef = __builtin_bit_cast(bf16x8, ve), eof = __builtin_bit_cast(bf16x8, eo);
#pragma unroll
              for (int kb = 0; kb < 4; ++kb) {
                  const LAS unsigned char* kblk = st + O_KN + (32 * ks + 8 * g) * PITCH + 32 * kb + trK;
                  const bf16x8 kt = cat8(trrd(kblk), trrd(kblk + 4 * PITCH));
                  C[kb][0] = __builtin_amdgcn_mfma_f32_16x16x32_bf16(kt, vef, C[kb][0], 0, 0, 0); C[kb][1] = __builtin_amdgcn_mfma_f32_16x16x32_bf16(kt, eof, C[kb][1], 0, 0, 0);
              }
          } }
        if (c + 1 < cfg::NCHUNK) write_stage(R, stn, cw, tid);
        asm volatile("s_waitcnt lgkmcnt(0)\n\ts_barrier" ::: "memory");
        { const LAS float* hsr = (const LAS float*)(lds + O_HS) + (c & 1) * 512;
          const size_t tok0 = (size_t)b * cfg::S + c * 64;
#pragma unroll
          for (int lb = 0; lb < 4; ++lb) { const int l = 16 * lb + fr; float tot = 0.f;
#pragma unroll
              for (int w = 0; w < 8; ++w) tot += hsr[w * 64 + l];
              const float rs = __builtin_amdgcn_rsqf(tot * (1.f / cfg::MDV) + cfg::EPS);
              const u32x2 og = (lb == 0) ? og0 : (lb == 1) ? og1 : (lb == 2) ? og2 : og3;
              u32x2 o; o.x = cvtpk(hv[lb][0] * rs * bflo(og.x), hv[lb][1] * rs * bfhi(og.x)); o.y = cvtpk(hv[lb][2] * rs * bflo(og.y), hv[lb][3] * rs * bfhi(og.y));
              *(u32x2*)(Y + (tok0 + l) * cfg::D + 512 + h * 128 + 16 * wid + 4 * g) = o; } }
    }
    __syncthreads();
}
}
#ifndef MK_PER_PHASE
#define MK_PER_PHASE 0
#endif
constexpr int LDS_BYTES = 147456, MISC_OFF = 131072 + 320, RSTAB_OFF = 131072 + 1024;
constexpr int NPHASE = 34;

struct Params { const float* in[24]; float* out; unsigned char* ws; int ph_lo, ph_hi, li, pad; };

struct MapId { __device__ __forceinline__ int operator()(int n) const { return n; } };
struct MapGate { int up; __device__ __forceinline__ int operator()(int n) const { return ((n >> 7) << 8) + up * 128 + (n & 127); } };
struct MapWin { __device__ __forceinline__ int operator()(int n) const {
    if (n < 384) return n;
    if (n < 416) { const int i = n - 384; return 384 + ((i < 16) ? 2 * i : 2 * (i - 16) + 1); }
    if (n < 1952) return n + 96;
    return n - 1952 + 416; } };
struct MapUq { __device__ __forceinline__ int operator()(int n) const { const int h = n / 96, d = n - h * 96; if (d < 64) return n; const int i = d - 64; return h * 96 + 64 + ((i < 16) ? 2 * i : 2 * (i - 16) + 1); } };
struct MapKv { __device__ __forceinline__ int operator()(int n) const { const int h = n >> 7, j = n & 127; return (j < 64) ? (h * 64 + j) : (512 + h * 64 + j - 64); } };
template <class Map> __device__ __forceinline__ void conv_item(const float* __restrict__ W, int K, int N, bf16_t* WT, const float* gA, const float* gB, int gsplit, const Map dst, LAS float* scr, int item, int lane) {
    const int nblk = (N + 31) >> 5, kb = item / nblk, nb = item - kb * nblk, k0 = 64 * kb, n0 = 32 * nb, n = n0 + 4 * (lane & 7);
#pragma unroll
    for (int i = 0; i < 8; ++i) { const int kk = 8 * i + (lane >> 3), k = k0 + kk; float gv = 1.f; if (gA) gv = (k < gsplit) ? gA[k] : gB[k - gsplit];
        f32x4 v = (f32x4){0.f, 0.f, 0.f, 0.f}; if (n < N) v = *(const f32x4*)(W + (size_t)k * N + n);
        LAS float* d = scr + kk * 33 + 4 * (lane & 7); d[0] = v[0] * gv; d[1] = v[1] * gv; d[2] = v[2] * gv; d[3] = v[3] * gv; }
    asm volatile("s_waitcnt lgkmcnt(0)" ::: "memory");
    const int c = lane & 7;
#pragma unroll
    for (int j = 0; j < 4; ++j) { const int nn = (lane >> 3) + 8 * j, nd = n0 + nn; const LAS float* s = scr + (8 * c) * 33 + nn;
        if (nd < N) { u32x4 o; o.x = cvtpk(s[0 * 33], s[1 * 33]); o.y = cvtpk(s[2 * 33], s[3 * 33]); o.z = cvtpk(s[4 * 33], s[5 * 33]); o.w = cvtpk(s[6 * 33], s[7 * 33]);
            *(u32x4*)(WT + (size_t)dst(nd) * K + k0 + 8 * c) = o; } }
    asm volatile("s_waitcnt lgkmcnt(0)" ::: "memory");
}
__device__ __forceinline__ float wave_sum(float v, int lane) {
#pragma unroll
    for (int o = 1; o < 64; o <<= 1) v += __uint_as_float((unsigned)__builtin_amdgcn_ds_bpermute((lane ^ o) << 2, (int)__float_as_uint(v)));
    return v;
}

__global__ void __launch_bounds__(512, 2) hymba_fwd(Params P) {
    extern __shared__ __attribute__((aligned(16))) unsigned char lds_raw[];
    LAS unsigned char* lds = (LAS unsigned char*)lds_raw;
    volatile LAS unsigned* MISC = (volatile LAS unsigned*)(lds + MISC_OFF);
    const int G = gridDim.x, bx = blockIdx.x;
#define LOCAL_TID() int tid = threadIdx.x; asm volatile("" : "+v"(tid)); const int lane = tid & 63, wave = __builtin_amdgcn_readfirstlane(tid >> 6), gw = bx * 8 + wave, NGW = G * 8; (void)lane; (void)gw; (void)NGW
    gu32* ctl = (gu32*)(P.ws + ws::CTL);
    { LOCAL_TID(); for (int u = tid; u < 32; u += 512) MISC[u] = 0u; }
    __syncthreads();
#if MK_PER_PHASE
    const int lo = P.ph_lo;
#else
    (void)xcd_barrier_post((unsigned*)ctl + ws::CW_BAR, MISC + 8);
#endif
#ifndef ATT_PROBE_VAR
#define ATT_PROBE_VAR 0
#endif
#ifndef PROBE_DOUBLE
#define PROBE_DOUBLE 0
#endif
#ifndef PH_MASK
#define PH_MASK 0xffff
#endif
#if MK_PER_PHASE
#define IN(k) (lo == (k))
#define SEAM(k) do { } while (0)
#else
#define IN(k) true
#define SEAM(k) do { XcdBarrier b_; unsigned* bp_ = (unsigned*)(P.ws + ws::CTL) + ws::CW_BAR; asm volatile("" : "+s"(bp_)); b_.bar = bp_; b_.x = (unsigned)__builtin_amdgcn_readfirstlane((int)xb_xcc_id()); b_.st = MISC + 8; xcd_barrier(b_); } while (0)
#endif
#define LAUNDER_W() GAS unsigned char* Wg_ = (GAS unsigned char*)P.ws; asm volatile("" : "+s"(Wg_)); unsigned char* W = (unsigned char*)Wg_

    if ((PH_MASK & 1) && IN(0)) {
        LOCAL_TID(); LAUNDER_W(); float* const ssqx = (float*)(W + ws::SSQX); bf16_t* const XBp = (bf16_t*)(W + ws::XB);
        LAS float* scr = (LAS float*)(lds + wave * 16384);
        constexpr int I_FF = 16 * 88, I_DN = 44 * 32, I_IN = 16 * 62, I_UQ = 4 * 24, I_KV = 2 * 32, I_O = 16 * 32;
        constexpr int I_LAYER = 4 * I_FF + 2 * I_DN + I_IN + I_UQ + I_KV + I_O;
        for (int it = gw; it < cfg::DEPTH * I_LAYER; it += NGW) {
            const int l = it / I_LAYER; int r = it - l * I_LAYER;
            unsigned char* wl = W + ws::WBASE + (size_t)l * ws::WLAYER;
            const size_t oFF = (size_t)l * cfg::D * cfg::FF;
            if (r < I_FF) { conv_item(P.in[3] + oFF, 1024, 2816, (bf16_t*)(wl + ws::W_GU1), P.in[2] + l * 1024, nullptr, 1024, MapGate{0}, scr, r, lane); continue; } r -= I_FF;
            if (r < I_FF) { conv_item(P.in[4] + oFF, 1024, 2816, (bf16_t*)(wl + ws::W_GU1), P.in[2] + l * 1024, nullptr, 1024, MapGate{1}, scr, r, lane); continue; } r -= I_FF;
            if (r < I_DN) { conv_item(P.in[5] + oFF, 2816, 1024, (bf16_t*)(wl + ws::W_D1), nullptr, nullptr, 0, MapId{}, scr, r, lane); continue; } r -= I_DN;
            if (r < I_FF) { conv_item(P.in[20] + oFF, 1024, 2816, (bf16_t*)(wl + ws::W_GU2), P.in[19] + l * 1024, nullptr, 1024, MapGate{0}, scr, r, lane); continue; } r -= I_FF;
            if (r < I_FF) { conv_item(P.in[21] + oFF, 1024, 2816, (bf16_t*)(wl + ws::W_GU2), P.in[19] + l * 1024, nullptr, 1024, MapGate{1}, scr, r, lane); continue; } r -= I_FF;
            if (r < I_DN) { conv_item(P.in[22] + oFF, 2816, 1024, (bf16_t*)(wl + ws::W_D2), nullptr, nullptr, 0, MapId{}, scr, r, lane); continue; } r -= I_DN;
            if (r < I_IN) { conv_item(P.in[7] + (size_t)l * 1024 * cfg::DIN, 1024, cfg::DIN, (bf16_t*)(wl + ws::W_IN), P.in[6] + l * 1024, nullptr, 1024, MapWin{}, scr, r, lane); continue; } r -= I_IN;
            if (r < I_UQ) { conv_item(P.in[9] + (size_t)l * 256 * 768, 256, 768, (bf16_t*)(wl + ws::W_UQ), P.in[8] + l * 256, nullptr, 256, MapUq{}, scr, r, lane); continue; } r -= I_UQ;
            if (r < I_KV) { conv_item(P.in[11] + (size_t)l * 128 * 1024, 128, 1024, (bf16_t*)(wl + ws::W_KV), P.in[10] + l * 128, nullptr, 128, MapKv{}, scr, r, lane); continue; } r -= I_KV;
            conv_item(P.in[18] + (size_t)l * 1024 * 1024, 1024, 1024, (bf16_t*)(wl + ws::W_O), P.in[16] + l * 512, P.in[17] + l * 512, 512, MapId{}, scr, r, lane);
        }
        for (int i = bx * 512 + tid; i < cfg::DEPTH * 88 * 128; i += G * 512) { const int l = i / (88 * 128), r = i - l * (88 * 128);
            *(u32x4*)(W + ws::WBASE + (size_t)l * ws::WLAYER + ws::W_IN + (size_t)424 * 2048 + (size_t)r * 16) = (u32x4){0u, 0u, 0u, 0u}; }
#ifdef NANFILL
        for (size_t i = (size_t)bx * 512 + tid; i < (NANFILL_BYTES >> 4); i += (size_t)G * 512) *(u32x4*)(W + NANFILL_OFF + i * 16) = (u32x4){0xffffffffu, 0xffffffffu, 0xffffffffu, 0xffffffffu};
#endif
        for (int i = bx * 512 + tid; i < cfg::DEPTH * 2568; i += G * 512) { const int l = i / 2568, r = i - l * 2568;
            const float v = (r < 2048) ? P.in[12][l * 2048 + r] : (r < 2560) ? P.in[13][l * 512 + r - 2048] : (r < 2564) ? P.in[14][l * 4 + r - 2560] : P.in[15][l * 4 + r - 2564];
            ((float*)(W + ws::SMALLP))[l * 4096 + r] = v; }
        for (int i = bx * 512 + tid; i < cfg::M * 16; i += G * 512) { const int tok = i >> 4, k = i & 15;
            const float inv = exp2f(-(float)k * (13.287712379549449f / 16.f)); const float ang = (float)((const int*)P.in[1])[tok] * inv;
            float sn, cs; sincosf(ang, &sn, &cs); ((f32x2*)(W + ws::ROPE))[i] = (f32x2){cs, sn}; }
        for (int m = gw; m < cfg::M; m += NGW) {
            const f32x4* xr = (const f32x4*)(P.in[0] + (size_t)m * cfg::D) + 4 * lane; f32x4 v[4]; float s = 0.f;
#pragma unroll
            for (int j = 0; j < 4; ++j) { v[j] = xr[j]; s += (v[j][0] * v[j][0] + v[j][1] * v[j][1]) + (v[j][2] * v[j][2] + v[j][3] * v[j][3]); }
            s = wave_sum(s, lane);
            u32x4* o16 = (u32x4*)(XBp + (size_t)m * cfg::D) + 2 * lane;
            o16[0] = (u32x4){cvtpk(v[0][0], v[0][1]), cvtpk(v[0][2], v[0][3]), cvtpk(v[1][0], v[1][1]), cvtpk(v[1][2], v[1][3])};
            o16[1] = (u32x4){cvtpk(v[2][0], v[2][1]), cvtpk(v[2][2], v[2][3]), cvtpk(v[3][0], v[3][1]), cvtpk(v[3][2], v[3][3])};
            if (lane < 16) ssqx[(size_t)m * 16 + lane] = (lane == 0) ? s : 0.f;
        }
        __syncthreads();
    }
    SEAM(0);
#if PROBE_DOUBLE == 9
    if ((PH_MASK & 1) && IN(0)) {
        LOCAL_TID(); LAUNDER_W(); float* const ssqx = (float*)(W + ws::SSQX); bf16_t* const XBp = (bf16_t*)(W + ws::XB);
        LAS float* scr = (LAS float*)(lds + wave * 16384);
        constexpr int I_FF = 16 * 88, I_DN = 44 * 32, I_IN = 16 * 62, I_UQ = 4 * 24, I_KV = 2 * 32, I_O = 16 * 32;
        constexpr int I_LAYER = 4 * I_FF + 2 * I_DN + I_IN + I_UQ + I_KV + I_O;
        for (int it = gw; it < cfg::DEPTH * I_LAYER; it += NGW) {
            const int l = it / I_LAYER; int r = it - l * I_LAYER;
            unsigned char* wl = W + ws::WBASE + (size_t)l * ws::WLAYER;
            const size_t oFF = (size_t)l * cfg::D * cfg::FF;
            if (r < I_FF) { conv_item(P.in[3] + oFF, 1024, 2816, (bf16_t*)(wl + ws::W_GU1), P.in[2] + l * 1024, nullptr, 1024, MapGate{0}, scr, r, lane); continue; } r -= I_FF;
            if (r < I_FF) { conv_item(P.in[4] + oFF, 1024, 2816, (bf16_t*)(wl + ws::W_GU1), P.in[2] + l * 1024, nullptr, 1024, MapGate{1}, scr, r, lane); continue; } r -= I_FF;
            if (r < I_DN) { conv_item(P.in[5] + oFF, 2816, 1024, (bf16_t*)(wl + ws::W_D1), nullptr, nullptr, 0, MapId{}, scr, r, lane); continue; } r -= I_DN;
            if (r < I_FF) { conv_item(P.in[20] + oFF, 1024, 2816, (bf16_t*)(wl + ws::W_GU2), P.in[19] + l * 1024, nullptr, 1024, MapGate{0}, scr, r, lane); continue; } r -= I_FF;
            if (r < I_FF) { conv_item(P.in[21] + oFF, 1024, 2816, (bf16_t*)(wl + ws::W_GU2), P.in[19] + l * 1024, nullptr, 1024, MapGate{1}, scr, r, lane); continue; } r -= I_FF;
            if (r < I_DN) { conv_item(P.in[22] + oFF, 2816, 1024, (bf16_t*)(wl + ws::W_D2), nullptr, nullptr, 0, MapId{}, scr, r, lane); continue; } r -= I_DN;
            if (r < I_IN) { conv_item(P.in[7] + (size_t)l * 1024 * cfg::DIN, 1024, cfg::DIN, (bf16_t*)(wl + ws::W_IN), P.in[6] + l * 1024, nullptr, 1024, MapWin{}, scr, r, lane); continue; } r -= I_IN;
            if (r < I_UQ) { conv_item(P.in[9] + (size_t)l * 256 * 768, 256, 768, (bf16_t*)(wl + ws::W_UQ), P.in[8] + l * 256, nullptr, 256, MapUq{}, scr, r, lane); continue; } r -= I_UQ;
            if (r < I_KV) { conv_item(P.in[11] + (size_t)l * 128 * 1024, 128, 1024, (bf16_t*)(wl + ws::W_KV), P.in[10] + l * 128, nullptr, 128, MapKv{}, scr, r, lane); continue; } r -= I_KV;
            conv_item(P.in[18] + (size_t)l * 1024 * 1024, 1024, 1024, (bf16_t*)(wl + ws::W_O), P.in[16] + l * 512, P.in[17] + l * 512, 512, MapId{}, scr, r, lane);
        }
        for (int i = bx * 512 + tid; i < cfg::DEPTH * 88 * 128; i += G * 512) { const int l = i / (88 * 128), r = i - l * (88 * 128);
            *(u32x4*)(W + ws::WBASE + (size_t)l * ws::WLAYER + ws::W_IN + (size_t)424 * 2048 + (size_t)r * 16) = (u32x4){0u, 0u, 0u, 0u}; }
#ifdef NANFILL
        for (size_t i = (size_t)bx * 512 + tid; i < (NANFILL_BYTES >> 4); i += (size_t)G * 512) *(u32x4*)(W + NANFILL_OFF + i * 16) = (u32x4){0xffffffffu, 0xffffffffu, 0xffffffffu, 0xffffffffu};
#endif
        for (int i = bx * 512 + tid; i < cfg::DEPTH * 2568; i += G * 512) { const int l = i / 2568, r = i - l * 2568;
            const float v = (r < 2048) ? P.in[12][l * 2048 + r] : (r < 2560) ? P.in[13][l * 512 + r - 2048] : (r < 2564) ? P.in[14][l * 4 + r - 2560] : P.in[15][l * 4 + r - 2564];
            ((float*)(W + ws::SMALLP))[l * 4096 + r] = v; }
        for (int i = bx * 512 + tid; i < cfg::M * 16; i += G * 512) { const int tok = i >> 4, k = i & 15;
            const float inv = exp2f(-(float)k * (13.287712379549449f / 16.f)); const float ang = (float)((const int*)P.in[1])[tok] * inv;
            float sn, cs; sincosf(ang, &sn, &cs); ((f32x2*)(W + ws::ROPE))[i] = (f32x2){cs, sn}; }
        for (int m = gw; m < cfg::M; m += NGW) {
            const f32x4* xr = (const f32x4*)(P.in[0] + (size_t)m * cfg::D) + lane; f32x4 v[4]; float s = 0.f;
#pragma unroll
            for (int j = 0; j < 4; ++j) { v[j] = xr[64 * j]; s += (v[j][0] * v[j][0] + v[j][1] * v[j][1]) + (v[j][2] * v[j][2] + v[j][3] * v[j][3]); }
            s = wave_sum(s, lane);
            u32x2* o8 = (u32x2*)(XBp + (size_t)m * cfg::D) + lane;
#pragma unroll
            for (int j = 0; j < 4; ++j) { u32x2 w; w.x = cvtpk(v[j][0], v[j][1]); w.y = cvtpk(v[j][2], v[j][3]); o8[64 * j] = w; }
            if (lane < 16) ssqx[(size_t)m * 16 + lane] = (lane == 0) ? s : 0.f;
        }
        __syncthreads();
    }
    SEAM(0);
#endif

    { constexpr int l = 0;
        const int pb = 1 + 8 * l;
        if ((PH_MASK & 2) && IN(pb + 0)) {
            LAUNDER_W(); unsigned char* wl = W + ws::WBASE + (size_t)l * ws::WLAYER;
            pg8::Gemm g{(const bf16_t*)(W + ws::XB), (const bf16_t*)(wl + ws::W_GU1), cfg::M, 2 * cfg::FF, cfg::D}; pg8::StaticOrder S; S.init(cfg::M, 2 * cfg::FF, G, bx);
            const int gid0_ = pg8::rstd_table((LAS float*)(lds + RSTAB_OFF), S, pg8::ssqx_buf(W, 3 * l), (int)threadIdx.x);
            pg8::EpiSwiGLU E{W, 3 * l, (const LAS float*)(lds + RSTAB_OFF), gid0_};
            pg8::gemm_phase<pg8::EpiSwiGLU, pg8::StaticOrder, true, true>(lds, g, S, E);
        }
        SEAM(pb + 0);
#if PROBE_DOUBLE == 1
        if ((PH_MASK & 2) && IN(pb + 0)) {
            LAUNDER_W(); unsigned char* wl = W + ws::WBASE + (size_t)l * ws::WLAYER;
            pg8::Gemm g{(const bf16_t*)(W + ws::XB), (const bf16_t*)(wl + ws::W_GU1), cfg::M, 2 * cfg::FF, cfg::D}; pg8::StaticOrder S; S.init(cfg::M, 2 * cfg::FF, G, bx);
            const int gid0_ = pg8::rstd_table((LAS float*)(lds + RSTAB_OFF), S, pg8::ssqx_buf(W, 3 * l), (int)threadIdx.x);
            pg8::EpiSwiGLU E{W, 3 * l, (const LAS float*)(lds + RSTAB_OFF), gid0_};
            pg8::gemm_phase<pg8::EpiSwiGLU, pg8::StaticOrder, true, true>(lds, g, S, E);
        }
        SEAM(pb + 0);
#endif
#if PROBE_DOUBLE == 11
        if ((PH_MASK & 2) && IN(pb + 0)) {
            LAUNDER_W(); unsigned char* wl = W + ws::WBASE + (size_t)l * ws::WLAYER;
            pg8::Gemm g{(const bf16_t*)(W + ws::XB), (const bf16_t*)(wl + ws::W_GU1), cfg::M, 2 * cfg::FF, cfg::D}; pg8::StaticOrder S; S.init(cfg::M, 2 * cfg::FF, G, bx);
            pg8::EpiNull E{P.out};
            pg8::gemm_phase<pg8::EpiNull, pg8::StaticOrder, true, true>(lds, g, S, E);
        }
        SEAM(pb + 0);
#endif
        if ((PH_MASK & 4) && IN(pb + 1)) {
            LAUNDER_W(); unsigned char* wl = W + ws::WBASE + (size_t)l * ws::WLAYER;
            pg8::Gemm g{(const bf16_t*)(W + ws::H), (const bf16_t*)(wl + ws::W_D1), cfg::M, cfg::D, cfg::FF}; pg8::StaticOrderRev S; S.init(cfg::M, cfg::D, G, bx);
            pg8::EpiResid E{W, 3 * l + 1, 0.5f};
            pg8::gemm_phase<pg8::EpiResid, pg8::StaticOrderRev, true, true>(lds, g, S, E);
        }
        SEAM(pb + 1);
#if PROBE_DOUBLE == 2
        if ((PH_MASK & 4) && IN(pb + 1)) {
            LAUNDER_W(); unsigned char* wl = W + ws::WBASE + (size_t)l * ws::WLAYER;
            pg8::Gemm g{(const bf16_t*)(W + ws::H), (const bf16_t*)(wl + ws::W_D1), cfg::M, cfg::D, cfg::FF}; pg8::StaticOrderRev S; S.init(cfg::M, cfg::D, G, bx);
            pg8::EpiResid E{W, 3 * l + 1, 0.0f};
            pg8::gemm_phase<pg8::EpiResid, pg8::StaticOrderRev, true, true>(lds, g, S, E);
        }
        SEAM(pb + 1);
#endif
        if ((PH_MASK & 8) && IN(pb + 2)) {
            LAUNDER_W(); unsigned char* wl = W + ws::WBASE + (size_t)l * ws::WLAYER;
            pg8::Gemm g{(const bf16_t*)(W + ws::XB), (const bf16_t*)(wl + ws::W_IN), cfg::M, cfg::DINP, cfg::D}; pg8::LatinOrder S; S.init(bx, 0, 8);
            pg8::EpiWin E{W, l};
            pg8::gemm_phase<pg8::EpiWin, pg8::LatinOrder, true, true>(lds, g, S, E);
        }
        SEAM(pb + 2);
#if PROBE_DOUBLE == 3
        if ((PH_MASK & 8) && IN(pb + 2)) {
            LAUNDER_W(); unsigned char* wl = W + ws::WBASE + (size_t)l * ws::WLAYER;
            pg8::Gemm g{(const bf16_t*)(W + ws::XB), (const bf16_t*)(wl + ws::W_IN), cfg::M, cfg::DINP, cfg::D}; pg8::StaticOrder S; S.init(cfg::M, cfg::DINP, G, bx);
            pg8::EpiWin E{W, l};
            pg8::gemm_phase<pg8::EpiWin, pg8::StaticOrder, true, true>(lds, g, S, E);
        }
        SEAM(pb + 2);
#endif
        if ((PH_MASK & (16 | 512 | 1024)) && IN(pb + 3)) {
            if (PH_MASK & 16) { LAUNDER_W(); unsigned char* wl = W + ws::WBASE + (size_t)l * ws::WLAYER;
              pg8::Gemm g{(const bf16_t*)(W + ws::CQ), (const bf16_t*)(wl + ws::W_UQ), cfg::M, 768, 256}; pg8::StaticOrder S; S.init(cfg::M, 768, G, bx);
              pg8::EpiQ E{W, l};
              pg8::gemm_phase<pg8::EpiQ, pg8::StaticOrder, true, true>(lds, g, S, E); }
            if (PH_MASK & 512) { LAUNDER_W(); unsigned char* wl = W + ws::WBASE + (size_t)l * ws::WLAYER;
              pg8::Gemm g{(const bf16_t*)(W + ws::CKV), (const bf16_t*)(wl + ws::W_KV), cfg::M, 512, 128}; pg8::StaticOrder S; S.init(cfg::M, 512, G, bx);
              pg8::EpiKN E{W, l};
              pg8::gemm_phase<pg8::EpiKN, pg8::StaticOrder, true, true>(lds, g, S, E); }
            if (PH_MASK & 1024) { LAUNDER_W(); unsigned char* wl = W + ws::WBASE + (size_t)l * ws::WLAYER;
              pg8::Gemm g{(const bf16_t*)(wl + ws::W_KV) + 512 * 128, (const bf16_t*)(W + ws::CKV), 512, cfg::M, 128}; pg8::StaticOrder S; S.init(512, cfg::M, G, bx);
              pg8::EpiVT E{W, l};
              pg8::gemm_phase<pg8::EpiVT, pg8::StaticOrder, true, true>(lds, g, S, E); }
        }
        SEAM(pb + 3);
#if PROBE_DOUBLE == 4
        if ((PH_MASK & (16 | 512 | 1024)) && IN(pb + 3)) {
            if (PH_MASK & 16) { LAUNDER_W(); unsigned char* wl = W + ws::WBASE + (size_t)l * ws::WLAYER;
              pg8::Gemm g{(const bf16_t*)(W + ws::CQ), (const bf16_t*)(wl + ws::W_UQ), cfg::M, 768, 256}; pg8::StaticOrder S; S.init(cfg::M, 768, G, bx);
              pg8::EpiQ E{W, l};
              pg8::gemm_phase<pg8::EpiQ, pg8::StaticOrder, true, true>(lds, g, S, E); }
            if (PH_MASK & 512) { LAUNDER_W(); unsigned char* wl = W + ws::WBASE + (size_t)l * ws::WLAYER;
              pg8::Gemm g{(const bf16_t*)(W + ws::CKV), (const bf16_t*)(wl + ws::W_KV), cfg::M, 512, 128}; pg8::StaticOrder S; S.init(cfg::M, 512, G, bx);
              pg8::EpiKN E{W, l};
              pg8::gemm_phase<pg8::EpiKN, pg8::StaticOrder, true, true>(lds, g, S, E); }
            if (PH_MASK & 1024) { LAUNDER_W(); unsigned char* wl = W + ws::WBASE + (size_t)l * ws::WLAYER;
              pg8::Gemm g{(const bf16_t*)(wl + ws::W_KV) + 512 * 128, (const bf16_t*)(W + ws::CKV), 512, cfg::M, 128}; pg8::StaticOrder S; S.init(512, cfg::M, G, bx);
              pg8::EpiVT E{W, l};
              pg8::gemm_phase<pg8::EpiVT, pg8::StaticOrder, true, true>(lds, g, S, E); }
        }
        SEAM(pb + 3);
#endif
        if ((PH_MASK & 96) && IN(pb + 4)) {
            LOCAL_TID(); LAUNDER_W(); const float* sp = (const float*)(W + ws::SMALLP) + l * 4096;
            const int x0 = (int)__builtin_amdgcn_readfirstlane((int)(xb_xcc_id() & 7u));
            for (int xs = 0; xs < 8; ++xs) {
                const int x = (x0 + xs) & 7;
                gu32* head = (gu32*)(W + ws::CTL) + ws::CW_QUEUE + (l * 8 + x) * 64 + 0 * 32;
                bool have = false; unsigned kp = 0u;
                for (;;) {
                    if (tid == 0) MISC[0] = have ? kp : __hip_atomic_fetch_add(head, 1u, __ATOMIC_RELAXED, __HIP_MEMORY_SCOPE_AGENT);
                    __syncthreads();
                    const int k = (int)MISC[0] + 0;
                    __syncthreads();
                    have = false;
                    if (k >= 200) break;
                    if (k < 8) { if (PH_MASK & 64) { const int u = x * 8 + k; mls::mlstm_unit(lds, u >> 2, u & 3, (const bf16_t*)(W + ws::QM), (const bf16_t*)(W + ws::KM), (const bf16_t*)(W + ws::VM), (const bf16_t*)(W + ws::OG),
                                                  (const float*)(W + ws::IFG), sp, sp + 2048, (bf16_t*)(W + ws::Y)); } }
                    else if (PH_MASK & 32) { const int a = k - 8; const int bhq = x * 16 + ((a < 64) ? (a & 15) : ((a - 64) & 15)); const int qa = (a < 64) ? (a >> 4) : 11 - ((a - 64) >> 4), qb2 = (a < 64) ? 15 - (a >> 4) : -1; att::attn_unit(lds, bhq, qa, qb2, (const bf16_t*)(W + ws::Q), (const bf16_t*)(W + ws::KF), (const bf16_t*)(W + ws::VT), (bf16_t*)(W + ws::Y), head, kp); have = true; }
                }
            }
        }
        SEAM(pb + 4);
#if PROBE_DOUBLE == 5
        if ((PH_MASK & 96) && IN(pb + 4)) {
            LOCAL_TID(); LAUNDER_W(); const float* sp = (const float*)(W + ws::SMALLP) + l * 4096;
            const int x0 = (int)__builtin_amdgcn_readfirstlane((int)(xb_xcc_id() & 7u));
            for (int xs = 0; xs < 8; ++xs) {
                const int x = (x0 + xs) & 7;
                gu32* head = (gu32*)(W + ws::CTL) + ws::CW_QUEUE + (l * 8 + x) * 64 + 1 * 32;
                for (;;) {
                    if (tid == 0) MISC[0] = __hip_atomic_fetch_add(head, 1u, __ATOMIC_RELAXED, __HIP_MEMORY_SCOPE_AGENT);
                    __syncthreads();
                    const int k = (int)MISC[0] + 0;
                    __syncthreads();
                    if (k >= 200) break;
                    if (k < 8) { if (PH_MASK & 64) { const int u = x * 8 + k; mls::mlstm_unit(lds, u >> 2, u & 3, (const bf16_t*)(W + ws::QM), (const bf16_t*)(W + ws::KM), (const bf16_t*)(W + ws::VM), (const bf16_t*)(W + ws::OG),
                                                  (const float*)(W + ws::IFG), sp, sp + 2048, (bf16_t*)(W + ws::Y)); } }
                    else if (PH_MASK & 32) { const int a = k - 8; const int bhq = x * 16 + ((a < 64) ? (a & 15) : ((a - 64) & 15)); const int qa = (a < 64) ? (a >> 4) : 11 - ((a - 64) >> 4), qb2 = (a < 64) ? 15 - (a >> 4) : -1; { unsigned kd_ = 0u; att::attn_unit(lds, bhq, qa, qb2, (const bf16_t*)(W + ws::Q), (const bf16_t*)(W + ws::KF), (const bf16_t*)(W + ws::VT), (bf16_t*)(W + ws::Y), head, kd_); } }
                }
            }
        }
        SEAM(pb + 4);
#endif
#if PROBE_DOUBLE == 7
        if ((PH_MASK & 96) && IN(pb + 4)) {
            LOCAL_TID(); LAUNDER_W(); const float* sp = (const float*)(W + ws::SMALLP) + l * 4096;
            const int x0 = (int)__builtin_amdgcn_readfirstlane((int)(xb_xcc_id() & 7u));
            for (int xs = 0; xs < 8; ++xs) {
                const int x = (x0 + xs) & 7;
                gu32* head = (gu32*)(W + ws::CTL) + ws::CW_QUEUE + (l * 8 + x) * 64 + 1 * 32;
                for (;;) {
                    if (tid == 0) MISC[0] = __hip_atomic_fetch_add(head, 1u, __ATOMIC_RELAXED, __HIP_MEMORY_SCOPE_AGENT);
                    __syncthreads();
                    const int k = (int)MISC[0] + 0;
                    __syncthreads();
                    if (k >= 8) break;
                    if (k < 8) { if (PH_MASK & 64) { const int u = x * 8 + k; mls::mlstm_unit(lds, u >> 2, u & 3, (const bf16_t*)(W + ws::QM), (const bf16_t*)(W + ws::KM), (const bf16_t*)(W + ws::VM), (const bf16_t*)(W + ws::OG),
                                                  (const float*)(W + ws::IFG), sp, sp + 2048, (bf16_t*)(W + ws::Y)); } }
                    else if (PH_MASK & 32) { const int a = k - 8; const int bhq = x * 16 + ((a < 64) ? (a & 15) : ((a - 64) & 15)); const int qa = (a < 64) ? (a >> 4) : 11 - ((a - 64) >> 4), qb2 = (a < 64) ? 15 - (a >> 4) : -1; { unsigned kd_ = 0u; att::attn_unit(lds, bhq, qa, qb2, (const bf16_t*)(W + ws::Q), (const bf16_t*)(W + ws::KF), (const bf16_t*)(W + ws::VT), (bf16_t*)(W + ws::Y), head, kd_); } }
                }
            }
        }
        SEAM(pb + 4);
#endif
#if PROBE_DOUBLE == 8
        if ((PH_MASK & 96) && IN(pb + 4)) {
            LOCAL_TID(); LAUNDER_W(); const float* sp = (const float*)(W + ws::SMALLP) + l * 4096;
            const int x0 = (int)__builtin_amdgcn_readfirstlane((int)(xb_xcc_id() & 7u));
            for (int xs = 0; xs < 8; ++xs) {
                const int x = (x0 + xs) & 7;
                gu32* head = (gu32*)(W + ws::CTL) + ws::CW_QUEUE + (l * 8 + x) * 64 + 1 * 32;
                for (;;) {
                    if (tid == 0) MISC[0] = __hip_atomic_fetch_add(head, 1u, __ATOMIC_RELAXED, __HIP_MEMORY_SCOPE_AGENT);
                    __syncthreads();
                    const int k = (int)MISC[0] + 8;
                    __syncthreads();
                    if (k >= 200) break;
                    if (k < 8) { if (PH_MASK & 64) { const int u = x * 8 + k; mls::mlstm_unit(lds, u >> 2, u & 3, (const bf16_t*)(W + ws::QM), (const bf16_t*)(W + ws::KM), (const bf16_t*)(W + ws::VM), (const bf16_t*)(W + ws::OG),
                                                  (const float*)(W + ws::IFG), sp, sp + 2048, (bf16_t*)(W + ws::Y)); } }
                    else if (PH_MASK & 32) { const int a = k - 8; const int bhq = x * 16 + ((a < 64) ? (a & 15) : ((a - 64) & 15)); const int qa = (a < 64) ? (a >> 4) : 11 - ((a - 64) >> 4), qb2 = (a < 64) ? 15 - (a >> 4) : -1; { unsigned kd_ = 0u; att::attn_unit(lds, bhq, qa, qb2, (const bf16_t*)(W + ws::Q), (const bf16_t*)(W + ws::KF), (const bf16_t*)(W + ws::VT), (bf16_t*)(W + ws::Y), head, kd_); } }
                }
            }
        }
        SEAM(pb + 4);
#endif
        if ((PH_MASK & 128) && IN(pb + 5)) {
            LAUNDER_W(); unsigned char* wl = W + ws::WBASE + (size_t)l * ws::WLAYER;
            pg8::Gemm g{(const bf16_t*)(W + ws::Y), (const bf16_t*)(wl + ws::W_O), cfg::M, cfg::D, cfg::D}; pg8::StaticOrder S; S.init(cfg::M, cfg::D, G, bx);
            pg8::EpiResid E{W, 3 * l + 2, 1.0f};
            pg8::gemm_phase<pg8::EpiResid, pg8::StaticOrder, true, true>(lds, g, S, E);
        }
        SEAM(pb + 5);
#if PROBE_DOUBLE == 6
        if ((PH_MASK & 128) && IN(pb + 5)) {
            LAUNDER_W(); unsigned char* wl = W + ws::WBASE + (size_t)l * ws::WLAYER;
            pg8::Gemm g{(const bf16_t*)(W + ws::Y), (const bf16_t*)(wl + ws::W_O), cfg::M, cfg::D, cfg::D}; pg8::StaticOrder S; S.init(cfg::M, cfg::D, G, bx);
            pg8::EpiResid E{W, 3 * l + 2, 0.0f};
            pg8::gemm_phase<pg8::EpiResid, pg8::StaticOrder, true, true>(lds, g, S, E);
        }
        SEAM(pb + 5);
#endif
        if ((PH_MASK & 2) && IN(pb + 6)) {
            LAUNDER_W(); unsigned char* wl = W + ws::WBASE + (size_t)l * ws::WLAYER;
            pg8::Gemm g{(const bf16_t*)(W + ws::XB), (const bf16_t*)(wl + ws::W_GU2), cfg::M, 2 * cfg::FF, cfg::D}; pg8::StaticOrder S; S.init(cfg::M, 2 * cfg::FF, G, bx);
            const int gid0_ = pg8::rstd_table((LAS float*)(lds + RSTAB_OFF), S, pg8::ssqx_buf(W, 3 * l + 2), (int)threadIdx.x);
            pg8::EpiSwiGLU E{W, 3 * l + 2, (const LAS float*)(lds + RSTAB_OFF), gid0_};
            pg8::gemm_phase<pg8::EpiSwiGLU, pg8::StaticOrder, true, true>(lds, g, S, E);
        }
        SEAM(pb + 6);
        if ((PH_MASK & 4) && IN(pb + 7)) {
            LAUNDER_W(); unsigned char* wl = W + ws::WBASE + (size_t)l * ws::WLAYER;
            pg8::Gemm g{(const bf16_t*)(W + ws::H), (const bf16_t*)(wl + ws::W_D2), cfg::M, cfg::D, cfg::FF}; pg8::StaticOrderRev S; S.init(cfg::M, cfg::D, G, bx);
            pg8::EpiResid E{W, 3 * l + 3, 0.5f};
            pg8::gemm_phase<pg8::EpiResid, pg8::StaticOrderRev, true, true>(lds, g, S, E);
        }
        SEAM(pb + 7);
        }
    { constexpr int l = 1;
        const int pb = 1 + 8 * l;
        if ((PH_MASK & 2) && IN(pb + 0)) {
            LAUNDER_W(); unsigned char* wl = W + ws::WBASE + (size_t)l * ws::WLAYER;
            pg8::Gemm g{(const bf16_t*)(W + ws::XB), (const bf16_t*)(wl + ws::W_GU1), cfg::M, 2 * cfg::FF, cfg::D}; pg8::StaticOrder S; S.init(cfg::M, 2 * cfg::FF, G, bx);
            const int gid0_ = pg8::rstd_table((LAS float*)(lds + RSTAB_OFF), S, pg8::ssqx_buf(W, 3 * l), (int)threadIdx.x);
            pg8::EpiSwiGLU E{W, 3 * l, (const LAS float*)(lds + RSTAB_OFF), gid0_};
            pg8::gemm_phase<pg8::EpiSwiGLU, pg8::StaticOrder, true, true>(lds, g, S, E);
        }
        SEAM(pb + 0);
#if PROBE_DOUBLE == 1
        if ((PH_MASK & 2) && IN(pb + 0)) {
            LAUNDER_W(); unsigned char* wl = W + ws::WBASE + (size_t)l * ws::WLAYER;
            pg8::Gemm g{(const bf16_t*)(W + ws::XB), (const bf16_t*)(wl + ws::W_GU1), cfg::M, 2 * cfg::FF, cfg::D}; pg8::StaticOrder S; S.init(cfg::M, 2 * cfg::FF, G, bx);
            const int gid0_ = pg8::rstd_table((LAS float*)(lds + RSTAB_OFF), S, pg8::ssqx_buf(W, 3 * l), (int)threadIdx.x);
            pg8::EpiSwiGLU E{W, 3 * l, (const LAS float*)(lds + RSTAB_OFF), gid0_};
            pg8::gemm_phase<pg8::EpiSwiGLU, pg8::StaticOrder, true, true>(lds, g, S, E);
        }
        SEAM(pb + 0);
#endif
#if PROBE_DOUBLE == 11
        if ((PH_MASK & 2) && IN(pb + 0)) {
            LAUNDER_W(); unsigned char* wl = W + ws::WBASE + (size_t)l * ws::WLAYER;
            pg8::Gemm g{(const bf16_t*)(W + ws::XB), (const bf16_t*)(wl + ws::W_GU1), cfg::M, 2 * cfg::FF, cfg::D}; pg8::StaticOrder S; S.init(cfg::M, 2 * cfg::FF, G, bx);
            pg8::EpiNull E{P.out};
            pg8::gemm_phase<pg8::EpiNull, pg8::StaticOrder, true, true>(lds, g, S, E);
        }
        SEAM(pb + 0);
#endif
        if ((PH_MASK & 4) && IN(pb + 1)) {
            LAUNDER_W(); unsigned char* wl = W + ws::WBASE + (size_t)l * ws::WLAYER;
            pg8::Gemm g{(const bf16_t*)(W + ws::H), (const bf16_t*)(wl + ws::W_D1), cfg::M, cfg::D, cfg::FF}; pg8::StaticOrderRev S; S.init(cfg::M, cfg::D, G, bx);
            pg8::EpiResid E{W, 3 * l + 1, 0.5f};
            pg8::gemm_phase<pg8::EpiResid, pg8::StaticOrderRev, true, true>(lds, g, S, E);
        }
        SEAM(pb + 1);
#if PROBE_DOUBLE == 2
        if ((PH_MASK & 4) && IN(pb + 1)) {
            LAUNDER_W(); unsigned char* wl = W + ws::WBASE + (size_t)l * ws::WLAYER;
            pg8::Gemm g{(const bf16_t*)(W + ws::H), (const bf16_t*)(wl + ws::W_D1), cfg::M, cfg::D, cfg::FF}; pg8::StaticOrderRev S; S.init(cfg::M, cfg::D, G, bx);
            pg8::EpiResid E{W, 3 * l + 1, 0.0f};
            pg8::gemm_phase<pg8::EpiResid, pg8::StaticOrderRev, true, true>(lds, g, S, E);
        }
        SEAM(pb + 1);
#endif
        if ((PH_MASK & 8) && IN(pb + 2)) {
            LAUNDER_W(); unsigned char* wl = W + ws::WBASE + (size_t)l * ws::WLAYER;
            pg8::Gemm g{(const bf16_t*)(W + ws::XB), (const bf16_t*)(wl + ws::W_IN), cfg::M, cfg::DINP, cfg::D}; pg8::LatinOrder S; S.init(bx, 0, 8);
            pg8::EpiWin E{W, l};
            pg8::gemm_phase<pg8::EpiWin, pg8::LatinOrder, true, true>(lds, g, S, E);
        }
        SEAM(pb + 2);
#if PROBE_DOUBLE == 3
        if ((PH_MASK & 8) && IN(pb + 2)) {
            LAUNDER_W(); unsigned char* wl = W + ws::WBASE + (size_t)l * ws::WLAYER;
            pg8::Gemm g{(const bf16_t*)(W + ws::XB), (const bf16_t*)(wl + ws::W_IN), cfg::M, cfg::DINP, cfg::D}; pg8::StaticOrder S; S.init(cfg::M, cfg::DINP, G, bx);
            pg8::EpiWin E{W, l};
            pg8::gemm_phase<pg8::EpiWin, pg8::StaticOrder, true, true>(lds, g, S, E);
        }
        SEAM(pb + 2);
#endif
        if ((PH_MASK & (16 | 512 | 1024)) && IN(pb + 3)) {
            if (PH_MASK & 16) { LAUNDER_W(); unsigned char* wl = W + ws::WBASE + (size_t)l * ws::WLAYER;
              pg8::Gemm g{(const bf16_t*)(W + ws::CQ), (const bf16_t*)(wl + ws::W_UQ), cfg::M, 768, 256}; pg8::StaticOrder S; S.init(cfg::M, 768, G, bx);
              pg8::EpiQ E{W, l};
              pg8::gemm_phase<pg8::EpiQ, pg8::StaticOrder, true, true>(lds, g, S, E); }
            if (PH_MASK & 512) { LAUNDER_W(); unsigned char* wl = W + ws::WBASE + (size_t)l * ws::WLAYER;
              pg8::Gemm g{(const bf16_t*)(W + ws::CKV), (const bf16_t*)(wl + ws::W_KV), cfg::M, 512, 128}; pg8::StaticOrder S; S.init(cfg::M, 512, G, bx);
              pg8::EpiKN E{W, l};
              pg8::gemm_phase<pg8::EpiKN, pg8::StaticOrder, true, true>(lds, g, S, E); }
            if (PH_MASK & 1024) { LAUNDER_W(); unsigned char* wl = W + ws::WBASE + (size_t)l * ws::WLAYER;
              pg8::Gemm g{(const bf16_t*)(wl + ws::W_KV) + 512 * 128, (const bf16_t*)(W + ws::CKV), 512, cfg::M, 128}; pg8::StaticOrder S; S.init(512, cfg::M, G, bx);
              pg8::EpiVT E{W, l};
              pg8::gemm_phase<pg8::EpiVT, pg8::StaticOrder, true, true>(lds, g, S, E); }
        }
        SEAM(pb + 3);
#if PROBE_DOUBLE == 4
        if ((PH_MASK & (16 | 512 | 1024)) && IN(pb + 3)) {
            if (PH_MASK & 16) { LAUNDER_W(); unsigned char* wl = W + ws::WBASE + (size_t)l * ws::WLAYER;
              pg8::Gemm g{(const bf16_t*)(W + ws::CQ), (const bf16_t*)(wl + ws::W_UQ), cfg::M, 768, 256}; pg8::StaticOrder S; S.init(cfg::M, 768, G, bx);
              pg8::EpiQ E{W, l};
              pg8::gemm_phase<pg8::EpiQ, pg8::StaticOrder, true, true>(lds, g, S, E); }
            if (PH_MASK & 512) { LAUNDER_W(); unsigned char* wl = W + ws::WBASE + (size_t)l * ws::WLAYER;
              pg8::Gemm g{(const bf16_t*)(W + ws::CKV), (const bf16_t*)(wl + ws::W_KV), cfg::M, 512, 128}; pg8::StaticOrder S; S.init(cfg::M, 512, G, bx);
              pg8::EpiKN E{W, l};
              pg8::gemm_phase<pg8::EpiKN, pg8::StaticOrder, true, true>(lds, g, S, E); }
            if (PH_MASK & 1024) { LAUNDER_W(); unsigned char* wl = W + ws::WBASE + (size_t)l * ws::WLAYER;
              pg8::Gemm g{(const bf16_t*)(wl + ws::W_KV) + 512 * 128, (const bf16_t*)(W + ws::CKV), 512, cfg::M, 128}; pg8::StaticOrder S; S.init(512, cfg::M, G, bx);
              pg8::EpiVT E{W, l};
              pg8::gemm_phase<pg8::EpiVT, pg8::StaticOrder, true, true>(lds, g, S, E); }
        }
        SEAM(pb + 3);
#endif
        if ((PH_MASK & 96) && IN(pb + 4)) {
            LOCAL_TID(); LAUNDER_W(); const float* sp = (const float*)(W + ws::SMALLP) + l * 4096;
            const int x0 = (int)__builtin_amdgcn_readfirstlane((int)(xb_xcc_id() & 7u));
            for (int xs = 0; xs < 8; ++xs) {
                const int x = (x0 + xs) & 7;
                gu32* head = (gu32*)(W + ws::CTL) + ws::CW_QUEUE + (l * 8 + x) * 64 + 0 * 32;
                bool have = false; unsigned kp = 0u;
                for (;;) {
                    if (tid == 0) MISC[0] = have ? kp : __hip_atomic_fetch_add(head, 1u, __ATOMIC_RELAXED, __HIP_MEMORY_SCOPE_AGENT);
                    __syncthreads();
                    const int k = (int)MISC[0] + 0;
                    __syncthreads();
                    have = false;
                    if (k >= 200) break;
                    if (k < 8) { if (PH_MASK & 64) { const int u = x * 8 + k; mls::mlstm_unit(lds, u >> 2, u & 3, (const bf16_t*)(W + ws::QM), (const bf16_t*)(W + ws::KM), (const bf16_t*)(W + ws::VM), (const bf16_t*)(W + ws::OG),
                                                  (const float*)(W + ws::IFG), sp, sp + 2048, (bf16_t*)(W + ws::Y)); } }
                    else if (PH_MASK & 32) { const int a = k - 8; const int bhq = x * 16 + ((a < 64) ? (a & 15) : ((a - 64) & 15)); const int qa = (a < 64) ? (a >> 4) : 11 - ((a - 64) >> 4), qb2 = (a < 64) ? 15 - (a >> 4) : -1; att::attn_unit(lds, bhq, qa, qb2, (const bf16_t*)(W + ws::Q), (const bf16_t*)(W + ws::KF), (const bf16_t*)(W + ws::VT), (bf16_t*)(W + ws::Y), head, kp); have = true; }
                }
            }
        }
        SEAM(pb + 4);
#if PROBE_DOUBLE == 5
        if ((PH_MASK & 96) && IN(pb + 4)) {
            LOCAL_TID(); LAUNDER_W(); const float* sp = (const float*)(W + ws::SMALLP) + l * 4096;
            const int x0 = (int)__builtin_amdgcn_readfirstlane((int)(xb_xcc_id() & 7u));
            for (int xs = 0; xs < 8; ++xs) {
                const int x = (x0 + xs) & 7;
                gu32* head = (gu32*)(W + ws::CTL) + ws::CW_QUEUE + (l * 8 + x) * 64 + 1 * 32;
                for (;;) {
                    if (tid == 0) MISC[0] = __hip_atomic_fetch_add(head, 1u, __ATOMIC_RELAXED, __HIP_MEMORY_SCOPE_AGENT);
                    __syncthreads();
                    const int k = (int)MISC[0] + 0;
                    __syncthreads();
                    if (k >= 200) break;
                    if (k < 8) { if (PH_MASK & 64) { const int u = x * 8 + k; mls::mlstm_unit(lds, u >> 2, u & 3, (const bf16_t*)(W + ws::QM), (const bf16_t*)(W + ws::KM), (const bf16_t*)(W + ws::VM), (const bf16_t*)(W + ws::OG),
                                                  (const float*)(W + ws::IFG), sp, sp + 2048, (bf16_t*)(W + ws::Y)); } }
                    else if (PH_MASK & 32) { const int a = k - 8; const int bhq = x * 16 + ((a < 64) ? (a & 15) : ((a - 64) & 15)); const int qa = (a < 64) ? (a >> 4) : 11 - ((a - 64) >> 4), qb2 = (a < 64) ? 15 - (a >> 4) : -1; { unsigned kd_ = 0u; att::attn_unit(lds, bhq, qa, qb2, (const bf16_t*)(W + ws::Q), (const bf16_t*)(W + ws::KF), (const bf16_t*)(W + ws::VT), (bf16_t*)(W + ws::Y), head, kd_); } }
                }
            }
        }
        SEAM(pb + 4);
#endif
#if PROBE_DOUBLE == 7
        if ((PH_MASK & 96) && IN(pb + 4)) {
            LOCAL_TID(); LAUNDER_W(); const float* sp = (const float*)(W + ws::SMALLP) + l * 4096;
            const int x0 = (int)__builtin_amdgcn_readfirstlane((int)(xb_xcc_id() & 7u));
            for (int xs = 0; xs < 8; ++xs) {
                const int x = (x0 + xs) & 7;
                gu32* head = (gu32*)(W + ws::CTL) + ws::CW_QUEUE + (l * 8 + x) * 64 + 1 * 32;
                for (;;) {
                    if (tid == 0) MISC[0] = __hip_atomic_fetch_add(head, 1u, __ATOMIC_RELAXED, __HIP_MEMORY_SCOPE_AGENT);
                    __syncthreads();
                    const int k = (int)MISC[0] + 0;
                    __syncthreads();
                    if (k >= 8) break;
                    if (k < 8) { if (PH_MASK & 64) { const int u = x * 8 + k; mls::mlstm_unit(lds, u >> 2, u & 3, (const bf16_t*)(W + ws::QM), (const bf16_t*)(W + ws::KM), (const bf16_t*)(W + ws::VM), (const bf16_t*)(W + ws::OG),
                                                  (const float*)(W + ws::IFG), sp, sp + 2048, (bf16_t*)(W + ws::Y)); } }
                    else if (PH_MASK & 32) { const int a = k - 8; const int bhq = x * 16 + ((a < 64) ? (a & 15) : ((a - 64) & 15)); const int qa = (a < 64) ? (a >> 4) : 11 - ((a - 64) >> 4), qb2 = (a < 64) ? 15 - (a >> 4) : -1; { unsigned kd_ = 0u; att::attn_unit(lds, bhq, qa, qb2, (const bf16_t*)(W + ws::Q), (const bf16_t*)(W + ws::KF), (const bf16_t*)(W + ws::VT), (bf16_t*)(W + ws::Y), head, kd_); } }
                }
            }
        }
        SEAM(pb + 4);
#endif
#if PROBE_DOUBLE == 8
        if ((PH_MASK & 96) && IN(pb + 4)) {
            LOCAL_TID(); LAUNDER_W(); const float* sp = (const float*)(W + ws::SMALLP) + l * 4096;
            const int x0 = (int)__builtin_amdgcn_readfirstlane((int)(xb_xcc_id() & 7u));
            for (int xs = 0; xs < 8; ++xs) {
                const int x = (x0 + xs) & 7;
                gu32* head = (gu32*)(W + ws::CTL) + ws::CW_QUEUE + (l * 8 + x) * 64 + 1 * 32;
                for (;;) {
                    if (tid == 0) MISC[0] = __hip_atomic_fetch_add(head, 1u, __ATOMIC_RELAXED, __HIP_MEMORY_SCOPE_AGENT);
                    __syncthreads();
                    const int k = (int)MISC[0] + 8;
                    __syncthreads();
                    if (k >= 200) break;
                    if (k < 8) { if (PH_MASK & 64) { const int u = x * 8 + k; mls::mlstm_unit(lds, u >> 2, u & 3, (const bf16_t*)(W + ws::QM), (const bf16_t*)(W + ws::KM), (const bf16_t*)(W + ws::VM), (const bf16_t*)(W + ws::OG),
                                                  (const float*)(W + ws::IFG), sp, sp + 2048, (bf16_t*)(W + ws::Y)); } }
                    else if (PH_MASK & 32) { const int a = k - 8; const int bhq = x * 16 + ((a < 64) ? (a & 15) : ((a - 64) & 15)); const int qa = (a < 64) ? (a >> 4) : 11 - ((a - 64) >> 4), qb2 = (a < 64) ? 15 - (a >> 4) : -1; { unsigned kd_ = 0u; att::attn_unit(lds, bhq, qa, qb2, (const bf16_t*)(W + ws::Q), (const bf16_t*)(W + ws::KF), (const bf16_t*)(W + ws::VT), (bf16_t*)(W + ws::Y), head, kd_); } }
                }
            }
        }
        SEAM(pb + 4);
#endif
        if ((PH_MASK & 128) && IN(pb + 5)) {
            LAUNDER_W(); unsigned char* wl = W + ws::WBASE + (size_t)l * ws::WLAYER;
            pg8::Gemm g{(const bf16_t*)(W + ws::Y), (const bf16_t*)(wl + ws::W_O), cfg::M, cfg::D, cfg::D}; pg8::StaticOrder S; S.init(cfg::M, cfg::D, G, bx);
            pg8::EpiResid E{W, 3 * l + 2, 1.0f};
            pg8::gemm_phase<pg8::EpiResid, pg8::StaticOrder, true, true>(lds, g, S, E);
        }
        SEAM(pb + 5);
#if PROBE_DOUBLE == 6
        if ((PH_MASK & 128) && IN(pb + 5)) {
            LAUNDER_W(); unsigned char* wl = W + ws::WBASE + (size_t)l * ws::WLAYER;
            pg8::Gemm g{(const bf16_t*)(W + ws::Y), (const bf16_t*)(wl + ws::W_O), cfg::M, cfg::D, cfg::D}; pg8::StaticOrder S; S.init(cfg::M, cfg::D, G, bx);
            pg8::EpiResid E{W, 3 * l + 2, 0.0f};
            pg8::gemm_phase<pg8::EpiResid, pg8::StaticOrder, true, true>(lds, g, S, E);
        }
        SEAM(pb + 5);
#endif
        if ((PH_MASK & 2) && IN(pb + 6)) {
            LAUNDER_W(); unsigned char* wl = W + ws::WBASE + (size_t)l * ws::WLAYER;
            pg8::Gemm g{(const bf16_t*)(W + ws::XB), (const bf16_t*)(wl + ws::W_GU2), cfg::M, 2 * cfg::FF, cfg::D}; pg8::StaticOrder S; S.init(cfg::M, 2 * cfg::FF, G, bx);
            const int gid0_ = pg8::rstd_table((LAS float*)(lds + RSTAB_OFF), S, pg8::ssqx_buf(W, 3 * l + 2), (int)threadIdx.x);
            pg8::EpiSwiGLU E{W, 3 * l + 2, (const LAS float*)(lds + RSTAB_OFF), gid0_};
            pg8::gemm_phase<pg8::EpiSwiGLU, pg8::StaticOrder, true, true>(lds, g, S, E);
        }
        SEAM(pb + 6);
        if ((PH_MASK & 4) && IN(pb + 7)) {
            LAUNDER_W(); unsigned char* wl = W + ws::WBASE + (size_t)l * ws::WLAYER;
            pg8::Gemm g{(const bf16_t*)(W + ws::H), (const bf16_t*)(wl + ws::W_D2), cfg::M, cfg::D, cfg::FF}; pg8::StaticOrderRev S; S.init(cfg::M, cfg::D, G, bx);
            pg8::EpiResid E{W, 3 * l + 3, 0.5f};
            pg8::gemm_phase<pg8::EpiResid, pg8::StaticOrderRev, true, true>(lds, g, S, E);
        }
        SEAM(pb + 7);
        }
    { constexpr int l = 2;
        const int pb = 1 + 8 * l;
        if ((PH_MASK & 2) && IN(pb + 0)) {
            LAUNDER_W(); unsigned char* wl = W + ws::WBASE + (size_t)l * ws::WLAYER;
            pg8::Gemm g{(const bf16_t*)(W + ws::XB), (const bf16_t*)(wl + ws::W_GU1), cfg::M, 2 * cfg::FF, cfg::D}; pg8::StaticOrder S; S.init(cfg::M, 2 * cfg::FF, G, bx);
            const int gid0_ = pg8::rstd_table((LAS float*)(lds + RSTAB_OFF), S, pg8::ssqx_buf(W, 3 * l), (int)threadIdx.x);
            pg8::EpiSwiGLU E{W, 3 * l, (const LAS float*)(lds + RSTAB_OFF), gid0_};
            pg8::gemm_phase<pg8::EpiSwiGLU, pg8::StaticOrder, true, true>(lds, g, S, E);
        }
        SEAM(pb + 0);
#if PROBE_DOUBLE == 1
        if ((PH_MASK & 2) && IN(pb + 0)) {
            LAUNDER_W(); unsigned char* wl = W + ws::WBASE + (size_t)l * ws::WLAYER;
            pg8::Gemm g{(const bf16_t*)(W + ws::XB), (const bf16_t*)(wl + ws::W_GU1), cfg::M, 2 * cfg::FF, cfg::D}; pg8::StaticOrder S; S.init(cfg::M, 2 * cfg::FF, G, bx);
            const int gid0_ = pg8::rstd_table((LAS float*)(lds + RSTAB_OFF), S, pg8::ssqx_buf(W, 3 * l), (int)threadIdx.x);
            pg8::EpiSwiGLU E{W, 3 * l, (const LAS float*)(lds + RSTAB_OFF), gid0_};
            pg8::gemm_phase<pg8::EpiSwiGLU, pg8::StaticOrder, true, true>(lds, g, S, E);
        }
        SEAM(pb + 0);
#endif
#if PROBE_DOUBLE == 11
        if ((PH_MASK & 2) && IN(pb + 0)) {
            LAUNDER_W(); unsigned char* wl = W + ws::WBASE + (size_t)l * ws::WLAYER;
            pg8::Gemm g{(const bf16_t*)(W + ws::XB), (const bf16_t*)(wl + ws::W_GU1), cfg::M, 2 * cfg::FF, cfg::D}; pg8::StaticOrder S; S.init(cfg::M, 2 * cfg::FF, G, bx);
            pg8::EpiNull E{P.out};
            pg8::gemm_phase<pg8::EpiNull, pg8::StaticOrder, true, true>(lds, g, S, E);
        }
        SEAM(pb + 0);
#endif
        if ((PH_MASK & 4) && IN(pb + 1)) {
            LAUNDER_W(); unsigned char* wl = W + ws::WBASE + (size_t)l * ws::WLAYER;
            pg8::Gemm g{(const bf16_t*)(W + ws::H), (const bf16_t*)(wl + ws::W_D1), cfg::M, cfg::D, cfg::FF}; pg8::StaticOrderRev S; S.init(cfg::M, cfg::D, G, bx);
            pg8::EpiResid E{W, 3 * l + 1, 0.5f};
            pg8::gemm_phase<pg8::EpiResid, pg8::StaticOrderRev, true, true>(lds, g, S, E);
        }
        SEAM(pb + 1);
#if PROBE_DOUBLE == 2
        if ((PH_MASK & 4) && IN(pb + 1)) {
            LAUNDER_W(); unsigned char* wl = W + ws::WBASE + (size_t)l * ws::WLAYER;
            pg8::Gemm g{(const bf16_t*)(W + ws::H), (const bf16_t*)(wl + ws::W_D1), cfg::M, cfg::D, cfg::FF}; pg8::StaticOrderRev S; S.init(cfg::M, cfg::D, G, bx);
            pg8::EpiResid E{W, 3 * l + 1, 0.0f};
            pg8::gemm_phase<pg8::EpiResid, pg8::StaticOrderRev, true, true>(lds, g, S, E);
        }
        SEAM(pb + 1);
#endif
        if ((PH_MASK & 8) && IN(pb + 2)) {
            LAUNDER_W(); unsigned char* wl = W + ws::WBASE + (size_t)l * ws::WLAYER;
            pg8::Gemm g{(const bf16_t*)(W + ws::XB), (const bf16_t*)(wl + ws::W_IN), cfg::M, cfg::DINP, cfg::D}; pg8::LatinOrder S; S.init(bx, 0, 8);
            pg8::EpiWin E{W, l};
            pg8::gemm_phase<pg8::EpiWin, pg8::LatinOrder, true, true>(lds, g, S, E);
        }
        SEAM(pb + 2);
#if PROBE_DOUBLE == 3
        if ((PH_MASK & 8) && IN(pb + 2)) {
            LAUNDER_W(); unsigned char* wl = W + ws::WBASE + (size_t)l * ws::WLAYER;
            pg8::Gemm g{(const bf16_t*)(W + ws::XB), (const bf16_t*)(wl + ws::W_IN), cfg::M, cfg::DINP, cfg::D}; pg8::StaticOrder S; S.init(cfg::M, cfg::DINP, G, bx);
            pg8::EpiWin E{W, l};
            pg8::gemm_phase<pg8::EpiWin, pg8::StaticOrder, true, true>(lds, g, S, E);
        }
        SEAM(pb + 2);
#endif
        if ((PH_MASK & (16 | 512 | 1024)) && IN(pb + 3)) {
            if (PH_MASK & 16) { LAUNDER_W(); unsigned char* wl = W + ws::WBASE + (size_t)l * ws::WLAYER;
              pg8::Gemm g{(const bf16_t*)(W + ws::CQ), (const bf16_t*)(wl + ws::W_UQ), cfg::M, 768, 256}; pg8::StaticOrder S; S.init(cfg::M, 768, G, bx);
              pg8::EpiQ E{W, l};
              pg8::gemm_phase<pg8::EpiQ, pg8::StaticOrder, true, true>(lds, g, S, E); }
            if (PH_MASK & 512) { LAUNDER_W(); unsigned char* wl = W + ws::WBASE + (size_t)l * ws::WLAYER;
              pg8::Gemm g{(const bf16_t*)(W + ws::CKV), (const bf16_t*)(wl + ws::W_KV), cfg::M, 512, 128}; pg8::StaticOrder S; S.init(cfg::M, 512, G, bx);
              pg8::EpiKN E{W, l};
              pg8::gemm_phase<pg8::EpiKN, pg8::StaticOrder, true, true>(lds, g, S, E); }
            if (PH_MASK & 1024) { LAUNDER_W(); unsigned char* wl = W + ws::WBASE + (size_t)l * ws::WLAYER;
              pg8::Gemm g{(const bf16_t*)(wl + ws::W_KV) + 512 * 128, (const bf16_t*)(W + ws::CKV), 512, cfg::M, 128}; pg8::StaticOrder S; S.init(512, cfg::M, G, bx);
              pg8::EpiVT E{W, l};
              pg8::gemm_phase<pg8::EpiVT, pg8::StaticOrder, true, true>(lds, g, S, E); }
        }
        SEAM(pb + 3);
#if PROBE_DOUBLE == 4
        if ((PH_MASK & (16 | 512 | 1024)) && IN(pb + 3)) {
            if (PH_MASK & 16) { LAUNDER_W(); unsigned char* wl = W + ws::WBASE + (size_t)l * ws::WLAYER;
              pg8::Gemm g{(const bf16_t*)(W + ws::CQ), (const bf16_t*)(wl + ws::W_UQ), cfg::M, 768, 256}; pg8::StaticOrder S; S.init(cfg::M, 768, G, bx);
              pg8::EpiQ E{W, l};
              pg8::gemm_phase<pg8::EpiQ, pg8::StaticOrder, true, true>(lds, g, S, E); }
            if (PH_MASK & 512) { LAUNDER_W(); unsigned char* wl = W + ws::WBASE + (size_t)l * ws::WLAYER;
              pg8::Gemm g{(const bf16_t*)(W + ws::CKV), (const bf16_t*)(wl + ws::W_KV), cfg::M, 512, 128}; pg8::StaticOrder S; S.init(cfg::M, 512, G, bx);
              pg8::EpiKN E{W, l};
              pg8::gemm_phase<pg8::EpiKN, pg8::StaticOrder, true, true>(lds, g, S, E); }
            if (PH_MASK & 1024) { LAUNDER_W(); unsigned char* wl = W + ws::WBASE + (size_t)l * ws::WLAYER;
              pg8::Gemm g{(const bf16_t*)(wl + ws::W_KV) + 512 * 128, (const bf16_t*)(W + ws::CKV), 512, cfg::M, 128}; pg8::StaticOrder S; S.init(512, cfg::M, G, bx);
              pg8::EpiVT E{W, l};
              pg8::gemm_phase<pg8::EpiVT, pg8::StaticOrder, true, true>(lds, g, S, E); }
        }
        SEAM(pb + 3);
#endif
        if ((PH_MASK & 96) && IN(pb + 4)) {
            LOCAL_TID(); LAUNDER_W(); const float* sp = (const float*)(W + ws::SMALLP) + l * 4096;
            const int x0 = (int)__builtin_amdgcn_readfirstlane((int)(xb_xcc_id() & 7u));
            for (int xs = 0; xs < 8; ++xs) {
                const int x = (x0 + xs) & 7;
                gu32* head = (gu32*)(W + ws::CTL) + ws::CW_QUEUE + (l * 8 + x) * 64 + 0 * 32;
                bool have = false; unsigned kp = 0u;
                for (;;) {
                    if (tid == 0) MISC[0] = have ? kp : __hip_atomic_fetch_add(head, 1u, __ATOMIC_RELAXED, __HIP_MEMORY_SCOPE_AGENT);
                    __syncthreads();
                    const int k = (int)MISC[0] + 0;
                    __syncthreads();
                    have = false;
                    if (k >= 200) break;
                    if (k < 8) { if (PH_MASK & 64) { const int u = x * 8 + k; mls::mlstm_unit(lds, u >> 2, u & 3, (const bf16_t*)(W + ws::QM), (const bf16_t*)(W + ws::KM), (const bf16_t*)(W + ws::VM), (const bf16_t*)(W + ws::OG),
                                                  (const float*)(W + ws::IFG), sp, sp + 2048, (bf16_t*)(W + ws::Y)); } }
                    else if (PH_MASK & 32) { const int a = k - 8; const int bhq = x * 16 + ((a < 64) ? (a & 15) : ((a - 64) & 15)); const int qa = (a < 64) ? (a >> 4) : 11 - ((a - 64) >> 4), qb2 = (a < 64) ? 15 - (a >> 4) : -1; att::attn_unit(lds, bhq, qa, qb2, (const bf16_t*)(W + ws::Q), (const bf16_t*)(W + ws::KF), (const bf16_t*)(W + ws::VT), (bf16_t*)(W + ws::Y), head, kp); have = true; }
                }
            }
        }
        SEAM(pb + 4);
#if PROBE_DOUBLE == 5
        if ((PH_MASK & 96) && IN(pb + 4)) {
            LOCAL_TID(); LAUNDER_W(); const float* sp = (const float*)(W + ws::SMALLP) + l * 4096;
            const int x0 = (int)__builtin_amdgcn_readfirstlane((int)(xb_xcc_id() & 7u));
            for (int xs = 0; xs < 8; ++xs) {
                const int x = (x0 + xs) & 7;
                gu32* head = (gu32*)(W + ws::CTL) + ws::CW_QUEUE + (l * 8 + x) * 64 + 1 * 32;
                for (;;) {
                    if (tid == 0) MISC[0] = __hip_atomic_fetch_add(head, 1u, __ATOMIC_RELAXED, __HIP_MEMORY_SCOPE_AGENT);
                    __syncthreads();
                    const int k = (int)MISC[0] + 0;
                    __syncthreads();
                    if (k >= 200) break;
                    if (k < 8) { if (PH_MASK & 64) { const int u = x * 8 + k; mls::mlstm_unit(lds, u >> 2, u & 3, (const bf16_t*)(W + ws::QM), (const bf16_t*)(W + ws::KM), (const bf16_t*)(W + ws::VM), (const bf16_t*)(W + ws::OG),
                                                  (const float*)(W + ws::IFG), sp, sp + 2048, (bf16_t*)(W + ws::Y)); } }
                    else if (PH_MASK & 32) { const int a = k - 8; const int bhq = x * 16 + ((a < 64) ? (a & 15) : ((a - 64) & 15)); const int qa = (a < 64) ? (a >> 4) : 11 - ((a - 64) >> 4), qb2 = (a < 64) ? 15 - (a >> 4) : -1; { unsigned kd_ = 0u; att::attn_unit(lds, bhq, qa, qb2, (const bf16_t*)(W + ws::Q), (const bf16_t*)(W + ws::KF), (const bf16_t*)(W + ws::VT), (bf16_t*)(W + ws::Y), head, kd_); } }
                }
            }
        }
        SEAM(pb + 4);
#endif
#if PROBE_DOUBLE == 7
        if ((PH_MASK & 96) && IN(pb + 4)) {
            LOCAL_TID(); LAUNDER_W(); const float* sp = (const float*)(W + ws::SMALLP) + l * 4096;
            const int x0 = (int)__builtin_amdgcn_readfirstlane((int)(xb_xcc_id() & 7u));
            for (int xs = 0; xs < 8; ++xs) {
                const int x = (x0 + xs) & 7;
                gu32* head = (gu32*)(W + ws::CTL) + ws::CW_QUEUE + (l * 8 + x) * 64 + 1 * 32;
                for (;;) {
                    if (tid == 0) MISC[0] = __hip_atomic_fetch_add(head, 1u, __ATOMIC_RELAXED, __HIP_MEMORY_SCOPE_AGENT);
                    __syncthreads();
                    const int k = (int)MISC[0] + 0;
                    __syncthreads();
                    if (k >= 8) break;
                    if (k < 8) { if (PH_MASK & 64) { const int u = x * 8 + k; mls::mlstm_unit(lds, u >> 2, u & 3, (const bf16_t*)(W + ws::QM), (const bf16_t*)(W + ws::KM), (const bf16_t*)(W + ws::VM), (const bf16_t*)(W + ws::OG),
                                                  (const float*)(W + ws::IFG), sp, sp + 2048, (bf16_t*)(W + ws::Y)); } }
                    else if (PH_MASK & 32) { const int a = k - 8; const int bhq = x * 16 + ((a < 64) ? (a & 15) : ((a - 64) & 15)); const int qa = (a < 64) ? (a >> 4) : 11 - ((a - 64) >> 4), qb2 = (a < 64) ? 15 - (a >> 4) : -1; { unsigned kd_ = 0u; att::attn_unit(lds, bhq, qa, qb2, (const bf16_t*)(W + ws::Q), (const bf16_t*)(W + ws::KF), (const bf16_t*)(W + ws::VT), (bf16_t*)(W + ws::Y), head, kd_); } }
                }
            }
        }
        SEAM(pb + 4);
#endif
#if PROBE_DOUBLE == 8
        if ((PH_MASK & 96) && IN(pb + 4)) {
            LOCAL_TID(); LAUNDER_W(); const float* sp = (const float*)(W + ws::SMALLP) + l * 4096;
            const int x0 = (int)__builtin_amdgcn_readfirstlane((int)(xb_xcc_id() & 7u));
            for (int xs = 0; xs < 8; ++xs) {
                const int x = (x0 + xs) & 7;
                gu32* head = (gu32*)(W + ws::CTL) + ws::CW_QUEUE + (l * 8 + x) * 64 + 1 * 32;
                for (;;) {
                    if (tid == 0) MISC[0] = __hip_atomic_fetch_add(head, 1u, __ATOMIC_RELAXED, __HIP_MEMORY_SCOPE_AGENT);
                    __syncthreads();
                    const int k = (int)MISC[0] + 8;
                    __syncthreads();
                    if (k >= 200) break;
                    if (k < 8) { if (PH_MASK & 64) { const int u = x * 8 + k; mls::mlstm_unit(lds, u >> 2, u & 3, (const bf16_t*)(W + ws::QM), (const bf16_t*)(W + ws::KM), (const bf16_t*)(W + ws::VM), (const bf16_t*)(W + ws::OG),
                                                  (const float*)(W + ws::IFG), sp, sp + 2048, (bf16_t*)(W + ws::Y)); } }
                    else if (PH_MASK & 32) { const int a = k - 8; const int bhq = x * 16 + ((a < 64) ? (a & 15) : ((a - 64) & 15)); const int qa = (a < 64) ? (a >> 4) : 11 - ((a - 64) >> 4), qb2 = (a < 64) ? 15 - (a >> 4) : -1; { unsigned kd_ = 0u; att::attn_unit(lds, bhq, qa, qb2, (const bf16_t*)(W + ws::Q), (const bf16_t*)(W + ws::KF), (const bf16_t*)(W + ws::VT), (bf16_t*)(W + ws::Y), head, kd_); } }
                }
            }
        }
        SEAM(pb + 4);
#endif
        if ((PH_MASK & 128) && IN(pb + 5)) {
            LAUNDER_W(); unsigned char* wl = W + ws::WBASE + (size_t)l * ws::WLAYER;
            pg8::Gemm g{(const bf16_t*)(W + ws::Y), (const bf16_t*)(wl + ws::W_O), cfg::M, cfg::D, cfg::D}; pg8::StaticOrder S; S.init(cfg::M, cfg::D, G, bx);
            pg8::EpiResid E{W, 3 * l + 2, 1.0f};
            pg8::gemm_phase<pg8::EpiResid, pg8::StaticOrder, true, true>(lds, g, S, E);
        }
        SEAM(pb + 5);
#if PROBE_DOUBLE == 6
        if ((PH_MASK & 128) && IN(pb + 5)) {
            LAUNDER_W(); unsigned char* wl = W + ws::WBASE + (size_t)l * ws::WLAYER;
            pg8::Gemm g{(const bf16_t*)(W + ws::Y), (const bf16_t*)(wl + ws::W_O), cfg::M, cfg::D, cfg::D}; pg8::StaticOrder S; S.init(cfg::M, cfg::D, G, bx);
            pg8::EpiResid E{W, 3 * l + 2, 0.0f};
            pg8::gemm_phase<pg8::EpiResid, pg8::StaticOrder, true, true>(lds, g, S, E);
        }
        SEAM(pb + 5);
#endif
        if ((PH_MASK & 2) && IN(pb + 6)) {
            LAUNDER_W(); unsigned char* wl = W + ws::WBASE + (size_t)l * ws::WLAYER;
            pg8::Gemm g{(const bf16_t*)(W + ws::XB), (const bf16_t*)(wl + ws::W_GU2), cfg::M, 2 * cfg::FF, cfg::D}; pg8::StaticOrder S; S.init(cfg::M, 2 * cfg::FF, G, bx);
            const int gid0_ = pg8::rstd_table((LAS float*)(lds + RSTAB_OFF), S, pg8::ssqx_buf(W, 3 * l + 2), (int)threadIdx.x);
            pg8::EpiSwiGLU E{W, 3 * l + 2, (const LAS float*)(lds + RSTAB_OFF), gid0_};
            pg8::gemm_phase<pg8::EpiSwiGLU, pg8::StaticOrder, true, true>(lds, g, S, E);
        }
        SEAM(pb + 6);
        if ((PH_MASK & 4) && IN(pb + 7)) {
            LAUNDER_W(); unsigned char* wl = W + ws::WBASE + (size_t)l * ws::WLAYER;
            pg8::Gemm g{(const bf16_t*)(W + ws::H), (const bf16_t*)(wl + ws::W_D2), cfg::M, cfg::D, cfg::FF}; pg8::StaticOrderRev S; S.init(cfg::M, cfg::D, G, bx);
            pg8::EpiResid E{W, 3 * l + 3, 0.5f};
            pg8::gemm_phase<pg8::EpiResid, pg8::StaticOrderRev, true, true>(lds, g, S, E);
        }
        SEAM(pb + 7);
        }
    { constexpr int l = 3;
        const int pb = 1 + 8 * l;
        if ((PH_MASK & 2) && IN(pb + 0)) {
            LAUNDER_W(); unsigned char* wl = W + ws::WBASE + (size_t)l * ws::WLAYER;
            pg8::Gemm g{(const bf16_t*)(W + ws::XB), (const bf16_t*)(wl + ws::W_GU1), cfg::M, 2 * cfg::FF, cfg::D}; pg8::StaticOrder S; S.init(cfg::M, 2 * cfg::FF, G, bx);
            const int gid0_ = pg8::rstd_table((LAS float*)(lds + RSTAB_OFF), S, pg8::ssqx_buf(W, 3 * l), (int)threadIdx.x);
            pg8::EpiSwiGLU E{W, 3 * l, (const LAS float*)(lds + RSTAB_OFF), gid0_};
            pg8::gemm_phase<pg8::EpiSwiGLU, pg8::StaticOrder, true, true>(lds, g, S, E);
        }
        SEAM(pb + 0);
#if PROBE_DOUBLE == 1
        if ((PH_MASK & 2) && IN(pb + 0)) {
            LAUNDER_W(); unsigned char* wl = W + ws::WBASE + (size_t)l * ws::WLAYER;
            pg8::Gemm g{(const bf16_t*)(W + ws::XB), (const bf16_t*)(wl + ws::W_GU1), cfg::M, 2 * cfg::FF, cfg::D}; pg8::StaticOrder S; S.init(cfg::M, 2 * cfg::FF, G, bx);
            const int gid0_ = pg8::rstd_table((LAS float*)(lds + RSTAB_OFF), S, pg8::ssqx_buf(W, 3 * l), (int)threadIdx.x);
            pg8::EpiSwiGLU E{W, 3 * l, (const LAS float*)(lds + RSTAB_OFF), gid0_};
            pg8::gemm_phase<pg8::EpiSwiGLU, pg8::StaticOrder, true, true>(lds, g, S, E);
        }
        SEAM(pb + 0);
#endif
#if PROBE_DOUBLE == 11
        if ((PH_MASK & 2) && IN(pb + 0)) {
            LAUNDER_W(); unsigned char* wl = W + ws::WBASE + (size_t)l * ws::WLAYER;
            pg8::Gemm g{(const bf16_t*)(W + ws::XB), (const bf16_t*)(wl + ws::W_GU1), cfg::M, 2 * cfg::FF, cfg::D}; pg8::StaticOrder S; S.init(cfg::M, 2 * cfg::FF, G, bx);
            pg8::EpiNull E{P.out};
            pg8::gemm_phase<pg8::EpiNull, pg8::StaticOrder, true, true>(lds, g, S, E);
        }
        SEAM(pb + 0);
#endif
        if ((PH_MASK & 4) && IN(pb + 1)) {
            LAUNDER_W(); unsigned char* wl = W + ws::WBASE + (size_t)l * ws::WLAYER;
            pg8::Gemm g{(const bf16_t*)(W + ws::H), (const bf16_t*)(wl + ws::W_D1), cfg::M, cfg::D, cfg::FF}; pg8::StaticOrderRev S; S.init(cfg::M, cfg::D, G, bx);
            pg8::EpiResid E{W, 3 * l + 1, 0.5f};
            pg8::gemm_phase<pg8::EpiResid, pg8::StaticOrderRev, true, true>(lds, g, S, E);
        }
        SEAM(pb + 1);
#if PROBE_DOUBLE == 2
        if ((PH_MASK & 4) && IN(pb + 1)) {
            LAUNDER_W(); unsigned char* wl = W + ws::WBASE + (size_t)l * ws::WLAYER;
            pg8::Gemm g{(const bf16_t*)(W + ws::H), (const bf16_t*)(wl + ws::W_D1), cfg::M, cfg::D, cfg::FF}; pg8::StaticOrderRev S; S.init(cfg::M, cfg::D, G, bx);
            pg8::EpiResid E{W, 3 * l + 1, 0.0f};
            pg8::gemm_phase<pg8::EpiResid, pg8::StaticOrderRev, true, true>(lds, g, S, E);
        }
        SEAM(pb + 1);
#endif
        if ((PH_MASK & 8) && IN(pb + 2)) {
            LAUNDER_W(); unsigned char* wl = W + ws::WBASE + (size_t)l * ws::WLAYER;
            pg8::Gemm g{(const bf16_t*)(W + ws::XB), (const bf16_t*)(wl + ws::W_IN), cfg::M, cfg::DINP, cfg::D}; pg8::LatinOrder S; S.init(bx, 0, 8);
            pg8::EpiWin E{W, l};
            pg8::gemm_phase<pg8::EpiWin, pg8::LatinOrder, true, true>(lds, g, S, E);
        }
        SEAM(pb + 2);
#if PROBE_DOUBLE == 3
        if ((PH_MASK & 8) && IN(pb + 2)) {
            LAUNDER_W(); unsigned char* wl = W + ws::WBASE + (size_t)l * ws::WLAYER;
            pg8::Gemm g{(const bf16_t*)(W + ws::XB), (const bf16_t*)(wl + ws::W_IN), cfg::M, cfg::DINP, cfg::D}; pg8::StaticOrder S; S.init(cfg::M, cfg::DINP, G, bx);
            pg8::EpiWin E{W, l};
            pg8::gemm_phase<pg8::EpiWin, pg8::StaticOrder, true, true>(lds, g, S, E);
        }
        SEAM(pb + 2);
#endif
        if ((PH_MASK & (16 | 512 | 1024)) && IN(pb + 3)) {
            if (PH_MASK & 16) { LAUNDER_W(); unsigned char* wl = W + ws::WBASE + (size_t)l * ws::WLAYER;
              pg8::Gemm g{(const bf16_t*)(W + ws::CQ), (const bf16_t*)(wl + ws::W_UQ), cfg::M, 768, 256}; pg8::StaticOrder S; S.init(cfg::M, 768, G, bx);
              pg8::EpiQ E{W, l};
              pg8::gemm_phase<pg8::EpiQ, pg8::StaticOrder, true, true>(lds, g, S, E); }
            if (PH_MASK & 512) { LAUNDER_W(); unsigned char* wl = W + ws::WBASE + (size_t)l * ws::WLAYER;
              pg8::Gemm g{(const bf16_t*)(W + ws::CKV), (const bf16_t*)(wl + ws::W_KV), cfg::M, 512, 128}; pg8::StaticOrder S; S.init(cfg::M, 512, G, bx);
              pg8::EpiKN E{W, l};
              pg8::gemm_phase<pg8::EpiKN, pg8::StaticOrder, true, true>(lds, g, S, E); }
            if (PH_MASK & 1024) { LAUNDER_W(); unsigned char* wl = W + ws::WBASE + (size_t)l * ws::WLAYER;
              pg8::Gemm g{(const bf16_t*)(wl + ws::W_KV) + 512 * 128, (const bf16_t*)(W + ws::CKV), 512, cfg::M, 128}; pg8::StaticOrder S; S.init(512, cfg::M, G, bx);
              pg8::EpiVT E{W, l};
              pg8::gemm_phase<pg8::EpiVT, pg8::StaticOrder, true, true>(lds, g, S, E); }
        }
        SEAM(pb + 3);
#if PROBE_DOUBLE == 4
        if ((PH_MASK & (16 | 512 | 1024)) && IN(pb + 3)) {
            if (PH_MASK & 16) { LAUNDER_W(); unsigned char* wl = W + ws::WBASE + (size_t)l * ws::WLAYER;
              pg8::Gemm g{(const bf16_t*)(W + ws::CQ), (const bf16_t*)(wl + ws::W_UQ), cfg::M, 768, 256}; pg8::StaticOrder S; S.init(cfg::M, 768, G, bx);
              pg8::EpiQ E{W, l};
              pg8::gemm_phase<pg8::EpiQ, pg8::StaticOrder, true, true>(lds, g, S, E); }
            if (PH_MASK & 512) { LAUNDER_W(); unsigned char* wl = W + ws::WBASE + (size_t)l * ws::WLAYER;
              pg8::Gemm g{(const bf16_t*)(W + ws::CKV), (const bf16_t*)(wl + ws::W_KV), cfg::M, 512, 128}; pg8::StaticOrder S; S.init(cfg::M, 512, G, bx);
              pg8::EpiKN E{W, l};
              pg8::gemm_phase<pg8::EpiKN, pg8::StaticOrder, true, true>(lds, g, S, E); }
            if (PH_MASK & 1024) { LAUNDER_W(); unsigned char* wl = W + ws::WBASE + (size_t)l * ws::WLAYER;
              pg8::Gemm g{(const bf16_t*)(wl + ws::W_KV) + 512 * 128, (const bf16_t*)(W + ws::CKV), 512, cfg::M, 128}; pg8::StaticOrder S; S.init(512, cfg::M, G, bx);
              pg8::EpiVT E{W, l};
              pg8::gemm_phase<pg8::EpiVT, pg8::StaticOrder, true, true>(lds, g, S, E); }
        }
        SEAM(pb + 3);
#endif
        if ((PH_MASK & 96) && IN(pb + 4)) {
            LOCAL_TID(); LAUNDER_W(); const float* sp = (const float*)(W + ws::SMALLP) + l * 4096;
            const int x0 = (int)__builtin_amdgcn_readfirstlane((int)(xb_xcc_id() & 7u));
            for (int xs = 0; xs < 8; ++xs) {
                const int x = (x0 + xs) & 7;
                gu32* head = (gu32*)(W + ws::CTL) + ws::CW_QUEUE + (l * 8 + x) * 64 + 0 * 32;
                bool have = false; unsigned kp = 0u;
                for (;;) {
                    if (tid == 0) MISC[0] = have ? kp : __hip_atomic_fetch_add(head, 1u, __ATOMIC_RELAXED, __HIP_MEMORY_SCOPE_AGENT);
                    __syncthreads();
                    const int k = (int)MISC[0] + 0;
                    __syncthreads();
                    have = false;
                    if (k >= 200) break;
                    if (k < 8) { if (PH_MASK & 64) { const int u = x * 8 + k; mls::mlstm_unit(lds, u >> 2, u & 3, (const bf16_t*)(W + ws::QM), (const bf16_t*)(W + ws::KM), (const bf16_t*)(W + ws::VM), (const bf16_t*)(W + ws::OG),
                                                  (const float*)(W + ws::IFG), sp, sp + 2048, (bf16_t*)(W + ws::Y)); } }
                    else if (PH_MASK & 32) { const int a = k - 8; const int bhq = x * 16 + ((a < 64) ? (a & 15) : ((a - 64) & 15)); const int qa = (a < 64) ? (a >> 4) : 11 - ((a - 64) >> 4), qb2 = (a < 64) ? 15 - (a >> 4) : -1; att::attn_unit(lds, bhq, qa, qb2, (const bf16_t*)(W + ws::Q), (const bf16_t*)(W + ws::KF), (const bf16_t*)(W + ws::VT), (bf16_t*)(W + ws::Y), head, kp); have = true; }
                }
            }
        }
        SEAM(pb + 4);
#if PROBE_DOUBLE == 5
        if ((PH_MASK & 96) && IN(pb + 4)) {
            LOCAL_TID(); LAUNDER_W(); const float* sp = (const float*)(W + ws::SMALLP) + l * 4096;
            const int x0 = (int)__builtin_amdgcn_readfirstlane((int)(xb_xcc_id() & 7u));
            for (int xs = 0; xs < 8; ++xs) {
                const int x = (x0 + xs) & 7;
                gu32* head = (gu32*)(W + ws::CTL) + ws::CW_QUEUE + (l * 8 + x) * 64 + 1 * 32;
                for (;;) {
                    if (tid == 0) MISC[0] = __hip_atomic_fetch_add(head, 1u, __ATOMIC_RELAXED, __HIP_MEMORY_SCOPE_AGENT);
                    __syncthreads();
                    const int k = (int)MISC[0] + 0;
                    __syncthreads();
                    if (k >= 200) break;
                    if (k < 8) { if (PH_MASK & 64) { const int u = x * 8 + k; mls::mlstm_unit(lds, u >> 2, u & 3, (const bf16_t*)(W + ws::QM), (const bf16_t*)(W + ws::KM), (const bf16_t*)(W + ws::VM), (const bf16_t*)(W + ws::OG),
                                                  (const float*)(W + ws::IFG), sp, sp + 2048, (bf16_t*)(W + ws::Y)); } }
                    else if (PH_MASK & 32) { const int a = k - 8; const int bhq = x * 16 + ((a < 64) ? (a & 15) : ((a - 64) & 15)); const int qa = (a < 64) ? (a >> 4) : 11 - ((a - 64) >> 4), qb2 = (a < 64) ? 15 - (a >> 4) : -1; { unsigned kd_ = 0u; att::attn_unit(lds, bhq, qa, qb2, (const bf16_t*)(W + ws::Q), (const bf16_t*)(W + ws::KF), (const bf16_t*)(W + ws::VT), (bf16_t*)(W + ws::Y), head, kd_); } }
                }
            }
        }
        SEAM(pb + 4);
#endif
#if PROBE_DOUBLE == 7
        if ((PH_MASK & 96) && IN(pb + 4)) {
            LOCAL_TID(); LAUNDER_W(); const float* sp = (const float*)(W + ws::SMALLP) + l * 4096;
            const int x0 = (int)__builtin_amdgcn_readfirstlane((int)(xb_xcc_id() & 7u));
            for (int xs = 0; xs < 8; ++xs) {
                const int x = (x0 + xs) & 7;
                gu32* head = (gu32*)(W + ws::CTL) + ws::CW_QUEUE + (l * 8 + x) * 64 + 1 * 32;
                for (;;) {
                    if (tid == 0) MISC[0] = __hip_atomic_fetch_add(head, 1u, __ATOMIC_RELAXED, __HIP_MEMORY_SCOPE_AGENT);
                    __syncthreads();
                    const int k = (int)MISC[0] + 0;
                    __syncthreads();
                    if (k >= 8) break;
                    if (k < 8) { if (PH_MASK & 64) { const int u = x * 8 + k; mls::mlstm_unit(lds, u >> 2, u & 3, (const bf16_t*)(W + ws::QM), (const bf16_t*)(W + ws::KM), (const bf16_t*)(W + ws::VM), (const bf16_t*)(W + ws::OG),
                                                  (const float*)(W + ws::IFG), sp, sp + 2048, (bf16_t*)(W + ws::Y)); } }
                    else if (PH_MASK & 32) { const int a = k - 8; const int bhq = x * 16 + ((a < 64) ? (a & 15) : ((a - 64) & 15)); const int qa = (a < 64) ? (a >> 4) : 11 - ((a - 64) >> 4), qb2 = (a < 64) ? 15 - (a >> 4) : -1; { unsigned kd_ = 0u; att::attn_unit(lds, bhq, qa, qb2, (const bf16_t*)(W + ws::Q), (const bf16_t*)(W + ws::KF), (const bf16_t*)(W + ws::VT), (bf16_t*)(W + ws::Y), head, kd_); } }
                }
            }
        }
        SEAM(pb + 4);
#endif
#if PROBE_DOUBLE == 8
        if ((PH_MASK & 96) && IN(pb + 4)) {
            LOCAL_TID(); LAUNDER_W(); const float* sp = (const float*)(W + ws::SMALLP) + l * 4096;
            const int x0 = (int)__builtin_amdgcn_readfirstlane((int)(xb_xcc_id() & 7u));
            for (int xs = 0; xs < 8; ++xs) {
                const int x = (x0 + xs) & 7;
                gu32* head = (gu32*)(W + ws::CTL) + ws::CW_QUEUE + (l * 8 + x) * 64 + 1 * 32;
                for (;;) {
                    if (tid == 0) MISC[0] = __hip_atomic_fetch_add(head, 1u, __ATOMIC_RELAXED, __HIP_MEMORY_SCOPE_AGENT);
                    __syncthreads();
                    const int k = (int)MISC[0] + 8;
                    __syncthreads();
                    if (k >= 200) break;
                    if (k < 8) { if (PH_MASK & 64) { const int u = x * 8 + k; mls::mlstm_unit(lds, u >> 2, u & 3, (const bf16_t*)(W + ws::QM), (const bf16_t*)(W + ws::KM), (const bf16_t*)(W + ws::VM), (const bf16_t*)(W + ws::OG),
                                                  (const float*)(W + ws::IFG), sp, sp + 2048, (bf16_t*)(W + ws::Y)); } }
                    else if (PH_MASK & 32) { const int a = k - 8; const int bhq = x * 16 + ((a < 64) ? (a & 15) : ((a - 64) & 15)); const int qa = (a < 64) ? (a >> 4) : 11 - ((a - 64) >> 4), qb2 = (a < 64) ? 15 - (a >> 4) : -1; { unsigned kd_ = 0u; att::attn_unit(lds, bhq, qa, qb2, (const bf16_t*)(W + ws::Q), (const bf16_t*)(W + ws::KF), (const bf16_t*)(W + ws::VT), (bf16_t*)(W + ws::Y), head, kd_); } }
                }
            }
        }
        SEAM(pb + 4);
#endif
        if ((PH_MASK & 128) && IN(pb + 5)) {
            LAUNDER_W(); unsigned char* wl = W + ws::WBASE + (size_t)l * ws::WLAYER;
            pg8::Gemm g{(const bf16_t*)(W + ws::Y), (const bf16_t*)(wl + ws::W_O), cfg::M, cfg::D, cfg::D}; pg8::StaticOrder S; S.init(cfg::M, cfg::D, G, bx);
            pg8::EpiResid E{W, 3 * l + 2, 1.0f};
            pg8::gemm_phase<pg8::EpiResid, pg8::StaticOrder, true, true>(lds, g, S, E);
        }
        SEAM(pb + 5);
#if PROBE_DOUBLE == 6
        if ((PH_MASK & 128) && IN(pb + 5)) {
            LAUNDER_W(); unsigned char* wl = W + ws::WBASE + (size_t)l * ws::WLAYER;
            pg8::Gemm g{(const bf16_t*)(W + ws::Y), (const bf16_t*)(wl + ws::W_O), cfg::M, cfg::D, cfg::D}; pg8::StaticOrder S; S.init(cfg::M, cfg::D, G, bx);
            pg8::EpiResid E{W, 3 * l + 2, 0.0f};
            pg8::gemm_phase<pg8::EpiResid, pg8::StaticOrder, true, true>(lds, g, S, E);
        }
        SEAM(pb + 5);
#endif
        if ((PH_MASK & 2) && IN(pb + 6)) {
            LAUNDER_W(); unsigned char* wl = W + ws::WBASE + (size_t)l * ws::WLAYER;
            pg8::Gemm g{(const bf16_t*)(W + ws::XB), (const bf16_t*)(wl + ws::W_GU2), cfg::M, 2 * cfg::FF, cfg::D}; pg8::StaticOrder S; S.init(cfg::M, 2 * cfg::FF, G, bx);
            const int gid0_ = pg8::rstd_table((LAS float*)(lds + RSTAB_OFF), S, pg8::ssqx_buf(W, 3 * l + 2), (int)threadIdx.x);
            pg8::EpiSwiGLU E{W, 3 * l + 2, (const LAS float*)(lds + RSTAB_OFF), gid0_};
            pg8::gemm_phase<pg8::EpiSwiGLU, pg8::StaticOrder, true, true>(lds, g, S, E);
        }
        SEAM(pb + 6);
        if ((PH_MASK & 4) && IN(pb + 7)) {
            LAUNDER_W(); unsigned char* wl = W + ws::WBASE + (size_t)l * ws::WLAYER;
            pg8::Gemm g{(const bf16_t*)(W + ws::H), (const bf16_t*)(wl + ws::W_D2), cfg::M, cfg::D, cfg::FF}; pg8::StaticOrderRev S; S.init(cfg::M, cfg::D, G, bx);
            pg8::EpiResid E{W, 3 * l + 3, 0.5f};
            pg8::gemm_phase<pg8::EpiResid, pg8::StaticOrderRev, true, true>(lds, g, S, E);
        }
        SEAM(pb + 7);
        }
    if ((PH_MASK & 256) && IN(33)) {
        LOCAL_TID(); LAUNDER_W(); const float* ssq = (const float*)(W + ws::SSQX);   const f32x4* gp = (const f32x4*)P.in[23] + 4 * lane;
        f32x4 gv[4];
#pragma unroll
        for (int j = 0; j < 4; ++j) gv[j] = gp[j];
        for (int m = gw; m < cfg::M; m += NGW) {
            const float rs = __builtin_amdgcn_rsqf(wave_sum((lane < 16) ? ssq[(size_t)m * 16 + lane] : 0.f, lane) * (1.f / cfg::D) + cfg::EPS);
            const u32x4* xr = (const u32x4*)((const bf16_t*)(W + ws::XB) + (size_t)m * cfg::D) + 2 * lane; f32x4* orow = (f32x4*)(P.out + (size_t)m * cfg::D) + 4 * lane;
            const u32x4 b0 = xr[0], b1 = xr[1];
            orow[0] = (f32x4){bflo(b0.x), bfhi(b0.x), bflo(b0.y), bfhi(b0.y)} * rs * gv[0]; orow[1] = (f32x4){bflo(b0.z), bfhi(b0.z), bflo(b0.w), bfhi(b0.w)} * rs * gv[1];
            orow[2] = (f32x4){bflo(b1.x), bfhi(b1.x), bflo(b1.y), bfhi(b1.y)} * rs * gv[2]; orow[3] = (f32x4){bflo(b1.z), bfhi(b1.z), bflo(b1.w), bfhi(b1.w)} * rs * gv[3];
        }
    }
#if PROBE_DOUBLE == 10
    SEAM(33);
    if ((PH_MASK & 256) && IN(33)) {
        LOCAL_TID(); LAUNDER_W(); const float* ssq = (const float*)(W + ws::SSQX);   const f32x4* gp = (const f32x4*)P.in[23] + lane;
        f32x4 gv[4];
#pragma unroll
        for (int j = 0; j < 4; ++j) gv[j] = gp[64 * j];
        for (int m = gw; m < cfg::M; m += NGW) {
            const float rs = __builtin_amdgcn_rsqf(wave_sum((lane < 16) ? ssq[(size_t)m * 16 + lane] : 0.f, lane) * (1.f / cfg::D) + cfg::EPS);
            const u32x2* xr = (const u32x2*)((const bf16_t*)(W + ws::XB) + (size_t)m * cfg::D) + lane; f32x4* orow = (f32x4*)(P.out + (size_t)m * cfg::D) + lane;
#pragma unroll
            for (int j = 0; j < 4; ++j) { const u32x2 b = xr[64 * j]; f32x4 v; v[0] = bflo(b.x); v[1] = bfhi(b.x); v[2] = bflo(b.y); v[3] = bfhi(b.y); orow[64 * j] = v * rs * gv[j]; }
        }
    }
#endif
#undef IN
#undef SEAM
}

extern "C" void kernel_launch(void* const* d_in, const int* in_sizes, int n_in, void* d_out, int out_size, void* d_ws, size_t ws_size, hipStream_t stream) {
    static int grid = 0;
    if (grid == 0) {
        if (n_in != 24 || in_sizes[0] != cfg::M * cfg::D || out_size != cfg::M * cfg::D || ws_size < ws::END) { fprintf(stderr, "kernel_launch: unexpected shapes / workspace (n_in %d, ws %zu)\n", n_in, ws_size); grid = -1; return; }
        int dev = 0, cus = 0, per_cu = 0;
        if (hipGetDevice(&dev) != hipSuccess || hipDeviceGetAttribute(&cus, hipDeviceAttributeMultiprocessorCount, dev) != hipSuccess) { grid = -1; return; }
        if (hipFuncSetAttribute((const void*)hymba_fwd, hipFuncAttributeMaxDynamicSharedMemorySize, LDS_BYTES) != hipSuccess) { fprintf(stderr, "kernel_launch: hipFuncSetAttribute failed\n"); grid = -1; return; }
        if (hipOccupancyMaxActiveBlocksPerMultiprocessor(&per_cu, (const void*)hymba_fwd, 512, LDS_BYTES) != hipSuccess || per_cu < 1) fprintf(stderr, "kernel_launch: occupancy query reports %d\n", per_cu);
        (void)hipGetLastError();
        if (cus < 256) { fprintf(stderr, "kernel_launch: built for a 256-CU device (MI355X); found %d CUs; nothing launched\n", cus); grid = -1; return; }
        grid = 256;
    }
    if (grid < 0) return;
    (void)hipMemsetAsync((char*)d_ws + ws::CTL, 0, ws::ZERO_BYTES, stream);
    Params p{};
    for (int i = 0; i < 24; ++i) p.in[i] = (const float*)d_in[i];
    p.out = (float*)d_out; p.ws = (unsigned char*)d_ws; p.pad = 0;
#if MK_PER_PHASE
#ifdef BISECT_MASK
    { static bool once = false; if (!once) { once = true; (void)hipFuncSetAttribute((const void*)hymba_fwd_loop, hipFuncAttributeMaxDynamicSharedMemorySize, LDS_BYTES); } }
    for (int ph = 0; ph < NPHASE; ++ph) { p.ph_lo = ph; p.ph_hi = ph + 1; p.li = 0; const int t = (ph == 0) ? 0 : (ph == 33) ? 9 : 1 + ((ph - 1) & 7);
        if ((BISECT_MASK >> t) & 1) hipLaunchKernelGGL(hymba_fwd, dim3(grid), dim3(512), LDS_BYTES, stream, p); else hipLaunchKernelGGL(hymba_fwd_loop, dim3(grid), dim3(512), LDS_BYTES, stream, p); }
#else
    for (int ph = 0; ph < NPHASE; ++ph) { p.ph_lo = ph; p.ph_hi = ph + 1; p.li = 0; hipLaunchKernelGGL(hymba_fwd, dim3(grid), dim3(512), LDS_BYTES, stream, p); }
#endif
#else
    p.ph_lo = 0; p.ph_hi = NPHASE; p.li = 0;
    hipLaunchKernelGGL(hymba_fwd, dim3(grid), dim3(512), LDS_BYTES, stream, p);
#endif
}
```
